# Optimizing an MI355X kernel written in HIP

```python
import jax, jax.numpy as jnp
from jax import lax
import numpy as np

D_MODEL = 1024
BATCH = 4
SEQ = 4096
DEPTH = 2
DEC_BATCH = 16
DEC_SEQ = 2048
PAST_LEN = 128

GRID_W = 64
D_FF = 2816
N_MOD = 9
LRU_W = 384
LRU_BLOCKS = 6
LRU_BS = LRU_W // LRU_BLOCKS
LRU_C = 8.0
CONV_W = 4
RWKV_HEADS = 4
RWKV_HD = 64
RWKV_W = RWKV_HEADS * RWKV_HD
W_LORA = 64
A_LORA = 64
G_LORA = 128
RWKV_IN = 3 * RWKV_W + W_LORA + A_LORA + G_LORA
ATT_HEADS = 6
ATT_KV = 2
ATT_G = ATT_HEADS // ATT_KV
ATT_HD = 64
ATT_Q = ATT_HEADS * ATT_HD
ATT_KVW = ATT_KV * ATT_HD
Q_BLOCK = 128
ROPE_THETA = 10000.0
ROPE_PAIRS = ATT_HD // 4
D_MIX = LRU_W + RWKV_W + ATT_Q
D_IN = 2 * LRU_W + RWKV_IN + ATT_Q + 2 * ATT_KVW
NORM_EPS = 1e-6
GN_EPS = 64e-5

kernel_name = "hybrid_bidir_hymba_encoder"


def rmsnorm(x, g):
    xf = x.astype(jnp.float32)
    y = xf * lax.rsqrt(jnp.mean(xf * xf, axis=-1, keepdims=True) + NORM_EPS)
    return (y * g.astype(jnp.float32)).astype(x.dtype)


def head_rms(x, g):
    xf = x.astype(jnp.float32)
    return xf * lax.rsqrt(jnp.mean(xf * xf, axis=-1, keepdims=True) + NORM_EPS) * g.astype(jnp.float32)


def swiglu(h, w_in, w_out):
    gate, up = jnp.split(h @ w_in, 2, axis=-1)
    return (jax.nn.silu(gate) * up) @ w_out


def rope_tables(seq):
    n_rows = seq // GRID_W
    row = jnp.repeat(jnp.arange(n_rows, dtype=jnp.float32), GRID_W)
    col = jnp.tile(jnp.arange(GRID_W, dtype=jnp.float32), n_rows)
    inv = ROPE_THETA ** (-jnp.arange(ROPE_PAIRS, dtype=jnp.float32) / ROPE_PAIRS)
    ang = jnp.stack([row[:, None] * inv, col[:, None] * inv], axis=1)
    return jnp.cos(ang), jnp.sin(ang)


def apply_rope2d(x, cos, sin):
    b, s, h, _ = x.shape
    xr = x.reshape(b, s, h, 2, 2, ROPE_PAIRS)
    x1, x2 = xr[..., 0, :], xr[..., 1, :]
    c = cos[None, :, None]
    sn = sin[None, :, None]
    out = jnp.stack([x1 * c - x2 * sn, x2 * c + x1 * sn], axis=-2)
    return out.reshape(b, s, h, ATT_HD)


def lru_combine(e1, e2):
    a1, b1 = e1
    a2, b2 = e2
    return a1 * a2, a2 * b1 + b2


def rglru_mixer(xb, yb, lp):
    b, s, _ = xb.shape
    xf = xb.astype(jnp.float32)
    left = CONV_W // 2
    xp = jnp.pad(xf, ((0, 0), (left, CONV_W - 1 - left), (0, 0)))
    w = lp["lru_conv_w"].astype(jnp.float32)
    xc = sum(xp[:, j:j + s] * w[j] for j in range(CONV_W)) + lp["lru_conv_b"].astype(jnp.float32)
    xblk = xc.reshape(b, s, LRU_BLOCKS, LRU_BS)
    h = jnp.zeros_like(xc)
    for d, rev in ((0, False), (1, True)):
        r = jax.nn.sigmoid(jnp.einsum("bsni,nij->bsnj", xblk, lp["lru_w_gate_a"][d].astype(jnp.float32)).reshape(b, s, LRU_W) + lp["lru_b_gate_a"][d])
        i = jax.nn.sigmoid(jnp.einsum("bsni,nij->bsnj", xblk, lp["lru_w_gate_x"][d].astype(jnp.float32)).reshape(b, s, LRU_W) + lp["lru_b_gate_x"][d])
        log_a = -LRU_C * r * jax.nn.softplus(-lp["lru_lambda"][d].astype(jnp.float32))
        a = jnp.exp(log_a)
        u = jnp.sqrt(-jnp.expm1(2.0 * log_a)) * (i * xc)
        _, hd = lax.associative_scan(lru_combine, (a, u), reverse=rev, axis=1)
        h = h + hd
    return h * jax.nn.gelu(yb.astype(jnp.float32))


def rwkv_scan(r, w, k, v, kk, bb, reverse):
    b, _, h, n = r.shape
    xs = tuple(jnp.moveaxis(t, 1, 0) for t in (r, w, k, v, kk, bb))

    def step(st, inp):
        r_t, w_t, k_t, v_t, kk_t, b_t = inp
        sa = jnp.einsum("bhvk,bhk->bhv", st, -kk_t)
        st = st * w_t[:, :, None, :] + sa[..., None] * b_t[:, :, None, :] + v_t[..., None] * k_t[:, :, None, :]
        y = jnp.einsum("bhvk,bhk->bhv", st, r_t)
        return st, y

    st0 = jnp.zeros((b, h, n, n), jnp.float32)
    _, y = lax.scan(step, st0, xs, reverse=reverse)
    return jnp.moveaxis(y, 0, 1)


def rwkv_mixer(zr, lp):
    b, s, _ = zr.shape
    f = zr.astype(jnp.float32)
    prev = jnp.pad(f[:, :-1], ((0, 0), (1, 0), (0, 0)))
    nxt = jnp.pad(f[:, 1:], ((0, 0), (0, 1), (0, 0)))
    f = f + lp["rwkv_mu"].astype(jnp.float32) * (0.5 * (prev + nxt) - f)
    r, k, v, xw, xa, xg = jnp.split(f, [RWKV_W, 2 * RWKV_W, 3 * RWKV_W, 3 * RWKV_W + W_LORA, 3 * RWKV_W + W_LORA + A_LORA], axis=-1)

    def hd(t):
        return t.reshape(b, s, RWKV_HEADS, RWKV_HD)

    g = jax.nn.sigmoid(xg) @ lp["rwkv_g_up"].astype(jnp.float32)
    kk = hd(k * lp["rwkv_k_k"].astype(jnp.float32))
    kk = kk / jnp.maximum(jnp.sqrt(jnp.sum(kk * kk, axis=-1, keepdims=True)), 1e-12)
    a_lora = xa @ lp["rwkv_a_up"].astype(jnp.float32)
    w_lora = jnp.tanh(xw)
    k_a = lp["rwkv_k_a"].astype(jnp.float32)
    y = jnp.zeros((b, s, RWKV_HEADS, RWKV_HD), jnp.float32)
    for d, rev in ((0, False), (1, True)):
        u = lp["rwkv_w0"][d].astype(jnp.float32) + w_lora @ lp["rwkv_w_up"][d].astype(jnp.float32)
        w = jnp.exp(-jnp.exp(-jax.nn.softplus(-u) - 0.5))
        a = jax.nn.sigmoid(lp["rwkv_a0"][d].astype(jnp.float32) + a_lora)
        kd = k * (1.0 + (a - 1.0) * k_a)
        y = y + rwkv_scan(hd(r), hd(w), hd(kd), hd(v), kk, kk * hd(a), rev)
    mu = jnp.mean(y, axis=-1, keepdims=True)
    var = jnp.mean(jnp.square(y - mu), axis=-1, keepdims=True)
    yn = ((y - mu) * lax.rsqrt(var + GN_EPS)).reshape(b, s, RWKV_W)
    yn = yn * lp["rwkv_ln_g"].astype(jnp.float32) + lp["rwkv_ln_b"].astype(jnp.float32)
    bonus = (jnp.sum(hd(r) * hd(k) * lp["rwkv_r_k"].astype(jnp.float32), axis=-1, keepdims=True) * hd(v)).reshape(b, s, RWKV_W)
    return (yn + bonus) * g


def attention(q, k, v, q_g, k_g, rope):
    b, s, _ = q.shape
    cos, sin = rope
    q = apply_rope2d(head_rms(q.reshape(b, s, ATT_HEADS, ATT_HD), q_g), cos, sin)
    k = apply_rope2d(head_rms(k.reshape(b, s, ATT_KV, ATT_HD), k_g), cos, sin)
    v = v.astype(jnp.float32).reshape(b, s, ATT_KV, ATT_HD)
    nblk = s // Q_BLOCK
    qb = jnp.moveaxis(q.reshape(b, nblk, Q_BLOCK, ATT_KV, ATT_G, ATT_HD), 1, 0)
    scale = ATT_HD ** -0.5

    def block(qi):
        sc = jnp.einsum("bqkgd,bskd->bkgqs", qi, k) * scale
        p = jax.nn.softmax(sc, axis=-1)
        return jnp.einsum("bkgqs,bskd->bqkgd", p, v)

    o = lax.map(block, qb)
    return jnp.moveaxis(o, 0, 1).reshape(b, s, ATT_Q)


def mixer(h, lp, rope):
    z = h @ lp["w_mix_in"]
    o1 = 2 * LRU_W + RWKV_IN
    xb, yb, zr, q, k, v = jnp.split(z, [LRU_W, 2 * LRU_W, o1, o1 + ATT_Q, o1 + ATT_Q + ATT_KVW], axis=-1)
    o_lru = rglru_mixer(xb, yb, lp)
    o_rwkv = rwkv_mixer(zr, lp)
    o_att = attention(q, k, v, lp["attn_q_norm"], lp["attn_k_norm"], rope)
    o = jnp.concatenate([o_lru, o_rwkv, o_att], axis=-1).astype(h.dtype)
    return o @ lp["w_mix_out"]


def layer(x, c, lp, rope):
    mod = (jax.nn.silu(c) @ lp["w_ada"] + lp["b_ada"])[:, None, :]
    sh1, sc1, g1, sh2, sc2, g2, sh3, sc3, g3 = jnp.split(mod, N_MOD, axis=-1)
    h = rmsnorm(x, lp["norm_g"][0]) * (1 + sc1) + sh1
    x = x + 0.5 * g1 * swiglu(h, lp["ffn_w_in"][0], lp["ffn_w_out"][0])
    h = rmsnorm(x, lp["norm_g"][1]) * (1 + sc2) + sh2
    x = x + g2 * mixer(h, lp, rope)
    h = rmsnorm(x, lp["norm_g"][2]) * (1 + sc3) + sh3
    x = x + 0.5 * g3 * swiglu(h, lp["ffn_w_in"][1], lp["ffn_w_out"][1])
    return x


def trunk(x, c, params):
    rope = rope_tables(x.shape[1])
    for l in range(DEPTH):
        lp = {name: arr[l] for name, arr in params.items()}
        x = layer(x, c, lp, rope)
    return x


def setup_inputs(seed: int = 0) -> dict:
    key = jax.random.key(seed)
    ks = jax.random.split(key, 32)
    f32 = jnp.float32

    def nrm(k, shape, s):
        return jax.random.normal(k, shape, f32) * s

    u = jax.random.uniform(ks[13], (DEPTH, 2, LRU_W), f32, minval=0.9, maxval=0.999)
    a_lru = u ** (1.0 / LRU_C)
    return {
        "x_prompt": nrm(ks[0], (BATCH, SEQ, D_MODEL), 1.0),
        "x_sample": nrm(ks[1], (DEC_BATCH, DEC_SEQ, D_MODEL), 1.0),
        "c_prompt": nrm(ks[2], (BATCH, D_MODEL), 1.0),
        "c_sample": nrm(ks[3], (DEC_BATCH, D_MODEL), 1.0),
        "w_ada": nrm(ks[4], (DEPTH, D_MODEL, N_MOD * D_MODEL), 0.5 * D_MODEL ** -0.5),
        "b_ada": nrm(ks[5], (DEPTH, N_MOD * D_MODEL), 0.02),
        "norm_g": 1.0 + nrm(ks[6], (DEPTH, 3, D_MODEL), 0.02),
        "ffn_w_in": nrm(ks[7], (DEPTH, 2, D_MODEL, 2 * D_FF), D_MODEL ** -0.5),
        "ffn_w_out": nrm(ks[8], (DEPTH, 2, D_FF, D_MODEL), D_FF ** -0.5),
        "w_mix_in": nrm(ks[9], (DEPTH, D_MODEL, D_IN), D_MODEL ** -0.5),
        "w_mix_out": nrm(ks[10], (DEPTH, D_MIX, D_MODEL), D_MIX ** -0.5),
        "lru_conv_w": nrm(ks[11], (DEPTH, CONV_W, LRU_W), CONV_W ** -0.5),
        "lru_conv_b": nrm(ks[12], (DEPTH, LRU_W), 0.02),
        "lru_w_gate_a": nrm(ks[14], (DEPTH, 2, LRU_BLOCKS, LRU_BS, LRU_BS), LRU_BS ** -0.5),
        "lru_b_gate_a": nrm(ks[15], (DEPTH, 2, LRU_W), 0.02),
        "lru_w_gate_x": nrm(ks[16], (DEPTH, 2, LRU_BLOCKS, LRU_BS, LRU_BS), LRU_BS ** -0.5),
        "lru_b_gate_x": nrm(ks[17], (DEPTH, 2, LRU_W), 0.02),
        "lru_lambda": jnp.log(a_lru) - jnp.log1p(-a_lru),
        "rwkv_mu": jax.random.uniform(ks[18], (DEPTH, RWKV_IN), f32),
        "rwkv_w_up": nrm(ks[19], (DEPTH, 2, W_LORA, RWKV_W), 0.1),
        "rwkv_w0": jax.random.uniform(ks[20], (DEPTH, 2, RWKV_W), f32, minval=-6.0, maxval=1.0),
        "rwkv_a_up": nrm(ks[21], (DEPTH, A_LORA, RWKV_W), 0.1),
        "rwkv_a0": nrm(ks[22], (DEPTH, 2, RWKV_W), 0.5),
        "rwkv_g_up": nrm(ks[23], (DEPTH, G_LORA, RWKV_W), G_LORA ** -0.5),
        "rwkv_k_k": 0.85 + nrm(ks[24], (DEPTH, RWKV_W), 0.05),
        "rwkv_k_a": 1.0 + nrm(ks[25], (DEPTH, RWKV_W), 0.05),
        "rwkv_r_k": nrm(ks[26], (DEPTH, RWKV_HEADS, RWKV_HD), 0.1),
        "rwkv_ln_g": 1.0 + nrm(ks[27], (DEPTH, RWKV_W), 0.02),
        "rwkv_ln_b": nrm(ks[28], (DEPTH, RWKV_W), 0.02),
        "attn_q_norm": 1.0 + nrm(ks[29], (DEPTH, ATT_HD), 0.02),
        "attn_k_norm": 1.0 + nrm(ks[30], (DEPTH, ATT_HD), 0.02),
    }


def reference(x_prompt, x_sample, c_prompt, c_sample, w_ada, b_ada, norm_g, ffn_w_in, ffn_w_out, w_mix_in, w_mix_out, lru_conv_w, lru_conv_b, lru_w_gate_a, lru_b_gate_a, lru_w_gate_x, lru_b_gate_x, lru_lambda, rwkv_mu, rwkv_w_up, rwkv_w0, rwkv_a_up, rwkv_a0, rwkv_g_up, rwkv_k_k, rwkv_k_a, rwkv_r_k, rwkv_ln_g, rwkv_ln_b, attn_q_norm, attn_k_norm):
    params = {
        "w_ada": w_ada, "b_ada": b_ada, "norm_g": norm_g,
        "ffn_w_in": ffn_w_in, "ffn_w_out": ffn_w_out,
        "w_mix_in": w_mix_in, "w_mix_out": w_mix_out,
        "lru_conv_w": lru_conv_w, "lru_conv_b": lru_conv_b,
        "lru_w_gate_a": lru_w_gate_a, "lru_b_gate_a": lru_b_gate_a,
        "lru_w_gate_x": lru_w_gate_x, "lru_b_gate_x": lru_b_gate_x, "lru_lambda": lru_lambda,
        "rwkv_mu": rwkv_mu, "rwkv_w_up": rwkv_w_up, "rwkv_w0": rwkv_w0,
        "rwkv_a_up": rwkv_a_up, "rwkv_a0": rwkv_a0, "rwkv_g_up": rwkv_g_up,
        "rwkv_k_k": rwkv_k_k, "rwkv_k_a": rwkv_k_a, "rwkv_r_k": rwkv_r_k,
        "rwkv_ln_g": rwkv_ln_g, "rwkv_ln_b": rwkv_ln_b,
        "attn_q_norm": attn_q_norm, "attn_k_norm": attn_k_norm,
    }
    y_prompt = trunk(x_prompt, c_prompt, params)
    y_sample = trunk(x_sample, c_sample, params)
    return (y_prompt, y_sample)
```

```cpp
#include <hip/hip_runtime.h>
#include <hip/hip_cooperative_groups.h>
#include <cstdio>
#include <cstdint>
namespace cg = cooperative_groups;
namespace pg8 {
#define PG8_LAS __attribute__((address_space(3)))
typedef unsigned short bf16_t;
typedef short bf16x8 __attribute__((ext_vector_type(8)));
typedef float f32x4 __attribute__((ext_vector_type(4)));
typedef unsigned u32x4 __attribute__((ext_vector_type(4)));
constexpr int BM = 256, BK = 64, HALF = 128, HTB = HALF * BK * 2  , STAGE_BYTES = 8 * HTB, NXCD = 8, WGM = 8;

__host__ __device__ __forceinline__ int lds_byte(int r, int c) { const int st = (r >> 4) * 2 + (c >> 5), rr = r & 15, cc = c & 31, ob = rr * 64 + cc * 2; return st * 1024 + (ob ^ (((ob >> 9) & 1) << 5)); }
__host__ __device__ __forceinline__ void stage_rc(int b, int& R, int& C) { const int st = b / 1024, sb = b % 1024, swz = sb ^ (((sb >> 9) & 1) << 5); R = (st >> 1) * 16 + swz / 64; C = (st & 1) * 32 + (swz % 64) / 2; }
__host__ __device__ __forceinline__ int perm32(int rho) { const int n = rho >> 4, i = rho & 15; return 8 * (i >> 2) + 4 * n + (i & 3); }

struct Unit { int pm, pn; };
struct Gemm { const bf16_t* A; const bf16_t* Bt; int M, N, K; };

struct StaticOrder {
    int nM, nN, nwg, G, c;
    __host__ __device__ void init(int M, int N, int G_, int c_) { nM = M / BM; nN = N / BM; nwg = nM * nN; G = G_; c = c_; }
    __host__ __device__ bool next(int i, Unit& u) const {
        const long L = (long)i * G + c; if (L >= nwg) return false;
        int wgid = (int)L; { const int q = nwg / NXCD, r = nwg % NXCD, xcd = wgid % NXCD, off = wgid / NXCD; wgid = (xcd < r ? xcd * (q + 1) : r * (q + 1) + (xcd - r) * q) + off; }
        const int nig = WGM * nN, gid = wgid / nig, fm = gid * WGM, gsz = (nM - fm) < WGM ? (nM - fm) : WGM;
        u.pm = fm + ((wgid % nig) % gsz); u.pn = (wgid % nig) / gsz; return true;
    }
    __device__ __forceinline__ void a_ready(const Unit&) const {}
    __device__ __forceinline__ void done(const Unit&) const {}
};

__device__ __forceinline__ unsigned cvt_pk_bf16(float lo, float hi) { unsigned r; asm volatile("v_cvt_pk_bf16_f32 %0, %1, %2" : "=v"(r) : "v"(lo), "v"(hi)); return r; }
typedef float f32x2 __attribute__((ext_vector_type(2)));
__device__ __forceinline__ f32x2 gelu_pk(f32x2 v) {
    const f32x2 av = __builtin_elementwise_abs(v), d = av * 0.2316418882f + 1.0f;
    f32x2 t; t.x = __builtin_amdgcn_rcpf(d.x); t.y = __builtin_amdgcn_rcpf(d.y);
    f32x2 q = t * 0.5307027145f + (-0.7265760135f); q = q * t + 0.7107068705f; q = q * t + (-0.142248368f); q = q * t + 0.127414796f; q = q * t;
    const f32x2 s = (v * v) * (-0.72134752044f);
    f32x2 e; e.x = __builtin_amdgcn_exp2f(s.x); e.y = __builtin_amdgcn_exp2f(s.y);
    const f32x2 m = v * (q * e), r = v - m;
    f32x2 o; o.x = v.x < 0.f ? m.x : r.x; o.y = v.y < 0.f ? m.y : r.y; return o;
}

template <int ACT  > struct EpiBf16 {
    static constexpr bool PERM = true, AFTER_DRAIN = false; static_assert(ACT == 0 || ACT == 1, "EpiBf16: ACT is 0 (none) or 1 (gelu_pk)");
    bf16_t* O; int ldc; const float* bias; int split_cols; size_t split_stride; float scale0;
    __device__ __forceinline__ void operator()(const f32x4 (&acc)[2][2][4][2], const Unit& u, int wr, int wc, int fr, int fq) const {
        const int row0 = u.pm * BM + wr * 64 + fr; int colt = u.pn * BM; bf16_t* base = O;
        float sc = 1.f; if (split_cols) { const int t = colt / split_cols; base += (size_t)t * split_stride; colt -= t * split_cols; if (t == 0) sc = scale0; }
        const int col0 = colt + wc * 32 + 8 * fq, bcol0 = u.pn * BM + wc * 32 + 8 * fq;
        f32x4 bv[2][2];
#pragma unroll
        for (int bj = 0; bj < 2; ++bj)
#pragma unroll
            for (int n = 0; n < 2; ++n) bv[bj][n] = bias ? *(const f32x4*)(bias + bcol0 + bj * HALF + 4 * n) : (f32x4){0.f, 0.f, 0.f, 0.f};
#pragma unroll
        for (int ai = 0; ai < 2; ++ai)
#pragma unroll
            for (int m = 0; m < 4; ++m) { bf16_t* rowp = base + (size_t)(row0 + ai * HALF + m * 16) * ldc + col0;
#pragma unroll
                for (int bj = 0; bj < 2; ++bj) { f32x4 v0 = acc[ai][bj][m][0] + bv[bj][0], v1 = acc[ai][bj][m][1] + bv[bj][1];
                    if (ACT == 1) { f32x2 a = gelu_pk((f32x2){v0[0], v0[1]}), b = gelu_pk((f32x2){v0[2], v0[3]}), c = gelu_pk((f32x2){v1[0], v1[1]}), d = gelu_pk((f32x2){v1[2], v1[3]});
                        v0 = (f32x4){a.x, a.y, b.x, b.y}; v1 = (f32x4){c.x, c.y, d.x, d.y}; }
                    v0 = v0 * sc; v1 = v1 * sc; u32x4 w; w.x = cvt_pk_bf16(v0[0], v0[1]); w.y = cvt_pk_bf16(v0[2], v0[3]); w.z = cvt_pk_bf16(v1[0], v1[1]); w.w = cvt_pk_bf16(v1[2], v1[3]);
                    *(u32x4*)(rowp + bj * HALF) = w; } }
    }
};
template <class Epi, class Sched, bool ALIGN_EPI = false, bool SP2 = false>
__device__ __forceinline__ void gemm_phase(PG8_LAS unsigned char* lds, const Gemm g, const Sched& S, const Epi& E) {
    int tid_o = threadIdx.x; asm volatile("" : "+v"(tid_o)); const int tid = tid_o, wid = __builtin_amdgcn_readfirstlane(tid >> 6), lane = tid & 63, wr = wid >> 2, wc = wid & 3, fr = lane & 15, fq = lane >> 4;
    const int K = g.K, nt = K / BK;
    unsigned voffA[2], voffB[2];
#pragma unroll
    for (int i = 0; i < 2; ++i) { int R, C; stage_rc(tid * 16 + i * 8192, R, C); const int Rb = Epi::PERM ? ((R & ~31) + perm32(R & 31)) : R;
        voffA[i] = (unsigned)(R * K + C) * 2u; voffB[i] = (unsigned)(Rb * K + C) * 2u; }
    const size_t kstep = (size_t)(BK * 2);
    const size_t hstep = (size_t)HALF * K * 2;
    const size_t tstep = 2 * hstep;
    const unsigned ldsw = (unsigned)wid * 1024u;
    const int aoff = lds_byte(wr * 64 + fr, fq * 8), boff = lds_byte(wc * 32 + fr, fq * 8);
#define PG8_SA(b, h) (((b) * 2 + (h)) * HTB)
#define PG8_SB(b, h) ((4 + (b) * 2 + (h)) * HTB)
#define PG8_STAGE(bufoff, gbase, voff) do { _Pragma("unroll") for (int _i = 0; _i < 2; ++_i) \
        __builtin_amdgcn_global_load_lds((const unsigned*)((const char*)(gbase) + (voff)[_i]), (PG8_LAS unsigned*)(lds + (bufoff) + ldsw + _i * 8192), 16, 0, 0); } while (0)
#define PG8_LDA(dst, b, h) do { _Pragma("unroll") for (int m = 0; m < 4; ++m) _Pragma("unroll") for (int k = 0; k < 2; ++k) dst[m][k] = *(const PG8_LAS bf16x8*)(lds + PG8_SA(b, h) + aoff + m * 2048 + k * 1024); } while (0)
#define PG8_LDB(dst, b, h) do { _Pragma("unroll") for (int n = 0; n < 2; ++n) _Pragma("unroll") for (int k = 0; k < 2; ++k) dst[n][k] = *(const PG8_LAS bf16x8*)(lds + PG8_SB(b, h) + boff + n * 2048 + k * 1024); } while (0)
#define PG8_MMA(ai, bj, At, Bt) do { __builtin_amdgcn_s_setprio(1); _Pragma("unroll") for (int m = 0; m < 4; ++m) _Pragma("unroll") for (int n = 0; n < 2; ++n) _Pragma("unroll") for (int k = 0; k < 2; ++k) \
        acc[ai][bj][m][n] = __builtin_amdgcn_mfma_f32_16x16x32_bf16(Bt[n][k], At[m][k], acc[ai][bj][m][n], 0, 0, 0); __builtin_amdgcn_s_setprio(0); } while (0)
#define PG8_WAIT_V(n) asm volatile("s_waitcnt vmcnt(" #n ")" ::: "memory")
#define PG8_WAIT_L(n) asm volatile("s_waitcnt lgkmcnt(" #n ")" ::: "memory")
#define PG8_BAR __builtin_amdgcn_s_barrier()
#define PG8_SCHED __builtin_amdgcn_sched_barrier(0)
    Unit cur, nxt; int ui = 0;
    if (!S.next(0, cur)) return;
    f32x4 acc[2][2][4][2];
#pragma unroll
    for (int a = 0; a < 2; ++a)
#pragma unroll
        for (int b = 0; b < 2; ++b)
#pragma unroll
            for (int m = 0; m < 4; ++m)
#pragma unroll
                for (int n = 0; n < 2; ++n) acc[a][b][m][n] = (f32x4){0.f, 0.f, 0.f, 0.f};
    bf16x8 At[4][2], B0[2][2], B1[2][2];
    const char* cA = (const char*)g.A + (size_t)cur.pm * tstep; const char* cB = (const char*)g.Bt + (size_t)cur.pn * tstep;
    S.a_ready(cur);
    if constexpr (SP2) {
        PG8_STAGE(PG8_SB(0, 0), cB, voffB); PG8_STAGE(PG8_SB(0, 1), cB + hstep, voffB); PG8_STAGE(PG8_SA(0, 0), cA, voffA); PG8_STAGE(PG8_SA(0, 1), cA + hstep, voffA);
        if (wr == 1) PG8_BAR;
        PG8_WAIT_V(2); PG8_BAR;
        PG8_STAGE(PG8_SB(1, 0), cB + kstep, voffB); PG8_STAGE(PG8_SA(1, 0), cA + kstep, voffA); PG8_STAGE(PG8_SB(1, 1), cB + hstep + kstep, voffB);
        PG8_WAIT_V(6); PG8_BAR;
    } else {
        PG8_STAGE(PG8_SB(0, 0), cB, voffB); PG8_STAGE(PG8_SA(0, 0), cA, voffA); PG8_STAGE(PG8_SB(0, 1), cB + hstep, voffB); PG8_STAGE(PG8_SA(0, 1), cA + hstep, voffA);
        if (wr == 1) PG8_BAR;
        PG8_WAIT_V(4); PG8_BAR;
        PG8_STAGE(PG8_SB(1, 0), cB + kstep, voffB); PG8_STAGE(PG8_SA(1, 0), cA + kstep, voffA); PG8_STAGE(PG8_SB(1, 1), cB + hstep + kstep, voffB);
        PG8_WAIT_V(6); PG8_BAR;
    }
    for (;;) {
        const bool has_next = S.next(ui + 1, nxt);
        const char* nA = has_next ? (const char*)g.A + (size_t)nxt.pm * tstep : cA; const char* nB = has_next ? (const char*)g.Bt + (size_t)nxt.pn * tstep : cB;
        for (int t = 0; t < nt; t += 2) {
            const bool last = (t == nt - 2);
            const char* a1 = cA + (size_t)(t + 1) * kstep;
            const char* a2 = last ? nA : cA + (size_t)(t + 2) * kstep; const char* b2 = last ? nB : cB + (size_t)(t + 2) * kstep;
            const char* a3 = a2 + kstep; const char* b3 = b2 + kstep;
            if (last && has_next) S.a_ready(nxt);
            if constexpr (SP2) {
            PG8_LDB(B0, 0, 0); PG8_LDB(B1, 0, 1); PG8_SCHED; PG8_LDA(At, 0, 0); PG8_STAGE(PG8_SA(1, 1), a1 + hstep, voffA);
            PG8_WAIT_V(8); PG8_WAIT_L(0); PG8_BAR; PG8_MMA(0, 0, At, B0); PG8_MMA(0, 1, At, B1); PG8_BAR; PG8_SCHED;
            PG8_LDA(At, 0, 1); PG8_STAGE(PG8_SB(0, 0), b2, voffB); PG8_STAGE(PG8_SB(0, 1), b2 + hstep, voffB); PG8_STAGE(PG8_SA(0, 0), a2, voffA);
            PG8_WAIT_V(8); PG8_WAIT_L(0); PG8_BAR; PG8_MMA(1, 0, At, B0); PG8_MMA(1, 1, At, B1); PG8_BAR; PG8_SCHED;
            PG8_LDB(B0, 1, 0); PG8_LDB(B1, 1, 1); PG8_SCHED; PG8_LDA(At, 1, 0); PG8_STAGE(PG8_SA(0, 1), a2 + hstep, voffA);
            PG8_WAIT_V(8); PG8_WAIT_L(0); PG8_BAR; PG8_MMA(0, 0, At, B0); PG8_MMA(0, 1, At, B1); PG8_BAR; PG8_SCHED;
            PG8_LDA(At, 1, 1); PG8_STAGE(PG8_SB(1, 0), b3, voffB); PG8_STAGE(PG8_SB(1, 1), b3 + hstep, voffB); PG8_STAGE(PG8_SA(1, 0), a3, voffA);
            PG8_WAIT_V(8); PG8_WAIT_L(0); PG8_BAR; PG8_MMA(1, 0, At, B0); PG8_MMA(1, 1, At, B1); PG8_BAR; PG8_SCHED;
            } else {
            PG8_LDB(B0, 0, 0); PG8_SCHED; PG8_LDA(At, 0, 0); PG8_STAGE(PG8_SA(1, 1), a1 + hstep, voffA);
            PG8_WAIT_L(8); PG8_BAR; PG8_WAIT_L(0); PG8_MMA(0, 0, At, B0); PG8_BAR; PG8_SCHED;
            PG8_LDB(B1, 0, 1); PG8_STAGE(PG8_SB(0, 0), b2, voffB);
            PG8_BAR; PG8_WAIT_L(0); PG8_MMA(0, 1, At, B1); PG8_BAR;
            PG8_LDA(At, 0, 1); PG8_STAGE(PG8_SA(0, 0), a2, voffA);
            PG8_BAR; PG8_WAIT_L(0); PG8_MMA(1, 0, At, B0); PG8_BAR; PG8_SCHED;
            PG8_STAGE(PG8_SB(0, 1), b2 + hstep, voffB);
            PG8_WAIT_V(6); PG8_BAR; PG8_MMA(1, 1, At, B1); PG8_BAR;
            PG8_LDB(B0, 1, 0); PG8_SCHED; PG8_LDA(At, 1, 0); PG8_STAGE(PG8_SA(0, 1), a2 + hstep, voffA);
            PG8_WAIT_L(8); PG8_BAR; PG8_WAIT_L(0); PG8_MMA(0, 0, At, B0); PG8_BAR; PG8_SCHED;
            PG8_LDB(B1, 1, 1); PG8_STAGE(PG8_SB(1, 0), b3, voffB);
            PG8_BAR; PG8_WAIT_L(0); PG8_MMA(0, 1, At, B1); PG8_BAR;
            PG8_LDA(At, 1, 1); PG8_STAGE(PG8_SA(1, 0), a3, voffA);
            PG8_BAR; PG8_WAIT_L(0); PG8_MMA(1, 0, At, B0); PG8_BAR; PG8_SCHED;
            PG8_STAGE(PG8_SB(1, 1), b3 + hstep, voffB);
            PG8_WAIT_V(6); PG8_BAR; PG8_MMA(1, 1, At, B1); PG8_BAR;
            }
        }
        if constexpr (ALIGN_EPI) { if (wr == 0) PG8_BAR; }
        if constexpr (!Epi::AFTER_DRAIN) { E(acc, cur, wr, wc, fr, fq); S.done(cur); }
        if (!has_next) break;
#pragma unroll
        for (int a = 0; a < 2; ++a)
#pragma unroll
            for (int b = 0; b < 2; ++b)
#pragma unroll
                for (int m = 0; m < 4; ++m)
#pragma unroll
                    for (int n = 0; n < 2; ++n) acc[a][b][m][n] = (f32x4){0.f, 0.f, 0.f, 0.f};
        cur = nxt; cA = nA; cB = nB; ++ui;
        if constexpr (ALIGN_EPI) { if (wr == 1) PG8_BAR; }
    }
    PG8_WAIT_V(0);
    if constexpr (!ALIGN_EPI) { if (wr == 0) PG8_BAR; }
    PG8_BAR;
    if constexpr (Epi::AFTER_DRAIN) { E.fused(acc, cur, wr, wc, fr, fq, lds, wid, lane); S.done(cur); }
#undef PG8_SA
#undef PG8_SB
#undef PG8_STAGE
#undef PG8_LDA
#undef PG8_LDB
#undef PG8_MMA
#undef PG8_WAIT_V
#undef PG8_WAIT_L
#undef PG8_BAR
#undef PG8_SCHED
}
}

#define LAS __attribute__((address_space(3)))
typedef unsigned short bf16;
typedef unsigned u32x4_t __attribute__((ext_vector_type(4)));
typedef unsigned u32x2_t __attribute__((ext_vector_type(2)));
typedef float f32x4_t __attribute__((ext_vector_type(4)));
typedef float f32x2_t __attribute__((ext_vector_type(2)));

constexpr int DM = 1024, MTOK = 49152, NSEQ = 20, DFF = 2816, NFF = 5632, NMIXP = 2560, NMIX = 2432, ZP = 1792;
constexpr int NTHR = 512;
constexpr float QSCALE = 0.125f * 1.4426950408889634f;
constexpr size_t MiB = 1u << 20;
constexpr size_t ZERO_BYTES = 8 * MiB;
constexpr size_t OFF_CTR = 0, OFF_ROPE = 32768, OFF_SS = 65536, OFF_MOD = 2 * MiB, OFF_BIAS = 4 * MiB, OFF_GV = 7 * MiB, OFF_GATE = 7 * MiB + 512 * 1024;
constexpr size_t OFF_W = 8 * MiB, W_LAYER = 40 * MiB;
constexpr size_t WO_IN = 0, WO_OUT = 22 * MiB, WO_MI = 33 * MiB, WO_MO = 38 * MiB;
constexpr size_t OFF_XN = 88 * MiB, OFF_YF = 88 * MiB, OFF_YB = 136 * MiB;
constexpr size_t OFF_HID = 184 * MiB, OFF_Z = 184 * MiB, OFF_QK = 352 * MiB, OFF_VR = 400 * MiB, OFF_OMIX = 412 * MiB, WS_END = 508 * MiB;
constexpr int LDS_BYTES = 147456, MISC_OFF = 131072;

struct KP { const float* in[31]; float* out; unsigned char* ws; };

__device__ __forceinline__ int seq_of_row(int m) { return m < 16384 ? (m >> 12) : 4 + ((m - 16384) >> 11); }
__device__ __forceinline__ int seq_start(int s) { return s < 4 ? s * 4096 : 16384 + (s - 4) * 2048; }
__device__ __forceinline__ int seq_len(int s) { return s < 4 ? 4096 : 2048; }
__device__ __forceinline__ unsigned f2bf(float f) { unsigned u = __builtin_bit_cast(unsigned, f); return (u + 0x7fffu + ((u >> 16) & 1u)) >> 16; }
__device__ __forceinline__ unsigned pk2(float lo, float hi) { return f2bf(lo) | (f2bf(hi) << 16); }
__device__ __forceinline__ float bf2f(unsigned short b) { return __builtin_bit_cast(float, (unsigned)b << 16); }
__device__ __forceinline__ float sigmoidf_(float x) { return 1.0f / (1.0f + __expf(-x)); }
__device__ __forceinline__ float wave_sum(float v) {
#pragma unroll
    for (int o = 1; o < 64; o <<= 1) v += __shfl_xor(v, o);
    return v;
}
__host__ __device__ __forceinline__ int map_ffn(int n) { const int half = n >= DFF ? 1 : 0; const int n2 = half ? n - DFF : n; return 256 * (n2 >> 7) + 128 * half + (n2 & 127); }
__host__ __device__ __forceinline__ int map_mix(int n) {
    if (n < 1792 || n >= 2304) return n;
    const int hh = (n - 1792) >> 6, d = (n - 1792) & 63;
    return 256 * (7 + (hh >> 2)) + 128 * (d >> 5) + 32 * (hh & 3) + 8 * ((d & 15) >> 2) + 4 * ((d >> 4) & 1) + (d & 3);
}

namespace pg8 {
struct EpiSwiglu {
    static constexpr bool PERM = true, AFTER_DRAIN = false;
    bf16_t* H; const float* ss; const float* bias;
    __device__ __forceinline__ void operator()(const f32x4 (&acc)[2][2][4][2], const Unit& u, int wr, int wc, int fr, int fq) const {
        const int row0 = u.pm * BM + wr * 64 + fr; const int s = seq_of_row(u.pm * BM);
        const float* bp = bias + (size_t)s * NFF + u.pn * 256 + wc * 32 + 8 * fq;
        f32x4 bg[2], bu[2];
#pragma unroll
        for (int n = 0; n < 2; ++n) { bg[n] = *(const f32x4*)(bp + 4 * n); bu[n] = *(const f32x4*)(bp + 128 + 4 * n); }
#pragma unroll
        for (int ai = 0; ai < 2; ++ai)
#pragma unroll
            for (int m = 0; m < 4; ++m) {
                const int row = row0 + ai * HALF + m * 16;
                const float rs = rsqrtf(ss[row] * (1.0f / 1024.0f) + 1e-6f);
                float h[8];
#pragma unroll
                for (int n = 0; n < 2; ++n) {
                    const f32x4 g = acc[ai][0][m][n] * rs + bg[n], up = acc[ai][1][m][n] * rs + bu[n];
#pragma unroll
                    for (int i = 0; i < 4; ++i) h[4 * n + i] = g[i] * sigmoidf_(g[i]) * up[i];
                }
                u32x4 w; w.x = cvt_pk_bf16(h[0], h[1]); w.y = cvt_pk_bf16(h[2], h[3]); w.z = cvt_pk_bf16(h[4], h[5]); w.w = cvt_pk_bf16(h[6], h[7]);
                *(u32x4*)(H + (size_t)row * DFF + u.pn * 128 + wc * 32 + 8 * fq) = w;
            }
    }
};
struct EpiZ {
    static constexpr bool PERM = true, AFTER_DRAIN = false;
    bf16_t* Z; bf16_t* QK; bf16_t* VR; const float* ss; const float* bias; const float* qg; const float* kg; const float* rope;
    __device__ __forceinline__ void operator()(const f32x4 (&acc)[2][2][4][2], const Unit& u, int wr, int wc, int fr, int fq) const {
        const int row0 = u.pm * BM + wr * 64 + fr; const int s = seq_of_row(u.pm * BM); const int t0 = row0 - seq_start(s);
        const float* bp = bias + (size_t)s * NFF + u.pn * 256 + wc * 32 + 8 * fq;
        f32x4 bv[2][2];
#pragma unroll
        for (int bj = 0; bj < 2; ++bj)
#pragma unroll
            for (int n = 0; n < 2; ++n) bv[bj][n] = *(const f32x4*)(bp + bj * 128 + 4 * n);
        if (u.pn < 7 || u.pn == 9) {
#pragma unroll
            for (int ai = 0; ai < 2; ++ai)
#pragma unroll
                for (int m = 0; m < 4; ++m) {
                    const int row = row0 + ai * HALF + m * 16;
                    const float rs = rsqrtf(ss[row] * (1.0f / 1024.0f) + 1e-6f);
#pragma unroll
                    for (int bj = 0; bj < 2; ++bj) {
                        const f32x4 v0 = acc[ai][bj][m][0] * rs + bv[bj][0], v1 = acc[ai][bj][m][1] * rs + bv[bj][1];
                        u32x4 w; w.x = cvt_pk_bf16(v0[0], v0[1]); w.y = cvt_pk_bf16(v0[2], v0[3]); w.z = cvt_pk_bf16(v1[0], v1[1]); w.w = cvt_pk_bf16(v1[2], v1[3]);
                        if (u.pn < 7) *(u32x4*)(Z + (size_t)row * ZP + u.pn * 256 + bj * 128 + wc * 32 + 8 * fq) = w;
                        else if (bj == 0) *(u32x4*)(VR + (size_t)row * 128 + wc * 32 + 8 * fq) = w;
                    }
                }
        } else {
            const int hh = (u.pn - 7) * 4 + wc; const bool isq = hh < 6; const float* gp = isq ? qg : kg; const float osc = isq ? QSCALE : 1.0f;
            f32x4 gn[2][2];
#pragma unroll
            for (int bj = 0; bj < 2; ++bj)
#pragma unroll
                for (int n = 0; n < 2; ++n) gn[bj][n] = *(const f32x4*)(gp + 32 * bj + 16 * n + 4 * fq);
#pragma unroll
            for (int ai = 0; ai < 2; ++ai)
#pragma unroll
                for (int m = 0; m < 4; ++m) {
                    const int row = row0 + ai * HALF + m * 16; const int t = t0 + ai * HALF + m * 16;
                    const float rs = rsqrtf(ss[row] * (1.0f / 1024.0f) + 1e-6f);
                    f32x4 v[2][2]; float q = 0.f;
#pragma unroll
                    for (int bj = 0; bj < 2; ++bj)
#pragma unroll
                        for (int n = 0; n < 2; ++n) { v[bj][n] = acc[ai][bj][m][n] * rs + bv[bj][n]; q += (v[bj][n][0] * v[bj][n][0] + v[bj][n][1] * v[bj][n][1]) + (v[bj][n][2] * v[bj][n][2] + v[bj][n][3] * v[bj][n][3]); }
                    q += __shfl_xor(q, 16); q += __shfl_xor(q, 32);
                    const float r = rsqrtf(q * (1.0f / 64.0f) + 1e-6f);
#pragma unroll
                    for (int bj = 0; bj < 2; ++bj) {
                        const int pos = bj == 0 ? (t >> 6) : (t & 63);
                        const f32x4 x1 = v[bj][0] * r * gn[bj][0], x2 = v[bj][1] * r * gn[bj][1];
                        const float* rp = rope + (pos * 16 + 4 * fq) * 2;
                        const f32x4 cs0 = *(const f32x4*)(rp), cs1 = *(const f32x4*)(rp + 4);
                        const float c[4] = {cs0[0], cs0[2], cs1[0], cs1[2]}, sn[4] = {cs0[1], cs0[3], cs1[1], cs1[3]};
                        float o1[4], o2[4];
#pragma unroll
                        for (int i = 0; i < 4; ++i) { o1[i] = (x1[i] * c[i] - x2[i] * sn[i]) * osc; o2[i] = (x2[i] * c[i] + x1[i] * sn[i]) * osc; }
                        u32x4 w; w.x = cvt_pk_bf16(o1[0], o1[1]); w.y = cvt_pk_bf16(o1[2], o1[3]); w.z = cvt_pk_bf16(o2[0], o2[1]); w.w = cvt_pk_bf16(o2[2], o2[3]);
                        *(u32x4*)(QK + (size_t)row * 512 + hh * 64 + 32 * bj + 8 * fq) = w;
                    }
                }
        }
    }
};
struct EpiResid {
    static constexpr bool PERM = false, AFTER_DRAIN = false;
    const float* xin_p; const float* xin_s; float* out; bf16_t* xn; float* ssn; const float* gate; const float* gvn;
    __device__ __forceinline__ void operator()(const f32x4 (&acc)[2][2][4][2], const Unit& u, int wr, int wc, int fr, int fq) const {
        const int rowt = u.pm * BM; const int s = seq_of_row(rowt);
        const float* xb = rowt < 16384 ? xin_p : xin_s - (size_t)16384 * DM;
        const int row0 = rowt + wr * 64 + fr; const int col0 = u.pn * BM + wc * 32 + 4 * fq;
        f32x4 gt[2][2];
#pragma unroll
        for (int bj = 0; bj < 2; ++bj)
#pragma unroll
            for (int n = 0; n < 2; ++n) gt[bj][n] = *(const f32x4*)(gate + (size_t)s * DM + col0 + bj * HALF + n * 16);
#pragma unroll
        for (int ai = 0; ai < 2; ++ai)
#pragma unroll
            for (int m = 0; m < 4; ++m) {
                const int row = row0 + ai * HALF + m * 16; const size_t off = (size_t)row * DM + col0; float q = 0.f;
#pragma unroll
                for (int bj = 0; bj < 2; ++bj)
#pragma unroll
                    for (int n = 0; n < 2; ++n) {
                        const f32x4 xo = *(const f32x4*)(xb + off + bj * HALF + n * 16);
                        const f32x4 val = xo + gt[bj][n] * acc[ai][bj][m][n];
                        *(f32x4*)(out + off + bj * HALF + n * 16) = val;
                        if (gvn) {
                            q += (val[0] * val[0] + val[1] * val[1]) + (val[2] * val[2] + val[3] * val[3]);
                            const f32x4 gv = *(const f32x4*)(gvn + (size_t)s * DM + col0 + bj * HALF + n * 16);
                            const f32x4 o = val * gv; unsigned long long w = (unsigned long long)cvt_pk_bf16(o[0], o[1]) | ((unsigned long long)cvt_pk_bf16(o[2], o[3]) << 32);
                            *(unsigned long long*)(xn + off + bj * HALF + n * 16) = w;
                        }
                    }
                if (gvn) { q += __shfl_xor(q, 16); q += __shfl_xor(q, 32); if (fq == 0) atomicAdd(ssn + row, q); }
            }
    }
};
}

template <int MAP> __device__ __forceinline__ void transpose_item(const float* W, int K, int N, bf16* WT, float* scr, int item, int lane) {
    const int nblk = N / 32, kb = item / nblk, nb = item % nblk, k0 = 64 * kb, n0 = 32 * nb;
#pragma unroll 8
    for (int i = 0; i < 32; ++i) { const int kk = 2 * i + (lane >> 5); scr[kk * 33 + (lane & 31)] = W[(size_t)(k0 + kk) * N + n0 + (lane & 31)]; }
    __builtin_amdgcn_wave_barrier(); asm volatile("s_waitcnt lgkmcnt(0)" ::: "memory");
    const int c = lane & 7;
#pragma unroll
    for (int j = 0; j < 4; ++j) { const int n = (lane >> 3) + 8 * j; const float* sp = scr + (8 * c) * 33 + n;
        u32x4_t o; o.x = pk2(sp[0 * 33], sp[1 * 33]); o.y = pk2(sp[2 * 33], sp[3 * 33]); o.z = pk2(sp[4 * 33], sp[5 * 33]); o.w = pk2(sp[6 * 33], sp[7 * 33]);
        const int nsrc = n0 + n; const int nd = MAP == 1 ? map_ffn(nsrc) : (MAP == 2 ? map_mix(nsrc) : nsrc);
        *(u32x4_t*)(WT + (size_t)nd * K + k0 + 8 * c) = o; }
    __builtin_amdgcn_wave_barrier(); asm volatile("s_waitcnt lgkmcnt(0)" ::: "memory");
}

template <int MODE, int MAP> __device__ __forceinline__ void smallm_unit(const KP& p, float* sA, int l, int j, const float* W, int ldw, int nvalid, float* dest, int ldd, int nchunk, int kchunk) {
    int tid_o = threadIdx.x; asm volatile("" : "+v"(tid_o)); const int tid = tid_o; const int k0 = kchunk * 128;
    __syncthreads();
    for (int e = tid; e < 128 * NSEQ; e += NTHR) {
        const int k = e / NSEQ, s = e % NSEQ; float v;
        if (MODE == 0) { const float c = s < 4 ? p.in[2][s * DM + k0 + k] : p.in[3][(s - 4) * DM + k0 + k]; v = c * sigmoidf_(c); }
        else { const float* mod = (const float*)(p.ws + OFF_MOD) + ((size_t)l * NSEQ + s) * 9216 + 3 * j * 1024 + k0 + k; v = *mod + p.in[5][l * 9216 + 3 * j * 1024 + k0 + k]; }
        sA[k * NSEQ + s] = v;
    }
    __syncthreads();
    const int n = nchunk * 256 + (tid & 255), kh = tid >> 8;
    float acc[NSEQ];
#pragma unroll
    for (int s = 0; s < NSEQ; ++s) acc[s] = 0.f;
    if (n < nvalid) {
        for (int kk = 0; kk < 64; ++kk) {
            const int k = kh * 64 + kk; const float w = W[(size_t)(k0 + k) * ldw + n];
            const f32x4_t* ap = (const f32x4_t*)(sA + k * NSEQ);
#pragma unroll
            for (int q = 0; q < 5; ++q) { const f32x4_t a = ap[q]; acc[4 * q] += a[0] * w; acc[4 * q + 1] += a[1] * w; acc[4 * q + 2] += a[2] * w; acc[4 * q + 3] += a[3] * w; }
        }
        const int nd = MAP == 1 ? map_ffn(n) : (MAP == 2 ? map_mix(n) : n);
#pragma unroll
        for (int s = 0; s < NSEQ; ++s) atomicAdd(dest + (size_t)s * ldd + nd, acc[s]);
    }
}

__device__ __forceinline__ void rwkv_unit(const KP& p, unsigned char* lds, int l, int s, int h, int d) {
    int tid_o = threadIdx.x; asm volatile("" : "+v"(tid_o)); const int tid = tid_o, lane = tid & 63, wid = tid >> 6;
    float* WUP = (float*)lds;
    float* AUP = WUP + 4096;
    float* FS = AUP + 4096;
    float* UL = FS + 32 * 192;
    float* AL = UL + 2048;
    float* OPS = AL + 2048;
    float* YBUF = OPS + 32 * 384;
    const bf16* Z = (const bf16*)(p.ws + OFF_Z);
    float* Y = (float*)(p.ws + (d == 0 ? OFF_YF : OFF_YB));
    const float* mu = p.in[18] + l * 1024;
    const float* w_up = p.in[19] + ((size_t)l * 2 + d) * 64 * 256;
    const float* w0 = p.in[20] + (l * 2 + d) * 256 + 64 * h;
    const float* a_up = p.in[21] + (size_t)l * 64 * 256;
    const float* a0 = p.in[22] + (l * 2 + d) * 256 + 64 * h;
    const float* k_k = p.in[24] + l * 256 + 64 * h;
    const float* k_a = p.in[25] + l * 256 + 64 * h;
    const int S = seq_len(s), start = seq_start(s);
    __syncthreads();
    for (int e = tid; e < 4096; e += NTHR) { const int i = e >> 6, j = e & 63; WUP[e] = w_up[i * 256 + 64 * h + j]; AUP[e] = a_up[i * 256 + 64 * h + j]; }
    float st[16];
#pragma unroll
    for (int i = 0; i < 16; ++i) st[i] = 0.f;
    const int vl = lane & 15, kq = lane >> 4;
    for (int blk = 0; blk < S / 32; ++blk) {
        __syncthreads();
        for (int e = tid; e < 32 * 320; e += NTHR) {
            const int t = e / 320, c = e % 320;
            const int tt = d == 0 ? blk * 32 + t : S - 1 - (blk * 32 + t);
            int zc; if (c < 64) zc = 64 * h + c; else if (c < 128) zc = 256 + 64 * h + (c - 64); else if (c < 192) zc = 512 + 64 * h + (c - 128); else if (c < 256) zc = 768 + (c - 192); else zc = 832 + (c - 256);
            const bf16* zp = Z + (size_t)(start + tt) * ZP + 768 + zc;
            const float f = bf2f(zp[0]); const float pv = tt > 0 ? bf2f(zp[-ZP]) : 0.f; const float nx = tt < S - 1 ? bf2f(zp[ZP]) : 0.f;
            const float fs = f + mu[zc] * (0.5f * (pv + nx) - f);
            if (c < 64) OPS[t * 384 + 4 * 64 + c] = fs;
            else if (c < 128) FS[t * 192 + (c - 64)] = fs;
            else if (c < 192) OPS[t * 384 + 5 * 64 + (c - 128)] = fs;
            else if (c < 256) FS[t * 192 + 64 + (c - 192)] = tanhf(fs);
            else FS[t * 192 + 128 + (c - 256)] = fs;
        }
        __syncthreads();
        {
            const int j = tid & 63, which = (tid >> 6) & 1, tg = tid >> 7;
            const float* Wm = which ? AUP : WUP; const float* xs = FS + (which ? 128 : 64);
            float acc[8];
#pragma unroll
            for (int t = 0; t < 8; ++t) acc[t] = 0.f;
            for (int i = 0; i < 64; ++i) { const float w = Wm[i * 64 + j];
#pragma unroll
                for (int t = 0; t < 8; ++t) acc[t] += xs[(tg * 8 + t) * 192 + i] * w; }
            float* o = which ? AL : UL;
#pragma unroll
            for (int t = 0; t < 8; ++t) o[(tg * 8 + t) * 64 + j] = acc[t];
        }
        __syncthreads();
        for (int q = 0; q < 4; ++q) {
            const int t = wid * 4 + q, j = lane;
            const float k = FS[t * 192 + j]; const float kkv = k * k_k[j];
            const float n2 = wave_sum(kkv * kkv); const float kk = kkv / fmaxf(sqrtf(n2), 1e-12f);
            const float uu = w0[j] + UL[t * 64 + j]; const float wdec = __expf(-0.6065306597126334f * sigmoidf_(uu));
            const float a = sigmoidf_(a0[j] + AL[t * 64 + j]);
            OPS[t * 384 + j] = -kk; OPS[t * 384 + 64 + j] = wdec; OPS[t * 384 + 128 + j] = kk * a; OPS[t * 384 + 192 + j] = k * (1.0f + (a - 1.0f) * k_a[j]);
        }
        __syncthreads();
        if (wid < 4) {
            for (int t = 0; t < 32; ++t) {
                const float* op = OPS + t * 384 + 16 * kq;
                float nk[16], wv[16], bb[16], kd[16], rr[16];
#pragma unroll
                for (int q = 0; q < 4; ++q) {
                    const f32x4_t a = *(const f32x4_t*)(op + 4 * q), b = *(const f32x4_t*)(op + 64 + 4 * q), c = *(const f32x4_t*)(op + 128 + 4 * q), e = *(const f32x4_t*)(op + 192 + 4 * q), f = *(const f32x4_t*)(op + 256 + 4 * q);
#pragma unroll
                    for (int i = 0; i < 4; ++i) { nk[4 * q + i] = a[i]; wv[4 * q + i] = b[i]; bb[4 * q + i] = c[i]; kd[4 * q + i] = e[i]; rr[4 * q + i] = f[i]; }
                }
                const float v = OPS[t * 384 + 320 + 16 * wid + vl];
                float sa = 0.f;
#pragma unroll
                for (int i = 0; i < 16; ++i) sa += st[i] * nk[i];
                sa += __shfl_xor(sa, 16); sa += __shfl_xor(sa, 32);
                float y = 0.f;
#pragma unroll
                for (int i = 0; i < 16; ++i) { st[i] = st[i] * wv[i] + sa * bb[i] + v * kd[i]; y += st[i] * rr[i]; }
                y += __shfl_xor(y, 16); y += __shfl_xor(y, 32);
                if (kq == 0) YBUF[t * 64 + 16 * wid + vl] = y;
            }
        }
        __syncthreads();
        for (int e = tid; e < 2048; e += NTHR) { const int t = e >> 6, j = e & 63; const int tt = d == 0 ? blk * 32 + t : S - 1 - (blk * 32 + t); Y[(size_t)(start + tt) * 256 + 64 * h + j] = YBUF[e]; }
    }
}

__device__ __forceinline__ float gelu_tanh(float x) { const float u = 0.7978845608028654f * (x + 0.044715f * x * x * x); return 0.5f * x * (1.0f + tanhf(u)); }

__device__ __forceinline__ void lru_unit(const KP& p, unsigned char* lds, int l, int s, int n) {
    int tid_o = threadIdx.x; asm volatile("" : "+v"(tid_o)); const int tid = tid_o, lane = tid & 63, wid = tid >> 6;
    float* WA = (float*)lds;
    float* WX = WA + 4096;
    float* XC = WX + 4096;
    float* GA = XC + 4096;
    float* GX = GA + 4096;
    float* HF = GX + 4096;
    float* YG = HF + 4096;
    float* HO = YG + 4096;
    const bf16* Z = (const bf16*)(p.ws + OFF_Z);
    bf16* OM = (bf16*)(p.ws + OFF_OMIX);
    const float* cw = p.in[11] + l * 4 * 384 + 64 * n; const float* cb = p.in[12] + l * 384 + 64 * n;
    const int S = seq_len(s), start = seq_start(s);
    for (int d = 0; d < 2; ++d) {
        const float* wga = p.in[13] + (((size_t)l * 2 + d) * 6 + n) * 4096; const float* wgx = p.in[15] + (((size_t)l * 2 + d) * 6 + n) * 4096;
        const float* bga = p.in[14] + (l * 2 + d) * 384 + 64 * n; const float* bgx = p.in[16] + (l * 2 + d) * 384 + 64 * n;
        const float* lam = p.in[17] + (l * 2 + d) * 384 + 64 * n;
        __threadfence();
        __syncthreads();
        for (int e = tid; e < 4096; e += NTHR) { WA[e] = wga[e]; WX[e] = wgx[e]; }
        float hstate = 0.f;
        for (int blk = 0; blk < S / 64; ++blk) {
            __syncthreads();
            for (int e = tid; e < 4096; e += NTHR) {
                const int t = e >> 6, c = e & 63; const int tt = d == 0 ? blk * 64 + t : S - 1 - (blk * 64 + t);
                float xc = cb[c];
#pragma unroll
                for (int j = 0; j < 4; ++j) { const int t2 = tt - 2 + j; if (t2 >= 0 && t2 < S) xc += cw[j * 384 + c] * bf2f(Z[(size_t)(start + t2) * ZP + 64 * n + c]); }
                XC[e] = xc;
                if (d == 1) { HF[e] = bf2f(OM[(size_t)(start + tt) * DM + 64 * n + c]); YG[e] = gelu_tanh(bf2f(Z[(size_t)(start + tt) * ZP + 384 + 64 * n + c])); }
            }
            __syncthreads();
            {
                const int c = tid & 63, which = (tid >> 6) & 1, tg = tid >> 7;
                const float* Wm = which ? WX : WA; float acc[16];
#pragma unroll
                for (int t = 0; t < 16; ++t) acc[t] = 0.f;
                for (int i = 0; i < 64; ++i) { const float w = Wm[i * 64 + c];
#pragma unroll
                    for (int t = 0; t < 16; ++t) acc[t] += XC[(tg * 16 + t) * 64 + i] * w; }
                const float bsv = which ? bgx[c] : bga[c]; float* o = which ? GX : GA;
#pragma unroll
                for (int t = 0; t < 16; ++t) o[(tg * 16 + t) * 64 + c] = sigmoidf_(acc[t] + bsv);
            }
            __syncthreads();
            for (int e = tid; e < 4096; e += NTHR) {
                const int c = e & 63; const float lm = -lam[c]; const float sp = lm > 20.f ? lm : log1pf(__expf(lm));
                const float la = -8.0f * GA[e] * sp; const float a = __expf(la); const float uu = sqrtf(-expm1f(2.0f * la)) * GX[e] * XC[e];
                GA[e] = a; GX[e] = uu;
            }
            __syncthreads();
            if (wid == 0) {
                for (int t = 0; t < 64; ++t) { hstate = GA[t * 64 + lane] * hstate + GX[t * 64 + lane]; HO[t * 64 + lane] = d == 0 ? hstate : (HF[t * 64 + lane] + hstate) * YG[t * 64 + lane]; }
            }
            __syncthreads();
            for (int e = tid; e < 4096; e += NTHR) { const int t = e >> 6, c = e & 63; const int tt = d == 0 ? blk * 64 + t : S - 1 - (blk * 64 + t); OM[(size_t)(start + tt) * DM + 64 * n + c] = (bf16)f2bf(HO[e]); }
        }
    }
}

__device__ __forceinline__ void attn_naive_unit(const KP& p, unsigned char* lds, int s, int hq, int qb) {
    int tid_o = threadIdx.x; asm volatile("" : "+v"(tid_o)); const int tid = tid_o; const int g = hq / 3;
    float* KT = (float*)lds; float* VT = KT + 4096;
    const bf16* QK = (const bf16*)(p.ws + OFF_QK); const bf16* VR = (const bf16*)(p.ws + OFF_VR); bf16* OM = (bf16*)(p.ws + OFF_OMIX);
    const int S = seq_len(s), start = seq_start(s); const int m = start + qb * 512 + tid;
    f32x4_t q4[16], o4[16];
    { const u32x4_t* qp = (const u32x4_t*)(QK + (size_t)m * 512 + 64 * hq);
#pragma unroll
      for (int c = 0; c < 8; ++c) { const u32x4_t w = qp[c];
          q4[2 * c] = (f32x4_t){__builtin_bit_cast(float, w[0] << 16), __builtin_bit_cast(float, w[0] & 0xffff0000u), __builtin_bit_cast(float, w[1] << 16), __builtin_bit_cast(float, w[1] & 0xffff0000u)};
          q4[2 * c + 1] = (f32x4_t){__builtin_bit_cast(float, w[2] << 16), __builtin_bit_cast(float, w[2] & 0xffff0000u), __builtin_bit_cast(float, w[3] << 16), __builtin_bit_cast(float, w[3] & 0xffff0000u)}; } }
#pragma unroll
    for (int i = 0; i < 16; ++i) o4[i] = (f32x4_t){0.f, 0.f, 0.f, 0.f};
    float mx = -1e30f, lsum = 0.f;
#pragma unroll 1
    for (int kt = 0; kt < S / 64; ++kt) {
        __syncthreads();
        { const int r = tid >> 3, c8 = (tid & 7) * 8; const size_t row = (size_t)(start + kt * 64 + r);
          const u32x4_t kw = *(const u32x4_t*)(QK + row * 512 + 384 + 64 * g + c8); const u32x4_t vw = *(const u32x4_t*)(VR + row * 128 + 64 * g + c8);
#pragma unroll
          for (int i = 0; i < 4; ++i) { KT[r * 64 + c8 + 2 * i] = __builtin_bit_cast(float, kw[i] << 16); KT[r * 64 + c8 + 2 * i + 1] = __builtin_bit_cast(float, kw[i] & 0xffff0000u);
              VT[r * 64 + c8 + 2 * i] = __builtin_bit_cast(float, vw[i] << 16); VT[r * 64 + c8 + 2 * i + 1] = __builtin_bit_cast(float, vw[i] & 0xffff0000u); } }
        __syncthreads();
#pragma unroll 1
        for (int j = 0; j < 64; ++j) {
            const f32x4_t* kr = (const f32x4_t*)(KT + j * 64); f32x4_t a4 = (f32x4_t){0.f, 0.f, 0.f, 0.f};
#pragma unroll
            for (int c = 0; c < 16; ++c) a4 += q4[c] * kr[c];
            const float sc = (a4[0] + a4[1]) + (a4[2] + a4[3]);
            if (sc > mx) { const float al = exp2f(mx - sc); mx = sc; lsum *= al;
#pragma unroll
                for (int c = 0; c < 16; ++c) o4[c] *= al; }
            const float pj = exp2f(sc - mx); lsum += pj; const f32x4_t* vr = (const f32x4_t*)(VT + j * 64);
#pragma unroll
            for (int c = 0; c < 16; ++c) o4[c] += vr[c] * pj;
        }
    }
    const float il = 1.0f / lsum;
    u32x4_t* op = (u32x4_t*)(OM + (size_t)m * DM + 640 + 64 * hq);
#pragma unroll
    for (int c = 0; c < 8; ++c) { const f32x4_t a = o4[2 * c] * il, bq = o4[2 * c + 1] * il; u32x4_t w; w.x = pk2(a[0], a[1]); w.y = pk2(a[2], a[3]); w.z = pk2(bq[0], bq[1]); w.w = pk2(bq[2], bq[3]); op[c] = w; }
}

__device__ __forceinline__ void rwkv_post_tile(const KP& p, unsigned char* lds, int l, int tile) {
    int tid_o = threadIdx.x; asm volatile("" : "+v"(tid_o)); const int tid = tid_o, lane = tid & 63;
    float* SG = (float*)lds;
    float* GO = SG + 4096;
    const bf16* Z = (const bf16*)(p.ws + OFF_Z); bf16* OM = (bf16*)(p.ws + OFF_OMIX);
    const float* YF = (const float*)(p.ws + OFF_YF); const float* YBk = (const float*)(p.ws + OFF_YB);
    const float* mu = p.in[18] + l * 1024; const float* g_up = p.in[23] + (size_t)l * 128 * 256;
    const int m0 = tile * 32; const int s = seq_of_row(m0); const int S = seq_len(s), start = seq_start(s);
    __syncthreads();
    for (int e = tid; e < 4096; e += NTHR) {
        const int t = e >> 7, c = e & 127; const int m = m0 + t, tt = m - start; const bf16* zp = Z + (size_t)m * ZP + 768 + 896 + c;
        const float f = bf2f(zp[0]); const float pv = tt > 0 ? bf2f(zp[-ZP]) : 0.f; const float nx = tt < S - 1 ? bf2f(zp[ZP]) : 0.f;
        SG[e] = sigmoidf_(f + mu[896 + c] * (0.5f * (pv + nx) - f));
    }
    __syncthreads();
    const int c = tid & 255, tg = tid >> 8;
    {
        float acc[16];
#pragma unroll
        for (int t = 0; t < 16; ++t) acc[t] = 0.f;
        for (int i = 0; i < 128; ++i) { const float w = g_up[i * 256 + c];
#pragma unroll
            for (int t = 0; t < 16; ++t) acc[t] += SG[(tg * 16 + t) * 128 + i] * w; }
#pragma unroll
        for (int t = 0; t < 16; ++t) GO[(tg * 16 + t) * 256 + c] = acc[t];
    }
    const float rk = p.in[26][l * 256 + c], lg = p.in[27][l * 256 + c], lb = p.in[28][l * 256 + c];
    const float mr = mu[c], mk = mu[256 + c], mv = mu[512 + c];
    for (int t = 0; t < 16; ++t) {
        const int m = m0 + tg * 16 + t, tt = m - start; const bf16* zp = Z + (size_t)m * ZP + 768 + c;
        const bool hp = tt > 0, hn = tt < S - 1;
        float f = bf2f(zp[0]), pv = hp ? bf2f(zp[-ZP]) : 0.f, nx = hn ? bf2f(zp[ZP]) : 0.f; const float r = f + mr * (0.5f * (pv + nx) - f);
        f = bf2f(zp[256]); pv = hp ? bf2f(zp[256 - ZP]) : 0.f; nx = hn ? bf2f(zp[256 + ZP]) : 0.f; const float k = f + mk * (0.5f * (pv + nx) - f);
        f = bf2f(zp[512]); pv = hp ? bf2f(zp[512 - ZP]) : 0.f; nx = hn ? bf2f(zp[512 + ZP]) : 0.f; const float v = f + mv * (0.5f * (pv + nx) - f);
        const float y = YF[(size_t)m * 256 + c] + YBk[(size_t)m * 256 + c];
        const float mean = wave_sum(y) * (1.0f / 64.0f); const float dv = y - mean; const float var = wave_sum(dv * dv) * (1.0f / 64.0f);
        const float yn = dv * rsqrtf(var + 64e-5f) * lg + lb;
        const float bon = wave_sum(r * k * rk);
        const float outv = (yn + bon * v) * GO[(tg * 16 + t) * 256 + c];
        OM[(size_t)m * DM + 384 + c] = (bf16)f2bf(outv);
    }
    (void)lane;
}

__global__ void __launch_bounds__(NTHR, 2) fwd_megakernel(KP p) {
    extern __shared__ __attribute__((aligned(16))) unsigned char lds[];
    cg::grid_group grid = cg::this_grid();
    const int tid = threadIdx.x, lane = tid & 63, wid = tid >> 6;
    const int G = gridDim.x, bx = blockIdx.x;
    const int gw = bx * 8 + wid, NGW = G * 8;
    unsigned char* ws = p.ws;
    volatile int* misc = (volatile int*)(lds + MISC_OFF);
    PG8_LAS unsigned char* ldsg = (PG8_LAS unsigned char*)lds;

    {
        float* scr = (float*)(lds + wid * 16384);
        for (int l = 0; l < 2; ++l) {
            unsigned char* wl = ws + OFF_W + l * W_LAYER;
            constexpr int I_IN = 16 * 176, I_OUT = 44 * 32, I_MI = 16 * 76, I_MO = 16 * 32, I_TOT = 2 * I_IN + 2 * I_OUT + I_MI + I_MO;
            for (int it = gw; it < I_TOT; it += NGW) {
                int r = it;
                if (r < 2 * I_IN) { const int f = r / I_IN; transpose_item<1>(p.in[7] + ((size_t)l * 2 + f) * DM * NFF, DM, NFF, (bf16*)(wl + WO_IN + f * 11 * MiB), scr, r % I_IN, lane); continue; } r -= 2 * I_IN;
                if (r < 2 * I_OUT) { const int f = r / I_OUT; transpose_item<0>(p.in[8] + ((size_t)l * 2 + f) * DFF * DM, DFF, DM, (bf16*)(wl + WO_OUT + f * (11 * MiB / 2)), scr, r % I_OUT, lane); continue; } r -= 2 * I_OUT;
                if (r < I_MI) { transpose_item<2>(p.in[9] + (size_t)l * DM * NMIX, DM, NMIX, (bf16*)(wl + WO_MI), scr, r, lane); continue; } r -= I_MI;
                transpose_item<0>(p.in[10] + (size_t)l * DM * DM, DM, DM, (bf16*)(wl + WO_MO), scr, r, lane);
            }
            u32x4_t* padp = (u32x4_t*)(wl + WO_MI + (size_t)NMIX * DM * 2);
            for (int e = bx * NTHR + tid; e < 128 * DM * 2 / 16; e += G * NTHR) padp[e] = (u32x4_t){0u, 0u, 0u, 0u};
        }
        __syncthreads();
        for (int u = bx; u < 2 * 36 * 8; u += G) { const int l = u / 288, r = u % 288;
            smallm_unit<0, 0>(p, (float*)lds, l, 0, p.in[4] + (size_t)l * DM * 9216, 9216, 9216, (float*)(ws + OFF_MOD) + (size_t)l * NSEQ * 9216, 9216, r / 8, r % 8); }
        if (bx == 0) { float* rope = (float*)(ws + OFF_ROPE);
            for (int e = tid; e < 1024; e += NTHR) { const int pos = e >> 4, pp = e & 15; const float inv = exp2f(-(float)pp * (13.287712379549449f / 16.0f)); const float a = (float)pos * inv; const float kr = rintf(a * 0.15915494309189535f); float rr = fmaf(-kr, 6.2831854820251465f, a); rr = fmaf(-kr, -1.7484555e-7f, rr); rope[2 * e] = __cosf(rr); rope[2 * e + 1] = __sinf(rr); } }
    }
    grid.sync();
    {
        const float* MOD = (const float*)(ws + OFF_MOD); float* GV = (float*)(ws + OFF_GV); float* GT = (float*)(ws + OFF_GATE);
        for (int e = bx * NTHR + tid; e < 6 * NSEQ * DM; e += G * NTHR) {
            const int c = e & 1023, s = (e >> 10) % NSEQ, inst = e / (NSEQ * DM); const int l = inst / 3, j = inst % 3;
            const float* mr = MOD + ((size_t)l * NSEQ + s) * 9216; const float* ba = p.in[5] + l * 9216;
            const float sc = mr[(3 * j + 1) * 1024 + c] + ba[(3 * j + 1) * 1024 + c], gg = mr[(3 * j + 2) * 1024 + c] + ba[(3 * j + 2) * 1024 + c];
            GV[e] = p.in[6][(l * 3 + j) * DM + c] * (1.0f + sc); GT[e] = (j == 1 ? 1.0f : 0.5f) * gg;
        }
        for (int u = bx; u < 2 * 432; u += G) { const int l = u / 432, r = u % 432; float* bdst = (float*)(ws + OFF_BIAS);
            if (r < 176) smallm_unit<1, 1>(p, (float*)lds, l, 0, p.in[7] + ((size_t)l * 2 + 0) * DM * NFF, NFF, NFF, bdst + (size_t)(l * 3 + 0) * NSEQ * NFF, NFF, r / 8, r % 8);
            else if (r < 256) smallm_unit<1, 2>(p, (float*)lds, l, 1, p.in[9] + (size_t)l * DM * NMIX, NMIX, NMIX, bdst + (size_t)(l * 3 + 1) * NSEQ * NFF, NFF, (r - 176) / 8, (r - 176) % 8);
            else smallm_unit<1, 1>(p, (float*)lds, l, 2, p.in[7] + ((size_t)l * 2 + 1) * DM * NFF, NFF, NFF, bdst + (size_t)(l * 3 + 2) * NSEQ * NFF, NFF, (r - 256) / 8, (r - 256) % 8); }
        bf16* XN = (bf16*)(ws + OFF_XN); float* SS0 = (float*)(ws + OFF_SS);
        for (int m = gw; m < MTOK; m += NGW) {
            const int s = seq_of_row(m); const float* xr = m < 16384 ? p.in[0] + (size_t)m * DM : p.in[1] + (size_t)(m - 16384) * DM;
            const float* mr = MOD + (size_t)s * 9216 + 1024; const float* ba = p.in[5] + 1024; const float* ng = p.in[6];
            float q = 0.f;
#pragma unroll
            for (int j = 0; j < 4; ++j) { const int c = 4 * lane + 256 * j; const f32x4_t v = *(const f32x4_t*)(xr + c); const f32x4_t sc = *(const f32x4_t*)(mr + c) + *(const f32x4_t*)(ba + c); const f32x4_t g = *(const f32x4_t*)(ng + c) * (sc + 1.0f);
                q += (v[0] * v[0] + v[1] * v[1]) + (v[2] * v[2] + v[3] * v[3]); const f32x4_t o = v * g;
                *(unsigned long long*)(XN + (size_t)m * DM + c) = (unsigned long long)pk2(o[0], o[1]) | ((unsigned long long)pk2(o[2], o[3]) << 32); }
            q = wave_sum(q); if (lane == 0) SS0[m] = q;
        }
    }
    grid.sync();

    for (int l = 0; l < 2; ++l) {
        unsigned char* wl = ws + OFF_W + l * W_LAYER;
        const float* GV = (const float*)(ws + OFF_GV); const float* GT = (const float*)(ws + OFF_GATE); const float* BI = (const float*)(ws + OFF_BIAS); float* SS = (float*)(ws + OFF_SS);
        bf16* XN = (bf16*)(ws + OFF_XN); bf16* HID = (bf16*)(ws + OFF_HID); bf16* OMIX = (bf16*)(ws + OFF_OMIX);
        for (int f = 0; f < 2; ++f) {
            const int j = f == 0 ? 0 : 2; const int inst = l * 3 + j;
            if (f == 1) {
                {
                    pg8::Gemm g{XN, (const pg8::bf16_t*)(wl + WO_MI), MTOK, NMIXP, DM}; pg8::StaticOrder S; S.init(MTOK, NMIXP, G, bx);
                    pg8::EpiZ E{(bf16*)(ws + OFF_Z), (bf16*)(ws + OFF_QK), (bf16*)(ws + OFF_VR), SS + (size_t)(l * 3 + 1) * MTOK, BI + (size_t)(l * 3 + 1) * NSEQ * NFF, p.in[29] + l * 64, p.in[30] + l * 64, (const float*)(ws + OFF_ROPE)};
                    pg8::gemm_phase<pg8::EpiZ, pg8::StaticOrder, true, true>(ldsg, g, S, E);
                }
                grid.sync();
                {
                    unsigned* ctr = (unsigned*)(ws + OFF_CTR) + 64 * l;
                    constexpr int NU_R = 160, NU_L = 120, NU_A = 576, NU = NU_R + NU_L + NU_A;
                    for (;;) {
                        __syncthreads(); if (tid == 0) misc[0] = (int)atomicAdd(ctr, 1u); __syncthreads();
                        const int u = misc[0]; if (u >= NU) break;
                        if (u < 32) rwkv_unit(p, lds, l, u >> 3, (u >> 1) & 3, u & 1);
                        else if (u < 160) { const int i2 = u - 32; rwkv_unit(p, lds, l, 4 + (i2 >> 3), (i2 >> 1) & 3, i2 & 1); }
                        else if (u < 184) { const int i3 = u - 160; lru_unit(p, lds, l, i3 / 6, i3 % 6); }
                        else if (u < 280) { const int i4 = u - 184; lru_unit(p, lds, l, 4 + i4 / 6, i4 % 6); }
                        else { const int i5 = u - 280; if (i5 < 192) attn_naive_unit(p, lds, i5 / 48, (i5 >> 3) % 6, i5 & 7); else { const int i6 = i5 - 192; attn_naive_unit(p, lds, 4 + i6 / 24, (i6 >> 2) % 6, i6 & 3); } }
                    }
                }
                grid.sync();
                for (int t = bx; t < MTOK / 32; t += G) rwkv_post_tile(p, lds, l, t);
                grid.sync();
                {
                    pg8::Gemm g{OMIX, (const pg8::bf16_t*)(wl + WO_MO), MTOK, DM, DM}; pg8::StaticOrder S; S.init(MTOK, DM, G, bx);
                    pg8::EpiResid E{p.out, p.out + (size_t)16384 * DM, p.out, XN, SS + (size_t)(l * 3 + 2) * MTOK, GT + (size_t)(l * 3 + 1) * NSEQ * DM, GV + (size_t)(l * 3 + 2) * NSEQ * DM};
                    pg8::gemm_phase<pg8::EpiResid, pg8::StaticOrder, true, true>(ldsg, g, S, E);
                }
                grid.sync();
            }
            {
                pg8::Gemm g{XN, (const pg8::bf16_t*)(wl + WO_IN + f * 11 * MiB), MTOK, NFF, DM}; pg8::StaticOrder S; S.init(MTOK, NFF, G, bx);
                pg8::EpiSwiglu E{HID, SS + (size_t)inst * MTOK, BI + (size_t)inst * NSEQ * NFF};
                pg8::gemm_phase<pg8::EpiSwiglu, pg8::StaticOrder, true, true>(ldsg, g, S, E);
            }
            grid.sync();
            {
                const bool first = (l == 0 && f == 0), last = (l == 1 && f == 1);
                const int ninst = inst + 1;
                pg8::Gemm g{HID, (const pg8::bf16_t*)(wl + WO_OUT + f * (11 * MiB / 2)), MTOK, DM, DFF}; pg8::StaticOrder S; S.init(MTOK, DM, G, bx);
                pg8::EpiResid E{first ? p.in[0] : p.out, first ? p.in[1] : p.out + (size_t)16384 * DM, p.out, XN, last ? nullptr : SS + (size_t)ninst * MTOK, GT + (size_t)inst * NSEQ * DM, last ? nullptr : GV + (size_t)ninst * NSEQ * DM};
                pg8::gemm_phase<pg8::EpiResid, pg8::StaticOrder, true, true>(ldsg, g, S, E);
            }
            if (!(l == 1 && f == 1)) grid.sync();
        }
    }
}

extern "C" void kernel_launch(void* const* d_in, const int* in_sizes, int n_in, void* d_out, int out_size, void* d_ws, size_t ws_size, hipStream_t stream) {
    static int grid = 0;
    if (grid == 0) {
        if (n_in != 31 || ws_size < WS_END) { fprintf(stderr, "kernel_launch: unexpected n_in %d / ws %zu\n", n_in, ws_size); grid = -1; return; }
        int dev = 0, cus = 0, per_cu = 0;
        hipGetDevice(&dev); hipDeviceGetAttribute(&cus, hipDeviceAttributeMultiprocessorCount, dev);
        hipFuncSetAttribute((const void*)fwd_megakernel, hipFuncAttributeMaxDynamicSharedMemorySize, LDS_BYTES);
        hipOccupancyMaxActiveBlocksPerMultiprocessor(&per_cu, (const void*)fwd_megakernel, NTHR, LDS_BYTES);
        if (per_cu < 1) per_cu = 1;
        grid = cus * per_cu;
        (void)hipGetLastError();
    }
    if (grid < 0) return;
    hipMemsetAsync(d_ws, 0, ZERO_BYTES, stream);
    KP p{};
    for (int i = 0; i < 31; ++i) p.in[i] = (const float*)d_in[i];
    p.out = (float*)d_out; p.ws = (unsigned char*)d_ws;
    void* args[] = {&p};
    hipError_t e = hipLaunchCooperativeKernel((const void*)fwd_megakernel, dim3(grid), dim3(NTHR), args, LDS_BYTES, stream);
    if (e != hipSuccess) fprintf(stderr, "cooperative launch failed: %s (grid %d)\n", hipGetErrorString(e), grid);
}
```

```cpp
#include <hip/hip_runtime.h>
#include <hip/hip_cooperative_groups.h>
#include <cstdio>
#include <cstdint>
namespace cg = cooperative_groups;
namespace pg8 {
#define PG8_LAS __attribute__((address_space(3)))
typedef unsigned short bf16_t;
typedef short bf16x8 __attribute__((ext_vector_type(8)));
typedef float f32x4 __attribute__((ext_vector_type(4)));
typedef unsigned u32x4 __attribute__((ext_vector_type(4)));
constexpr int BM = 256, BK = 64, HALF = 128, HTB = HALF * BK * 2  , STAGE_BYTES = 8 * HTB, NXCD = 8, WGM = 8;

__host__ __device__ __forceinline__ int lds_byte(int r, int c) { const int st = (r >> 4) * 2 + (c >> 5), rr = r & 15, cc = c & 31, ob = rr * 64 + cc * 2; return st * 1024 + (ob ^ (((ob >> 9) & 1) << 5)); }
__host__ __device__ __forceinline__ void stage_rc(int b, int& R, int& C) { const int st = b / 1024, sb = b % 1024, swz = sb ^ (((sb >> 9) & 1) << 5); R = (st >> 1) * 16 + swz / 64; C = (st & 1) * 32 + (swz % 64) / 2; }
__host__ __device__ __forceinline__ int perm32(int rho) { const int n = rho >> 4, i = rho & 15; return 8 * (i >> 2) + 4 * n + (i & 3); }

struct Unit { int pm, pn; };
struct Gemm { const bf16_t* A; const bf16_t* Bt; int M, N, K; };

struct StaticOrder {
    int nM, nN, nwg, G, c;
    __host__ __device__ void init(int M, int N, int G_, int c_) { nM = M / BM; nN = N / BM; nwg = nM * nN; G = G_; c = c_; }
    __host__ __device__ bool next(int i, Unit& u) const {
        const long L = (long)i * G + c; if (L >= nwg) return false;
        int wgid = (int)L; { const int q = nwg / NXCD, r = nwg % NXCD, xcd = wgid % NXCD, off = wgid / NXCD; wgid = (xcd < r ? xcd * (q + 1) : r * (q + 1) + (xcd - r) * q) + off; }
        const int nig = WGM * nN, gid = wgid / nig, fm = gid * WGM, gsz = (nM - fm) < WGM ? (nM - fm) : WGM;
        u.pm = fm + ((wgid % nig) % gsz); u.pn = (wgid % nig) / gsz; return true;
    }
    __device__ __forceinline__ void a_ready(const Unit&) const {}
    __device__ __forceinline__ void done(const Unit&) const {}
};

__device__ __forceinline__ unsigned cvt_pk_bf16(float lo, float hi) { unsigned r; asm volatile("v_cvt_pk_bf16_f32 %0, %1, %2" : "=v"(r) : "v"(lo), "v"(hi)); return r; }
typedef float f32x2 __attribute__((ext_vector_type(2)));
__device__ __forceinline__ f32x2 gelu_pk(f32x2 v) {
    const f32x2 av = __builtin_elementwise_abs(v), d = av * 0.2316418882f + 1.0f;
    f32x2 t; t.x = __builtin_amdgcn_rcpf(d.x); t.y = __builtin_amdgcn_rcpf(d.y);
    f32x2 q = t * 0.5307027145f + (-0.7265760135f); q = q * t + 0.7107068705f; q = q * t + (-0.142248368f); q = q * t + 0.127414796f; q = q * t;
    const f32x2 s = (v * v) * (-0.72134752044f);
    f32x2 e; e.x = __builtin_amdgcn_exp2f(s.x); e.y = __builtin_amdgcn_exp2f(s.y);
    const f32x2 m = v * (q * e), r = v - m;
    f32x2 o; o.x = v.x < 0.f ? m.x : r.x; o.y = v.y < 0.f ? m.y : r.y; return o;
}

template <int ACT  > struct EpiBf16 {
    static constexpr bool PERM = true, AFTER_DRAIN = false; static_assert(ACT == 0 || ACT == 1, "EpiBf16: ACT is 0 (none) or 1 (gelu_pk)");
    bf16_t* O; int ldc; const float* bias; int split_cols; size_t split_stride; float scale0;
    __device__ __forceinline__ void operator()(const f32x4 (&acc)[2][2][4][2], const Unit& u, int wr, int wc, int fr, int fq) const {
        const int row0 = u.pm * BM + wr * 64 + fr; int colt = u.pn * BM; bf16_t* base = O;
        float sc = 1.f; if (split_cols) { const int t = colt / split_cols; base += (size_t)t * split_stride; colt -= t * split_cols; if (t == 0) sc = scale0; }
        const int col0 = colt + wc * 32 + 8 * fq, bcol0 = u.pn * BM + wc * 32 + 8 * fq;
        f32x4 bv[2][2];
#pragma unroll
        for (int bj = 0; bj < 2; ++bj)
#pragma unroll
            for (int n = 0; n < 2; ++n) bv[bj][n] = bias ? *(const f32x4*)(bias + bcol0 + bj * HALF + 4 * n) : (f32x4){0.f, 0.f, 0.f, 0.f};
#pragma unroll
        for (int ai = 0; ai < 2; ++ai)
#pragma unroll
            for (int m = 0; m < 4; ++m) { bf16_t* rowp = base + (size_t)(row0 + ai * HALF + m * 16) * ldc + col0;
#pragma unroll
                for (int bj = 0; bj < 2; ++bj) { f32x4 v0 = acc[ai][bj][m][0] + bv[bj][0], v1 = acc[ai][bj][m][1] + bv[bj][1];
                    if (ACT == 1) { f32x2 a = gelu_pk((f32x2){v0[0], v0[1]}), b = gelu_pk((f32x2){v0[2], v0[3]}), c = gelu_pk((f32x2){v1[0], v1[1]}), d = gelu_pk((f32x2){v1[2], v1[3]});
                        v0 = (f32x4){a.x, a.y, b.x, b.y}; v1 = (f32x4){c.x, c.y, d.x, d.y}; }
                    v0 = v0 * sc; v1 = v1 * sc; u32x4 w; w.x = cvt_pk_bf16(v0[0], v0[1]); w.y = cvt_pk_bf16(v0[2], v0[3]); w.z = cvt_pk_bf16(v1[0], v1[1]); w.w = cvt_pk_bf16(v1[2], v1[3]);
                    *(u32x4*)(rowp + bj * HALF) = w; } }
    }
};
template <class Epi, class Sched, bool ALIGN_EPI = false, bool SP2 = false>
__device__ __forceinline__ void gemm_phase(PG8_LAS unsigned char* lds, const Gemm g, const Sched& S, const Epi& E) {
    int tid_o = threadIdx.x; asm volatile("" : "+v"(tid_o)); const int tid = tid_o, wid = __builtin_amdgcn_readfirstlane(tid >> 6), lane = tid & 63, wr = wid >> 2, wc = wid & 3, fr = lane & 15, fq = lane >> 4;
    const int K = g.K, nt = K / BK;
    unsigned voffA[2], voffB[2];
#pragma unroll
    for (int i = 0; i < 2; ++i) { int R, C; stage_rc(tid * 16 + i * 8192, R, C); const int Rb = Epi::PERM ? ((R & ~31) + perm32(R & 31)) : R;
        voffA[i] = (unsigned)(R * K + C) * 2u; voffB[i] = (unsigned)(Rb * K + C) * 2u; }
    const size_t kstep = (size_t)(BK * 2);
    const size_t hstep = (size_t)HALF * K * 2;
    const size_t tstep = 2 * hstep;
    const unsigned ldsw = (unsigned)wid * 1024u;
    const int aoff = lds_byte(wr * 64 + fr, fq * 8), boff = lds_byte(wc * 32 + fr, fq * 8);
#define PG8_SA(b, h) (((b) * 2 + (h)) * HTB)
#define PG8_SB(b, h) ((4 + (b) * 2 + (h)) * HTB)
#define PG8_STAGE(bufoff, gbase, voff) do { _Pragma("unroll") for (int _i = 0; _i < 2; ++_i) \
        __builtin_amdgcn_global_load_lds((const unsigned*)((const char*)(gbase) + (voff)[_i]), (PG8_LAS unsigned*)(lds + (bufoff) + ldsw + _i * 8192), 16, 0, 0); } while (0)
#define PG8_LDA(dst, b, h) do { _Pragma("unroll") for (int m = 0; m < 4; ++m) _Pragma("unroll") for (int k = 0; k < 2; ++k) dst[m][k] = *(const PG8_LAS bf16x8*)(lds + PG8_SA(b, h) + aoff + m * 2048 + k * 1024); } while (0)
#define PG8_LDB(dst, b, h) do { _Pragma("unroll") for (int n = 0; n < 2; ++n) _Pragma("unroll") for (int k = 0; k < 2; ++k) dst[n][k] = *(const PG8_LAS bf16x8*)(lds + PG8_SB(b, h) + boff + n * 2048 + k * 1024); } while (0)
#define PG8_MMA(ai, bj, At, Bt) do { __builtin_amdgcn_s_setprio(1); _Pragma("unroll") for (int m = 0; m < 4; ++m) _Pragma("unroll") for (int n = 0; n < 2; ++n) _Pragma("unroll") for (int k = 0; k < 2; ++k) \
        acc[ai][bj][m][n] = __builtin_amdgcn_mfma_f32_16x16x32_bf16(Bt[n][k], At[m][k], acc[ai][bj][m][n], 0, 0, 0); __builtin_amdgcn_s_setprio(0); } while (0)
#define PG8_WAIT_V(n) asm volatile("s_waitcnt vmcnt(" #n ")" ::: "memory")
#define PG8_WAIT_L(n) asm volatile("s_waitcnt lgkmcnt(" #n ")" ::: "memory")
#define PG8_BAR __builtin_amdgcn_s_barrier()
#define PG8_SCHED __builtin_amdgcn_sched_barrier(0)
    Unit cur, nxt; int ui = 0;
    if (!S.next(0, cur)) return;
    f32x4 acc[2][2][4][2];
#pragma unroll
    for (int a = 0; a < 2; ++a)
#pragma unroll
        for (int b = 0; b < 2; ++b)
#pragma unroll
            for (int m = 0; m < 4; ++m)
#pragma unroll
                for (int n = 0; n < 2; ++n) acc[a][b][m][n] = (f32x4){0.f, 0.f, 0.f, 0.f};
    bf16x8 At[4][2], B0[2][2], B1[2][2];
    const char* cA = (const char*)g.A + (size_t)cur.pm * tstep; const char* cB = (const char*)g.Bt + (size_t)cur.pn * tstep;
    S.a_ready(cur);
    if constexpr (SP2) {
        PG8_STAGE(PG8_SB(0, 0), cB, voffB); PG8_STAGE(PG8_SB(0, 1), cB + hstep, voffB); PG8_STAGE(PG8_SA(0, 0), cA, voffA); PG8_STAGE(PG8_SA(0, 1), cA + hstep, voffA);
        if (wr == 1) PG8_BAR;
        PG8_WAIT_V(2); PG8_BAR;
        PG8_STAGE(PG8_SB(1, 0), cB + kstep, voffB); PG8_STAGE(PG8_SA(1, 0), cA + kstep, voffA); PG8_STAGE(PG8_SB(1, 1), cB + hstep + kstep, voffB);
        PG8_WAIT_V(6); PG8_BAR;
    } else {
        PG8_STAGE(PG8_SB(0, 0), cB, voffB); PG8_STAGE(PG8_SA(0, 0), cA, voffA); PG8_STAGE(PG8_SB(0, 1), cB + hstep, voffB); PG8_STAGE(PG8_SA(0, 1), cA + hstep, voffA);
        if (wr == 1) PG8_BAR;
        PG8_WAIT_V(4); PG8_BAR;
        PG8_STAGE(PG8_SB(1, 0), cB + kstep, voffB); PG8_STAGE(PG8_SA(1, 0), cA + kstep, voffA); PG8_STAGE(PG8_SB(1, 1), cB + hstep + kstep, voffB);
        PG8_WAIT_V(6); PG8_BAR;
    }
    for (;;) {
        const bool has_next = S.next(ui + 1, nxt);
        const char* nA = has_next ? (const char*)g.A + (size_t)nxt.pm * tstep : cA; const char* nB = has_next ? (const char*)g.Bt + (size_t)nxt.pn * tstep : cB;
        for (int t = 0; t < nt; t += 2) {
            const bool last = (t == nt - 2);
            const char* a1 = cA + (size_t)(t + 1) * kstep;
            const char* a2 = last ? nA : cA + (size_t)(t + 2) * kstep; const char* b2 = last ? nB : cB + (size_t)(t + 2) * kstep;
            const char* a3 = a2 + kstep; const char* b3 = b2 + kstep;
            if (last && has_next) S.a_ready(nxt);
            if constexpr (SP2) {
            PG8_LDB(B0, 0, 0); PG8_LDB(B1, 0, 1); PG8_SCHED; PG8_LDA(At, 0, 0); PG8_STAGE(PG8_SA(1, 1), a1 + hstep, voffA);
            PG8_WAIT_V(8); PG8_WAIT_L(0); PG8_BAR; PG8_MMA(0, 0, At, B0); PG8_MMA(0, 1, At, B1); PG8_BAR; PG8_SCHED;
            PG8_LDA(At, 0, 1); PG8_STAGE(PG8_SB(0, 0), b2, voffB); PG8_STAGE(PG8_SB(0, 1), b2 + hstep, voffB); PG8_STAGE(PG8_SA(0, 0), a2, voffA);
            PG8_WAIT_V(8); PG8_WAIT_L(0); PG8_BAR; PG8_MMA(1, 0, At, B0); PG8_MMA(1, 1, At, B1); PG8_BAR; PG8_SCHED;
            PG8_LDB(B0, 1, 0); PG8_LDB(B1, 1, 1); PG8_SCHED; PG8_LDA(At, 1, 0); PG8_STAGE(PG8_SA(0, 1), a2 + hstep, voffA);
            PG8_WAIT_V(8); PG8_WAIT_L(0); PG8_BAR; PG8_MMA(0, 0, At, B0); PG8_MMA(0, 1, At, B1); PG8_BAR; PG8_SCHED;
            PG8_LDA(At, 1, 1); PG8_STAGE(PG8_SB(1, 0), b3, voffB); PG8_STAGE(PG8_SB(1, 1), b3 + hstep, voffB); PG8_STAGE(PG8_SA(1, 0), a3, voffA);
            PG8_WAIT_V(8); PG8_WAIT_L(0); PG8_BAR; PG8_MMA(1, 0, At, B0); PG8_MMA(1, 1, At, B1); PG8_BAR; PG8_SCHED;
            } else {
            PG8_LDB(B0, 0, 0); PG8_SCHED; PG8_LDA(At, 0, 0); PG8_STAGE(PG8_SA(1, 1), a1 + hstep, voffA);
            PG8_WAIT_L(8); PG8_BAR; PG8_WAIT_L(0); PG8_MMA(0, 0, At, B0); PG8_BAR; PG8_SCHED;
            PG8_LDB(B1, 0, 1); PG8_STAGE(PG8_SB(0, 0), b2, voffB);
            PG8_BAR; PG8_WAIT_L(0); PG8_MMA(0, 1, At, B1); PG8_BAR;
            PG8_LDA(At, 0, 1); PG8_STAGE(PG8_SA(0, 0), a2, voffA);
            PG8_BAR; PG8_WAIT_L(0); PG8_MMA(1, 0, At, B0); PG8_BAR; PG8_SCHED;
            PG8_STAGE(PG8_SB(0, 1), b2 + hstep, voffB);
            PG8_WAIT_V(6); PG8_BAR; PG8_MMA(1, 1, At, B1); PG8_BAR;
            PG8_LDB(B0, 1, 0); PG8_SCHED; PG8_LDA(At, 1, 0); PG8_STAGE(PG8_SA(0, 1), a2 + hstep, voffA);
            PG8_WAIT_L(8); PG8_BAR; PG8_WAIT_L(0); PG8_MMA(0, 0, At, B0); PG8_BAR; PG8_SCHED;
            PG8_LDB(B1, 1, 1); PG8_STAGE(PG8_SB(1, 0), b3, voffB);
            PG8_BAR; PG8_WAIT_L(0); PG8_MMA(0, 1, At, B1); PG8_BAR;
            PG8_LDA(At, 1, 1); PG8_STAGE(PG8_SA(1, 0), a3, voffA);
            PG8_BAR; PG8_WAIT_L(0); PG8_MMA(1, 0, At, B0); PG8_BAR; PG8_SCHED;
            PG8_STAGE(PG8_SB(1, 1), b3 + hstep, voffB);
            PG8_WAIT_V(6); PG8_BAR; PG8_MMA(1, 1, At, B1); PG8_BAR;
            }
        }
        if constexpr (ALIGN_EPI) { if (wr == 0) PG8_BAR; }
        if constexpr (!Epi::AFTER_DRAIN) { E(acc, cur, wr, wc, fr, fq); S.done(cur); }
        if (!has_next) break;
#pragma unroll
        for (int a = 0; a < 2; ++a)
#pragma unroll
            for (int b = 0; b < 2; ++b)
#pragma unroll
                for (int m = 0; m < 4; ++m)
#pragma unroll
                    for (int n = 0; n < 2; ++n) acc[a][b][m][n] = (f32x4){0.f, 0.f, 0.f, 0.f};
        cur = nxt; cA = nA; cB = nB; ++ui;
        if constexpr (ALIGN_EPI) { if (wr == 1) PG8_BAR; }
    }
    PG8_WAIT_V(0);
    if constexpr (!ALIGN_EPI) { if (wr == 0) PG8_BAR; }
    PG8_BAR;
    if constexpr (Epi::AFTER_DRAIN) { E.fused(acc, cur, wr, wc, fr, fq, lds, wid, lane); S.done(cur); }
#undef PG8_SA
#undef PG8_SB
#undef PG8_STAGE
#undef PG8_LDA
#undef PG8_LDB
#undef PG8_MMA
#undef PG8_WAIT_V
#undef PG8_WAIT_L
#undef PG8_BAR
#undef PG8_SCHED
}
}
#include <hip/hip_bf16.h>
#include <cmath>
namespace attn_body {
using bf16=__hip_bfloat16;
using bf16x8=__attribute__((ext_vector_type(8)))short;
using s16x4=__attribute__((ext_vector_type(4)))short;
using f32x16=__attribute__((ext_vector_type(16)))float;
using u32x4=__attribute__((ext_vector_type(4)))unsigned;
constexpr int D=64,QP=512,KP=512,VP=128,OP=1024;
constexpr int NW=8,QBLK=32,QB=QBLK*NW,KVBLK=64;
constexpr int ATTN_UNIT_ROWS=QB;
__device__ __forceinline__ int crow(int r,int hi){return (r&3)+8*(r>>2)+4*hi;}
#define SBAR() __builtin_amdgcn_sched_barrier(0)
__device__ __forceinline__ void cmask(f32x16&p0,f32x16&p1,int jb,int qrel,int hi){
  const float NEG=-INFINITY; int kb=64*jb+4*hi;
  #pragma unroll
  for(int r=0;r<16;++r){int kv=kb+(r&3)+8*(r>>2); if(kv>qrel)p0[r]=NEG; if(kv+32>qrel)p1[r]=NEG;}
}

constexpr int NSLOT=3, SLOTB=8192;
constexpr int LDS_K=0, LDS_V=NSLOT*SLOTB, LDS_WS=2*NSLOT*SLOTB, LDS_OST=LDS_WS+NW*64*4, LDS_BYTES=LDS_OST+NW*4096;
constexpr float C2=0.125f*1.4426950408889634f;
__device__ __forceinline__ void glds16(const void*gsrc,unsigned lds_dst){unsigned keep;
  asm volatile("s_mov_b32 %0, m0\n\ts_mov_b32 m0, %2\n\ts_nop 0\n\tglobal_load_lds_dwordx4 %1, off\n\ts_mov_b32 m0, %0":"=&s"(keep):"v"(gsrc),"s"(lds_dst):"memory");}
__device__ __forceinline__ float max3f(float a,float b,float c){float r;asm("v_max3_f32 %0, %1, %2, %3":"=v"(r):"v"(a),"v"(b),"v"(c));return r;}
__device__ __forceinline__ float max2f(float a,float b){float r;asm("v_max_f32_e32 %0, %1, %2":"=v"(r):"v"(a),"v"(b));return r;}
__device__ __forceinline__ float fadd_s(float a,float b){float r;asm("v_add_f32_e32 %0, %1, %2":"=v"(r):"v"(a),"v"(b));return r;}
__device__ __forceinline__ float fsub_s(float a,float b){float r;asm("v_sub_f32_e32 %0, %1, %2":"=v"(r):"v"(a),"v"(b));return r;}
typedef float f32x2_t __attribute__((ext_vector_type(2))); typedef __bf16 bf16x2_t __attribute__((ext_vector_type(2)));
__device__ __forceinline__ unsigned cvtpk_s(float lo,float hi){f32x2_t v={lo,hi};bf16x2_t b=__builtin_convertvector(v,bf16x2_t);return __builtin_bit_cast(unsigned,b);}
#define WAIT_BAR(N) asm volatile("s_waitcnt vmcnt(" #N ") lgkmcnt(0)\n\ts_barrier":::"memory")

__device__ __forceinline__ void qkt(f32x16&p0,f32x16&p1,const char*Kslot,const bf16x8*qr,const f32x16&negm,int r32,int hi){
  const char*kb=Kslot+hi*1024+r32*16;
  #pragma unroll
  for(int d0=0;d0<4;++d0){
    const bf16x8 b0=*reinterpret_cast<const bf16x8*>(kb+d0*2048);
    const bf16x8 b1=*reinterpret_cast<const bf16x8*>(kb+d0*2048+512);
    if(d0==0){p0=__builtin_amdgcn_mfma_f32_32x32x16_bf16(b0,qr[0],negm,0,0,0);p1=__builtin_amdgcn_mfma_f32_32x32x16_bf16(b1,qr[0],negm,0,0,0);}
    else{p0=__builtin_amdgcn_mfma_f32_32x32x16_bf16(b0,qr[d0],p0,0,0,0);p1=__builtin_amdgcn_mfma_f32_32x32x16_bf16(b1,qr[d0],p1,0,0,0);}}
}
typedef __attribute__((address_space(3))) const char* lds_cptr;
typedef short v4i16_t __attribute__((ext_vector_type(4)));
__device__ __forceinline__ void kload8(bf16x8*kf,lds_cptr kp){
  kf[0]=*(const __attribute__((address_space(3))) bf16x8*)(kp);      kf[1]=*(const __attribute__((address_space(3))) bf16x8*)(kp+512);
  kf[2]=*(const __attribute__((address_space(3))) bf16x8*)(kp+2048); kf[3]=*(const __attribute__((address_space(3))) bf16x8*)(kp+2560);
  kf[4]=*(const __attribute__((address_space(3))) bf16x8*)(kp+4096); kf[5]=*(const __attribute__((address_space(3))) bf16x8*)(kp+4608);
  kf[6]=*(const __attribute__((address_space(3))) bf16x8*)(kp+6144); kf[7]=*(const __attribute__((address_space(3))) bf16x8*)(kp+6656);
}
__device__ __forceinline__ void kload2(bf16x8*kf,lds_cptr kp,int j){ kf[2*j]=*(const __attribute__((address_space(3))) bf16x8*)(kp+j*2048); kf[2*j+1]=*(const __attribute__((address_space(3))) bf16x8*)(kp+j*2048+512); }
__device__ __forceinline__ s16x4 vtr(lds_cptr p){ return __builtin_bit_cast(s16x4,__builtin_amdgcn_ds_read_tr16_b64_v4i16((__attribute__((address_space(3))) v4i16_t*)p)); }
__device__ __forceinline__ float rowmax(const f32x16&p0,const f32x16&p1){
  float a=max3f(p0[0],p0[1],p1[0]),b=max3f(p0[2],p0[3],p1[1]);a=max3f(a,p1[2],p1[3]);
  #pragma unroll
  for(int r=4;r<16;r+=4){a=max3f(a,p0[r],p0[r+1]);b=max3f(b,p0[r+2],p0[r+3]);a=max3f(a,p1[r],p1[r+1]);b=max3f(b,p1[r+2],p1[r+3]);}
  const float m=max2f(a,b);
  auto rr=__builtin_amdgcn_permlane32_swap(__float_as_uint(m),__float_as_uint(m),false,false);
  return max2f(__uint_as_float(rr[0]),__uint_as_float(rr[1]));
}
__device__ __forceinline__ void pv(f32x16*o,int vb,bf16x8 pa0,bf16x8 pa1,bf16x8 pa2,bf16x8 pa3){
  #pragma unroll
  for(int d0=0;d0<2;++d0){s16x4 lo[4],hi[4];
    #pragma unroll
    for(int ks=0;ks<4;++ks){
      asm volatile("ds_read_b64_tr_b16 %0,%1 offset:%c2":"=&v"(lo[ks]):"v"(vb),"i"(d0*4096+ks*1024):"memory");
      asm volatile("ds_read_b64_tr_b16 %0,%1 offset:%c2":"=&v"(hi[ks]):"v"(vb),"i"(d0*4096+ks*1024+512):"memory");}
    asm volatile("s_waitcnt lgkmcnt(0)":::"memory");SBAR();
    #define PK(k) (bf16x8){lo[k][0],lo[k][1],lo[k][2],lo[k][3],hi[k][0],hi[k][1],hi[k][2],hi[k][3]}
    o[d0]=__builtin_amdgcn_mfma_f32_32x32x16_bf16(pa0,PK(0),o[d0],0,0,0);
    o[d0]=__builtin_amdgcn_mfma_f32_32x32x16_bf16(pa1,PK(1),o[d0],0,0,0);
    o[d0]=__builtin_amdgcn_mfma_f32_32x32x16_bf16(pa2,PK(2),o[d0],0,0,0);
    o[d0]=__builtin_amdgcn_mfma_f32_32x32x16_bf16(pa3,PK(3),o[d0],0,0,0);
    #undef PK
  }
}

#ifndef ATTN_STORE16
#define ATTN_STORE16(p,v) (*(u32x4*)(p)=(v))
#endif
template<int THRL> __device__ __forceinline__ void attn_unit(int rowbase_i,int S,int qb,int qcol,int kcol,int vcol,int ocol,const bf16*Q,const bf16*__restrict__ K,const bf16*__restrict__ V,bf16*O,char*shm){
  int tid_o=threadIdx.x; asm volatile("":"+v"(tid_o)); const int tid=tid_o,lane=tid&63,r32=lane&31,hi=lane>>5; const int wid=__builtin_amdgcn_readfirstlane(tid>>6);
  const long rowbase=(long)rowbase_i; const int q0=qb*QB;
  const bf16*Qw=Q+(rowbase+q0+wid*QBLK)*QP+qcol;
  const bf16*Kh=K+rowbase*KP+kcol,*Vh=V+rowbase*VP+vcol;
  const unsigned lds0=(unsigned)(uintptr_t)shm;
  float*wsf=(float*)(shm+LDS_WS)+wid*64;
  const bf16*ksrc=Kh+(long)lane*KP+wid*8;
  const bf16*vsrc=Vh+(long)(16*(wid&3)+(lane>>2))*VP+(wid>>2)*32+(lane&3)*8;
  const unsigned kdst=lds0+LDS_K+wid*1024, vdst=lds0+LDS_V+wid*1024;
  #define DMA_K(t,slot) glds16(ksrc+(long)(t)*KVBLK*KP,(unsigned)__builtin_amdgcn_readfirstlane(kdst+(slot)))
  #define DMA_V(t,slot) glds16(vsrc+(long)(t)*KVBLK*VP,(unsigned)__builtin_amdgcn_readfirstlane(vdst+(slot)))
  const int vb0=(int)(lds0+LDS_V)+((lane>>4)&1)*32+(lane&3)*8+(4*hi+((lane&15)>>2))*64;
  const char*Kbase=shm+LDS_K; bf16x8 kf[8];
  const lds_cptr shm3=(lds_cptr)shm; const lds_cptr kp0=shm3+LDS_K+hi*1024+r32*16; const lds_cptr vp0=shm3+LDS_V+((lane>>4)&1)*32+(lane&3)*8+(4*hi+((lane&15)>>2))*64;
  const int NT=S/KVBLK;
  DMA_K(0,0);DMA_V(0,0);DMA_K(1,SLOTB);
  bf16x8 qr[4];
  #pragma unroll
  for(int d0=0;d0<4;++d0)qr[d0]=*reinterpret_cast<const bf16x8*>(&Qw[(long)r32*QP+d0*16+hi*8]);
  float mhat=0.f,l_reg=0.f;f32x16 o[2];o[0]=f32x16{};o[1]=f32x16{};f32x16 negm=f32x16{};asm volatile("":"+v"(negm));
  const int qrel=wid*QBLK+r32;
  #define CMASK(P0,P1,t) do{}while(0)
  bool resc=false;
  #define START(P0,P1) do{ const float rm=rowmax(P0,P1); resc=false; \
    { const float dl=rm; mhat=fadd_s(mhat,dl); \
      _Pragma("unroll") for(int r=0;r<16;++r){P0[r]=fsub_s(P0[r],dl);P1[r]=fsub_s(P1[r],dl);} \
      _Pragma("unroll") for(int r=0;r<16;++r)negm[r]=-mhat; asm volatile("":"+v"(negm)); } \
    _Pragma("unroll") for(int r=0;r<16;++r)P0[r]=__builtin_amdgcn_exp2f(P0[r]); }while(0)
  #define RESC() do{ if(resc){ asm volatile("s_waitcnt lgkmcnt(0)":::"memory"); \
      _Pragma("unroll") for(int d_=0;d_<2;++d_) _Pragma("unroll") for(int r=0;r<16;++r)o[d_][r]*=wsf[crow(r,hi)]; } }while(0)
  f32x16 pA0,pA1,pB0,pB1;
  int sl_prev=0,sl_cur=0,sl_next=SLOTB;
  #define ROT() do{sl_prev=sl_cur;sl_cur=sl_next;sl_next=(sl_next==(NSLOT-1)*SLOTB)?0:sl_next+SLOTB;}while(0)
  DMA_K(2,2*SLOTB);
  WAIT_BAR(3);
  qkt(pA0,pA1,Kbase,qr,negm,r32,hi);asm volatile("s_nop 15\n\ts_nop 7":"+v"(pA0),"+v"(pA1));CMASK(pA0,pA1,0);
  START(pA0,pA1);
  _Pragma("unroll") for(int r=0;r<16;++r)pA1[r]=__builtin_amdgcn_exp2f(pA1[r]);
  WAIT_BAR(0);
  DMA_K(3,0);DMA_V(1,SLOTB);
  ROT();
  kload8(kf,kp0+sl_cur);
  WAIT_BAR(2);
  s16x4 vlo[8],vhi[8]; u32x4 pw0,pw1,pw2,pw3;
  #define PKW(P,B) cvtpk_s(P[B],P[B+1])
  #define PAF(k) __builtin_bit_cast(bf16x8,pw##k)
  #define VFR(i) (bf16x8){vlo[i][0],vlo[i][1],vlo[i][2],vlo[i][3],vhi[i][0],vhi[i][1],vhi[i][2],vhi[i][3]}
  #define PIN(x) asm volatile("":"+v"(x))
  #define MX3(a,b,c) __builtin_fmaxf(__builtin_fmaxf((a),(b)),(c))
  #define GAPA(MF,A0,A1,A2,A3,W0,W1,PW) do{ MF; sacc+=A0; sacc+=A1; sacc+=A2; sacc+=A3; PIN(sacc); W0; W1; PIN(PW); SBAR(); }while(0)
  #define EX(v) __builtin_amdgcn_exp2f(v)
  #define GAPB(MF,X,B) do{ MF; X[B]=EX(X[B]); X[B+1]=EX(X[B+1]); X[B+2]=EX(X[B+2]); X[B+3]=EX(X[B+3]); PIN(X); SBAR(); }while(0)
  #define VRD(i) do{ vlo[i]=vtr(vp_+(((i)>>2)*4096+((i)&3)*1024)); vhi[i]=vtr(vp_+(((i)>>2)*4096+((i)&3)*1024+512)); }while(0)
  #define KRD(G,j) do{ if(G){ kload2(kf,kp0+sl_next,j); SBAR(); } }while(0)
  #define STEP(C0,C1,P0,P1,t,GK,GV,GL) do{ SBAR(); \
    const lds_cptr vp_=vp0+sl_prev; \
    VRD(0); SBAR(); float sacc=(P0[0]+P0[1]); \
    GAPA(C0=__builtin_amdgcn_mfma_f32_32x32x16_bf16(kf[0],qr[0],negm,0,0,0), P0[2],P0[3],P0[4],P0[5],     pw0[0]=PKW(P0,0), pw0[1]=PKW(P0,2), pw0); \
    VRD(4); SBAR(); GAPA(C1=__builtin_amdgcn_mfma_f32_32x32x16_bf16(kf[1],qr[0],negm,0,0,0), P0[6],P0[7],P0[8],P0[9],     pw0[2]=PKW(P0,4), pw0[3]=PKW(P0,6), pw0); \
    VRD(1); SBAR(); GAPA(C0=__builtin_amdgcn_mfma_f32_32x32x16_bf16(kf[2],qr[1],C0,0,0,0),   P0[10],P0[11],P0[12],P0[13], pw1[0]=PKW(P0,8), pw1[1]=PKW(P0,10), pw1); \
    VRD(5); SBAR(); GAPA(C1=__builtin_amdgcn_mfma_f32_32x32x16_bf16(kf[3],qr[1],C1,0,0,0),   P0[14],P0[15],P1[0],P1[1],   pw1[2]=PKW(P0,12),pw1[3]=PKW(P0,14), pw1); \
    VRD(2); SBAR(); GAPA(C0=__builtin_amdgcn_mfma_f32_32x32x16_bf16(kf[4],qr[2],C0,0,0,0),   P1[2],P1[3],P1[4],P1[5],     pw2[0]=PKW(P1,0), pw2[1]=PKW(P1,2), pw2); \
    VRD(6); SBAR(); GAPA(C1=__builtin_amdgcn_mfma_f32_32x32x16_bf16(kf[5],qr[2],C1,0,0,0),   P1[6],P1[7],P1[8],P1[9],     pw2[2]=PKW(P1,4), pw2[3]=PKW(P1,6), pw2); \
    VRD(3); SBAR(); GAPA(C0=__builtin_amdgcn_mfma_f32_32x32x16_bf16(kf[6],qr[3],C0,0,0,0),   P1[10],P1[11],P1[12],P1[13], pw3[0]=PKW(P1,8), pw3[1]=PKW(P1,10), pw3); \
    VRD(7); SBAR(); GAPA(C1=__builtin_amdgcn_mfma_f32_32x32x16_bf16(kf[7],qr[3],C1,0,0,0),   P1[14],P1[15],0.f,0.f,       pw3[2]=PKW(P1,12),pw3[3]=PKW(P1,14), pw3); \
    l_reg+=sacc; \
    if(GK){DMA_K((t)+3,sl_cur);} if(GV){DMA_V((t)+1,sl_next);} \
    CMASK(C0,C1,t); \
    { float a=MX3(C0[0],C0[1],C1[0]),b=MX3(C0[2],C0[3],C1[1]); a=MX3(a,C1[2],C1[3]); \
      _Pragma("unroll") for(int r=4;r<16;r+=4){a=MX3(a,C0[r],C0[r+1]);b=MX3(b,C0[r+2],C0[r+3]);a=MX3(a,C1[r],C1[r+1]);b=MX3(b,C1[r+2],C1[r+3]);} \
      float rm=__builtin_fmaxf(a,b); { auto rr=__builtin_amdgcn_permlane32_swap(__float_as_uint(rm),__float_as_uint(rm),false,false); rm=__builtin_fmaxf(__uint_as_float(rr[0]),__uint_as_float(rr[1])); } \
      resc=false; \
      if(__builtin_expect(__any(rm>(float)THRL),0)){ const float dl=__builtin_fmaxf(rm,0.f); mhat+=dl; \
        _Pragma("unroll") for(int r=0;r<16;++r){C0[r]-=dl;C1[r]-=dl;} \
        _Pragma("unroll") for(int r=0;r<16;++r)negm[r]=-mhat; asm volatile("":"+v"(negm)); \
        const float f=__builtin_amdgcn_exp2f(-dl); l_reg*=f; if(hi==0)wsf[r32]=f; resc=true; } } \
    SBAR(); \
    GAPB(o[0]=__builtin_amdgcn_mfma_f32_32x32x16_bf16(PAF(0),VFR(0),o[0],0,0,0), C0,0); \
    GAPB(o[1]=__builtin_amdgcn_mfma_f32_32x32x16_bf16(PAF(0),VFR(4),o[1],0,0,0), C0,4); \
    KRD(GL,0); GAPB(o[0]=__builtin_amdgcn_mfma_f32_32x32x16_bf16(PAF(1),VFR(1),o[0],0,0,0), C0,8); \
    KRD(GL,1); GAPB(o[1]=__builtin_amdgcn_mfma_f32_32x32x16_bf16(PAF(1),VFR(5),o[1],0,0,0), C0,12); \
    KRD(GL,2); GAPB(o[0]=__builtin_amdgcn_mfma_f32_32x32x16_bf16(PAF(2),VFR(2),o[0],0,0,0), C1,0); \
    KRD(GL,3); GAPB(o[1]=__builtin_amdgcn_mfma_f32_32x32x16_bf16(PAF(2),VFR(6),o[1],0,0,0), C1,4); \
    GAPB(o[0]=__builtin_amdgcn_mfma_f32_32x32x16_bf16(PAF(3),VFR(3),o[0],0,0,0), C1,8); \
    GAPB(o[1]=__builtin_amdgcn_mfma_f32_32x32x16_bf16(PAF(3),VFR(7),o[1],0,0,0), C1,12); \
    }while(0)
  int t=1;
  #undef CMASK
  #define CMASK(P0,P1,t) do{}while(0)
  for(;t+5<NT;t+=2){
    STEP(pB0,pB1,pA0,pA1,t,true,true,true);     WAIT_BAR(2); RESC(); ROT();
    STEP(pA0,pA1,pB0,pB1,t+1,true,true,true);   WAIT_BAR(2); RESC(); ROT();
  }
  #undef CMASK
  #define CMASK(P0,P1,t) do{}while(0)
  #define ENDW(tt) do{ if((tt)+3<NT){WAIT_BAR(2);} else if((tt)+2<NT){WAIT_BAR(1);} else {WAIT_BAR(0);} }while(0)
  for(;t+1<NT;t+=2){
    STEP(pB0,pB1,pA0,pA1,t,(t+3<NT),(t+1<NT),(t+1<NT));       ENDW(t);   RESC(); ROT();
    STEP(pA0,pA1,pB0,pB1,t+1,(t+4<NT),(t+2<NT),(t+2<NT));     ENDW(t+1); RESC(); ROT();
  }
  STEP(pB0,pB1,pA0,pA1,NT-1,false,false,false); RESC();
  { float sacc=pB0[0]+pB0[1]; _Pragma("unroll") for(int r=2;r<16;++r)sacc+=pB0[r]; _Pragma("unroll") for(int r=0;r<16;++r)sacc+=pB1[r]; l_reg+=sacc;
    pw0=(u32x4){PKW(pB0,0),PKW(pB0,2),PKW(pB0,4),PKW(pB0,6)};pw1=(u32x4){PKW(pB0,8),PKW(pB0,10),PKW(pB0,12),PKW(pB0,14)};pw2=(u32x4){PKW(pB1,0),PKW(pB1,2),PKW(pB1,4),PKW(pB1,6)};pw3=(u32x4){PKW(pB1,8),PKW(pB1,10),PKW(pB1,12),PKW(pB1,14)};
    SBAR(); pv(o,vb0+sl_cur,PAF(0),PAF(1),PAF(2),PAF(3)); }
  #undef PKW
  #undef PAF
  #undef VFR
  #undef PIN
  #undef MX3
  #undef GAPA
  #undef GAPB
  #undef EX
  #undef VRD
  #undef KRD
  #undef STEP
  #undef ENDW
  {auto rr=__builtin_amdgcn_permlane32_swap(__float_as_uint(l_reg),__float_as_uint(l_reg),false,false);l_reg=__uint_as_float(rr[0])+__uint_as_float(rr[1]);}
  if(hi==0)wsf[32+r32]=l_reg;asm volatile("s_waitcnt lgkmcnt(0)":::"memory");
  float rli[16];
  #pragma unroll
  for(int r=0;r<16;++r)rli[r]=__builtin_amdgcn_rcpf(wsf[32+crow(r,hi)]);
  bf16*Ow=O+(rowbase+q0+wid*QBLK)*OP+ocol;
  { bf16*stg=(bf16*)(shm+LDS_OST)+wid*2048;
    #pragma unroll
    for(int r=0;r<16;++r){const int orow=crow(r,hi);
      #pragma unroll
      for(int d0=0;d0<2;++d0)stg[orow*64+d0*32+r32]=__float2bfloat16(o[d0][r]*rli[r]);}
    asm volatile("s_waitcnt lgkmcnt(0)":::"memory");
    #pragma unroll
    for(int i=0;i<4;++i){const int row=i*8+(lane>>3),ch=lane&7; const u32x4 v=*(const u32x4*)(stg+row*64+ch*8); ATTN_STORE16(Ow+(long)row*OP+ch*8,v);} }
  asm volatile("s_waitcnt lgkmcnt(0)\n\ts_barrier":::"memory");
  #undef DMA_K
  #undef DMA_V
  #undef CMASK
  #undef START
  #undef RESC
  #undef ROT
}
constexpr int ATTN_LDS_BYTES=LDS_BYTES;
#undef SBAR
#undef WAIT_BAR
}

#define LAS __attribute__((address_space(3)))
typedef unsigned short bf16;
typedef unsigned u32x4_t __attribute__((ext_vector_type(4)));
typedef unsigned u32x2_t __attribute__((ext_vector_type(2)));
typedef float f32x4_t __attribute__((ext_vector_type(4)));
typedef float f32x2_t __attribute__((ext_vector_type(2)));

constexpr int DM = 1024, MTOK = 49152, NSEQ = 20, DFF = 2816, NFF = 5632, NMIXP = 2560, NMIX = 2432, ZP = 1792;
constexpr int NTHR = 512;
constexpr float QSCALE = 0.125f * 1.4426950408889634f;
constexpr size_t MiB = 1u << 20;
constexpr size_t ZERO_BYTES = 8 * MiB;
constexpr size_t OFF_CTR = 0, OFF_ROPE = 32768, OFF_SS = 65536, OFF_MOD = 2 * MiB, OFF_BIAS = 4 * MiB, OFF_GV = 7 * MiB, OFF_GATE = 7 * MiB + 512 * 1024;
constexpr size_t OFF_W = 8 * MiB, W_LAYER = 40 * MiB;
constexpr size_t WO_IN = 0, WO_OUT = 22 * MiB, WO_MI = 33 * MiB, WO_MO = 38 * MiB;
constexpr size_t OFF_XN = 88 * MiB, OFF_YF = 88 * MiB, OFF_YB = 136 * MiB;
constexpr size_t OFF_HID = 184 * MiB, OFF_Z = 184 * MiB, OFF_QK = 352 * MiB, OFF_VR = 400 * MiB, OFF_OMIX = 412 * MiB, WS_END = 508 * MiB;
constexpr int LDS_BYTES = 147456, MISC_OFF = 131072;

struct KP { const float* in[31]; float* out; unsigned char* ws; };

__device__ __forceinline__ int seq_of_row(int m) { return m < 16384 ? (m >> 12) : 4 + ((m - 16384) >> 11); }
__device__ __forceinline__ int seq_start(int s) { return s < 4 ? s * 4096 : 16384 + (s - 4) * 2048; }
__device__ __forceinline__ int seq_len(int s) { return s < 4 ? 4096 : 2048; }
__device__ __forceinline__ unsigned f2bf(float f) { unsigned u = __builtin_bit_cast(unsigned, f); return (u + 0x7fffu + ((u >> 16) & 1u)) >> 16; }
__device__ __forceinline__ unsigned pk2(float lo, float hi) { return f2bf(lo) | (f2bf(hi) << 16); }
__device__ __forceinline__ float bf2f(unsigned short b) { return __builtin_bit_cast(float, (unsigned)b << 16); }
__device__ __forceinline__ float sigmoidf_(float x) { return 1.0f / (1.0f + __expf(-x)); }
__device__ __forceinline__ float wave_sum(float v) {
#pragma unroll
    for (int o = 1; o < 64; o <<= 1) v += __shfl_xor(v, o);
    return v;
}
__host__ __device__ __forceinline__ int map_ffn(int n) { const int half = n >= DFF ? 1 : 0; const int n2 = half ? n - DFF : n; return 256 * (n2 >> 7) + 128 * half + (n2 & 127); }
__host__ __device__ __forceinline__ int map_mix(int n) {
    if (n < 1792 || n >= 2304) return n;
    const int hh = (n - 1792) >> 6, d = (n - 1792) & 63;
    return 256 * (7 + (hh >> 2)) + 128 * (d >> 5) + 32 * (hh & 3) + 8 * ((d & 15) >> 2) + 4 * ((d >> 4) & 1) + (d & 3);
}

namespace pg8 {
struct EpiSwiglu {
    static constexpr bool PERM = true, AFTER_DRAIN = false;
    bf16_t* H; const float* ss; const float* bias;
    __device__ __forceinline__ void operator()(const f32x4 (&acc)[2][2][4][2], const Unit& u, int wr, int wc, int fr, int fq) const {
        const int row0 = u.pm * BM + wr * 64 + fr; const int s = seq_of_row(u.pm * BM);
        const float* bp = bias + (size_t)s * NFF + u.pn * 256 + wc * 32 + 8 * fq;
        f32x4 bg[2], bu[2];
#pragma unroll
        for (int n = 0; n < 2; ++n) { bg[n] = *(const f32x4*)(bp + 4 * n); bu[n] = *(const f32x4*)(bp + 128 + 4 * n); }
#pragma unroll
        for (int ai = 0; ai < 2; ++ai)
#pragma unroll
            for (int m = 0; m < 4; ++m) {
                const int row = row0 + ai * HALF + m * 16;
                const float rs = rsqrtf(ss[row] * (1.0f / 1024.0f) + 1e-6f);
                float h[8];
#pragma unroll
                for (int n = 0; n < 2; ++n) {
                    const f32x4 g = acc[ai][0][m][n] * rs + bg[n], up = acc[ai][1][m][n] * rs + bu[n];
#pragma unroll
                    for (int i = 0; i < 4; ++i) h[4 * n + i] = g[i] * sigmoidf_(g[i]) * up[i];
                }
                u32x4 w; w.x = cvt_pk_bf16(h[0], h[1]); w.y = cvt_pk_bf16(h[2], h[3]); w.z = cvt_pk_bf16(h[4], h[5]); w.w = cvt_pk_bf16(h[6], h[7]);
                *(u32x4*)(H + (size_t)row * DFF + u.pn * 128 + wc * 32 + 8 * fq) = w;
            }
    }
};
struct EpiZ {
    static constexpr bool PERM = true, AFTER_DRAIN = false;
    bf16_t* Z; bf16_t* QK; bf16_t* VR; const float* ss; const float* bias; const float* qg; const float* kg; const float* rope;
    __device__ __forceinline__ void operator()(const f32x4 (&acc)[2][2][4][2], const Unit& u, int wr, int wc, int fr, int fq) const {
        const int row0 = u.pm * BM + wr * 64 + fr; const int s = seq_of_row(u.pm * BM); const int t0 = row0 - seq_start(s);
        const float* bp = bias + (size_t)s * NFF + u.pn * 256 + wc * 32 + 8 * fq;
        f32x4 bv[2][2];
#pragma unroll
        for (int bj = 0; bj < 2; ++bj)
#pragma unroll
            for (int n = 0; n < 2; ++n) bv[bj][n] = *(const f32x4*)(bp + bj * 128 + 4 * n);
        if (u.pn < 7 || u.pn == 9) {
#pragma unroll
            for (int ai = 0; ai < 2; ++ai)
#pragma unroll
                for (int m = 0; m < 4; ++m) {
                    const int row = row0 + ai * HALF + m * 16;
                    const float rs = rsqrtf(ss[row] * (1.0f / 1024.0f) + 1e-6f);
#pragma unroll
                    for (int bj = 0; bj < 2; ++bj) {
                        const f32x4 v0 = acc[ai][bj][m][0] * rs + bv[bj][0], v1 = acc[ai][bj][m][1] * rs + bv[bj][1];
                        u32x4 w; w.x = cvt_pk_bf16(v0[0], v0[1]); w.y = cvt_pk_bf16(v0[2], v0[3]); w.z = cvt_pk_bf16(v1[0], v1[1]); w.w = cvt_pk_bf16(v1[2], v1[3]);
                        if (u.pn < 7) *(u32x4*)(Z + (size_t)row * ZP + u.pn * 256 + bj * 128 + wc * 32 + 8 * fq) = w;
                        else if (bj == 0) *(u32x4*)(VR + (size_t)row * 128 + wc * 32 + 8 * fq) = w;
                    }
                }
        } else {
            const int hh = (u.pn - 7) * 4 + wc; const bool isq = hh < 6; const float* gp = isq ? qg : kg; const float osc = isq ? QSCALE : 1.0f;
            f32x4 gn[2][2];
#pragma unroll
            for (int bj = 0; bj < 2; ++bj)
#pragma unroll
                for (int n = 0; n < 2; ++n) gn[bj][n] = *(const f32x4*)(gp + 32 * bj + 16 * n + 4 * fq);
#pragma unroll
            for (int ai = 0; ai < 2; ++ai)
#pragma unroll
                for (int m = 0; m < 4; ++m) {
                    const int row = row0 + ai * HALF + m * 16; const int t = t0 + ai * HALF + m * 16;
                    const float rs = rsqrtf(ss[row] * (1.0f / 1024.0f) + 1e-6f);
                    f32x4 v[2][2]; float q = 0.f;
#pragma unroll
                    for (int bj = 0; bj < 2; ++bj)
#pragma unroll
                        for (int n = 0; n < 2; ++n) { v[bj][n] = acc[ai][bj][m][n] * rs + bv[bj][n]; q += (v[bj][n][0] * v[bj][n][0] + v[bj][n][1] * v[bj][n][1]) + (v[bj][n][2] * v[bj][n][2] + v[bj][n][3] * v[bj][n][3]); }
                    q += __shfl_xor(q, 16); q += __shfl_xor(q, 32);
                    const float r = rsqrtf(q * (1.0f / 64.0f) + 1e-6f);
#pragma unroll
                    for (int bj = 0; bj < 2; ++bj) {
                        const int pos = bj == 0 ? (t >> 6) : (t & 63);
                        const f32x4 x1 = v[bj][0] * r * gn[bj][0], x2 = v[bj][1] * r * gn[bj][1];
                        const float* rp = rope + (pos * 16 + 4 * fq) * 2;
                        const f32x4 cs0 = *(const f32x4*)(rp), cs1 = *(const f32x4*)(rp + 4);
                        const float c[4] = {cs0[0], cs0[2], cs1[0], cs1[2]}, sn[4] = {cs0[1], cs0[3], cs1[1], cs1[3]};
                        float o1[4], o2[4];
#pragma unroll
                        for (int i = 0; i < 4; ++i) { o1[i] = (x1[i] * c[i] - x2[i] * sn[i]) * osc; o2[i] = (x2[i] * c[i] + x1[i] * sn[i]) * osc; }
                        u32x4 w; w.x = cvt_pk_bf16(o1[0], o1[1]); w.y = cvt_pk_bf16(o1[2], o1[3]); w.z = cvt_pk_bf16(o2[0], o2[1]); w.w = cvt_pk_bf16(o2[2], o2[3]);
                        *(u32x4*)(QK + (size_t)row * 512 + hh * 64 + 32 * bj + 8 * fq) = w;
                    }
                }
        }
    }
};
struct EpiResid {
    static constexpr bool PERM = false, AFTER_DRAIN = false;
    const float* xin_p; const float* xin_s; float* out; bf16_t* xn; float* ssn; const float* gate; const float* gvn;
    __device__ __forceinline__ void operator()(const f32x4 (&acc)[2][2][4][2], const Unit& u, int wr, int wc, int fr, int fq) const {
        const int rowt = u.pm * BM; const int s = seq_of_row(rowt);
        const float* xb = rowt < 16384 ? xin_p : xin_s - (size_t)16384 * DM;
        const int row0 = rowt + wr * 64 + fr; const int col0 = u.pn * BM + wc * 32 + 4 * fq;
        f32x4 gt[2][2];
#pragma unroll
        for (int bj = 0; bj < 2; ++bj)
#pragma unroll
            for (int n = 0; n < 2; ++n) gt[bj][n] = *(const f32x4*)(gate + (size_t)s * DM + col0 + bj * HALF + n * 16);
#pragma unroll
        for (int ai = 0; ai < 2; ++ai)
#pragma unroll
            for (int m = 0; m < 4; ++m) {
                const int row = row0 + ai * HALF + m * 16; const size_t off = (size_t)row * DM + col0; float q = 0.f;
#pragma unroll
                for (int bj = 0; bj < 2; ++bj)
#pragma unroll
                    for (int n = 0; n < 2; ++n) {
                        const f32x4 xo = *(const f32x4*)(xb + off + bj * HALF + n * 16);
                        const f32x4 val = xo + gt[bj][n] * acc[ai][bj][m][n];
                        *(f32x4*)(out + off + bj * HALF + n * 16) = val;
                        if (gvn) {
                            q += (val[0] * val[0] + val[1] * val[1]) + (val[2] * val[2] + val[3] * val[3]);
                            const f32x4 gv = *(const f32x4*)(gvn + (size_t)s * DM + col0 + bj * HALF + n * 16);
                            const f32x4 o = val * gv; unsigned long long w = (unsigned long long)cvt_pk_bf16(o[0], o[1]) | ((unsigned long long)cvt_pk_bf16(o[2], o[3]) << 32);
                            *(unsigned long long*)(xn + off + bj * HALF + n * 16) = w;
                        }
                    }
                if (gvn) { q += __shfl_xor(q, 16); q += __shfl_xor(q, 32); if (fq == 0) atomicAdd(ssn + row, q); }
            }
    }
};
}

template <int MAP> __device__ __forceinline__ void transpose_item(const float* W, int K, int N, bf16* WT, float* scr, int item, int lane) {
    const int nblk = N / 32, kb = item / nblk, nb = item % nblk, k0 = 64 * kb, n0 = 32 * nb;
#pragma unroll 8
    for (int i = 0; i < 32; ++i) { const int kk = 2 * i + (lane >> 5); scr[kk * 33 + (lane & 31)] = W[(size_t)(k0 + kk) * N + n0 + (lane & 31)]; }
    __builtin_amdgcn_wave_barrier(); asm volatile("s_waitcnt lgkmcnt(0)" ::: "memory");
    const int c = lane & 7;
#pragma unroll
    for (int j = 0; j < 4; ++j) { const int n = (lane >> 3) + 8 * j; const float* sp = scr + (8 * c) * 33 + n;
        u32x4_t o; o.x = pk2(sp[0 * 33], sp[1 * 33]); o.y = pk2(sp[2 * 33], sp[3 * 33]); o.z = pk2(sp[4 * 33], sp[5 * 33]); o.w = pk2(sp[6 * 33], sp[7 * 33]);
        const int nsrc = n0 + n; const int nd = MAP == 1 ? map_ffn(nsrc) : (MAP == 2 ? map_mix(nsrc) : nsrc);
        *(u32x4_t*)(WT + (size_t)nd * K + k0 + 8 * c) = o; }
    __builtin_amdgcn_wave_barrier(); asm volatile("s_waitcnt lgkmcnt(0)" ::: "memory");
}

template <int MODE, int MAP> __device__ __forceinline__ void smallm_unit(const KP& p, float* sA, int l, int j, const float* W, int ldw, int nvalid, float* dest, int ldd, int nchunk, int kchunk) {
    int tid_o = threadIdx.x; asm volatile("" : "+v"(tid_o)); const int tid = tid_o; const int k0 = kchunk * 128;
    __syncthreads();
    for (int e = tid; e < 128 * NSEQ; e += NTHR) {
        const int k = e / NSEQ, s = e % NSEQ; float v;
        if (MODE == 0) { const float c = s < 4 ? p.in[2][s * DM + k0 + k] : p.in[3][(s - 4) * DM + k0 + k]; v = c * sigmoidf_(c); }
        else { const float* mod = (const float*)(p.ws + OFF_MOD) + ((size_t)l * NSEQ + s) * 9216 + 3 * j * 1024 + k0 + k; v = *mod + p.in[5][l * 9216 + 3 * j * 1024 + k0 + k]; }
        sA[k * NSEQ + s] = v;
    }
    __syncthreads();
    const int n = nchunk * 256 + (tid & 255), kh = tid >> 8;
    float acc[NSEQ];
#pragma unroll
    for (int s = 0; s < NSEQ; ++s) acc[s] = 0.f;
    if (n < nvalid) {
        for (int kk = 0; kk < 64; ++kk) {
            const int k = kh * 64 + kk; const float w = W[(size_t)(k0 + k) * ldw + n];
            const f32x4_t* ap = (const f32x4_t*)(sA + k * NSEQ);
#pragma unroll
            for (int q = 0; q < 5; ++q) { const f32x4_t a = ap[q]; acc[4 * q] += a[0] * w; acc[4 * q + 1] += a[1] * w; acc[4 * q + 2] += a[2] * w; acc[4 * q + 3] += a[3] * w; }
        }
        const int nd = MAP == 1 ? map_ffn(n) : (MAP == 2 ? map_mix(n) : n);
#pragma unroll
        for (int s = 0; s < NSEQ; ++s) atomicAdd(dest + (size_t)s * ldd + nd, acc[s]);
    }
}

#define DPP_FMAC(acc, x, s, J) asm volatile("v_fmac_f32_dpp %0, %1, %2 row_newbcast:" #J " row_mask:0xf bank_mask:0xf" : "+v"(acc) : "v"(x), "v"(s))
#define DPP_FMAC_N(acc, x, s, J) asm volatile("s_nop 1\n\tv_fmac_f32_dpp %0, %1, %2 row_newbcast:" #J " row_mask:0xf bank_mask:0xf" : "+v"(acc) : "v"(x), "v"(s))
#define DPP_MUL(s, x, J) asm volatile("v_mul_f32_dpp %0, %1, %0 row_newbcast:" #J " row_mask:0xf bank_mask:0xf" : "+v"(s) : "v"(x))
#define DPP_MUL_N(s, x, J) asm volatile("s_nop 1\n\tv_mul_f32_dpp %0, %1, %0 row_newbcast:" #J " row_mask:0xf bank_mask:0xf" : "+v"(s) : "v"(x))
#define REP15(M, X) M(1, X) M(2, X) M(3, X) M(4, X) M(5, X) M(6, X) M(7, X) M(8, X) M(9, X) M(10, X) M(11, X) M(12, X) M(13, X) M(14, X) M(15, X)
__device__ __forceinline__ float row4_sum(float x) {
    auto r1 = __builtin_amdgcn_permlane16_swap(__float_as_uint(x), __float_as_uint(x), false, false); x = __uint_as_float(r1[0]) + __uint_as_float(r1[1]);
    auto r2 = __builtin_amdgcn_permlane32_swap(__float_as_uint(x), __float_as_uint(x), false, false); return __uint_as_float(r2[0]) + __uint_as_float(r2[1]);
}
__device__ __forceinline__ void rwkv_unit(const KP& p, unsigned char* lds, int l, int s, int h, int d) {
    int tid_o = threadIdx.x; asm volatile("" : "+v"(tid_o)); const int tid = tid_o, lane = tid & 63; const int wid = __builtin_amdgcn_readfirstlane(tid >> 6);
    constexpr int TB = 16;
    f32x2_t* W2 = (f32x2_t*)lds;
    float* OPS = (float*)(lds + 32768);
    float* YBUF = (float*)(lds + 32768 + 49152);
    float* PWS = (float*)(lds + 32768 + 49152 + 8192) + (wid & 3) * 768;
    const bf16* Z = (const bf16*)(p.ws + OFF_Z);
    float* Y = (float*)(p.ws + (d == 0 ? OFF_YF : OFF_YB));
    const float* mu = p.in[18] + l * 1024;
    const float* w_up = p.in[19] + ((size_t)l * 2 + d) * 64 * 256;
    const float* a_up = p.in[21] + (size_t)l * 64 * 256;
    const int S = seq_len(s), start = seq_start(s); const int NB = S / TB;
    __syncthreads();
    for (int e = tid; e < 4096; e += NTHR) { const int i = e >> 6, j = e & 63; W2[e] = (f32x2_t){w_up[i * 256 + 64 * h + j], a_up[i * 256 + 64 * h + j]}; }
    __syncthreads();
    if (wid >= 4) {
        const int pw = wid - 4;
        f32x2_t* X2 = (f32x2_t*)PWS; float* KK = PWS + 512;
        const float w0 = p.in[20][(l * 2 + d) * 256 + 64 * h + lane], a0 = p.in[22][(l * 2 + d) * 256 + 64 * h + lane];
        const float k_k = p.in[24][l * 256 + 64 * h + lane], k_a = p.in[25][l * 256 + 64 * h + lane];
        int it_t[3], it_zc[3], it_g[3], it_w[3]; f32x4_t mu0[3], mu1[3];
#pragma unroll
        for (int i = 0; i < 3; ++i) { int e = lane + 64 * i; if (e > 159) e = 159; const int t = e / 40, c = e % 40, g = c >> 3, wi = (c & 7) * 8;
            it_t[i] = t; it_g[i] = g; it_w[i] = wi; it_zc[i] = (g == 0 ? 64 * h : g == 1 ? 256 + 64 * h : g == 2 ? 512 + 64 * h : 768 + (g - 3) * 64) + wi;
            mu0[i] = *(const f32x4_t*)(mu + it_zc[i]); mu1[i] = *(const f32x4_t*)(mu + it_zc[i] + 4); }
        u32x4_t rc[3], rp[3], rn[3];
#define RW_ISSUE(b_) do { _Pragma("unroll") for (int i = 0; i < 3; ++i) { const int si = (b_) * TB + 4 * pw + it_t[i]; const int tt = d == 0 ? si : S - 1 - si; const bf16* zp = Z + (size_t)(start + tt) * ZP + 768 + it_zc[i]; \
                rc[i] = *(const u32x4_t*)zp; rp[i] = tt > 0 ? *(const u32x4_t*)(zp - ZP) : (u32x4_t){0u, 0u, 0u, 0u}; rn[i] = tt < S - 1 ? *(const u32x4_t*)(zp + ZP) : (u32x4_t){0u, 0u, 0u, 0u}; } } while (0)
#define RW_PREP(b_) do { \
            float* ops = OPS + ((b_) & 1) * (TB * 384); \
            _Pragma("unroll") for (int i = 0; i < 3; ++i) if (lane + 64 * i < 160) { \
                float fs[8]; \
                _Pragma("unroll") for (int q = 0; q < 4; ++q) { \
                    const float c0 = __builtin_bit_cast(float, rc[i][q] << 16), c1 = __builtin_bit_cast(float, rc[i][q] & 0xffff0000u); \
                    const float p0 = __builtin_bit_cast(float, rp[i][q] << 16), p1 = __builtin_bit_cast(float, rp[i][q] & 0xffff0000u); \
                    const float n0 = __builtin_bit_cast(float, rn[i][q] << 16), n1 = __builtin_bit_cast(float, rn[i][q] & 0xffff0000u); \
                    const float m0 = q < 2 ? mu0[i][2 * q] : mu1[i][2 * q - 4], m1 = q < 2 ? mu0[i][2 * q + 1] : mu1[i][2 * q - 3]; \
                    fs[2 * q] = c0 + m0 * (0.5f * (p0 + n0) - c0); fs[2 * q + 1] = c1 + m1 * (0.5f * (p1 + n1) - c1); \
                } \
                const int t = it_t[i], tl = 4 * pw + t, g = it_g[i], wi = it_w[i]; \
                if (g == 0) { *(f32x4_t*)(ops + tl * 384 + 256 + wi) = (f32x4_t){fs[0], fs[1], fs[2], fs[3]}; *(f32x4_t*)(ops + tl * 384 + 256 + wi + 4) = (f32x4_t){fs[4], fs[5], fs[6], fs[7]}; } \
                else if (g == 2) { *(f32x4_t*)(ops + tl * 384 + 320 + wi) = (f32x4_t){fs[0], fs[1], fs[2], fs[3]}; *(f32x4_t*)(ops + tl * 384 + 320 + wi + 4) = (f32x4_t){fs[4], fs[5], fs[6], fs[7]}; } \
                else if (g == 1) { *(f32x4_t*)(KK + t * 64 + wi) = (f32x4_t){fs[0], fs[1], fs[2], fs[3]}; *(f32x4_t*)(KK + t * 64 + wi + 4) = (f32x4_t){fs[4], fs[5], fs[6], fs[7]}; } \
                else if (g == 3) { _Pragma("unroll") for (int q = 0; q < 8; ++q) X2[t * 64 + wi + q].x = tanhf(fs[q]); } \
                else { _Pragma("unroll") for (int q = 0; q < 8; ++q) X2[t * 64 + wi + q].y = fs[q]; } \
            } \
            if ((b_) + 1 < NB) RW_ISSUE((b_) + 1); \
            f32x2_t acc[4]; \
            _Pragma("unroll") for (int t = 0; t < 4; ++t) acc[t] = (f32x2_t){0.f, 0.f}; \
            _Pragma("unroll 4") for (int i = 0; i < 64; i += 2) { \
                const f32x2_t wa = W2[i * 64 + lane], wb = W2[(i + 1) * 64 + lane]; \
                _Pragma("unroll") for (int t = 0; t < 4; ++t) { const f32x4_t x = *(const f32x4_t*)(X2 + t * 64 + i); acc[t] += (f32x2_t){x[0], x[1]} * wa; acc[t] += (f32x2_t){x[2], x[3]} * wb; } \
            } \
            _Pragma("unroll") for (int t = 0; t < 4; ++t) { \
                const int tl = 4 * pw + t; const float k = KK[t * 64 + lane]; const float kkv = k * k_k; \
                const float n2 = wave_sum(kkv * kkv); const float kk = kkv / fmaxf(sqrtf(n2), 1e-12f); \
                const float wdec = __expf(-0.6065306597126334f * sigmoidf_(w0 + acc[t].x)); const float a = sigmoidf_(a0 + acc[t].y); \
                float* o = ops + tl * 384 + lane; o[0] = -kk; o[64] = wdec; o[128] = kk * a; o[192] = k * (1.0f + (a - 1.0f) * k_a); \
            } } while (0)
#define RW_YFLUSH(b_) do { const float* ybp = YBUF + ((b_) & 1) * (TB * 64); \
            _Pragma("unroll") for (int t = 0; t < 4; ++t) { const int si = (b_) * TB + 4 * pw + t; const int tt = d == 0 ? si : S - 1 - si; Y[(size_t)(start + tt) * 256 + 64 * h + lane] = ybp[(4 * pw + t) * 64 + lane]; } } while (0)
        RW_ISSUE(0); RW_PREP(0);
        __syncthreads();
        for (int b = 0; b < NB; ++b) {
            if (b > 0) RW_YFLUSH(b - 1);
            if (b + 1 < NB) RW_PREP(b + 1);
            __syncthreads();
        }
        RW_YFLUSH(NB - 1);
#undef RW_ISSUE
#undef RW_PREP
#undef RW_YFLUSH
    } else {
        float st[16];
#pragma unroll
        for (int i = 0; i < 16; ++i) st[i] = 0.f;
        const int vofs = 320 + 16 * wid + (lane & 15);
        __syncthreads();
        for (int b = 0; b < NB; ++b) {
            const float* ops = OPS + (b & 1) * (TB * 384); float* yb = YBUF + (b & 1) * (TB * 64);
            float xn = ops[lane], xw = ops[64 + lane], xb = ops[128 + lane], xk = ops[192 + lane], xr = ops[256 + lane], vv = ops[vofs];
#pragma unroll 2
            for (int t = 0; t < TB; ++t) {
                const float* nx = ops + (t + 1 < TB ? t + 1 : t) * 384;
                const float nxn = nx[lane], nxw = nx[64 + lane], nxb = nx[128 + lane], nxk = nx[192 + lane], nxr = nx[256 + lane], nvv = nx[vofs];
                float sa0 = 0.f, sa1 = 0.f;
                DPP_FMAC_N(sa0, xn, st[0], 0); DPP_FMAC(sa1, xn, st[1], 1);
                DPP_FMAC(sa0, xn, st[2], 2); DPP_FMAC(sa1, xn, st[3], 3); DPP_FMAC(sa0, xn, st[4], 4); DPP_FMAC(sa1, xn, st[5], 5); DPP_FMAC(sa0, xn, st[6], 6); DPP_FMAC(sa1, xn, st[7], 7);
                DPP_FMAC(sa0, xn, st[8], 8); DPP_FMAC(sa1, xn, st[9], 9); DPP_FMAC(sa0, xn, st[10], 10); DPP_FMAC(sa1, xn, st[11], 11); DPP_FMAC(sa0, xn, st[12], 12); DPP_FMAC(sa1, xn, st[13], 13); DPP_FMAC(sa0, xn, st[14], 14); DPP_FMAC(sa1, xn, st[15], 15);
                const float sa = row4_sum(sa0 + sa1);
                DPP_MUL_N(st[0], xw, 0);
#define M_MUL(J, X) DPP_MUL(st[J], X, J);
                REP15(M_MUL, xw)
#undef M_MUL
                DPP_FMAC_N(st[0], xb, sa, 0);
#define M_FB(J, X) DPP_FMAC(st[J], X, sa, J);
                REP15(M_FB, xb)
#undef M_FB
                DPP_FMAC_N(st[0], xk, vv, 0);
#define M_FK(J, X) DPP_FMAC(st[J], X, vv, J);
                REP15(M_FK, xk)
#undef M_FK
                float y0 = 0.f, y1 = 0.f;
                DPP_FMAC_N(y0, xr, st[0], 0); DPP_FMAC(y1, xr, st[1], 1);
                DPP_FMAC(y0, xr, st[2], 2); DPP_FMAC(y1, xr, st[3], 3); DPP_FMAC(y0, xr, st[4], 4); DPP_FMAC(y1, xr, st[5], 5); DPP_FMAC(y0, xr, st[6], 6); DPP_FMAC(y1, xr, st[7], 7);
                DPP_FMAC(y0, xr, st[8], 8); DPP_FMAC(y1, xr, st[9], 9); DPP_FMAC(y0, xr, st[10], 10); DPP_FMAC(y1, xr, st[11], 11); DPP_FMAC(y0, xr, st[12], 12); DPP_FMAC(y1, xr, st[13], 13); DPP_FMAC(y0, xr, st[14], 14); DPP_FMAC(y1, xr, st[15], 15);
                const float y = row4_sum(y0 + y1);
                if (lane < 16) yb[t * 64 + 16 * wid + lane] = y;
                xn = nxn; xw = nxw; xb = nxb; xk = nxk; xr = nxr; vv = nvv;
            }
            __syncthreads();
        }
    }
}

__device__ __forceinline__ float gelu_tanh(float x) { const float u = 0.7978845608028654f * (x + 0.044715f * x * x * x); return 0.5f * x * (1.0f + tanhf(u)); }

__device__ __forceinline__ void lru_unit(const KP& p, unsigned char* lds, int l, int s, int n) {
    int tid_o = threadIdx.x; asm volatile("" : "+v"(tid_o)); const int tid = tid_o, lane = tid & 63; const int wid = __builtin_amdgcn_readfirstlane(tid >> 6);
    f32x2_t* W2 = (f32x2_t*)lds;
    float* XC = (float*)(lds + 32768);
    float* GA = XC + 4096;
    float* GX = GA + 4096;
    float* HF = GX + 4096;
    float* YG = HF + 4096;
    float* HO = YG + 4096;
    const bf16* Z = (const bf16*)(p.ws + OFF_Z);
    bf16* OM = (bf16*)(p.ws + OFF_OMIX);
    const int S = seq_len(s), start = seq_start(s); const int NB = S / 64;
    const int t_ = tid >> 3, c8 = (tid & 7) * 8;
    f32x4_t cw0[4], cw1[4];
#pragma unroll
    for (int j = 0; j < 4; ++j) { cw0[j] = *(const f32x4_t*)(p.in[11] + l * 4 * 384 + j * 384 + 64 * n + c8); cw1[j] = *(const f32x4_t*)(p.in[11] + l * 4 * 384 + j * 384 + 64 * n + c8 + 4); }
    const f32x4_t cb0 = *(const f32x4_t*)(p.in[12] + l * 384 + 64 * n + c8), cb1 = *(const f32x4_t*)(p.in[12] + l * 384 + 64 * n + c8 + 4);
    for (int d = 0; d < 2; ++d) {
        const float* wga = p.in[13] + (((size_t)l * 2 + d) * 6 + n) * 4096; const float* wgx = p.in[15] + (((size_t)l * 2 + d) * 6 + n) * 4096;
        const int cc = tid & 63;
        const float bga = p.in[14][(l * 2 + d) * 384 + 64 * n + cc], bgx = p.in[16][(l * 2 + d) * 384 + 64 * n + cc];
        const float lm = -p.in[17][(l * 2 + d) * 384 + 64 * n + cc]; const float sp8 = -8.0f * (lm > 20.f ? lm : log1pf(__expf(lm)));
        __threadfence();
        __syncthreads();
        for (int e = tid; e < 4096; e += NTHR) W2[e] = (f32x2_t){wga[e], wgx[e]};
        float hstate = 0.f;
        u32x4_t rr[4], rh, ry;
#define LRU_ISSUE(blk_) do { const int tt = d == 0 ? (blk_) * 64 + t_ : S - 1 - ((blk_) * 64 + t_); \
            _Pragma("unroll") for (int j = 0; j < 4; ++j) { const int t2 = tt - 2 + j; rr[j] = (t2 >= 0 && t2 < S) ? *(const u32x4_t*)(Z + (size_t)(start + t2) * ZP + 64 * n + c8) : (u32x4_t){0u, 0u, 0u, 0u}; } \
            if (d == 1) { rh = *(const u32x4_t*)(OM + (size_t)(start + tt) * DM + 64 * n + c8); ry = *(const u32x4_t*)(Z + (size_t)(start + tt) * ZP + 384 + 64 * n + c8); } } while (0)
        LRU_ISSUE(0);
        for (int blk = 0; blk < NB; ++blk) {
            __syncthreads();
            {
                f32x4_t x0 = cb0, x1 = cb1;
#pragma unroll
                for (int j = 0; j < 4; ++j) {
                    const f32x4_t a = (f32x4_t){__builtin_bit_cast(float, rr[j][0] << 16), __builtin_bit_cast(float, rr[j][0] & 0xffff0000u), __builtin_bit_cast(float, rr[j][1] << 16), __builtin_bit_cast(float, rr[j][1] & 0xffff0000u)};
                    const f32x4_t b = (f32x4_t){__builtin_bit_cast(float, rr[j][2] << 16), __builtin_bit_cast(float, rr[j][2] & 0xffff0000u), __builtin_bit_cast(float, rr[j][3] << 16), __builtin_bit_cast(float, rr[j][3] & 0xffff0000u)};
                    x0 += cw0[j] * a; x1 += cw1[j] * b;
                }
                *(f32x4_t*)(XC + t_ * 64 + c8) = x0; *(f32x4_t*)(XC + t_ * 64 + c8 + 4) = x1;
                if (d == 1) {
                    float hf[8], yg[8];
#pragma unroll
                    for (int q = 0; q < 4; ++q) { hf[2 * q] = __builtin_bit_cast(float, rh[q] << 16); hf[2 * q + 1] = __builtin_bit_cast(float, rh[q] & 0xffff0000u);
                        yg[2 * q] = gelu_tanh(__builtin_bit_cast(float, ry[q] << 16)); yg[2 * q + 1] = gelu_tanh(__builtin_bit_cast(float, ry[q] & 0xffff0000u)); }
                    *(f32x4_t*)(HF + t_ * 64 + c8) = (f32x4_t){hf[0], hf[1], hf[2], hf[3]}; *(f32x4_t*)(HF + t_ * 64 + c8 + 4) = (f32x4_t){hf[4], hf[5], hf[6], hf[7]};
                    *(f32x4_t*)(YG + t_ * 64 + c8) = (f32x4_t){yg[0], yg[1], yg[2], yg[3]}; *(f32x4_t*)(YG + t_ * 64 + c8 + 4) = (f32x4_t){yg[4], yg[5], yg[6], yg[7]};
                }
                if (blk + 1 < NB) LRU_ISSUE(blk + 1);
            }
            __syncthreads();
            {
                const int tg = tid >> 6; f32x2_t acc[8];
#pragma unroll
                for (int t = 0; t < 8; ++t) acc[t] = (f32x2_t){0.f, 0.f};
#pragma unroll 2
                for (int i = 0; i < 64; i += 4) {
                    const f32x2_t w0 = W2[i * 64 + cc], w1 = W2[(i + 1) * 64 + cc], w2 = W2[(i + 2) * 64 + cc], w3 = W2[(i + 3) * 64 + cc];
#pragma unroll
                    for (int t = 0; t < 8; ++t) { const f32x4_t x = *(const f32x4_t*)(XC + (tg * 8 + t) * 64 + i);
                        acc[t] += w0 * x[0]; acc[t] += w1 * x[1]; acc[t] += w2 * x[2]; acc[t] += w3 * x[3]; }
                }
#pragma unroll
                for (int t = 0; t < 8; ++t) {
                    const int e = (tg * 8 + t) * 64 + cc;
                    const float ra = sigmoidf_(acc[t].x + bga), ix = sigmoidf_(acc[t].y + bgx);
                    const float la = sp8 * ra; const float a = __expf(la); const float uu = sqrtf(-expm1f(2.0f * la)) * ix * XC[e];
                    GA[e] = a; GX[e] = uu;
                }
            }
            __syncthreads();
            if (wid == 0) {
#pragma unroll 8
                for (int t = 0; t < 64; ++t) { hstate = GA[t * 64 + lane] * hstate + GX[t * 64 + lane]; HO[t * 64 + lane] = d == 0 ? hstate : (HF[t * 64 + lane] + hstate) * YG[t * 64 + lane]; }
            }
            __syncthreads();
            {   const int tt = d == 0 ? blk * 64 + t_ : S - 1 - (blk * 64 + t_);
                const f32x4_t a = *(const f32x4_t*)(HO + t_ * 64 + c8), b = *(const f32x4_t*)(HO + t_ * 64 + c8 + 4);
                u32x4_t w; w.x = pk2(a[0], a[1]); w.y = pk2(a[2], a[3]); w.z = pk2(b[0], b[1]); w.w = pk2(b[2], b[3]);
                *(u32x4_t*)(OM + (size_t)(start + tt) * DM + 64 * n + c8) = w; }
        }
#undef LRU_ISSUE
    }
}

__device__ __forceinline__ void rwkv_post_tile(const KP& p, unsigned char* lds, int l, int tile) {
    int tid_o = threadIdx.x; asm volatile("" : "+v"(tid_o)); const int tid = tid_o, lane = tid & 63;
    float* SG = (float*)lds;
    float* GO = SG + 4096;
    const bf16* Z = (const bf16*)(p.ws + OFF_Z); bf16* OM = (bf16*)(p.ws + OFF_OMIX);
    const float* YF = (const float*)(p.ws + OFF_YF); const float* YBk = (const float*)(p.ws + OFF_YB);
    const float* mu = p.in[18] + l * 1024; const float* g_up = p.in[23] + (size_t)l * 128 * 256;
    const int m0 = tile * 32; const int s = seq_of_row(m0); const int S = seq_len(s), start = seq_start(s);
    __syncthreads();
    for (int e = tid; e < 4096; e += NTHR) {
        const int t = e >> 7, c = e & 127; const int m = m0 + t, tt = m - start; const bf16* zp = Z + (size_t)m * ZP + 768 + 896 + c;
        const float f = bf2f(zp[0]); const float pv = tt > 0 ? bf2f(zp[-ZP]) : 0.f; const float nx = tt < S - 1 ? bf2f(zp[ZP]) : 0.f;
        SG[e] = sigmoidf_(f + mu[896 + c] * (0.5f * (pv + nx) - f));
    }
    __syncthreads();
    const int c = tid & 255, tg = tid >> 8;
    {
        float acc[16];
#pragma unroll
        for (int t = 0; t < 16; ++t) acc[t] = 0.f;
        for (int i = 0; i < 128; ++i) { const float w = g_up[i * 256 + c];
#pragma unroll
            for (int t = 0; t < 16; ++t) acc[t] += SG[(tg * 16 + t) * 128 + i] * w; }
#pragma unroll
        for (int t = 0; t < 16; ++t) GO[(tg * 16 + t) * 256 + c] = acc[t];
    }
    const float rk = p.in[26][l * 256 + c], lg = p.in[27][l * 256 + c], lb = p.in[28][l * 256 + c];
    const float mr = mu[c], mk = mu[256 + c], mv = mu[512 + c];
    for (int t = 0; t < 16; ++t) {
        const int m = m0 + tg * 16 + t, tt = m - start; const bf16* zp = Z + (size_t)m * ZP + 768 + c;
        const bool hp = tt > 0, hn = tt < S - 1;
        float f = bf2f(zp[0]), pv = hp ? bf2f(zp[-ZP]) : 0.f, nx = hn ? bf2f(zp[ZP]) : 0.f; const float r = f + mr * (0.5f * (pv + nx) - f);
        f = bf2f(zp[256]); pv = hp ? bf2f(zp[256 - ZP]) : 0.f; nx = hn ? bf2f(zp[256 + ZP]) : 0.f; const float k = f + mk * (0.5f * (pv + nx) - f);
        f = bf2f(zp[512]); pv = hp ? bf2f(zp[512 - ZP]) : 0.f; nx = hn ? bf2f(zp[512 + ZP]) : 0.f; const float v = f + mv * (0.5f * (pv + nx) - f);
        const float y = YF[(size_t)m * 256 + c] + YBk[(size_t)m * 256 + c];
        const float mean = wave_sum(y) * (1.0f / 64.0f); const float dv = y - mean; const float var = wave_sum(dv * dv) * (1.0f / 64.0f);
        const float yn = dv * rsqrtf(var + 64e-5f) * lg + lb;
        const float bon = wave_sum(r * k * rk);
        const float outv = (yn + bon * v) * GO[(tg * 16 + t) * 256 + c];
        OM[(size_t)m * DM + 384 + c] = (bf16)f2bf(outv);
    }
    (void)lane;
}

__global__ void __launch_bounds__(NTHR, 2) fwd_megakernel(KP p) {
    extern __shared__ __attribute__((aligned(16))) unsigned char lds[];
    cg::grid_group grid = cg::this_grid();
    const int tid = threadIdx.x, lane = tid & 63, wid = tid >> 6;
    const int G = gridDim.x, bx = blockIdx.x;
    const int gw = bx * 8 + wid, NGW = G * 8;
    unsigned char* ws = p.ws;
    volatile int* misc = (volatile int*)(lds + MISC_OFF);
    PG8_LAS unsigned char* ldsg = (PG8_LAS unsigned char*)lds;

    {
        float* scr = (float*)(lds + wid * 16384);
        for (int l = 0; l < 2; ++l) {
            unsigned char* wl = ws + OFF_W + l * W_LAYER;
            constexpr int I_IN = 16 * 176, I_OUT = 44 * 32, I_MI = 16 * 76, I_MO = 16 * 32, I_TOT = 2 * I_IN + 2 * I_OUT + I_MI + I_MO;
            for (int it = gw; it < I_TOT; it += NGW) {
                int r = it;
                if (r < 2 * I_IN) { const int f = r / I_IN; transpose_item<1>(p.in[7] + ((size_t)l * 2 + f) * DM * NFF, DM, NFF, (bf16*)(wl + WO_IN + f * 11 * MiB), scr, r % I_IN, lane); continue; } r -= 2 * I_IN;
                if (r < 2 * I_OUT) { const int f = r / I_OUT; transpose_item<0>(p.in[8] + ((size_t)l * 2 + f) * DFF * DM, DFF, DM, (bf16*)(wl + WO_OUT + f * (11 * MiB / 2)), scr, r % I_OUT, lane); continue; } r -= 2 * I_OUT;
                if (r < I_MI) { transpose_item<2>(p.in[9] + (size_t)l * DM * NMIX, DM, NMIX, (bf16*)(wl + WO_MI), scr, r, lane); continue; } r -= I_MI;
                transpose_item<0>(p.in[10] + (size_t)l * DM * DM, DM, DM, (bf16*)(wl + WO_MO), scr, r, lane);
            }
            u32x4_t* padp = (u32x4_t*)(wl + WO_MI + (size_t)NMIX * DM * 2);
            for (int e = bx * NTHR + tid; e < 128 * DM * 2 / 16; e += G * NTHR) padp[e] = (u32x4_t){0u, 0u, 0u, 0u};
        }
        __syncthreads();
        for (int u = bx; u < 2 * 36 * 8; u += G) { const int l = u / 288, r = u % 288;
            smallm_unit<0, 0>(p, (float*)lds, l, 0, p.in[4] + (size_t)l * DM * 9216, 9216, 9216, (float*)(ws + OFF_MOD) + (size_t)l * NSEQ * 9216, 9216, r / 8, r % 8); }
        if (bx == 0) { float* rope = (float*)(ws + OFF_ROPE);
            for (int e = tid; e < 1024; e += NTHR) { const int pos = e >> 4, pp = e & 15; const float inv = exp2f(-(float)pp * (13.287712379549449f / 16.0f)); const float a = (float)pos * inv; const float kr = rintf(a * 0.15915494309189535f); float rr = fmaf(-kr, 6.2831854820251465f, a); rr = fmaf(-kr, -1.7484555e-7f, rr); rope[2 * e] = __cosf(rr); rope[2 * e + 1] = __sinf(rr); } }
    }
    grid.sync();
    {
        const float* MOD = (const float*)(ws + OFF_MOD); float* GV = (float*)(ws + OFF_GV); float* GT = (float*)(ws + OFF_GATE);
        for (int e = bx * NTHR + tid; e < 6 * NSEQ * DM; e += G * NTHR) {
            const int c = e & 1023, s = (e >> 10) % NSEQ, inst = e / (NSEQ * DM); const int l = inst / 3, j = inst % 3;
            const float* mr = MOD + ((size_t)l * NSEQ + s) * 9216; const float* ba = p.in[5] + l * 9216;
            const float sc = mr[(3 * j + 1) * 1024 + c] + ba[(3 * j + 1) * 1024 + c], gg = mr[(3 * j + 2) * 1024 + c] + ba[(3 * j + 2) * 1024 + c];
            GV[e] = p.in[6][(l * 3 + j) * DM + c] * (1.0f + sc); GT[e] = (j == 1 ? 1.0f : 0.5f) * gg;
        }
        for (int u = bx; u < 2 * 432; u += G) { const int l = u / 432, r = u % 432; float* bdst = (float*)(ws + OFF_BIAS);
            if (r < 176) smallm_unit<1, 1>(p, (float*)lds, l, 0, p.in[7] + ((size_t)l * 2 + 0) * DM * NFF, NFF, NFF, bdst + (size_t)(l * 3 + 0) * NSEQ * NFF, NFF, r / 8, r % 8);
            else if (r < 256) smallm_unit<1, 2>(p, (float*)lds, l, 1, p.in[9] + (size_t)l * DM * NMIX, NMIX, NMIX, bdst + (size_t)(l * 3 + 1) * NSEQ * NFF, NFF, (r - 176) / 8, (r - 176) % 8);
            else smallm_unit<1, 1>(p, (float*)lds, l, 2, p.in[7] + ((size_t)l * 2 + 1) * DM * NFF, NFF, NFF, bdst + (size_t)(l * 3 + 2) * NSEQ * NFF, NFF, (r - 256) / 8, (r - 256) % 8); }
        bf16* XN = (bf16*)(ws + OFF_XN); float* SS0 = (float*)(ws + OFF_SS);
        for (int m = gw; m < MTOK; m += NGW) {
            const int s = seq_of_row(m); const float* xr = m < 16384 ? p.in[0] + (size_t)m * DM : p.in[1] + (size_t)(m - 16384) * DM;
            const float* mr = MOD + (size_t)s * 9216 + 1024; const float* ba = p.in[5] + 1024; const float* ng = p.in[6];
            float q = 0.f;
#pragma unroll
            for (int j = 0; j < 4; ++j) { const int c = 4 * lane + 256 * j; const f32x4_t v = *(const f32x4_t*)(xr + c); const f32x4_t sc = *(const f32x4_t*)(mr + c) + *(const f32x4_t*)(ba + c); const f32x4_t g = *(const f32x4_t*)(ng + c) * (sc + 1.0f);
                q += (v[0] * v[0] + v[1] * v[1]) + (v[2] * v[2] + v[3] * v[3]); const f32x4_t o = v * g;
                *(unsigned long long*)(XN + (size_t)m * DM + c) = (unsigned long long)pk2(o[0], o[1]) | ((unsigned long long)pk2(o[2], o[3]) << 32); }
            q = wave_sum(q); if (lane == 0) SS0[m] = q;
        }
    }
    grid.sync();

    for (int l = 0; l < 2; ++l) {
        unsigned char* wl = ws + OFF_W + l * W_LAYER;
        const float* GV = (const float*)(ws + OFF_GV); const float* GT = (const float*)(ws + OFF_GATE); const float* BI = (const float*)(ws + OFF_BIAS); float* SS = (float*)(ws + OFF_SS);
        bf16* XN = (bf16*)(ws + OFF_XN); bf16* HID = (bf16*)(ws + OFF_HID); bf16* OMIX = (bf16*)(ws + OFF_OMIX);
        for (int f = 0; f < 2; ++f) {
            const int j = f == 0 ? 0 : 2; const int inst = l * 3 + j;
            if (f == 1) {
                {
                    pg8::Gemm g{XN, (const pg8::bf16_t*)(wl + WO_MI), MTOK, NMIXP, DM}; pg8::StaticOrder S; S.init(MTOK, NMIXP, G, bx);
                    pg8::EpiZ E{(bf16*)(ws + OFF_Z), (bf16*)(ws + OFF_QK), (bf16*)(ws + OFF_VR), SS + (size_t)(l * 3 + 1) * MTOK, BI + (size_t)(l * 3 + 1) * NSEQ * NFF, p.in[29] + l * 64, p.in[30] + l * 64, (const float*)(ws + OFF_ROPE)};
                    pg8::gemm_phase<pg8::EpiZ, pg8::StaticOrder, true, true>(ldsg, g, S, E);
                }
                grid.sync();
                {
                    unsigned* ctr = (unsigned*)(ws + OFF_CTR) + 64 * l;
                    constexpr int NU_R = 160, NU_L = 120, NU_A = 1152, NU = NU_R + NU_L + NU_A;
                    for (;;) {
                        __syncthreads(); if (tid == 0) misc[0] = (int)atomicAdd(ctr, 1u); __syncthreads();
                        const int u = misc[0]; if (u >= NU) break;
                        if (u < 32) rwkv_unit(p, lds, l, u >> 3, (u >> 1) & 3, u & 1);
                        else if (u < 160) { const int i2 = u - 32; rwkv_unit(p, lds, l, 4 + (i2 >> 3), (i2 >> 1) & 3, i2 & 1); }
                        else if (u < 184) { const int i3 = u - 160; lru_unit(p, lds, l, i3 / 6, i3 % 6); }
                        else if (u < 280) { const int i4 = u - 184; lru_unit(p, lds, l, 4 + i4 / 6, i4 % 6); }
                        else { const int i5 = u - 280; int s_, hq, qb;
                            if (i5 < 384) { s_ = i5 / 96; const int r = i5 % 96; hq = (r / 48) * 3 + (r % 48) / 16; qb = r & 15; }
                            else { const int i6 = i5 - 384; s_ = 4 + i6 / 48; const int r = i6 % 48; hq = (r / 24) * 3 + (r % 24) / 8; qb = r & 7; }
                            const int g_ = hq / 3;
                            attn_body::attn_unit<8>(seq_start(s_), seq_len(s_), qb, 64 * hq, 384 + 64 * g_, 64 * g_, 640 + 64 * hq, (const attn_body::bf16*)(ws + OFF_QK), (const attn_body::bf16*)(ws + OFF_QK), (const attn_body::bf16*)(ws + OFF_VR), (attn_body::bf16*)(ws + OFF_OMIX), (char*)lds); }
                    }
                }
                grid.sync();
                for (int t = bx; t < MTOK / 32; t += G) rwkv_post_tile(p, lds, l, t);
                grid.sync();
                {
                    pg8::Gemm g{OMIX, (const pg8::bf16_t*)(wl + WO_MO), MTOK, DM, DM}; pg8::StaticOrder S; S.init(MTOK, DM, G, bx);
                    pg8::EpiResid E{p.out, p.out + (size_t)16384 * DM, p.out, XN, SS + (size_t)(l * 3 + 2) * MTOK, GT + (size_t)(l * 3 + 1) * NSEQ * DM, GV + (size_t)(l * 3 + 2) * NSEQ * DM};
                    pg8::gemm_phase<pg8::EpiResid, pg8::StaticOrder, true, true>(ldsg, g, S, E);
                }
                grid.sync();
            }
            {
                pg8::Gemm g{XN, (const pg8::bf16_t*)(wl + WO_IN + f * 11 * MiB), MTOK, NFF, DM}; pg8::StaticOrder S; S.init(MTOK, NFF, G, bx);
                pg8::EpiSwiglu E{HID, SS + (size_t)inst * MTOK, BI + (size_t)inst * NSEQ * NFF};
                pg8::gemm_phase<pg8::EpiSwiglu, pg8::StaticOrder, true, true>(ldsg, g, S, E);
            }
            grid.sync();
            {
                const bool first = (l == 0 && f == 0), last = (l == 1 && f == 1);
                const int ninst = inst + 1;
                pg8::Gemm g{HID, (const pg8::bf16_t*)(wl + WO_OUT + f * (11 * MiB / 2)), MTOK, DM, DFF}; pg8::StaticOrder S; S.init(MTOK, DM, G, bx);
                pg8::EpiResid E{first ? p.in[0] : p.out, first ? p.in[1] : p.out + (size_t)16384 * DM, p.out, XN, last ? nullptr : SS + (size_t)ninst * MTOK, GT + (size_t)inst * NSEQ * DM, last ? nullptr : GV + (size_t)ninst * NSEQ * DM};
                pg8::gemm_phase<pg8::EpiResid, pg8::StaticOrder, true, true>(ldsg, g, S, E);
            }
            if (!(l == 1 && f == 1)) grid.sync();
        }
    }
}

extern "C" void kernel_launch(void* const* d_in, const int* in_sizes, int n_in, void* d_out, int out_size, void* d_ws, size_t ws_size, hipStream_t stream) {
    static int grid = 0;
    if (grid == 0) {
        if (n_in != 31 || ws_size < WS_END) { fprintf(stderr, "kernel_launch: unexpected n_in %d / ws %zu\n", n_in, ws_size); grid = -1; return; }
        int dev = 0, cus = 0, per_cu = 0;
        hipGetDevice(&dev); hipDeviceGetAttribute(&cus, hipDeviceAttributeMultiprocessorCount, dev);
        hipFuncSetAttribute((const void*)fwd_megakernel, hipFuncAttributeMaxDynamicSharedMemorySize, LDS_BYTES);
        hipOccupancyMaxActiveBlocksPerMultiprocessor(&per_cu, (const void*)fwd_megakernel, NTHR, LDS_BYTES);
        if (per_cu < 1) per_cu = 1;
        grid = cus * per_cu;
        (void)hipGetLastError();
    }
    if (grid < 0) return;
    hipMemsetAsync(d_ws, 0, ZERO_BYTES, stream);
    KP p{};
    for (int i = 0; i < 31; ++i) p.in[i] = (const float*)d_in[i];
    p.out = (float*)d_out; p.ws = (unsigned char*)d_ws;
    void* args[] = {&p};
    hipError_t e = hipLaunchCooperativeKernel((const void*)fwd_megakernel, dim3(grid), dim3(NTHR), args, LDS_BYTES, stream);
    if (e != hipSuccess) fprintf(stderr, "cooperative launch failed: %s (grid %d)\n", hipGetErrorString(e), grid);
}
```

```cpp
#include <hip/hip_runtime.h>
#include <hip/hip_cooperative_groups.h>
#include <cstdio>
#include <cstdint>
namespace cg = cooperative_groups;
namespace pg8 {
#define PG8_LAS __attribute__((address_space(3)))
typedef unsigned short bf16_t;
typedef short bf16x8 __attribute__((ext_vector_type(8)));
typedef float f32x4 __attribute__((ext_vector_type(4)));
typedef unsigned u32x4 __attribute__((ext_vector_type(4)));
constexpr int BM = 256, BK = 64, HALF = 128, HTB = HALF * BK * 2  , STAGE_BYTES = 8 * HTB, NXCD = 8, WGM = 8;

__host__ __device__ __forceinline__ int lds_byte(int r, int c) { const int st = (r >> 4) * 2 + (c >> 5), rr = r & 15, cc = c & 31, ob = rr * 64 + cc * 2; return st * 1024 + (ob ^ (((ob >> 9) & 1) << 5)); }
__host__ __device__ __forceinline__ void stage_rc(int b, int& R, int& C) { const int st = b / 1024, sb = b % 1024, swz = sb ^ (((sb >> 9) & 1) << 5); R = (st >> 1) * 16 + swz / 64; C = (st & 1) * 32 + (swz % 64) / 2; }
__host__ __device__ __forceinline__ int perm32(int rho) { const int n = rho >> 4, i = rho & 15; return 8 * (i >> 2) + 4 * n + (i & 3); }

struct Unit { int pm, pn; };
struct Gemm { const bf16_t* A; const bf16_t* Bt; int M, N, K; };

struct StaticOrder {
    int nM, nN, nwg, G, c;
    __host__ __device__ void init(int M, int N, int G_, int c_) { nM = M / BM; nN = N / BM; nwg = nM * nN; G = G_; c = c_; }
    __host__ __device__ bool next(int i, Unit& u) const {
        const long L = (long)i * G + c; if (L >= nwg) return false;
        int wgid = (int)L; { const int q = nwg / NXCD, r = nwg % NXCD, xcd = wgid % NXCD, off = wgid / NXCD; wgid = (xcd < r ? xcd * (q + 1) : r * (q + 1) + (xcd - r) * q) + off; }
        const int nig = WGM * nN, gid = wgid / nig, fm = gid * WGM, gsz = (nM - fm) < WGM ? (nM - fm) : WGM;
        u.pm = fm + ((wgid % nig) % gsz); u.pn = (wgid % nig) / gsz; return true;
    }
    __device__ __forceinline__ void a_ready(const Unit&) const {}
    __device__ __forceinline__ void done(const Unit&) const {}
};

__device__ __forceinline__ unsigned cvt_pk_bf16(float lo, float hi) { unsigned r; asm volatile("v_cvt_pk_bf16_f32 %0, %1, %2" : "=v"(r) : "v"(lo), "v"(hi)); return r; }
typedef float f32x2 __attribute__((ext_vector_type(2)));
__device__ __forceinline__ f32x2 gelu_pk(f32x2 v) {
    const f32x2 av = __builtin_elementwise_abs(v), d = av * 0.2316418882f + 1.0f;
    f32x2 t; t.x = __builtin_amdgcn_rcpf(d.x); t.y = __builtin_amdgcn_rcpf(d.y);
    f32x2 q = t * 0.5307027145f + (-0.7265760135f); q = q * t + 0.7107068705f; q = q * t + (-0.142248368f); q = q * t + 0.127414796f; q = q * t;
    const f32x2 s = (v * v) * (-0.72134752044f);
    f32x2 e; e.x = __builtin_amdgcn_exp2f(s.x); e.y = __builtin_amdgcn_exp2f(s.y);
    const f32x2 m = v * (q * e), r = v - m;
    f32x2 o; o.x = v.x < 0.f ? m.x : r.x; o.y = v.y < 0.f ? m.y : r.y; return o;
}

template <int ACT  > struct EpiBf16 {
    static constexpr bool PERM = true, AFTER_DRAIN = false; static_assert(ACT == 0 || ACT == 1, "EpiBf16: ACT is 0 (none) or 1 (gelu_pk)");
    bf16_t* O; int ldc; const float* bias; int split_cols; size_t split_stride; float scale0;
    __device__ __forceinline__ void operator()(const f32x4 (&acc)[2][2][4][2], const Unit& u, int wr, int wc, int fr, int fq) const {
        const int row0 = u.pm * BM + wr * 64 + fr; int colt = u.pn * BM; bf16_t* base = O;
        float sc = 1.f; if (split_cols) { const int t = colt / split_cols; base += (size_t)t * split_stride; colt -= t * split_cols; if (t == 0) sc = scale0; }
        const int col0 = colt + wc * 32 + 8 * fq, bcol0 = u.pn * BM + wc * 32 + 8 * fq;
        f32x4 bv[2][2];
#pragma unroll
        for (int bj = 0; bj < 2; ++bj)
#pragma unroll
            for (int n = 0; n < 2; ++n) bv[bj][n] = bias ? *(const f32x4*)(bias + bcol0 + bj * HALF + 4 * n) : (f32x4){0.f, 0.f, 0.f, 0.f};
#pragma unroll
        for (int ai = 0; ai < 2; ++ai)
#pragma unroll
            for (int m = 0; m < 4; ++m) { bf16_t* rowp = base + (size_t)(row0 + ai * HALF + m * 16) * ldc + col0;
#pragma unroll
                for (int bj = 0; bj < 2; ++bj) { f32x4 v0 = acc[ai][bj][m][0] + bv[bj][0], v1 = acc[ai][bj][m][1] + bv[bj][1];
                    if (ACT == 1) { f32x2 a = gelu_pk((f32x2){v0[0], v0[1]}), b = gelu_pk((f32x2){v0[2], v0[3]}), c = gelu_pk((f32x2){v1[0], v1[1]}), d = gelu_pk((f32x2){v1[2], v1[3]});
                        v0 = (f32x4){a.x, a.y, b.x, b.y}; v1 = (f32x4){c.x, c.y, d.x, d.y}; }
                    v0 = v0 * sc; v1 = v1 * sc; u32x4 w; w.x = cvt_pk_bf16(v0[0], v0[1]); w.y = cvt_pk_bf16(v0[2], v0[3]); w.z = cvt_pk_bf16(v1[0], v1[1]); w.w = cvt_pk_bf16(v1[2], v1[3]);
                    *(u32x4*)(rowp + bj * HALF) = w; } }
    }
};
template <class Epi, class Sched, bool ALIGN_EPI = false, bool SP2 = false>
__device__ __forceinline__ void gemm_phase(PG8_LAS unsigned char* lds, const Gemm g, const Sched& S, const Epi& E) {
    int tid_o = threadIdx.x; asm volatile("" : "+v"(tid_o)); const int tid = tid_o, wid = __builtin_amdgcn_readfirstlane(tid >> 6), lane = tid & 63, wr = wid >> 2, wc = wid & 3, fr = lane & 15, fq = lane >> 4;
    const int K = g.K, nt = K / BK;
    unsigned voffA[2], voffB[2];
#pragma unroll
    for (int i = 0; i < 2; ++i) { int R, C; stage_rc(tid * 16 + i * 8192, R, C); const int Rb = Epi::PERM ? ((R & ~31) + perm32(R & 31)) : R;
        voffA[i] = (unsigned)(R * K + C) * 2u; voffB[i] = (unsigned)(Rb * K + C) * 2u; }
    const size_t kstep = (size_t)(BK * 2);
    const size_t hstep = (size_t)HALF * K * 2;
    const size_t tstep = 2 * hstep;
    const unsigned ldsw = (unsigned)wid * 1024u;
    const int aoff = lds_byte(wr * 64 + fr, fq * 8), boff = lds_byte(wc * 32 + fr, fq * 8);
#define PG8_SA(b, h) (((b) * 2 + (h)) * HTB)
#define PG8_SB(b, h) ((4 + (b) * 2 + (h)) * HTB)
#define PG8_STAGE(bufoff, gbase, voff) do { _Pragma("unroll") for (int _i = 0; _i < 2; ++_i) \
        __builtin_amdgcn_global_load_lds((const unsigned*)((const char*)(gbase) + (voff)[_i]), (PG8_LAS unsigned*)(lds + (bufoff) + ldsw + _i * 8192), 16, 0, 0); } while (0)
#define PG8_LDA(dst, b, h) do { _Pragma("unroll") for (int m = 0; m < 4; ++m) _Pragma("unroll") for (int k = 0; k < 2; ++k) dst[m][k] = *(const PG8_LAS bf16x8*)(lds + PG8_SA(b, h) + aoff + m * 2048 + k * 1024); } while (0)
#define PG8_LDB(dst, b, h) do { _Pragma("unroll") for (int n = 0; n < 2; ++n) _Pragma("unroll") for (int k = 0; k < 2; ++k) dst[n][k] = *(const PG8_LAS bf16x8*)(lds + PG8_SB(b, h) + boff + n * 2048 + k * 1024); } while (0)
#define PG8_MMA(ai, bj, At, Bt) do { __builtin_amdgcn_s_setprio(1); _Pragma("unroll") for (int m = 0; m < 4; ++m) _Pragma("unroll") for (int n = 0; n < 2; ++n) _Pragma("unroll") for (int k = 0; k < 2; ++k) \
        acc[ai][bj][m][n] = __builtin_amdgcn_mfma_f32_16x16x32_bf16(Bt[n][k], At[m][k], acc[ai][bj][m][n], 0, 0, 0); __builtin_amdgcn_s_setprio(0); } while (0)
#define PG8_WAIT_V(n) asm volatile("s_waitcnt vmcnt(" #n ")" ::: "memory")
#define PG8_WAIT_L(n) asm volatile("s_waitcnt lgkmcnt(" #n ")" ::: "memory")
#define PG8_BAR __builtin_amdgcn_s_barrier()
#define PG8_SCHED __builtin_amdgcn_sched_barrier(0)
    Unit cur, nxt; int ui = 0;
    if (!S.next(0, cur)) return;
    f32x4 acc[2][2][4][2];
#pragma unroll
    for (int a = 0; a < 2; ++a)
#pragma unroll
        for (int b = 0; b < 2; ++b)
#pragma unroll
            for (int m = 0; m < 4; ++m)
#pragma unroll
                for (int n = 0; n < 2; ++n) acc[a][b][m][n] = (f32x4){0.f, 0.f, 0.f, 0.f};
    bf16x8 At[4][2], B0[2][2], B1[2][2];
    const char* cA = (const char*)g.A + (size_t)cur.pm * tstep; const char* cB = (const char*)g.Bt + (size_t)cur.pn * tstep;
    S.a_ready(cur);
    if constexpr (SP2) {
        PG8_STAGE(PG8_SB(0, 0), cB, voffB); PG8_STAGE(PG8_SB(0, 1), cB + hstep, voffB); PG8_STAGE(PG8_SA(0, 0), cA, voffA); PG8_STAGE(PG8_SA(0, 1), cA + hstep, voffA);
        if (wr == 1) PG8_BAR;
        PG8_WAIT_V(2); PG8_BAR;
        PG8_STAGE(PG8_SB(1, 0), cB + kstep, voffB); PG8_STAGE(PG8_SA(1, 0), cA + kstep, voffA); PG8_STAGE(PG8_SB(1, 1), cB + hstep + kstep, voffB);
        PG8_WAIT_V(6); PG8_BAR;
    } else {
        PG8_STAGE(PG8_SB(0, 0), cB, voffB); PG8_STAGE(PG8_SA(0, 0), cA, voffA); PG8_STAGE(PG8_SB(0, 1), cB + hstep, voffB); PG8_STAGE(PG8_SA(0, 1), cA + hstep, voffA);
        if (wr == 1) PG8_BAR;
        PG8_WAIT_V(4); PG8_BAR;
        PG8_STAGE(PG8_SB(1, 0), cB + kstep, voffB); PG8_STAGE(PG8_SA(1, 0), cA + kstep, voffA); PG8_STAGE(PG8_SB(1, 1), cB + hstep + kstep, voffB);
        PG8_WAIT_V(6); PG8_BAR;
    }
    for (;;) {
        const bool has_next = S.next(ui + 1, nxt);
        const char* nA = has_next ? (const char*)g.A + (size_t)nxt.pm * tstep : cA; const char* nB = has_next ? (const char*)g.Bt + (size_t)nxt.pn * tstep : cB;
        for (int t = 0; t < nt; t += 2) {
            const bool last = (t == nt - 2);
            const char* a1 = cA + (size_t)(t + 1) * kstep;
            const char* a2 = last ? nA : cA + (size_t)(t + 2) * kstep; const char* b2 = last ? nB : cB + (size_t)(t + 2) * kstep;
            const char* a3 = a2 + kstep; const char* b3 = b2 + kstep;
            if (last && has_next) S.a_ready(nxt);
            if constexpr (SP2) {
            PG8_LDB(B0, 0, 0); PG8_LDB(B1, 0, 1); PG8_SCHED; PG8_LDA(At, 0, 0); PG8_STAGE(PG8_SA(1, 1), a1 + hstep, voffA);
            PG8_WAIT_V(8); PG8_WAIT_L(0); PG8_BAR; PG8_MMA(0, 0, At, B0); PG8_MMA(0, 1, At, B1); PG8_BAR; PG8_SCHED;
            PG8_LDA(At, 0, 1); PG8_STAGE(PG8_SB(0, 0), b2, voffB); PG8_STAGE(PG8_SB(0, 1), b2 + hstep, voffB); PG8_STAGE(PG8_SA(0, 0), a2, voffA);
            PG8_WAIT_V(8); PG8_WAIT_L(0); PG8_BAR; PG8_MMA(1, 0, At, B0); PG8_MMA(1, 1, At, B1); PG8_BAR; PG8_SCHED;
            PG8_LDB(B0, 1, 0); PG8_LDB(B1, 1, 1); PG8_SCHED; PG8_LDA(At, 1, 0); PG8_STAGE(PG8_SA(0, 1), a2 + hstep, voffA);
            PG8_WAIT_V(8); PG8_WAIT_L(0); PG8_BAR; PG8_MMA(0, 0, At, B0); PG8_MMA(0, 1, At, B1); PG8_BAR; PG8_SCHED;
            PG8_LDA(At, 1, 1); PG8_STAGE(PG8_SB(1, 0), b3, voffB); PG8_STAGE(PG8_SB(1, 1), b3 + hstep, voffB); PG8_STAGE(PG8_SA(1, 0), a3, voffA);
            PG8_WAIT_V(8); PG8_WAIT_L(0); PG8_BAR; PG8_MMA(1, 0, At, B0); PG8_MMA(1, 1, At, B1); PG8_BAR; PG8_SCHED;
            } else {
            PG8_LDB(B0, 0, 0); PG8_SCHED; PG8_LDA(At, 0, 0); PG8_STAGE(PG8_SA(1, 1), a1 + hstep, voffA);
            PG8_WAIT_L(8); PG8_BAR; PG8_WAIT_L(0); PG8_MMA(0, 0, At, B0); PG8_BAR; PG8_SCHED;
            PG8_LDB(B1, 0, 1); PG8_STAGE(PG8_SB(0, 0), b2, voffB);
            PG8_BAR; PG8_WAIT_L(0); PG8_MMA(0, 1, At, B1); PG8_BAR;
            PG8_LDA(At, 0, 1); PG8_STAGE(PG8_SA(0, 0), a2, voffA);
            PG8_BAR; PG8_WAIT_L(0); PG8_MMA(1, 0, At, B0); PG8_BAR; PG8_SCHED;
            PG8_STAGE(PG8_SB(0, 1), b2 + hstep, voffB);
            PG8_WAIT_V(6); PG8_BAR; PG8_MMA(1, 1, At, B1); PG8_BAR;
            PG8_LDB(B0, 1, 0); PG8_SCHED; PG8_LDA(At, 1, 0); PG8_STAGE(PG8_SA(0, 1), a2 + hstep, voffA);
            PG8_WAIT_L(8); PG8_BAR; PG8_WAIT_L(0); PG8_MMA(0, 0, At, B0); PG8_BAR; PG8_SCHED;
            PG8_LDB(B1, 1, 1); PG8_STAGE(PG8_SB(1, 0), b3, voffB);
            PG8_BAR; PG8_WAIT_L(0); PG8_MMA(0, 1, At, B1); PG8_BAR;
            PG8_LDA(At, 1, 1); PG8_STAGE(PG8_SA(1, 0), a3, voffA);
            PG8_BAR; PG8_WAIT_L(0); PG8_MMA(1, 0, At, B0); PG8_BAR; PG8_SCHED;
            PG8_STAGE(PG8_SB(1, 1), b3 + hstep, voffB);
            PG8_WAIT_V(6); PG8_BAR; PG8_MMA(1, 1, At, B1); PG8_BAR;
            }
        }
        if constexpr (ALIGN_EPI) { if (wr == 0) PG8_BAR; }
        if constexpr (!Epi::AFTER_DRAIN) { E(acc, cur, wr, wc, fr, fq); S.done(cur); }
        if (!has_next) break;
#pragma unroll
        for (int a = 0; a < 2; ++a)
#pragma unroll
            for (int b = 0; b < 2; ++b)
#pragma unroll
                for (int m = 0; m < 4; ++m)
#pragma unroll
                    for (int n = 0; n < 2; ++n) acc[a][b][m][n] = (f32x4){0.f, 0.f, 0.f, 0.f};
        cur = nxt; cA = nA; cB = nB; ++ui;
        if constexpr (ALIGN_EPI) { if (wr == 1) PG8_BAR; }
    }
    PG8_WAIT_V(0);
    if constexpr (!ALIGN_EPI) { if (wr == 0) PG8_BAR; }
    PG8_BAR;
    if constexpr (Epi::AFTER_DRAIN) { E.fused(acc, cur, wr, wc, fr, fq, lds, wid, lane); S.done(cur); }
#undef PG8_SA
#undef PG8_SB
#undef PG8_STAGE
#undef PG8_LDA
#undef PG8_LDB
#undef PG8_MMA
#undef PG8_WAIT_V
#undef PG8_WAIT_L
#undef PG8_BAR
#undef PG8_SCHED
}
}
#include <hip/hip_bf16.h>
#include <cmath>
namespace attn_body {
using bf16=__hip_bfloat16;
using bf16x8=__attribute__((ext_vector_type(8)))short;
using s16x4=__attribute__((ext_vector_type(4)))short;
using f32x16=__attribute__((ext_vector_type(16)))float;
using u32x4=__attribute__((ext_vector_type(4)))unsigned;
constexpr int D=64,QP=512,KP=512,VP=128,OP=1024;
constexpr int NW=8,QBLK=32,QB=QBLK*NW,KVBLK=64;
constexpr int ATTN_UNIT_ROWS=QB;
__device__ __forceinline__ int crow(int r,int hi){return (r&3)+8*(r>>2)+4*hi;}
#define SBAR() __builtin_amdgcn_sched_barrier(0)
__device__ __forceinline__ void cmask(f32x16&p0,f32x16&p1,int jb,int qrel,int hi){
  const float NEG=-INFINITY; int kb=64*jb+4*hi;
  #pragma unroll
  for(int r=0;r<16;++r){int kv=kb+(r&3)+8*(r>>2); if(kv>qrel)p0[r]=NEG; if(kv+32>qrel)p1[r]=NEG;}
}

constexpr int NSLOT=3, SLOTB=8192;
constexpr int LDS_K=0, LDS_V=NSLOT*SLOTB, LDS_WS=2*NSLOT*SLOTB, LDS_OST=LDS_WS+NW*64*4, LDS_BYTES=LDS_OST+NW*4096;
constexpr float C2=0.125f*1.4426950408889634f;
__device__ __forceinline__ void glds16(const void*gsrc,unsigned lds_dst){unsigned keep;
  asm volatile("s_mov_b32 %0, m0\n\ts_mov_b32 m0, %2\n\ts_nop 0\n\tglobal_load_lds_dwordx4 %1, off\n\ts_mov_b32 m0, %0":"=&s"(keep):"v"(gsrc),"s"(lds_dst):"memory");}
__device__ __forceinline__ float max3f(float a,float b,float c){float r;asm("v_max3_f32 %0, %1, %2, %3":"=v"(r):"v"(a),"v"(b),"v"(c));return r;}
__device__ __forceinline__ float max2f(float a,float b){float r;asm("v_max_f32_e32 %0, %1, %2":"=v"(r):"v"(a),"v"(b));return r;}
__device__ __forceinline__ float fadd_s(float a,float b){float r;asm("v_add_f32_e32 %0, %1, %2":"=v"(r):"v"(a),"v"(b));return r;}
__device__ __forceinline__ float fsub_s(float a,float b){float r;asm("v_sub_f32_e32 %0, %1, %2":"=v"(r):"v"(a),"v"(b));return r;}
typedef float f32x2_t __attribute__((ext_vector_type(2))); typedef __bf16 bf16x2_t __attribute__((ext_vector_type(2)));
__device__ __forceinline__ unsigned cvtpk_s(float lo,float hi){f32x2_t v={lo,hi};bf16x2_t b=__builtin_convertvector(v,bf16x2_t);return __builtin_bit_cast(unsigned,b);}
#define WAIT_BAR(N) asm volatile("s_waitcnt vmcnt(" #N ") lgkmcnt(0)\n\ts_barrier":::"memory")

__device__ __forceinline__ void qkt(f32x16&p0,f32x16&p1,const char*Kslot,const bf16x8*qr,const f32x16&negm,int r32,int hi){
  const char*kb=Kslot+hi*1024+r32*16;
  #pragma unroll
  for(int d0=0;d0<4;++d0){
    const bf16x8 b0=*reinterpret_cast<const bf16x8*>(kb+d0*2048);
    const bf16x8 b1=*reinterpret_cast<const bf16x8*>(kb+d0*2048+512);
    if(d0==0){p0=__builtin_amdgcn_mfma_f32_32x32x16_bf16(b0,qr[0],negm,0,0,0);p1=__builtin_amdgcn_mfma_f32_32x32x16_bf16(b1,qr[0],negm,0,0,0);}
    else{p0=__builtin_amdgcn_mfma_f32_32x32x16_bf16(b0,qr[d0],p0,0,0,0);p1=__builtin_amdgcn_mfma_f32_32x32x16_bf16(b1,qr[d0],p1,0,0,0);}}
}
typedef __attribute__((address_space(3))) const char* lds_cptr;
typedef short v4i16_t __attribute__((ext_vector_type(4)));
__device__ __forceinline__ void kload8(bf16x8*kf,lds_cptr kp){
  kf[0]=*(const __attribute__((address_space(3))) bf16x8*)(kp);      kf[1]=*(const __attribute__((address_space(3))) bf16x8*)(kp+512);
  kf[2]=*(const __attribute__((address_space(3))) bf16x8*)(kp+2048); kf[3]=*(const __attribute__((address_space(3))) bf16x8*)(kp+2560);
  kf[4]=*(const __attribute__((address_space(3))) bf16x8*)(kp+4096); kf[5]=*(const __attribute__((address_space(3))) bf16x8*)(kp+4608);
  kf[6]=*(const __attribute__((address_space(3))) bf16x8*)(kp+6144); kf[7]=*(const __attribute__((address_space(3))) bf16x8*)(kp+6656);
}
__device__ __forceinline__ void kload2(bf16x8*kf,lds_cptr kp,int j){ kf[2*j]=*(const __attribute__((address_space(3))) bf16x8*)(kp+j*2048); kf[2*j+1]=*(const __attribute__((address_space(3))) bf16x8*)(kp+j*2048+512); }
__device__ __forceinline__ s16x4 vtr(lds_cptr p){ return __builtin_bit_cast(s16x4,__builtin_amdgcn_ds_read_tr16_b64_v4i16((__attribute__((address_space(3))) v4i16_t*)p)); }
__device__ __forceinline__ float rowmax(const f32x16&p0,const f32x16&p1){
  float a=max3f(p0[0],p0[1],p1[0]),b=max3f(p0[2],p0[3],p1[1]);a=max3f(a,p1[2],p1[3]);
  #pragma unroll
  for(int r=4;r<16;r+=4){a=max3f(a,p0[r],p0[r+1]);b=max3f(b,p0[r+2],p0[r+3]);a=max3f(a,p1[r],p1[r+1]);b=max3f(b,p1[r+2],p1[r+3]);}
  const float m=max2f(a,b);
  auto rr=__builtin_amdgcn_permlane32_swap(__float_as_uint(m),__float_as_uint(m),false,false);
  return max2f(__uint_as_float(rr[0]),__uint_as_float(rr[1]));
}
__device__ __forceinline__ void pv(f32x16*o,int vb,bf16x8 pa0,bf16x8 pa1,bf16x8 pa2,bf16x8 pa3){
  #pragma unroll
  for(int d0=0;d0<2;++d0){s16x4 lo[4],hi[4];
    #pragma unroll
    for(int ks=0;ks<4;++ks){
      asm volatile("ds_read_b64_tr_b16 %0,%1 offset:%c2":"=&v"(lo[ks]):"v"(vb),"i"(d0*4096+ks*1024):"memory");
      asm volatile("ds_read_b64_tr_b16 %0,%1 offset:%c2":"=&v"(hi[ks]):"v"(vb),"i"(d0*4096+ks*1024+512):"memory");}
    asm volatile("s_waitcnt lgkmcnt(0)":::"memory");SBAR();
    #define PK(k) (bf16x8){lo[k][0],lo[k][1],lo[k][2],lo[k][3],hi[k][0],hi[k][1],hi[k][2],hi[k][3]}
    o[d0]=__builtin_amdgcn_mfma_f32_32x32x16_bf16(pa0,PK(0),o[d0],0,0,0);
    o[d0]=__builtin_amdgcn_mfma_f32_32x32x16_bf16(pa1,PK(1),o[d0],0,0,0);
    o[d0]=__builtin_amdgcn_mfma_f32_32x32x16_bf16(pa2,PK(2),o[d0],0,0,0);
    o[d0]=__builtin_amdgcn_mfma_f32_32x32x16_bf16(pa3,PK(3),o[d0],0,0,0);
    #undef PK
  }
}

#ifndef ATTN_STORE16
#define ATTN_STORE16(p,v) (*(u32x4*)(p)=(v))
#endif
template<int THRL> __device__ __forceinline__ void attn_unit(int rowbase_i,int S,int qb,int qcol,int kcol,int vcol,int ocol,const bf16*Q,const bf16*__restrict__ K,const bf16*__restrict__ V,bf16*O,char*shm){
  int tid_o=threadIdx.x; asm volatile("":"+v"(tid_o)); const int tid=tid_o,lane=tid&63,r32=lane&31,hi=lane>>5; const int wid=__builtin_amdgcn_readfirstlane(tid>>6);
  const long rowbase=(long)rowbase_i; const int q0=qb*QB;
  const bf16*Qw=Q+(rowbase+q0+wid*QBLK)*QP+qcol;
  const bf16*Kh=K+rowbase*KP+kcol,*Vh=V+rowbase*VP+vcol;
  const unsigned lds0=(unsigned)(uintptr_t)shm;
  float*wsf=(float*)(shm+LDS_WS)+wid*64;
  const bf16*ksrc=Kh+(long)lane*KP+wid*8;
  const bf16*vsrc=Vh+(long)(16*(wid&3)+(lane>>2))*VP+(wid>>2)*32+(lane&3)*8;
  const unsigned kdst=lds0+LDS_K+wid*1024, vdst=lds0+LDS_V+wid*1024;
  #define DMA_K(t,slot) glds16(ksrc+(long)(t)*KVBLK*KP,(unsigned)__builtin_amdgcn_readfirstlane(kdst+(slot)))
  #define DMA_V(t,slot) glds16(vsrc+(long)(t)*KVBLK*VP,(unsigned)__builtin_amdgcn_readfirstlane(vdst+(slot)))
  const int vb0=(int)(lds0+LDS_V)+((lane>>4)&1)*32+(lane&3)*8+(4*hi+((lane&15)>>2))*64;
  const char*Kbase=shm+LDS_K; bf16x8 kf[8];
  const lds_cptr shm3=(lds_cptr)shm; const lds_cptr kp0=shm3+LDS_K+hi*1024+r32*16; const lds_cptr vp0=shm3+LDS_V+((lane>>4)&1)*32+(lane&3)*8+(4*hi+((lane&15)>>2))*64;
  const int NT=S/KVBLK;
  DMA_K(0,0);DMA_V(0,0);DMA_K(1,SLOTB);
  bf16x8 qr[4];
  #pragma unroll
  for(int d0=0;d0<4;++d0)qr[d0]=*reinterpret_cast<const bf16x8*>(&Qw[(long)r32*QP+d0*16+hi*8]);
  float mhat=0.f,l_reg=0.f;f32x16 o[2];o[0]=f32x16{};o[1]=f32x16{};f32x16 negm=f32x16{};asm volatile("":"+v"(negm));
  const int qrel=wid*QBLK+r32;
  #define CMASK(P0,P1,t) do{}while(0)
  bool resc=false;
  #define START(P0,P1) do{ const float rm=rowmax(P0,P1); resc=false; \
    { const float dl=rm; mhat=fadd_s(mhat,dl); \
      _Pragma("unroll") for(int r=0;r<16;++r){P0[r]=fsub_s(P0[r],dl);P1[r]=fsub_s(P1[r],dl);} \
      _Pragma("unroll") for(int r=0;r<16;++r)negm[r]=-mhat; asm volatile("":"+v"(negm)); } \
    _Pragma("unroll") for(int r=0;r<16;++r)P0[r]=__builtin_amdgcn_exp2f(P0[r]); }while(0)
  #define RESC() do{ if(resc){ asm volatile("s_waitcnt lgkmcnt(0)":::"memory"); \
      _Pragma("unroll") for(int d_=0;d_<2;++d_) _Pragma("unroll") for(int r=0;r<16;++r)o[d_][r]*=wsf[crow(r,hi)]; } }while(0)
  f32x16 pA0,pA1,pB0,pB1;
  int sl_prev=0,sl_cur=0,sl_next=SLOTB;
  #define ROT() do{sl_prev=sl_cur;sl_cur=sl_next;sl_next=(sl_next==(NSLOT-1)*SLOTB)?0:sl_next+SLOTB;}while(0)
  DMA_K(2,2*SLOTB);
  WAIT_BAR(3);
  qkt(pA0,pA1,Kbase,qr,negm,r32,hi);asm volatile("s_nop 15\n\ts_nop 7":"+v"(pA0),"+v"(pA1));CMASK(pA0,pA1,0);
  START(pA0,pA1);
  _Pragma("unroll") for(int r=0;r<16;++r)pA1[r]=__builtin_amdgcn_exp2f(pA1[r]);
  WAIT_BAR(0);
  DMA_K(3,0);DMA_V(1,SLOTB);
  ROT();
  kload8(kf,kp0+sl_cur);
  WAIT_BAR(2);
  s16x4 vlo[8],vhi[8]; u32x4 pw0,pw1,pw2,pw3;
  #define PKW(P,B) cvtpk_s(P[B],P[B+1])
  #define PAF(k) __builtin_bit_cast(bf16x8,pw##k)
  #define VFR(i) (bf16x8){vlo[i][0],vlo[i][1],vlo[i][2],vlo[i][3],vhi[i][0],vhi[i][1],vhi[i][2],vhi[i][3]}
  #define PIN(x) asm volatile("":"+v"(x))
  #define MX3(a,b,c) __builtin_fmaxf(__builtin_fmaxf((a),(b)),(c))
  #define GAPA(MF,A0,A1,A2,A3,W0,W1,PW) do{ MF; sacc+=A0; sacc+=A1; sacc+=A2; sacc+=A3; PIN(sacc); W0; W1; PIN(PW); SBAR(); }while(0)
  #define EX(v) __builtin_amdgcn_exp2f(v)
  #define GAPB(MF,X,B) do{ MF; X[B]=EX(X[B]); X[B+1]=EX(X[B+1]); X[B+2]=EX(X[B+2]); X[B+3]=EX(X[B+3]); PIN(X); SBAR(); }while(0)
  #define VRD(i) do{ vlo[i]=vtr(vp_+(((i)>>2)*4096+((i)&3)*1024)); vhi[i]=vtr(vp_+(((i)>>2)*4096+((i)&3)*1024+512)); }while(0)
  #define KRD(G,j) do{ if(G){ kload2(kf,kp0+sl_next,j); SBAR(); } }while(0)
  #define STEP(C0,C1,P0,P1,t,GK,GV,GL) do{ SBAR(); \
    const lds_cptr vp_=vp0+sl_prev; \
    VRD(0); SBAR(); float sacc=(P0[0]+P0[1]); \
    GAPA(C0=__builtin_amdgcn_mfma_f32_32x32x16_bf16(kf[0],qr[0],negm,0,0,0), P0[2],P0[3],P0[4],P0[5],     pw0[0]=PKW(P0,0), pw0[1]=PKW(P0,2), pw0); \
    VRD(4); SBAR(); GAPA(C1=__builtin_amdgcn_mfma_f32_32x32x16_bf16(kf[1],qr[0],negm,0,0,0), P0[6],P0[7],P0[8],P0[9],     pw0[2]=PKW(P0,4), pw0[3]=PKW(P0,6), pw0); \
    VRD(1); SBAR(); GAPA(C0=__builtin_amdgcn_mfma_f32_32x32x16_bf16(kf[2],qr[1],C0,0,0,0),   P0[10],P0[11],P0[12],P0[13], pw1[0]=PKW(P0,8), pw1[1]=PKW(P0,10), pw1); \
    VRD(5); SBAR(); GAPA(C1=__builtin_amdgcn_mfma_f32_32x32x16_bf16(kf[3],qr[1],C1,0,0,0),   P0[14],P0[15],P1[0],P1[1],   pw1[2]=PKW(P0,12),pw1[3]=PKW(P0,14), pw1); \
    VRD(2); SBAR(); GAPA(C0=__builtin_amdgcn_mfma_f32_32x32x16_bf16(kf[4],qr[2],C0,0,0,0),   P1[2],P1[3],P1[4],P1[5],     pw2[0]=PKW(P1,0), pw2[1]=PKW(P1,2), pw2); \
    VRD(6); SBAR(); GAPA(C1=__builtin_amdgcn_mfma_f32_32x32x16_bf16(kf[5],qr[2],C1,0,0,0),   P1[6],P1[7],P1[8],P1[9],     pw2[2]=PKW(P1,4), pw2[3]=PKW(P1,6), pw2); \
    VRD(3); SBAR(); GAPA(C0=__builtin_amdgcn_mfma_f32_32x32x16_bf16(kf[6],qr[3],C0,0,0,0),   P1[10],P1[11],P1[12],P1[13], pw3[0]=PKW(P1,8), pw3[1]=PKW(P1,10), pw3); \
    VRD(7); SBAR(); GAPA(C1=__builtin_amdgcn_mfma_f32_32x32x16_bf16(kf[7],qr[3],C1,0,0,0),   P1[14],P1[15],0.f,0.f,       pw3[2]=PKW(P1,12),pw3[3]=PKW(P1,14), pw3); \
    l_reg+=sacc; \
    if(GK){DMA_K((t)+3,sl_cur);} if(GV){DMA_V((t)+1,sl_next);} \
    CMASK(C0,C1,t); \
    { float a=MX3(C0[0],C0[1],C1[0]),b=MX3(C0[2],C0[3],C1[1]); a=MX3(a,C1[2],C1[3]); \
      _Pragma("unroll") for(int r=4;r<16;r+=4){a=MX3(a,C0[r],C0[r+1]);b=MX3(b,C0[r+2],C0[r+3]);a=MX3(a,C1[r],C1[r+1]);b=MX3(b,C1[r+2],C1[r+3]);} \
      float rm=__builtin_fmaxf(a,b); { auto rr=__builtin_amdgcn_permlane32_swap(__float_as_uint(rm),__float_as_uint(rm),false,false); rm=__builtin_fmaxf(__uint_as_float(rr[0]),__uint_as_float(rr[1])); } \
      resc=false; \
      if(__builtin_expect(__any(rm>(float)THRL),0)){ const float dl=__builtin_fmaxf(rm,0.f); mhat+=dl; \
        _Pragma("unroll") for(int r=0;r<16;++r){C0[r]-=dl;C1[r]-=dl;} \
        _Pragma("unroll") for(int r=0;r<16;++r)negm[r]=-mhat; asm volatile("":"+v"(negm)); \
        const float f=__builtin_amdgcn_exp2f(-dl); l_reg*=f; if(hi==0)wsf[r32]=f; resc=true; } } \
    SBAR(); \
    GAPB(o[0]=__builtin_amdgcn_mfma_f32_32x32x16_bf16(PAF(0),VFR(0),o[0],0,0,0), C0,0); \
    GAPB(o[1]=__builtin_amdgcn_mfma_f32_32x32x16_bf16(PAF(0),VFR(4),o[1],0,0,0), C0,4); \
    KRD(GL,0); GAPB(o[0]=__builtin_amdgcn_mfma_f32_32x32x16_bf16(PAF(1),VFR(1),o[0],0,0,0), C0,8); \
    KRD(GL,1); GAPB(o[1]=__builtin_amdgcn_mfma_f32_32x32x16_bf16(PAF(1),VFR(5),o[1],0,0,0), C0,12); \
    KRD(GL,2); GAPB(o[0]=__builtin_amdgcn_mfma_f32_32x32x16_bf16(PAF(2),VFR(2),o[0],0,0,0), C1,0); \
    KRD(GL,3); GAPB(o[1]=__builtin_amdgcn_mfma_f32_32x32x16_bf16(PAF(2),VFR(6),o[1],0,0,0), C1,4); \
    GAPB(o[0]=__builtin_amdgcn_mfma_f32_32x32x16_bf16(PAF(3),VFR(3),o[0],0,0,0), C1,8); \
    GAPB(o[1]=__builtin_amdgcn_mfma_f32_32x32x16_bf16(PAF(3),VFR(7),o[1],0,0,0), C1,12); \
    }while(0)
  int t=1;
  #undef CMASK
  #define CMASK(P0,P1,t) do{}while(0)
  for(;t+5<NT;t+=2){
    STEP(pB0,pB1,pA0,pA1,t,true,true,true);     WAIT_BAR(2); RESC(); ROT();
    STEP(pA0,pA1,pB0,pB1,t+1,true,true,true);   WAIT_BAR(2); RESC(); ROT();
  }
  #undef CMASK
  #define CMASK(P0,P1,t) do{}while(0)
  #define ENDW(tt) do{ if((tt)+3<NT){WAIT_BAR(2);} else if((tt)+2<NT){WAIT_BAR(1);} else {WAIT_BAR(0);} }while(0)
  for(;t+1<NT;t+=2){
    STEP(pB0,pB1,pA0,pA1,t,(t+3<NT),(t+1<NT),(t+1<NT));       ENDW(t);   RESC(); ROT();
    STEP(pA0,pA1,pB0,pB1,t+1,(t+4<NT),(t+2<NT),(t+2<NT));     ENDW(t+1); RESC(); ROT();
  }
  STEP(pB0,pB1,pA0,pA1,NT-1,false,false,false); RESC();
  { float sacc=pB0[0]+pB0[1]; _Pragma("unroll") for(int r=2;r<16;++r)sacc+=pB0[r]; _Pragma("unroll") for(int r=0;r<16;++r)sacc+=pB1[r]; l_reg+=sacc;
    pw0=(u32x4){PKW(pB0,0),PKW(pB0,2),PKW(pB0,4),PKW(pB0,6)};pw1=(u32x4){PKW(pB0,8),PKW(pB0,10),PKW(pB0,12),PKW(pB0,14)};pw2=(u32x4){PKW(pB1,0),PKW(pB1,2),PKW(pB1,4),PKW(pB1,6)};pw3=(u32x4){PKW(pB1,8),PKW(pB1,10),PKW(pB1,12),PKW(pB1,14)};
    SBAR(); pv(o,vb0+sl_cur,PAF(0),PAF(1),PAF(2),PAF(3)); }
  #undef PKW
  #undef PAF
  #undef VFR
  #undef PIN
  #undef MX3
  #undef GAPA
  #undef GAPB
  #undef EX
  #undef VRD
  #undef KRD
  #undef STEP
  #undef ENDW
  {auto rr=__builtin_amdgcn_permlane32_swap(__float_as_uint(l_reg),__float_as_uint(l_reg),false,false);l_reg=__uint_as_float(rr[0])+__uint_as_float(rr[1]);}
  if(hi==0)wsf[32+r32]=l_reg;asm volatile("s_waitcnt lgkmcnt(0)":::"memory");
  float rli[16];
  #pragma unroll
  for(int r=0;r<16;++r)rli[r]=__builtin_amdgcn_rcpf(wsf[32+crow(r,hi)]);
  bf16*Ow=O+(rowbase+q0+wid*QBLK)*OP+ocol;
  { bf16*stg=(bf16*)(shm+LDS_OST)+wid*2048;
    #pragma unroll
    for(int r=0;r<16;++r){const int orow=crow(r,hi);
      #pragma unroll
      for(int d0=0;d0<2;++d0)stg[orow*64+d0*32+r32]=__float2bfloat16(o[d0][r]*rli[r]);}
    asm volatile("s_waitcnt lgkmcnt(0)":::"memory");
    #pragma unroll
    for(int i=0;i<4;++i){const int row=i*8+(lane>>3),ch=lane&7; const u32x4 v=*(const u32x4*)(stg+row*64+ch*8); ATTN_STORE16(Ow+(long)row*OP+ch*8,v);} }
  asm volatile("s_waitcnt lgkmcnt(0)\n\ts_barrier":::"memory");
  #undef DMA_K
  #undef DMA_V
  #undef CMASK
  #undef START
  #undef RESC
  #undef ROT
}
constexpr int ATTN_LDS_BYTES=LDS_BYTES;
#undef SBAR
#undef WAIT_BAR
}

#define LAS __attribute__((address_space(3)))
#define LDS_BARRIER() asm volatile("s_waitcnt lgkmcnt(0)\n\ts_barrier" ::: "memory")
typedef unsigned short bf16;
typedef unsigned u32x4_t __attribute__((ext_vector_type(4)));
typedef unsigned u32x2_t __attribute__((ext_vector_type(2)));
typedef float f32x4_t __attribute__((ext_vector_type(4)));
typedef float f32x2_t __attribute__((ext_vector_type(2)));

constexpr int DM = 1024, MTOK = 49152, NSEQ = 20, DFF = 2816, NFF = 5632, NMIXP = 2560, NMIX = 2432, ZP = 1792;
constexpr int NTHR = 512;
constexpr float QSCALE = 0.125f * 1.4426950408889634f;
constexpr size_t MiB = 1u << 20;
constexpr size_t ZERO_BYTES = 8 * MiB;
constexpr size_t OFF_CTR = 0, OFF_ROPE = 32768, OFF_SS = 65536, OFF_MOD = 2 * MiB, OFF_BIAS = 4 * MiB, OFF_GV = 7 * MiB, OFF_GATE = 7 * MiB + 512 * 1024;
constexpr size_t OFF_W = 8 * MiB, W_LAYER = 40 * MiB;
constexpr size_t WO_IN = 0, WO_OUT = 22 * MiB, WO_MI = 33 * MiB, WO_MO = 38 * MiB;
constexpr size_t OFF_XN = 88 * MiB, OFF_YF = 88 * MiB, OFF_YB = 136 * MiB;
constexpr size_t OFF_HID = 184 * MiB, OFF_Z = 184 * MiB, OFF_QK = 352 * MiB, OFF_VR = 400 * MiB, OFF_OMIX = 412 * MiB, WS_END = 508 * MiB;
constexpr int LDS_BYTES = 147456, MISC_OFF = 131072;

struct KP { const float* in[31]; float* out; unsigned char* ws; };

__device__ __forceinline__ int seq_of_row(int m) { return m < 16384 ? (m >> 12) : 4 + ((m - 16384) >> 11); }
__device__ __forceinline__ int seq_start(int s) { return s < 4 ? s * 4096 : 16384 + (s - 4) * 2048; }
__device__ __forceinline__ int seq_len(int s) { return s < 4 ? 4096 : 2048; }
__device__ __forceinline__ unsigned f2bf(float f) { unsigned u = __builtin_bit_cast(unsigned, f); return (u + 0x7fffu + ((u >> 16) & 1u)) >> 16; }
__device__ __forceinline__ unsigned pk2(float lo, float hi) { return f2bf(lo) | (f2bf(hi) << 16); }
__device__ __forceinline__ float bf2f(unsigned short b) { return __builtin_bit_cast(float, (unsigned)b << 16); }
__device__ __forceinline__ float sigmoidf_(float x) { return 1.0f / (1.0f + __expf(-x)); }
#define DPP_ADD(v, CTRL) ((v) + __builtin_bit_cast(float, __builtin_amdgcn_update_dpp(0, __builtin_bit_cast(int, (v)), (CTRL), 0xf, 0xf, false)))
__device__ __forceinline__ float wave_sum(float v) {
    v = DPP_ADD(v, 0xB1);
    v = DPP_ADD(v, 0x4E);
    v = DPP_ADD(v, 0x141);
    v = DPP_ADD(v, 0x140);
    const f32x4_t d = __builtin_amdgcn_mfma_f32_16x16x4f32(1.0f, v, (f32x4_t){0.f, 0.f, 0.f, 0.f}, 0, 0, 0);
    return d[0];
}
__device__ __forceinline__ float tanh_fast(float x) { const float e = __expf(2.0f * x); return 1.0f - 2.0f * __builtin_amdgcn_rcpf(e + 1.0f); }
__host__ __device__ __forceinline__ int map_ffn(int n) { const int half = n >= DFF ? 1 : 0; const int n2 = half ? n - DFF : n; return 256 * (n2 >> 7) + 128 * half + (n2 & 127); }
__host__ __device__ __forceinline__ int map_mix(int n) {
    if (n < 1792 || n >= 2304) return n;
    const int hh = (n - 1792) >> 6, d = (n - 1792) & 63;
    return 256 * (7 + (hh >> 2)) + 128 * (d >> 5) + 32 * (hh & 3) + 8 * ((d & 15) >> 2) + 4 * ((d >> 4) & 1) + (d & 3);
}

namespace pg8 {
struct EpiSwiglu {
    static constexpr bool PERM = true, AFTER_DRAIN = false;
    bf16_t* H; const float* ss; const float* bias;
    __device__ __forceinline__ void operator()(const f32x4 (&acc)[2][2][4][2], const Unit& u, int wr, int wc, int fr, int fq) const {
        const int row0 = u.pm * BM + wr * 64 + fr; const int s = seq_of_row(u.pm * BM);
        const float* bp = bias + (size_t)s * NFF + u.pn * 256 + wc * 32 + 8 * fq;
        f32x4 bg[2], bu[2];
#pragma unroll
        for (int n = 0; n < 2; ++n) { bg[n] = *(const f32x4*)(bp + 4 * n); bu[n] = *(const f32x4*)(bp + 128 + 4 * n); }
#pragma unroll
        for (int ai = 0; ai < 2; ++ai)
#pragma unroll
            for (int m = 0; m < 4; ++m) {
                const int row = row0 + ai * HALF + m * 16;
                const float rs = rsqrtf(ss[row] * (1.0f / 1024.0f) + 1e-6f);
                float h[8];
#pragma unroll
                for (int n = 0; n < 2; ++n) {
                    const f32x4 g = acc[ai][0][m][n] * rs + bg[n], up = acc[ai][1][m][n] * rs + bu[n];
#pragma unroll
                    for (int i = 0; i < 4; ++i) h[4 * n + i] = g[i] * sigmoidf_(g[i]) * up[i];
                }
                u32x4 w; w.x = cvt_pk_bf16(h[0], h[1]); w.y = cvt_pk_bf16(h[2], h[3]); w.z = cvt_pk_bf16(h[4], h[5]); w.w = cvt_pk_bf16(h[6], h[7]);
                *(u32x4*)(H + (size_t)row * DFF + u.pn * 128 + wc * 32 + 8 * fq) = w;
            }
    }
};
struct EpiZ {
    static constexpr bool PERM = true, AFTER_DRAIN = false;
    bf16_t* Z; bf16_t* QK; bf16_t* VR; const float* ss; const float* bias; const float* qg; const float* kg; const float* rope;
    __device__ __forceinline__ void operator()(const f32x4 (&acc)[2][2][4][2], const Unit& u, int wr, int wc, int fr, int fq) const {
        const int row0 = u.pm * BM + wr * 64 + fr; const int s = seq_of_row(u.pm * BM); const int t0 = row0 - seq_start(s);
        const float* bp = bias + (size_t)s * NFF + u.pn * 256 + wc * 32 + 8 * fq;
        f32x4 bv[2][2];
#pragma unroll
        for (int bj = 0; bj < 2; ++bj)
#pragma unroll
            for (int n = 0; n < 2; ++n) bv[bj][n] = *(const f32x4*)(bp + bj * 128 + 4 * n);
        if (u.pn < 7 || u.pn == 9) {
#pragma unroll
            for (int ai = 0; ai < 2; ++ai)
#pragma unroll
                for (int m = 0; m < 4; ++m) {
                    const int row = row0 + ai * HALF + m * 16;
                    const float rs = rsqrtf(ss[row] * (1.0f / 1024.0f) + 1e-6f);
#pragma unroll
                    for (int bj = 0; bj < 2; ++bj) {
                        const f32x4 v0 = acc[ai][bj][m][0] * rs + bv[bj][0], v1 = acc[ai][bj][m][1] * rs + bv[bj][1];
                        u32x4 w; w.x = cvt_pk_bf16(v0[0], v0[1]); w.y = cvt_pk_bf16(v0[2], v0[3]); w.z = cvt_pk_bf16(v1[0], v1[1]); w.w = cvt_pk_bf16(v1[2], v1[3]);
                        if (u.pn < 7) *(u32x4*)(Z + (size_t)row * ZP + u.pn * 256 + bj * 128 + wc * 32 + 8 * fq) = w;
                        else if (bj == 0) *(u32x4*)(VR + (size_t)row * 128 + wc * 32 + 8 * fq) = w;
                    }
                }
        } else {
            const int hh = (u.pn - 7) * 4 + wc; const bool isq = hh < 6; const float* gp = isq ? qg : kg; const float osc = isq ? QSCALE : 1.0f;
            f32x4 gn[2][2];
#pragma unroll
            for (int bj = 0; bj < 2; ++bj)
#pragma unroll
                for (int n = 0; n < 2; ++n) gn[bj][n] = *(const f32x4*)(gp + 32 * bj + 16 * n + 4 * fq);
#pragma unroll
            for (int ai = 0; ai < 2; ++ai)
#pragma unroll
                for (int m = 0; m < 4; ++m) {
                    const int row = row0 + ai * HALF + m * 16; const int t = t0 + ai * HALF + m * 16;
                    const float rs = rsqrtf(ss[row] * (1.0f / 1024.0f) + 1e-6f);
                    f32x4 v[2][2]; float q = 0.f;
#pragma unroll
                    for (int bj = 0; bj < 2; ++bj)
#pragma unroll
                        for (int n = 0; n < 2; ++n) { v[bj][n] = acc[ai][bj][m][n] * rs + bv[bj][n]; q += (v[bj][n][0] * v[bj][n][0] + v[bj][n][1] * v[bj][n][1]) + (v[bj][n][2] * v[bj][n][2] + v[bj][n][3] * v[bj][n][3]); }
                    q += __shfl_xor(q, 16); q += __shfl_xor(q, 32);
                    const float r = rsqrtf(q * (1.0f / 64.0f) + 1e-6f);
#pragma unroll
                    for (int bj = 0; bj < 2; ++bj) {
                        const int pos = bj == 0 ? (t >> 6) : (t & 63);
                        const f32x4 x1 = v[bj][0] * r * gn[bj][0], x2 = v[bj][1] * r * gn[bj][1];
                        const float* rp = rope + (pos * 16 + 4 * fq) * 2;
                        const f32x4 cs0 = *(const f32x4*)(rp), cs1 = *(const f32x4*)(rp + 4);
                        const float c[4] = {cs0[0], cs0[2], cs1[0], cs1[2]}, sn[4] = {cs0[1], cs0[3], cs1[1], cs1[3]};
                        float o1[4], o2[4];
#pragma unroll
                        for (int i = 0; i < 4; ++i) { o1[i] = (x1[i] * c[i] - x2[i] * sn[i]) * osc; o2[i] = (x2[i] * c[i] + x1[i] * sn[i]) * osc; }
                        u32x4 w; w.x = cvt_pk_bf16(o1[0], o1[1]); w.y = cvt_pk_bf16(o1[2], o1[3]); w.z = cvt_pk_bf16(o2[0], o2[1]); w.w = cvt_pk_bf16(o2[2], o2[3]);
                        *(u32x4*)(QK + (size_t)row * 512 + hh * 64 + 32 * bj + 8 * fq) = w;
                    }
                }
        }
    }
};
struct EpiResid {
    static constexpr bool PERM = false, AFTER_DRAIN = false;
    const float* xin_p; const float* xin_s; float* out; bf16_t* xn; float* ssn; const float* gate; const float* gvn;
    __device__ __forceinline__ void operator()(const f32x4 (&acc)[2][2][4][2], const Unit& u, int wr, int wc, int fr, int fq) const {
        const int rowt = u.pm * BM; const int s = seq_of_row(rowt);
        const float* xb = rowt < 16384 ? xin_p : xin_s - (size_t)16384 * DM;
        const int row0 = rowt + wr * 64 + fr; const int col0 = u.pn * BM + wc * 32 + 4 * fq;
        f32x4 gt[2][2];
#pragma unroll
        for (int bj = 0; bj < 2; ++bj)
#pragma unroll
            for (int n = 0; n < 2; ++n) gt[bj][n] = *(const f32x4*)(gate + (size_t)s * DM + col0 + bj * HALF + n * 16);
#pragma unroll
        for (int ai = 0; ai < 2; ++ai)
#pragma unroll
            for (int m = 0; m < 4; ++m) {
                const int row = row0 + ai * HALF + m * 16; const size_t off = (size_t)row * DM + col0; float q = 0.f;
#pragma unroll
                for (int bj = 0; bj < 2; ++bj)
#pragma unroll
                    for (int n = 0; n < 2; ++n) {
                        const f32x4 xo = *(const f32x4*)(xb + off + bj * HALF + n * 16);
                        const f32x4 val = xo + gt[bj][n] * acc[ai][bj][m][n];
                        *(f32x4*)(out + off + bj * HALF + n * 16) = val;
                        if (gvn) {
                            q += (val[0] * val[0] + val[1] * val[1]) + (val[2] * val[2] + val[3] * val[3]);
                            const f32x4 gv = *(const f32x4*)(gvn + (size_t)s * DM + col0 + bj * HALF + n * 16);
                            const f32x4 o = val * gv; unsigned long long w = (unsigned long long)cvt_pk_bf16(o[0], o[1]) | ((unsigned long long)cvt_pk_bf16(o[2], o[3]) << 32);
                            *(unsigned long long*)(xn + off + bj * HALF + n * 16) = w;
                        }
                    }
                if (gvn) { q += __shfl_xor(q, 16); q += __shfl_xor(q, 32); if (fq == 0) atomicAdd(ssn + row, q); }
            }
    }
};
}

template <int MAP> __device__ __forceinline__ void transpose_item(const float* W, int K, int N, bf16* WT, float* scr, int item, int lane) {
    const int nblk = N / 32, kb = item / nblk, nb = item % nblk, k0 = 64 * kb, n0 = 32 * nb;
#pragma unroll 8
    for (int i = 0; i < 32; ++i) { const int kk = 2 * i + (lane >> 5); scr[kk * 33 + (lane & 31)] = W[(size_t)(k0 + kk) * N + n0 + (lane & 31)]; }
    __builtin_amdgcn_wave_barrier(); asm volatile("s_waitcnt lgkmcnt(0)" ::: "memory");
    const int c = lane & 7;
#pragma unroll
    for (int j = 0; j < 4; ++j) { const int n = (lane >> 3) + 8 * j; const float* sp = scr + (8 * c) * 33 + n;
        u32x4_t o; o.x = pk2(sp[0 * 33], sp[1 * 33]); o.y = pk2(sp[2 * 33], sp[3 * 33]); o.z = pk2(sp[4 * 33], sp[5 * 33]); o.w = pk2(sp[6 * 33], sp[7 * 33]);
        const int nsrc = n0 + n; const int nd = MAP == 1 ? map_ffn(nsrc) : (MAP == 2 ? map_mix(nsrc) : nsrc);
        *(u32x4_t*)(WT + (size_t)nd * K + k0 + 8 * c) = o; }
    __builtin_amdgcn_wave_barrier(); asm volatile("s_waitcnt lgkmcnt(0)" ::: "memory");
}

template <int MODE, int MAP> __device__ __forceinline__ void smallm_unit(const KP& p, float* sA, int l, int j, const float* W, int ldw, int nvalid, float* dest, int ldd, int nchunk, int kchunk) {
    int tid_o = threadIdx.x; asm volatile("" : "+v"(tid_o)); const int tid = tid_o; const int k0 = kchunk * 128;
    __syncthreads();
    for (int e = tid; e < 128 * NSEQ; e += NTHR) {
        const int k = e / NSEQ, s = e % NSEQ; float v;
        if (MODE == 0) { const float c = s < 4 ? p.in[2][s * DM + k0 + k] : p.in[3][(s - 4) * DM + k0 + k]; v = c * sigmoidf_(c); }
        else { const float* mod = (const float*)(p.ws + OFF_MOD) + ((size_t)l * NSEQ + s) * 9216 + 3 * j * 1024 + k0 + k; v = *mod + p.in[5][l * 9216 + 3 * j * 1024 + k0 + k]; }
        sA[k * NSEQ + s] = v;
    }
    __syncthreads();
    const int n = nchunk * 256 + (tid & 255), kh = tid >> 8;
    float acc[NSEQ];
#pragma unroll
    for (int s = 0; s < NSEQ; ++s) acc[s] = 0.f;
    if (n < nvalid) {
        for (int kb = 0; kb < 64; kb += 16) {
            float wv[16];
#pragma unroll
            for (int u = 0; u < 16; ++u) wv[u] = W[(size_t)(k0 + kh * 64 + kb + u) * ldw + n];
#pragma unroll
            for (int u = 0; u < 16; ++u) { const int k = kh * 64 + kb + u; const float w = wv[u];
                const f32x4_t* ap = (const f32x4_t*)(sA + k * NSEQ);
#pragma unroll
                for (int q = 0; q < 5; ++q) { const f32x4_t a = ap[q]; acc[4 * q] += a[0] * w; acc[4 * q + 1] += a[1] * w; acc[4 * q + 2] += a[2] * w; acc[4 * q + 3] += a[3] * w; } }
        }
        const int nd = MAP == 1 ? map_ffn(n) : (MAP == 2 ? map_mix(n) : n);
#pragma unroll
        for (int s = 0; s < NSEQ; ++s) atomicAdd(dest + (size_t)s * ldd + nd, acc[s]);
    }
}

#define DPP_FMAC(acc, x, s, J) asm volatile("v_fmac_f32_dpp %0, %1, %2 row_newbcast:" #J " row_mask:0xf bank_mask:0xf" : "+v"(acc) : "v"(x), "v"(s))
#define DPP_FMAC_N(acc, x, s, J) asm volatile("s_nop 1\n\tv_fmac_f32_dpp %0, %1, %2 row_newbcast:" #J " row_mask:0xf bank_mask:0xf" : "+v"(acc) : "v"(x), "v"(s))
#define DPP_MUL(s, x, J) asm volatile("v_mul_f32_dpp %0, %1, %0 row_newbcast:" #J " row_mask:0xf bank_mask:0xf" : "+v"(s) : "v"(x))
#define DPP_MUL_N(s, x, J) asm volatile("s_nop 1\n\tv_mul_f32_dpp %0, %1, %0 row_newbcast:" #J " row_mask:0xf bank_mask:0xf" : "+v"(s) : "v"(x))
#define REP15(M, X) M(1, X) M(2, X) M(3, X) M(4, X) M(5, X) M(6, X) M(7, X) M(8, X) M(9, X) M(10, X) M(11, X) M(12, X) M(13, X) M(14, X) M(15, X)
__device__ __forceinline__ float row4_sum(float x) {
    auto r1 = __builtin_amdgcn_permlane16_swap(__float_as_uint(x), __float_as_uint(x), false, false); x = __uint_as_float(r1[0]) + __uint_as_float(r1[1]);
    auto r2 = __builtin_amdgcn_permlane32_swap(__float_as_uint(x), __float_as_uint(x), false, false); return __uint_as_float(r2[0]) + __uint_as_float(r2[1]);
}
__device__ __forceinline__ void rwkv_unit(const KP& p, unsigned char* lds, int l, int s, int h, int d) {
    int tid_o = threadIdx.x; asm volatile("" : "+v"(tid_o)); const int tid = tid_o, lane = tid & 63; const int wid = __builtin_amdgcn_readfirstlane(tid >> 6);
    constexpr int TB = 16;
    f32x2_t* W2 = (f32x2_t*)lds;
    float* OPS = (float*)(lds + 32768);
    float* YBUF = (float*)(lds + 32768 + 49152);
    float* PWS = (float*)(lds + 32768 + 49152 + 8192) + (wid & 3) * 1024;
    const bf16* Z = (const bf16*)(p.ws + OFF_Z);
    float* Y = (float*)(p.ws + (d == 0 ? OFF_YF : OFF_YB));
    const float* mu = p.in[18] + l * 1024;
    const float* w_up = p.in[19] + ((size_t)l * 2 + d) * 64 * 256;
    const float* a_up = p.in[21] + (size_t)l * 64 * 256;
    const int S = seq_len(s), start = seq_start(s); const int NB = S / TB;
    __syncthreads();
    for (int e = tid; e < 4096; e += NTHR) { const int i = e >> 6, j = e & 63; W2[e] = (f32x2_t){w_up[i * 256 + 64 * h + j], a_up[i * 256 + 64 * h + j]}; }
    __syncthreads();
    if (wid >= 4) {
        const int pw = wid - 4;
        unsigned short* XWb = (unsigned short*)PWS; unsigned short* XAb = XWb + 256; float* KK = PWS + 256; float* UA = PWS + 512;
        typedef short bf16x8_t __attribute__((ext_vector_type(8)));
        bf16x8_t Bf[2][4][2];
        { const int kg = lane >> 4, cl = 64 * h + (lane & 15);
          _Pragma("unroll") for (int m = 0; m < 2; ++m) _Pragma("unroll") for (int ct = 0; ct < 4; ++ct) _Pragma("unroll") for (int ks = 0; ks < 2; ++ks) {
              const float* Wm = (m == 0 ? w_up : a_up) + (size_t)(32 * ks + 8 * kg) * 256 + cl + 16 * ct; u32x4_t pq;
              pq.x = pk2(Wm[0], Wm[256]); pq.y = pk2(Wm[512], Wm[768]); pq.z = pk2(Wm[1024], Wm[1280]); pq.w = pk2(Wm[1536], Wm[1792]); Bf[m][ct][ks] = __builtin_bit_cast(bf16x8_t, pq); } }
        const float w0 = p.in[20][(l * 2 + d) * 256 + 64 * h + lane], a0 = p.in[22][(l * 2 + d) * 256 + 64 * h + lane];
        const float k_k = p.in[24][l * 256 + 64 * h + lane], k_a = p.in[25][l * 256 + 64 * h + lane];
        int it_t[3], it_zc[3], it_g[3], it_w[3]; f32x4_t mu0[3], mu1[3];
#pragma unroll
        for (int i = 0; i < 3; ++i) { int e = lane + 64 * i; if (e > 159) e = 159; const int t = e / 40, c = e % 40, g = c >> 3, wi = (c & 7) * 8;
            it_t[i] = t; it_g[i] = g; it_w[i] = wi; it_zc[i] = (g == 0 ? 64 * h : g == 1 ? 256 + 64 * h : g == 2 ? 512 + 64 * h : 768 + (g - 3) * 64) + wi;
            mu0[i] = *(const f32x4_t*)(mu + it_zc[i]); mu1[i] = *(const f32x4_t*)(mu + it_zc[i] + 4); }
        u32x4_t rc[3], rp[3], rn[3];
#define RW_ISSUE(b_) do { _Pragma("unroll") for (int i = 0; i < 3; ++i) { const int si = (b_) * TB + 4 * pw + it_t[i]; const int tt = d == 0 ? si : S - 1 - si; const bf16* zp = Z + (size_t)(start + tt) * ZP + 768 + it_zc[i]; \
                rc[i] = *(const u32x4_t*)zp; rp[i] = tt > 0 ? *(const u32x4_t*)(zp - ZP) : (u32x4_t){0u, 0u, 0u, 0u}; rn[i] = tt < S - 1 ? *(const u32x4_t*)(zp + ZP) : (u32x4_t){0u, 0u, 0u, 0u}; } } while (0)
#define RW_PREP(b_) do { \
            float* ops = OPS + ((b_) & 1) * (TB * 384); \
            _Pragma("unroll") for (int i = 0; i < 3; ++i) if (lane + 64 * i < 160) { \
                float fs[8]; \
                _Pragma("unroll") for (int q = 0; q < 4; ++q) { \
                    const float c0 = __builtin_bit_cast(float, rc[i][q] << 16), c1 = __builtin_bit_cast(float, rc[i][q] & 0xffff0000u); \
                    const float p0 = __builtin_bit_cast(float, rp[i][q] << 16), p1 = __builtin_bit_cast(float, rp[i][q] & 0xffff0000u); \
                    const float n0 = __builtin_bit_cast(float, rn[i][q] << 16), n1 = __builtin_bit_cast(float, rn[i][q] & 0xffff0000u); \
                    const float m0 = q < 2 ? mu0[i][2 * q] : mu1[i][2 * q - 4], m1 = q < 2 ? mu0[i][2 * q + 1] : mu1[i][2 * q - 3]; \
                    fs[2 * q] = c0 + m0 * (0.5f * (p0 + n0) - c0); fs[2 * q + 1] = c1 + m1 * (0.5f * (p1 + n1) - c1); \
                } \
                const int t = it_t[i], tl = 4 * pw + t, g = it_g[i], wi = it_w[i]; \
                if (g == 0) { *(f32x4_t*)(ops + tl * 384 + 256 + wi) = (f32x4_t){fs[0], fs[1], fs[2], fs[3]}; *(f32x4_t*)(ops + tl * 384 + 256 + wi + 4) = (f32x4_t){fs[4], fs[5], fs[6], fs[7]}; } \
                else if (g == 2) { *(f32x4_t*)(ops + tl * 384 + 320 + wi) = (f32x4_t){fs[0], fs[1], fs[2], fs[3]}; *(f32x4_t*)(ops + tl * 384 + 320 + wi + 4) = (f32x4_t){fs[4], fs[5], fs[6], fs[7]}; } \
                else if (g == 1) { *(f32x4_t*)(KK + t * 64 + wi) = (f32x4_t){fs[0], fs[1], fs[2], fs[3]}; *(f32x4_t*)(KK + t * 64 + wi + 4) = (f32x4_t){fs[4], fs[5], fs[6], fs[7]}; } \
                else if (g == 3) { u32x4_t pq; pq.x = pk2(tanh_fast(fs[0]), tanh_fast(fs[1])); pq.y = pk2(tanh_fast(fs[2]), tanh_fast(fs[3])); pq.z = pk2(tanh_fast(fs[4]), tanh_fast(fs[5])); pq.w = pk2(tanh_fast(fs[6]), tanh_fast(fs[7])); *(u32x4_t*)(XWb + t * 64 + wi) = pq; } \
                else { u32x4_t pq; pq.x = pk2(fs[0], fs[1]); pq.y = pk2(fs[2], fs[3]); pq.z = pk2(fs[4], fs[5]); pq.w = pk2(fs[6], fs[7]); *(u32x4_t*)(XAb + t * 64 + wi) = pq; } \
            } \
            if ((b_) + 1 < NB) RW_ISSUE((b_) + 1); \
            { const int arow = lane & 15, akg = lane >> 4; \
              _Pragma("unroll") for (int m = 0; m < 2; ++m) { \
                bf16x8_t Af[2]; \
                _Pragma("unroll") for (int ks = 0; ks < 2; ++ks) { u32x4_t raw = *(const u32x4_t*)((m ? XAb : XWb) + (arow & 3) * 64 + 32 * ks + 8 * akg); if (arow >= 4) raw = (u32x4_t){0u, 0u, 0u, 0u}; Af[ks] = __builtin_bit_cast(bf16x8_t, raw); } \
                _Pragma("unroll") for (int ct = 0; ct < 4; ++ct) { f32x4_t am = (f32x4_t){0.f, 0.f, 0.f, 0.f}; \
                    am = __builtin_amdgcn_mfma_f32_16x16x32_bf16(Af[0], Bf[m][ct][0], am, 0, 0, 0); am = __builtin_amdgcn_mfma_f32_16x16x32_bf16(Af[1], Bf[m][ct][1], am, 0, 0, 0); \
                    if (lane < 16) { UA[(m * 4 + 0) * 64 + 16 * ct + lane] = am[0]; UA[(m * 4 + 1) * 64 + 16 * ct + lane] = am[1]; UA[(m * 4 + 2) * 64 + 16 * ct + lane] = am[2]; UA[(m * 4 + 3) * 64 + 16 * ct + lane] = am[3]; } } } } \
            _Pragma("unroll") for (int t = 0; t < 4; ++t) { \
                const int tl = 4 * pw + t; const float k = KK[t * 64 + lane]; const float kkv = k * k_k; \
                const float n2 = wave_sum(kkv * kkv); const float kk = kkv / fmaxf(sqrtf(n2), 1e-12f); \
                const float wdec = __expf(-0.6065306597126334f * sigmoidf_(w0 + UA[t * 64 + lane])); const float a = sigmoidf_(a0 + UA[(4 + t) * 64 + lane]); \
                float* o = ops + tl * 384 + lane; o[0] = -kk; o[64] = wdec; o[128] = kk * a; o[192] = k * (1.0f + (a - 1.0f) * k_a); \
            } } while (0)
#define RW_YFLUSH(b_) do { const float* ybp = YBUF + ((b_) & 1) * (TB * 64); \
            _Pragma("unroll") for (int t = 0; t < 4; ++t) { const int si = (b_) * TB + 4 * pw + t; const int tt = d == 0 ? si : S - 1 - si; Y[(size_t)(start + tt) * 256 + 64 * h + lane] = ybp[(4 * pw + t) * 64 + lane]; } } while (0)
        RW_ISSUE(0); RW_PREP(0);
        LDS_BARRIER();
        for (int b = 0; b < NB; ++b) {
            if (b > 0) RW_YFLUSH(b - 1);
            if (b + 1 < NB) RW_PREP(b + 1);
            LDS_BARRIER();
        }
        RW_YFLUSH(NB - 1);
#undef RW_ISSUE
#undef RW_PREP
#undef RW_YFLUSH
    } else {
        float st[16];
#pragma unroll
        for (int i = 0; i < 16; ++i) st[i] = 0.f;
        const int vofs = 320 + 16 * wid + (lane & 15);
        LDS_BARRIER();
        for (int b = 0; b < NB; ++b) {
            const float* ops = OPS + (b & 1) * (TB * 384); float* yb = YBUF + (b & 1) * (TB * 64);
            float xn = ops[lane], xw = ops[64 + lane], xb = ops[128 + lane], xk = ops[192 + lane], xr = ops[256 + lane], vv = ops[vofs];
#pragma unroll 2
            for (int t = 0; t < TB; ++t) {
                const float* nx = ops + (t + 1 < TB ? t + 1 : t) * 384;
                const float nxn = nx[lane], nxw = nx[64 + lane], nxb = nx[128 + lane], nxk = nx[192 + lane], nxr = nx[256 + lane], nvv = nx[vofs];
                float sa0 = 0.f, sa1 = 0.f, sa2 = 0.f, sa3 = 0.f;
                DPP_FMAC_N(sa0, xn, st[0], 0); DPP_FMAC(sa1, xn, st[1], 1); DPP_FMAC(sa2, xn, st[2], 2); DPP_FMAC(sa3, xn, st[3], 3);
                DPP_FMAC(sa0, xn, st[4], 4); DPP_FMAC(sa1, xn, st[5], 5); DPP_FMAC(sa2, xn, st[6], 6); DPP_FMAC(sa3, xn, st[7], 7);
                DPP_FMAC(sa0, xn, st[8], 8); DPP_FMAC(sa1, xn, st[9], 9); DPP_FMAC(sa2, xn, st[10], 10); DPP_FMAC(sa3, xn, st[11], 11);
                DPP_FMAC(sa0, xn, st[12], 12); DPP_FMAC(sa1, xn, st[13], 13); DPP_FMAC(sa2, xn, st[14], 14); DPP_FMAC(sa3, xn, st[15], 15);
                float sa = (sa0 + sa1) + (sa2 + sa3);
                { const f32x4_t da = __builtin_amdgcn_mfma_f32_16x16x4f32(1.0f, sa, (f32x4_t){0.f, 0.f, 0.f, 0.f}, 0, 0, 0); sa = da[0]; asm volatile("s_nop 15\n\ts_nop 3" : "+v"(sa)); }
                DPP_MUL_N(st[0], xw, 0);
#define M_MUL(J, X) DPP_MUL(st[J], X, J);
                REP15(M_MUL, xw)
#undef M_MUL
                DPP_FMAC_N(st[0], xb, sa, 0);
#define M_FB(J, X) DPP_FMAC(st[J], X, sa, J);
                REP15(M_FB, xb)
#undef M_FB
                DPP_FMAC_N(st[0], xk, vv, 0);
#define M_FK(J, X) DPP_FMAC(st[J], X, vv, J);
                REP15(M_FK, xk)
#undef M_FK
                float y0 = 0.f, y1 = 0.f, y2 = 0.f, y3 = 0.f;
                DPP_FMAC_N(y0, xr, st[0], 0); DPP_FMAC(y1, xr, st[1], 1); DPP_FMAC(y2, xr, st[2], 2); DPP_FMAC(y3, xr, st[3], 3);
                DPP_FMAC(y0, xr, st[4], 4); DPP_FMAC(y1, xr, st[5], 5); DPP_FMAC(y2, xr, st[6], 6); DPP_FMAC(y3, xr, st[7], 7);
                DPP_FMAC(y0, xr, st[8], 8); DPP_FMAC(y1, xr, st[9], 9); DPP_FMAC(y2, xr, st[10], 10); DPP_FMAC(y3, xr, st[11], 11);
                DPP_FMAC(y0, xr, st[12], 12); DPP_FMAC(y1, xr, st[13], 13); DPP_FMAC(y2, xr, st[14], 14); DPP_FMAC(y3, xr, st[15], 15);
                const float yp = (y0 + y1) + (y2 + y3);
                const f32x4_t dy = __builtin_amdgcn_mfma_f32_16x16x4f32(1.0f, yp, (f32x4_t){0.f, 0.f, 0.f, 0.f}, 0, 0, 0);
                if (lane < 16) yb[t * 64 + 16 * wid + lane] = dy[0];
                xn = nxn; xw = nxw; xb = nxb; xk = nxk; xr = nxr; vv = nvv;
            }
            LDS_BARRIER();
        }
    }
}

__device__ __forceinline__ float gelu_tanh(float x) { const float u = 0.7978845608028654f * (x + 0.044715f * x * x * x); return 0.5f * x * (1.0f + tanhf(u)); }

__device__ __forceinline__ void lru_unit(const KP& p, unsigned char* lds, int l, int s, int n) {
    int tid_o = threadIdx.x; asm volatile("" : "+v"(tid_o)); const int tid = tid_o, lane = tid & 63; const int wid = __builtin_amdgcn_readfirstlane(tid >> 6);
    f32x2_t* W2 = (f32x2_t*)lds;
    float* XC = (float*)(lds + 32768);
    float* GA = XC + 4096;
    float* GX = GA + 4096;
    float* HF = GX + 4096;
    float* YG = HF + 4096;
    float* HO = YG + 4096;
    const bf16* Z = (const bf16*)(p.ws + OFF_Z);
    bf16* OM = (bf16*)(p.ws + OFF_OMIX);
    const int S = seq_len(s), start = seq_start(s); const int NB = S / 64;
    const int t_ = tid >> 3, c8 = (tid & 7) * 8;
    f32x4_t cw0[4], cw1[4];
#pragma unroll
    for (int j = 0; j < 4; ++j) { cw0[j] = *(const f32x4_t*)(p.in[11] + l * 4 * 384 + j * 384 + 64 * n + c8); cw1[j] = *(const f32x4_t*)(p.in[11] + l * 4 * 384 + j * 384 + 64 * n + c8 + 4); }
    const f32x4_t cb0 = *(const f32x4_t*)(p.in[12] + l * 384 + 64 * n + c8), cb1 = *(const f32x4_t*)(p.in[12] + l * 384 + 64 * n + c8 + 4);
    for (int d = 0; d < 2; ++d) {
        const float* wga = p.in[13] + (((size_t)l * 2 + d) * 6 + n) * 4096; const float* wgx = p.in[15] + (((size_t)l * 2 + d) * 6 + n) * 4096;
        const int cc = tid & 63;
        const float bga = p.in[14][(l * 2 + d) * 384 + 64 * n + cc], bgx = p.in[16][(l * 2 + d) * 384 + 64 * n + cc];
        const float lm = -p.in[17][(l * 2 + d) * 384 + 64 * n + cc]; const float sp8 = -8.0f * (lm > 20.f ? lm : log1pf(__expf(lm)));
        __threadfence();
        __syncthreads();
        for (int e = tid; e < 4096; e += NTHR) W2[e] = (f32x2_t){wga[e], wgx[e]};
        float hstate = 0.f;
        u32x4_t rr[4], rh, ry;
#define LRU_ISSUE(blk_) do { const int tt = d == 0 ? (blk_) * 64 + t_ : S - 1 - ((blk_) * 64 + t_); \
            _Pragma("unroll") for (int j = 0; j < 4; ++j) { const int t2 = tt - 2 + j; rr[j] = (t2 >= 0 && t2 < S) ? *(const u32x4_t*)(Z + (size_t)(start + t2) * ZP + 64 * n + c8) : (u32x4_t){0u, 0u, 0u, 0u}; } \
            if (d == 1) { rh = *(const u32x4_t*)(OM + (size_t)(start + tt) * DM + 64 * n + c8); ry = *(const u32x4_t*)(Z + (size_t)(start + tt) * ZP + 384 + 64 * n + c8); } } while (0)
        LRU_ISSUE(0);
        for (int blk = 0; blk < NB; ++blk) {
            LDS_BARRIER();
            {
                f32x4_t x0 = cb0, x1 = cb1;
#pragma unroll
                for (int j = 0; j < 4; ++j) {
                    const f32x4_t a = (f32x4_t){__builtin_bit_cast(float, rr[j][0] << 16), __builtin_bit_cast(float, rr[j][0] & 0xffff0000u), __builtin_bit_cast(float, rr[j][1] << 16), __builtin_bit_cast(float, rr[j][1] & 0xffff0000u)};
                    const f32x4_t b = (f32x4_t){__builtin_bit_cast(float, rr[j][2] << 16), __builtin_bit_cast(float, rr[j][2] & 0xffff0000u), __builtin_bit_cast(float, rr[j][3] << 16), __builtin_bit_cast(float, rr[j][3] & 0xffff0000u)};
                    x0 += cw0[j] * a; x1 += cw1[j] * b;
                }
                *(f32x4_t*)(XC + t_ * 64 + c8) = x0; *(f32x4_t*)(XC + t_ * 64 + c8 + 4) = x1;
                if (d == 1) {
                    float hf[8], yg[8];
#pragma unroll
                    for (int q = 0; q < 4; ++q) { hf[2 * q] = __builtin_bit_cast(float, rh[q] << 16); hf[2 * q + 1] = __builtin_bit_cast(float, rh[q] & 0xffff0000u);
                        yg[2 * q] = gelu_tanh(__builtin_bit_cast(float, ry[q] << 16)); yg[2 * q + 1] = gelu_tanh(__builtin_bit_cast(float, ry[q] & 0xffff0000u)); }
                    *(f32x4_t*)(HF + t_ * 64 + c8) = (f32x4_t){hf[0], hf[1], hf[2], hf[3]}; *(f32x4_t*)(HF + t_ * 64 + c8 + 4) = (f32x4_t){hf[4], hf[5], hf[6], hf[7]};
                    *(f32x4_t*)(YG + t_ * 64 + c8) = (f32x4_t){yg[0], yg[1], yg[2], yg[3]}; *(f32x4_t*)(YG + t_ * 64 + c8 + 4) = (f32x4_t){yg[4], yg[5], yg[6], yg[7]};
                }
                if (blk + 1 < NB) LRU_ISSUE(blk + 1);
            }
            LDS_BARRIER();
            {
                const int tg = tid >> 6; f32x2_t acc[8];
#pragma unroll
                for (int t = 0; t < 8; ++t) acc[t] = (f32x2_t){0.f, 0.f};
#pragma unroll 1
                for (int i = 0; i < 64; i += 8) {
                    f32x2_t wq[8]; f32x4_t xq[8][2];
#pragma unroll
                    for (int q = 0; q < 8; ++q) wq[q] = W2[(i + q) * 64 + cc];
#pragma unroll
                    for (int t = 0; t < 8; ++t) { xq[t][0] = *(const f32x4_t*)(XC + (tg * 8 + t) * 64 + i); xq[t][1] = *(const f32x4_t*)(XC + (tg * 8 + t) * 64 + i + 4); }
                    __builtin_amdgcn_sched_barrier(0);
#pragma unroll
                    for (int q = 0; q < 2; ++q)
#pragma unroll
                        for (int t = 0; t < 8; ++t) { acc[t] += wq[4 * q] * xq[t][q][0]; acc[t] += wq[4 * q + 1] * xq[t][q][1]; acc[t] += wq[4 * q + 2] * xq[t][q][2]; acc[t] += wq[4 * q + 3] * xq[t][q][3]; }
                    __builtin_amdgcn_sched_barrier(0);
                }
#pragma unroll
                for (int t = 0; t < 8; ++t) {
                    const int e = (tg * 8 + t) * 64 + cc;
                    const float ra = sigmoidf_(acc[t].x + bga), ix = sigmoidf_(acc[t].y + bgx);
                    const float la = sp8 * ra; const float a = __expf(la); const float uu = sqrtf(-expm1f(2.0f * la)) * ix * XC[e];
                    GA[e] = a; GX[e] = uu;
                }
            }
            LDS_BARRIER();
            if (wid == 0) {
#pragma unroll 8
                for (int t = 0; t < 64; ++t) { hstate = GA[t * 64 + lane] * hstate + GX[t * 64 + lane]; HO[t * 64 + lane] = d == 0 ? hstate : (HF[t * 64 + lane] + hstate) * YG[t * 64 + lane]; }
            }
            LDS_BARRIER();
            {   const int tt = d == 0 ? blk * 64 + t_ : S - 1 - (blk * 64 + t_);
                const f32x4_t a = *(const f32x4_t*)(HO + t_ * 64 + c8), b = *(const f32x4_t*)(HO + t_ * 64 + c8 + 4);
                u32x4_t w; w.x = pk2(a[0], a[1]); w.y = pk2(a[2], a[3]); w.z = pk2(b[0], b[1]); w.w = pk2(b[2], b[3]);
                *(u32x4_t*)(OM + (size_t)(start + tt) * DM + 64 * n + c8) = w; }
        }
#undef LRU_ISSUE
    }
}

__device__ __forceinline__ void rwkv_post_tile(const KP& p, unsigned char* lds, int l, int tile) {
    int tid_o = threadIdx.x; asm volatile("" : "+v"(tid_o)); const int tid = tid_o, lane = tid & 63;
    float* SG = (float*)lds;
    float* GO = SG + 4096;
    const bf16* Z = (const bf16*)(p.ws + OFF_Z); bf16* OM = (bf16*)(p.ws + OFF_OMIX);
    const float* YF = (const float*)(p.ws + OFF_YF); const float* YBk = (const float*)(p.ws + OFF_YB);
    const float* mu = p.in[18] + l * 1024; const float* g_up = p.in[23] + (size_t)l * 128 * 256;
    const int m0 = tile * 32; const int s = seq_of_row(m0); const int S = seq_len(s), start = seq_start(s);
    __syncthreads();
    for (int e = tid; e < 4096; e += NTHR) {
        const int t = e >> 7, c = e & 127; const int m = m0 + t, tt = m - start; const bf16* zp = Z + (size_t)m * ZP + 768 + 896 + c;
        const float f = bf2f(zp[0]); const float pv = tt > 0 ? bf2f(zp[-ZP]) : 0.f; const float nx = tt < S - 1 ? bf2f(zp[ZP]) : 0.f;
        SG[e] = sigmoidf_(f + mu[896 + c] * (0.5f * (pv + nx) - f));
    }
    __syncthreads();
    const int c = tid & 255, tg = tid >> 8;
    {
        float acc[16];
#pragma unroll
        for (int t = 0; t < 16; ++t) acc[t] = 0.f;
        for (int ib = 0; ib < 128; ib += 16) {
            float wv[16];
#pragma unroll
            for (int u = 0; u < 16; ++u) wv[u] = g_up[(ib + u) * 256 + c];
#pragma unroll
            for (int u4 = 0; u4 < 16; u4 += 4)
#pragma unroll
                for (int t = 0; t < 16; ++t) { const f32x4_t x = *(const f32x4_t*)(SG + (tg * 16 + t) * 128 + ib + u4); acc[t] += x[0] * wv[u4] + x[1] * wv[u4 + 1] + x[2] * wv[u4 + 2] + x[3] * wv[u4 + 3]; }
        }
#pragma unroll
        for (int t = 0; t < 16; ++t) GO[(tg * 16 + t) * 256 + c] = acc[t];
    }
    const float rk = p.in[26][l * 256 + c], lg = p.in[27][l * 256 + c], lb = p.in[28][l * 256 + c];
    const float mr = mu[c], mk = mu[256 + c], mv = mu[512 + c];
    for (int t = 0; t < 16; ++t) {
        const int m = m0 + tg * 16 + t, tt = m - start; const bf16* zp = Z + (size_t)m * ZP + 768 + c;
        const bool hp = tt > 0, hn = tt < S - 1;
        float f = bf2f(zp[0]), pv = hp ? bf2f(zp[-ZP]) : 0.f, nx = hn ? bf2f(zp[ZP]) : 0.f; const float r = f + mr * (0.5f * (pv + nx) - f);
        f = bf2f(zp[256]); pv = hp ? bf2f(zp[256 - ZP]) : 0.f; nx = hn ? bf2f(zp[256 + ZP]) : 0.f; const float k = f + mk * (0.5f * (pv + nx) - f);
        f = bf2f(zp[512]); pv = hp ? bf2f(zp[512 - ZP]) : 0.f; nx = hn ? bf2f(zp[512 + ZP]) : 0.f; const float v = f + mv * (0.5f * (pv + nx) - f);
        const float y = YF[(size_t)m * 256 + c] + YBk[(size_t)m * 256 + c];
        const float mean = wave_sum(y) * (1.0f / 64.0f); const float dv = y - mean; const float var = wave_sum(dv * dv) * (1.0f / 64.0f);
        const float yn = dv * rsqrtf(var + 64e-5f) * lg + lb;
        const float bon = wave_sum(r * k * rk);
        const float outv = (yn + bon * v) * GO[(tg * 16 + t) * 256 + c];
        OM[(size_t)m * DM + 384 + c] = (bf16)f2bf(outv);
    }
    (void)lane;
}

__global__ void __launch_bounds__(NTHR, 2) fwd_megakernel(KP p) {
    extern __shared__ __attribute__((aligned(16))) unsigned char lds[];
    cg::grid_group grid = cg::this_grid();
    const int tid = threadIdx.x, lane = tid & 63, wid = tid >> 6;
    const int G = gridDim.x, bx = blockIdx.x;
    const int gw = bx * 8 + wid, NGW = G * 8;
    unsigned char* ws = p.ws;
    volatile int* misc = (volatile int*)(lds + MISC_OFF);
    PG8_LAS unsigned char* ldsg = (PG8_LAS unsigned char*)lds;

    {
        float* scr = (float*)(lds + wid * 16384);
        for (int l = 0; l < 2; ++l) {
            unsigned char* wl = ws + OFF_W + l * W_LAYER;
            constexpr int I_IN = 16 * 176, I_OUT = 44 * 32, I_MI = 16 * 76, I_MO = 16 * 32, I_TOT = 2 * I_IN + 2 * I_OUT + I_MI + I_MO;
            for (int it = gw; it < I_TOT; it += NGW) {
                int r = it;
                if (r < 2 * I_IN) { const int f = r / I_IN; transpose_item<1>(p.in[7] + ((size_t)l * 2 + f) * DM * NFF, DM, NFF, (bf16*)(wl + WO_IN + f * 11 * MiB), scr, r % I_IN, lane); continue; } r -= 2 * I_IN;
                if (r < 2 * I_OUT) { const int f = r / I_OUT; transpose_item<0>(p.in[8] + ((size_t)l * 2 + f) * DFF * DM, DFF, DM, (bf16*)(wl + WO_OUT + f * (11 * MiB / 2)), scr, r % I_OUT, lane); continue; } r -= 2 * I_OUT;
                if (r < I_MI) { transpose_item<2>(p.in[9] + (size_t)l * DM * NMIX, DM, NMIX, (bf16*)(wl + WO_MI), scr, r, lane); continue; } r -= I_MI;
                transpose_item<0>(p.in[10] + (size_t)l * DM * DM, DM, DM, (bf16*)(wl + WO_MO), scr, r, lane);
            }
            u32x4_t* padp = (u32x4_t*)(wl + WO_MI + (size_t)NMIX * DM * 2);
            for (int e = bx * NTHR + tid; e < 128 * DM * 2 / 16; e += G * NTHR) padp[e] = (u32x4_t){0u, 0u, 0u, 0u};
        }
        __syncthreads();
        for (int u = bx; u < 2 * 36 * 8; u += G) { const int l = u / 288, r = u % 288;
            smallm_unit<0, 0>(p, (float*)lds, l, 0, p.in[4] + (size_t)l * DM * 9216, 9216, 9216, (float*)(ws + OFF_MOD) + (size_t)l * NSEQ * 9216, 9216, r / 8, r % 8); }
        if (bx == 0) { float* rope = (float*)(ws + OFF_ROPE);
            for (int e = tid; e < 1024; e += NTHR) { const int pos = e >> 4, pp = e & 15; const float inv = exp2f(-(float)pp * (13.287712379549449f / 16.0f)); const float a = (float)pos * inv; const float kr = rintf(a * 0.15915494309189535f); float rr = fmaf(-kr, 6.2831854820251465f, a); rr = fmaf(-kr, -1.7484555e-7f, rr); rope[2 * e] = __cosf(rr); rope[2 * e + 1] = __sinf(rr); } }
    }
    grid.sync();
    {
        const float* MOD = (const float*)(ws + OFF_MOD); float* GV = (float*)(ws + OFF_GV); float* GT = (float*)(ws + OFF_GATE);
        for (int e = bx * NTHR + tid; e < 6 * NSEQ * DM; e += G * NTHR) {
            const int c = e & 1023, s = (e >> 10) % NSEQ, inst = e / (NSEQ * DM); const int l = inst / 3, j = inst % 3;
            const float* mr = MOD + ((size_t)l * NSEQ + s) * 9216; const float* ba = p.in[5] + l * 9216;
            const float sc = mr[(3 * j + 1) * 1024 + c] + ba[(3 * j + 1) * 1024 + c], gg = mr[(3 * j + 2) * 1024 + c] + ba[(3 * j + 2) * 1024 + c];
            GV[e] = p.in[6][(l * 3 + j) * DM + c] * (1.0f + sc); GT[e] = (j == 1 ? 1.0f : 0.5f) * gg;
        }
        for (int u = bx; u < 2 * 432; u += G) { const int l = u / 432, r = u % 432; float* bdst = (float*)(ws + OFF_BIAS);
            if (r < 176) smallm_unit<1, 1>(p, (float*)lds, l, 0, p.in[7] + ((size_t)l * 2 + 0) * DM * NFF, NFF, NFF, bdst + (size_t)(l * 3 + 0) * NSEQ * NFF, NFF, r / 8, r % 8);
            else if (r < 256) smallm_unit<1, 2>(p, (float*)lds, l, 1, p.in[9] + (size_t)l * DM * NMIX, NMIX, NMIX, bdst + (size_t)(l * 3 + 1) * NSEQ * NFF, NFF, (r - 176) / 8, (r - 176) % 8);
            else smallm_unit<1, 1>(p, (float*)lds, l, 2, p.in[7] + ((size_t)l * 2 + 1) * DM * NFF, NFF, NFF, bdst + (size_t)(l * 3 + 2) * NSEQ * NFF, NFF, (r - 256) / 8, (r - 256) % 8); }
        bf16* XN = (bf16*)(ws + OFF_XN); float* SS0 = (float*)(ws + OFF_SS);
        for (int m = gw; m < MTOK; m += NGW) {
            const int s = seq_of_row(m); const float* xr = m < 16384 ? p.in[0] + (size_t)m * DM : p.in[1] + (size_t)(m - 16384) * DM;
            const float* mr = MOD + (size_t)s * 9216 + 1024; const float* ba = p.in[5] + 1024; const float* ng = p.in[6];
            float q = 0.f;
#pragma unroll
            for (int j = 0; j < 4; ++j) { const int c = 4 * lane + 256 * j; const f32x4_t v = *(const f32x4_t*)(xr + c); const f32x4_t sc = *(const f32x4_t*)(mr + c) + *(const f32x4_t*)(ba + c); const f32x4_t g = *(const f32x4_t*)(ng + c) * (sc + 1.0f);
                q += (v[0] * v[0] + v[1] * v[1]) + (v[2] * v[2] + v[3] * v[3]); const f32x4_t o = v * g;
                *(unsigned long long*)(XN + (size_t)m * DM + c) = (unsigned long long)pk2(o[0], o[1]) | ((unsigned long long)pk2(o[2], o[3]) << 32); }
            q = wave_sum(q); if (lane == 0) SS0[m] = q;
        }
    }
    grid.sync();

    for (int l = 0; l < 2; ++l) {
        unsigned char* wl = ws + OFF_W + l * W_LAYER;
        const float* GV = (const float*)(ws + OFF_GV); const float* GT = (const float*)(ws + OFF_GATE); const float* BI = (const float*)(ws + OFF_BIAS); float* SS = (float*)(ws + OFF_SS);
        bf16* XN = (bf16*)(ws + OFF_XN); bf16* HID = (bf16*)(ws + OFF_HID); bf16* OMIX = (bf16*)(ws + OFF_OMIX);
        for (int f = 0; f < 2; ++f) {
            const int j = f == 0 ? 0 : 2; const int inst = l * 3 + j;
            if (f == 1) {
                {
                    pg8::Gemm g{XN, (const pg8::bf16_t*)(wl + WO_MI), MTOK, NMIXP, DM}; pg8::StaticOrder S; S.init(MTOK, NMIXP, G, bx);
                    pg8::EpiZ E{(bf16*)(ws + OFF_Z), (bf16*)(ws + OFF_QK), (bf16*)(ws + OFF_VR), SS + (size_t)(l * 3 + 1) * MTOK, BI + (size_t)(l * 3 + 1) * NSEQ * NFF, p.in[29] + l * 64, p.in[30] + l * 64, (const float*)(ws + OFF_ROPE)};
                    pg8::gemm_phase<pg8::EpiZ, pg8::StaticOrder, true, true>(ldsg, g, S, E);
                }
                grid.sync();
                {
                    unsigned* ctr = (unsigned*)(ws + OFF_CTR) + 64 * l;
                    constexpr int NU_R = 160, NU_L = 120, NU_A = 1152, NU = NU_R + NU_L + NU_A;
                    for (;;) {
                        __syncthreads(); if (tid == 0) misc[0] = (int)atomicAdd(ctr, 1u); __syncthreads();
                        const int u = misc[0]; if (u >= NU) break;
                        if (u < 32) rwkv_unit(p, lds, l, u >> 3, (u >> 1) & 3, u & 1);
                        else if (u < 160) { const int i2 = u - 32; rwkv_unit(p, lds, l, 4 + (i2 >> 3), (i2 >> 1) & 3, i2 & 1); }
                        else if (u < 184) { const int i3 = u - 160; lru_unit(p, lds, l, i3 / 6, i3 % 6); }
                        else if (u < 280) { const int i4 = u - 184; lru_unit(p, lds, l, 4 + i4 / 6, i4 % 6); }
                        else { const int i5 = u - 280; int s_, hq, qb;
                            if (i5 < 384) { s_ = i5 / 96; const int r = i5 % 96; hq = (r / 48) * 3 + (r % 48) / 16; qb = r & 15; }
                            else { const int i6 = i5 - 384; s_ = 4 + i6 / 48; const int r = i6 % 48; hq = (r / 24) * 3 + (r % 24) / 8; qb = r & 7; }
                            const int g_ = hq / 3;
                            attn_body::attn_unit<8>(seq_start(s_), seq_len(s_), qb, 64 * hq, 384 + 64 * g_, 64 * g_, 640 + 64 * hq, (const attn_body::bf16*)(ws + OFF_QK), (const attn_body::bf16*)(ws + OFF_QK), (const attn_body::bf16*)(ws + OFF_VR), (attn_body::bf16*)(ws + OFF_OMIX), (char*)lds); }
                    }
                }
                grid.sync();
                for (int t = bx; t < MTOK / 32; t += G) rwkv_post_tile(p, lds, l, t);
                grid.sync();
                {
                    pg8::Gemm g{OMIX, (const pg8::bf16_t*)(wl + WO_MO), MTOK, DM, DM}; pg8::StaticOrder S; S.init(MTOK, DM, G, bx);
                    pg8::EpiResid E{p.out, p.out + (size_t)16384 * DM, p.out, XN, SS + (size_t)(l * 3 + 2) * MTOK, GT + (size_t)(l * 3 + 1) * NSEQ * DM, GV + (size_t)(l * 3 + 2) * NSEQ * DM};
                    pg8::gemm_phase<pg8::EpiResid, pg8::StaticOrder, true, true>(ldsg, g, S, E);
                }
                grid.sync();
            }
            {
                pg8::Gemm g{XN, (const pg8::bf16_t*)(wl + WO_IN + f * 11 * MiB), MTOK, NFF, DM}; pg8::StaticOrder S; S.init(MTOK, NFF, G, bx);
                pg8::EpiSwiglu E{HID, SS + (size_t)inst * MTOK, BI + (size_t)inst * NSEQ * NFF};
                pg8::gemm_phase<pg8::EpiSwiglu, pg8::StaticOrder, true, true>(ldsg, g, S, E);
            }
            grid.sync();
            {
                const bool first = (l == 0 && f == 0), last = (l == 1 && f == 1);
                const int ninst = inst + 1;
                pg8::Gemm g{HID, (const pg8::bf16_t*)(wl + WO_OUT + f * (11 * MiB / 2)), MTOK, DM, DFF}; pg8::StaticOrder S; S.init(MTOK, DM, G, bx);
                pg8::EpiResid E{first ? p.in[0] : p.out, first ? p.in[1] : p.out + (size_t)16384 * DM, p.out, XN, last ? nullptr : SS + (size_t)ninst * MTOK, GT + (size_t)inst * NSEQ * DM, last ? nullptr : GV + (size_t)ninst * NSEQ * DM};
                pg8::gemm_phase<pg8::EpiResid, pg8::StaticOrder, true, true>(ldsg, g, S, E);
            }
            if (!(l == 1 && f == 1)) grid.sync();
        }
    }
}

extern "C" void kernel_launch(void* const* d_in, const int* in_sizes, int n_in, void* d_out, int out_size, void* d_ws, size_t ws_size, hipStream_t stream) {
    static int grid = 0;
    if (grid == 0) {
        if (n_in != 31 || ws_size < WS_END) { fprintf(stderr, "kernel_launch: unexpected n_in %d / ws %zu\n", n_in, ws_size); grid = -1; return; }
        int dev = 0, cus = 0, per_cu = 0;
        hipGetDevice(&dev); hipDeviceGetAttribute(&cus, hipDeviceAttributeMultiprocessorCount, dev);
        hipFuncSetAttribute((const void*)fwd_megakernel, hipFuncAttributeMaxDynamicSharedMemorySize, LDS_BYTES);
        hipOccupancyMaxActiveBlocksPerMultiprocessor(&per_cu, (const void*)fwd_megakernel, NTHR, LDS_BYTES);
        if (per_cu < 1) per_cu = 1;
        grid = cus * per_cu;
        (void)hipGetLastError();
    }
    if (grid < 0) return;
    hipMemsetAsync(d_ws, 0, ZERO_BYTES, stream);
    KP p{};
    for (int i = 0; i < 31; ++i) p.in[i] = (const float*)d_in[i];
    p.out = (float*)d_out; p.ws = (unsigned char*)d_ws;
    void* args[] = {&p};
    hipError_t e = hipLaunchCooperativeKernel((const void*)fwd_megakernel, dim3(grid), dim3(NTHR), args, LDS_BYTES, stream);
    if (e != hipSuccess) fprintf(stderr, "cooperative launch failed: %s (grid %d)\n", hipGetErrorString(e), grid);
}
```

```cpp
#include <hip/hip_runtime.h>
#include <hip/hip_cooperative_groups.h>
#include <cstdio>
#include <cstdint>
namespace cg = cooperative_groups;
namespace pg8 {
#define PG8_LAS __attribute__((address_space(3)))
typedef unsigned short bf16_t;
typedef short bf16x8 __attribute__((ext_vector_type(8)));
typedef float f32x4 __attribute__((ext_vector_type(4)));
typedef unsigned u32x4 __attribute__((ext_vector_type(4)));
constexpr int BM = 256, BK = 64, HALF = 128, HTB = HALF * BK * 2  , STAGE_BYTES = 8 * HTB, NXCD = 8, WGM = 8;

__host__ __device__ __forceinline__ int lds_byte(int r, int c) { const int st = (r >> 4) * 2 + (c >> 5), rr = r & 15, cc = c & 31, ob = rr * 64 + cc * 2; return st * 1024 + (ob ^ (((ob >> 9) & 1) << 5)); }
__host__ __device__ __forceinline__ void stage_rc(int b, int& R, int& C) { const int st = b / 1024, sb = b % 1024, swz = sb ^ (((sb >> 9) & 1) << 5); R = (st >> 1) * 16 + swz / 64; C = (st & 1) * 32 + (swz % 64) / 2; }
__host__ __device__ __forceinline__ int perm32(int rho) { const int n = rho >> 4, i = rho & 15; return 8 * (i >> 2) + 4 * n + (i & 3); }

struct Unit { int pm, pn; };
struct Gemm { const bf16_t* A; const bf16_t* Bt; int M, N, K; };

struct StaticOrder {
    int nM, nN, nwg, G, c;
    __host__ __device__ void init(int M, int N, int G_, int c_) { nM = M / BM; nN = N / BM; nwg = nM * nN; G = G_; c = c_; }
    __host__ __device__ bool next(int i, Unit& u) const {
        const long L = (long)i * G + c; if (L >= nwg) return false;
        int wgid = (int)L; { const int q = nwg / NXCD, r = nwg % NXCD, xcd = wgid % NXCD, off = wgid / NXCD; wgid = (xcd < r ? xcd * (q + 1) : r * (q + 1) + (xcd - r) * q) + off; }
        const int nig = WGM * nN, gid = wgid / nig, fm = gid * WGM, gsz = (nM - fm) < WGM ? (nM - fm) : WGM;
        u.pm = fm + ((wgid % nig) % gsz); u.pn = (wgid % nig) / gsz; return true;
    }
    __device__ __forceinline__ void a_ready(const Unit&) const {}
    __device__ __forceinline__ void done(const Unit&) const {}
};

__device__ __forceinline__ unsigned cvt_pk_bf16(float lo, float hi) { unsigned r; asm volatile("v_cvt_pk_bf16_f32 %0, %1, %2" : "=v"(r) : "v"(lo), "v"(hi)); return r; }
typedef float f32x2 __attribute__((ext_vector_type(2)));
__device__ __forceinline__ f32x2 gelu_pk(f32x2 v) {
    const f32x2 av = __builtin_elementwise_abs(v), d = av * 0.2316418882f + 1.0f;
    f32x2 t; t.x = __builtin_amdgcn_rcpf(d.x); t.y = __builtin_amdgcn_rcpf(d.y);
    f32x2 q = t * 0.5307027145f + (-0.7265760135f); q = q * t + 0.7107068705f; q = q * t + (-0.142248368f); q = q * t + 0.127414796f; q = q * t;
    const f32x2 s = (v * v) * (-0.72134752044f);
    f32x2 e; e.x = __builtin_amdgcn_exp2f(s.x); e.y = __builtin_amdgcn_exp2f(s.y);
    const f32x2 m = v * (q * e), r = v - m;
    f32x2 o; o.x = v.x < 0.f ? m.x : r.x; o.y = v.y < 0.f ? m.y : r.y; return o;
}

template <int ACT  > struct EpiBf16 {
    static constexpr bool PERM = true, AFTER_DRAIN = false; static_assert(ACT == 0 || ACT == 1, "EpiBf16: ACT is 0 (none) or 1 (gelu_pk)");
    bf16_t* O; int ldc; const float* bias; int split_cols; size_t split_stride; float scale0;
    __device__ __forceinline__ void operator()(const f32x4 (&acc)[2][2][4][2], const Unit& u, int wr, int wc, int fr, int fq) const {
        const int row0 = u.pm * BM + wr * 64 + fr; int colt = u.pn * BM; bf16_t* base = O;
        float sc = 1.f; if (split_cols) { const int t = colt / split_cols; base += (size_t)t * split_stride; colt -= t * split_cols; if (t == 0) sc = scale0; }
        const int col0 = colt + wc * 32 + 8 * fq, bcol0 = u.pn * BM + wc * 32 + 8 * fq;
        f32x4 bv[2][2];
#pragma unroll
        for (int bj = 0; bj < 2; ++bj)
#pragma unroll
            for (int n = 0; n < 2; ++n) bv[bj][n] = bias ? *(const f32x4*)(bias + bcol0 + bj * HALF + 4 * n) : (f32x4){0.f, 0.f, 0.f, 0.f};
#pragma unroll
        for (int ai = 0; ai < 2; ++ai)
#pragma unroll
            for (int m = 0; m < 4; ++m) { bf16_t* rowp = base + (size_t)(row0 + ai * HALF + m * 16) * ldc + col0;
#pragma unroll
                for (int bj = 0; bj < 2; ++bj) { f32x4 v0 = acc[ai][bj][m][0] + bv[bj][0], v1 = acc[ai][bj][m][1] + bv[bj][1];
                    if (ACT == 1) { f32x2 a = gelu_pk((f32x2){v0[0], v0[1]}), b = gelu_pk((f32x2){v0[2], v0[3]}), c = gelu_pk((f32x2){v1[0], v1[1]}), d = gelu_pk((f32x2){v1[2], v1[3]});
                        v0 = (f32x4){a.x, a.y, b.x, b.y}; v1 = (f32x4){c.x, c.y, d.x, d.y}; }
                    v0 = v0 * sc; v1 = v1 * sc; u32x4 w; w.x = cvt_pk_bf16(v0[0], v0[1]); w.y = cvt_pk_bf16(v0[2], v0[3]); w.z = cvt_pk_bf16(v1[0], v1[1]); w.w = cvt_pk_bf16(v1[2], v1[3]);
                    *(u32x4*)(rowp + bj * HALF) = w; } }
    }
};
template <class Epi, class Sched, bool ALIGN_EPI = false, bool SP2 = false>
__device__ __forceinline__ void gemm_phase(PG8_LAS unsigned char* lds, const Gemm g, const Sched& S, const Epi& E) {
    int tid_o = threadIdx.x; asm volatile("" : "+v"(tid_o)); const int tid = tid_o, wid = __builtin_amdgcn_readfirstlane(tid >> 6), lane = tid & 63, wr = wid >> 2, wc = wid & 3, fr = lane & 15, fq = lane >> 4;
    const int K = g.K, nt = K / BK;
    unsigned voffA[2], voffB[2];
#pragma unroll
    for (int i = 0; i < 2; ++i) { int R, C; stage_rc(tid * 16 + i * 8192, R, C); const int Rb = Epi::PERM ? ((R & ~31) + perm32(R & 31)) : R;
        voffA[i] = (unsigned)(R * K + C) * 2u; voffB[i] = (unsigned)(Rb * K + C) * 2u; }
    const size_t kstep = (size_t)(BK * 2);
    const size_t hstep = (size_t)HALF * K * 2;
    const size_t tstep = 2 * hstep;
    const unsigned ldsw = (unsigned)wid * 1024u;
    const int aoff = lds_byte(wr * 64 + fr, fq * 8), boff = lds_byte(wc * 32 + fr, fq * 8);
#define PG8_SA(b, h) (((b) * 2 + (h)) * HTB)
#define PG8_SB(b, h) ((4 + (b) * 2 + (h)) * HTB)
#define PG8_STAGE(bufoff, gbase, voff) do { _Pragma("unroll") for (int _i = 0; _i < 2; ++_i) \
        __builtin_amdgcn_global_load_lds((const unsigned*)((const char*)(gbase) + (voff)[_i]), (PG8_LAS unsigned*)(lds + (bufoff) + ldsw + _i * 8192), 16, 0, 0); } while (0)
#define PG8_LDA(dst, b, h) do { _Pragma("unroll") for (int m = 0; m < 4; ++m) _Pragma("unroll") for (int k = 0; k < 2; ++k) dst[m][k] = *(const PG8_LAS bf16x8*)(lds + PG8_SA(b, h) + aoff + m * 2048 + k * 1024); } while (0)
#define PG8_LDB(dst, b, h) do { _Pragma("unroll") for (int n = 0; n < 2; ++n) _Pragma("unroll") for (int k = 0; k < 2; ++k) dst[n][k] = *(const PG8_LAS bf16x8*)(lds + PG8_SB(b, h) + boff + n * 2048 + k * 1024); } while (0)
#define PG8_MMA(ai, bj, At, Bt) do { __builtin_amdgcn_s_setprio(1); _Pragma("unroll") for (int m = 0; m < 4; ++m) _Pragma("unroll") for (int n = 0; n < 2; ++n) _Pragma("unroll") for (int k = 0; k < 2; ++k) \
        acc[ai][bj][m][n] = __builtin_amdgcn_mfma_f32_16x16x32_bf16(Bt[n][k], At[m][k], acc[ai][bj][m][n], 0, 0, 0); __builtin_amdgcn_s_setprio(0); } while (0)
#define PG8_WAIT_V(n) asm volatile("s_waitcnt vmcnt(" #n ")" ::: "memory")
#define PG8_WAIT_L(n) asm volatile("s_waitcnt lgkmcnt(" #n ")" ::: "memory")
#define PG8_BAR __builtin_amdgcn_s_barrier()
#define PG8_SCHED __builtin_amdgcn_sched_barrier(0)
    Unit cur, nxt; int ui = 0;
    if (!S.next(0, cur)) return;
    f32x4 acc[2][2][4][2];
#pragma unroll
    for (int a = 0; a < 2; ++a)
#pragma unroll
        for (int b = 0; b < 2; ++b)
#pragma unroll
            for (int m = 0; m < 4; ++m)
#pragma unroll
                for (int n = 0; n < 2; ++n) acc[a][b][m][n] = (f32x4){0.f, 0.f, 0.f, 0.f};
    bf16x8 At[4][2], B0[2][2], B1[2][2];
    const char* cA = (const char*)g.A + (size_t)cur.pm * tstep; const char* cB = (const char*)g.Bt + (size_t)cur.pn * tstep;
    S.a_ready(cur);
    if constexpr (SP2) {
        PG8_STAGE(PG8_SB(0, 0), cB, voffB); PG8_STAGE(PG8_SB(0, 1), cB + hstep, voffB); PG8_STAGE(PG8_SA(0, 0), cA, voffA); PG8_STAGE(PG8_SA(0, 1), cA + hstep, voffA);
        if (wr == 1) PG8_BAR;
        PG8_WAIT_V(2); PG8_BAR;
        PG8_STAGE(PG8_SB(1, 0), cB + kstep, voffB); PG8_STAGE(PG8_SA(1, 0), cA + kstep, voffA); PG8_STAGE(PG8_SB(1, 1), cB + hstep + kstep, voffB);
        PG8_WAIT_V(6); PG8_BAR;
    } else {
        PG8_STAGE(PG8_SB(0, 0), cB, voffB); PG8_STAGE(PG8_SA(0, 0), cA, voffA); PG8_STAGE(PG8_SB(0, 1), cB + hstep, voffB); PG8_STAGE(PG8_SA(0, 1), cA + hstep, voffA);
        if (wr == 1) PG8_BAR;
        PG8_WAIT_V(4); PG8_BAR;
        PG8_STAGE(PG8_SB(1, 0), cB + kstep, voffB); PG8_STAGE(PG8_SA(1, 0), cA + kstep, voffA); PG8_STAGE(PG8_SB(1, 1), cB + hstep + kstep, voffB);
        PG8_WAIT_V(6); PG8_BAR;
    }
    for (;;) {
        const bool has_next = S.next(ui + 1, nxt);
        const char* nA = has_next ? (const char*)g.A + (size_t)nxt.pm * tstep : cA; const char* nB = has_next ? (const char*)g.Bt + (size_t)nxt.pn * tstep : cB;
        for (int t = 0; t < nt; t += 2) {
            const bool last = (t == nt - 2);
            const char* a1 = cA + (size_t)(t + 1) * kstep;
            const char* a2 = last ? nA : cA + (size_t)(t + 2) * kstep; const char* b2 = last ? nB : cB + (size_t)(t + 2) * kstep;
            const char* a3 = a2 + kstep; const char* b3 = b2 + kstep;
            if (last && has_next) S.a_ready(nxt);
            if constexpr (SP2) {
            PG8_LDB(B0, 0, 0); PG8_LDB(B1, 0, 1); PG8_SCHED; PG8_LDA(At, 0, 0); PG8_STAGE(PG8_SA(1, 1), a1 + hstep, voffA);
            PG8_WAIT_V(8); PG8_WAIT_L(0); PG8_BAR; PG8_MMA(0, 0, At, B0); PG8_MMA(0, 1, At, B1); PG8_BAR; PG8_SCHED;
            PG8_LDA(At, 0, 1); PG8_STAGE(PG8_SB(0, 0), b2, voffB); PG8_STAGE(PG8_SB(0, 1), b2 + hstep, voffB); PG8_STAGE(PG8_SA(0, 0), a2, voffA);
            PG8_WAIT_V(8); PG8_WAIT_L(0); PG8_BAR; PG8_MMA(1, 0, At, B0); PG8_MMA(1, 1, At, B1); PG8_BAR; PG8_SCHED;
            PG8_LDB(B0, 1, 0); PG8_LDB(B1, 1, 1); PG8_SCHED; PG8_LDA(At, 1, 0); PG8_STAGE(PG8_SA(0, 1), a2 + hstep, voffA);
            PG8_WAIT_V(8); PG8_WAIT_L(0); PG8_BAR; PG8_MMA(0, 0, At, B0); PG8_MMA(0, 1, At, B1); PG8_BAR; PG8_SCHED;
            PG8_LDA(At, 1, 1); PG8_STAGE(PG8_SB(1, 0), b3, voffB); PG8_STAGE(PG8_SB(1, 1), b3 + hstep, voffB); PG8_STAGE(PG8_SA(1, 0), a3, voffA);
            PG8_WAIT_V(8); PG8_WAIT_L(0); PG8_BAR; PG8_MMA(1, 0, At, B0); PG8_MMA(1, 1, At, B1); PG8_BAR; PG8_SCHED;
            } else {
            PG8_LDB(B0, 0, 0); PG8_SCHED; PG8_LDA(At, 0, 0); PG8_STAGE(PG8_SA(1, 1), a1 + hstep, voffA);
            PG8_WAIT_L(8); PG8_BAR; PG8_WAIT_L(0); PG8_MMA(0, 0, At, B0); PG8_BAR; PG8_SCHED;
            PG8_LDB(B1, 0, 1); PG8_STAGE(PG8_SB(0, 0), b2, voffB);
            PG8_BAR; PG8_WAIT_L(0); PG8_MMA(0, 1, At, B1); PG8_BAR;
            PG8_LDA(At, 0, 1); PG8_STAGE(PG8_SA(0, 0), a2, voffA);
            PG8_BAR; PG8_WAIT_L(0); PG8_MMA(1, 0, At, B0); PG8_BAR; PG8_SCHED;
            PG8_STAGE(PG8_SB(0, 1), b2 + hstep, voffB);
            PG8_WAIT_V(6); PG8_BAR; PG8_MMA(1, 1, At, B1); PG8_BAR;
            PG8_LDB(B0, 1, 0); PG8_SCHED; PG8_LDA(At, 1, 0); PG8_STAGE(PG8_SA(0, 1), a2 + hstep, voffA);
            PG8_WAIT_L(8); PG8_BAR; PG8_WAIT_L(0); PG8_MMA(0, 0, At, B0); PG8_BAR; PG8_SCHED;
            PG8_LDB(B1, 1, 1); PG8_STAGE(PG8_SB(1, 0), b3, voffB);
            PG8_BAR; PG8_WAIT_L(0); PG8_MMA(0, 1, At, B1); PG8_BAR;
            PG8_LDA(At, 1, 1); PG8_STAGE(PG8_SA(1, 0), a3, voffA);
            PG8_BAR; PG8_WAIT_L(0); PG8_MMA(1, 0, At, B0); PG8_BAR; PG8_SCHED;
            PG8_STAGE(PG8_SB(1, 1), b3 + hstep, voffB);
            PG8_WAIT_V(6); PG8_BAR; PG8_MMA(1, 1, At, B1); PG8_BAR;
            }
        }
        if constexpr (ALIGN_EPI) { if (wr == 0) PG8_BAR; }
        if constexpr (!Epi::AFTER_DRAIN) { E(acc, cur, wr, wc, fr, fq); S.done(cur); }
        if (!has_next) break;
#pragma unroll
        for (int a = 0; a < 2; ++a)
#pragma unroll
            for (int b = 0; b < 2; ++b)
#pragma unroll
                for (int m = 0; m < 4; ++m)
#pragma unroll
                    for (int n = 0; n < 2; ++n) acc[a][b][m][n] = (f32x4){0.f, 0.f, 0.f, 0.f};
        cur = nxt; cA = nA; cB = nB; ++ui;
        if constexpr (ALIGN_EPI) { if (wr == 1) PG8_BAR; }
    }
    PG8_WAIT_V(0);
    if constexpr (!ALIGN_EPI) { if (wr == 0) PG8_BAR; }
    PG8_BAR;
    if constexpr (Epi::AFTER_DRAIN) { E.fused(acc, cur, wr, wc, fr, fq, lds, wid, lane); S.done(cur); }
#undef PG8_SA
#undef PG8_SB
#undef PG8_STAGE
#undef PG8_LDA
#undef PG8_LDB
#undef PG8_MMA
#undef PG8_WAIT_V
#undef PG8_WAIT_L
#undef PG8_BAR
#undef PG8_SCHED
}
}
#include <hip/hip_bf16.h>
#include <cmath>
namespace attn_body {
using bf16=__hip_bfloat16;
using bf16x8=__attribute__((ext_vector_type(8)))short;
using s16x4=__attribute__((ext_vector_type(4)))short;
using f32x16=__attribute__((ext_vector_type(16)))float;
using u32x4=__attribute__((ext_vector_type(4)))unsigned;
constexpr int D=64,QP=512,KP=512,VP=128,OP=1024;
constexpr int NW=8,QBLK=32,QB=QBLK*NW,KVBLK=64;
constexpr int ATTN_UNIT_ROWS=QB;
__device__ __forceinline__ int crow(int r,int hi){return (r&3)+8*(r>>2)+4*hi;}
#define SBAR() __builtin_amdgcn_sched_barrier(0)
__device__ __forceinline__ void cmask(f32x16&p0,f32x16&p1,int jb,int qrel,int hi){
  const float NEG=-INFINITY; int kb=64*jb+4*hi;
  #pragma unroll
  for(int r=0;r<16;++r){int kv=kb+(r&3)+8*(r>>2); if(kv>qrel)p0[r]=NEG; if(kv+32>qrel)p1[r]=NEG;}
}

constexpr int NSLOT=3, SLOTB=8192;
constexpr int LDS_K=0, LDS_V=NSLOT*SLOTB, LDS_WS=2*NSLOT*SLOTB, LDS_OST=LDS_WS+NW*64*4, LDS_BYTES=LDS_OST+NW*4096;
constexpr float C2=0.125f*1.4426950408889634f;
__device__ __forceinline__ void glds16(const void*gsrc,unsigned lds_dst){unsigned keep;
  asm volatile("s_mov_b32 %0, m0\n\ts_mov_b32 m0, %2\n\ts_nop 0\n\tglobal_load_lds_dwordx4 %1, off\n\ts_mov_b32 m0, %0":"=&s"(keep):"v"(gsrc),"s"(lds_dst):"memory");}
__device__ __forceinline__ float max3f(float a,float b,float c){float r;asm("v_max3_f32 %0, %1, %2, %3":"=v"(r):"v"(a),"v"(b),"v"(c));return r;}
__device__ __forceinline__ float max2f(float a,float b){float r;asm("v_max_f32_e32 %0, %1, %2":"=v"(r):"v"(a),"v"(b));return r;}
__device__ __forceinline__ float fadd_s(float a,float b){float r;asm("v_add_f32_e32 %0, %1, %2":"=v"(r):"v"(a),"v"(b));return r;}
__device__ __forceinline__ float fsub_s(float a,float b){float r;asm("v_sub_f32_e32 %0, %1, %2":"=v"(r):"v"(a),"v"(b));return r;}
typedef float f32x2_t __attribute__((ext_vector_type(2))); typedef __bf16 bf16x2_t __attribute__((ext_vector_type(2)));
__device__ __forceinline__ unsigned cvtpk_s(float lo,float hi){f32x2_t v={lo,hi};bf16x2_t b=__builtin_convertvector(v,bf16x2_t);return __builtin_bit_cast(unsigned,b);}
#define WAIT_BAR(N) asm volatile("s_waitcnt vmcnt(" #N ") lgkmcnt(0)\n\ts_barrier":::"memory")

__device__ __forceinline__ void qkt(f32x16&p0,f32x16&p1,const char*Kslot,const bf16x8*qr,const f32x16&negm,int r32,int hi){
  const char*kb=Kslot+hi*1024+r32*16;
  #pragma unroll
  for(int d0=0;d0<4;++d0){
    const bf16x8 b0=*reinterpret_cast<const bf16x8*>(kb+d0*2048);
    const bf16x8 b1=*reinterpret_cast<const bf16x8*>(kb+d0*2048+512);
    if(d0==0){p0=__builtin_amdgcn_mfma_f32_32x32x16_bf16(b0,qr[0],negm,0,0,0);p1=__builtin_amdgcn_mfma_f32_32x32x16_bf16(b1,qr[0],negm,0,0,0);}
    else{p0=__builtin_amdgcn_mfma_f32_32x32x16_bf16(b0,qr[d0],p0,0,0,0);p1=__builtin_amdgcn_mfma_f32_32x32x16_bf16(b1,qr[d0],p1,0,0,0);}}
}
typedef __attribute__((address_space(3))) const char* lds_cptr;
typedef short v4i16_t __attribute__((ext_vector_type(4)));
__device__ __forceinline__ void kload8(bf16x8*kf,lds_cptr kp){
  kf[0]=*(const __attribute__((address_space(3))) bf16x8*)(kp);      kf[1]=*(const __attribute__((address_space(3))) bf16x8*)(kp+512);
  kf[2]=*(const __attribute__((address_space(3))) bf16x8*)(kp+2048); kf[3]=*(const __attribute__((address_space(3))) bf16x8*)(kp+2560);
  kf[4]=*(const __attribute__((address_space(3))) bf16x8*)(kp+4096); kf[5]=*(const __attribute__((address_space(3))) bf16x8*)(kp+4608);
  kf[6]=*(const __attribute__((address_space(3))) bf16x8*)(kp+6144); kf[7]=*(const __attribute__((address_space(3))) bf16x8*)(kp+6656);
}
__device__ __forceinline__ void kload2(bf16x8*kf,lds_cptr kp,int j){ kf[2*j]=*(const __attribute__((address_space(3))) bf16x8*)(kp+j*2048); kf[2*j+1]=*(const __attribute__((address_space(3))) bf16x8*)(kp+j*2048+512); }
__device__ __forceinline__ s16x4 vtr(lds_cptr p){ return __builtin_bit_cast(s16x4,__builtin_amdgcn_ds_read_tr16_b64_v4i16((__attribute__((address_space(3))) v4i16_t*)p)); }
__device__ __forceinline__ float rowmax(const f32x16&p0,const f32x16&p1){
  float a=max3f(p0[0],p0[1],p1[0]),b=max3f(p0[2],p0[3],p1[1]);a=max3f(a,p1[2],p1[3]);
  #pragma unroll
  for(int r=4;r<16;r+=4){a=max3f(a,p0[r],p0[r+1]);b=max3f(b,p0[r+2],p0[r+3]);a=max3f(a,p1[r],p1[r+1]);b=max3f(b,p1[r+2],p1[r+3]);}
  const float m=max2f(a,b);
  auto rr=__builtin_amdgcn_permlane32_swap(__float_as_uint(m),__float_as_uint(m),false,false);
  return max2f(__uint_as_float(rr[0]),__uint_as_float(rr[1]));
}
__device__ __forceinline__ void pv(f32x16*o,int vb,bf16x8 pa0,bf16x8 pa1,bf16x8 pa2,bf16x8 pa3){
  #pragma unroll
  for(int d0=0;d0<2;++d0){s16x4 lo[4],hi[4];
    #pragma unroll
    for(int ks=0;ks<4;++ks){
      asm volatile("ds_read_b64_tr_b16 %0,%1 offset:%c2":"=&v"(lo[ks]):"v"(vb),"i"(d0*4096+ks*1024):"memory");
      asm volatile("ds_read_b64_tr_b16 %0,%1 offset:%c2":"=&v"(hi[ks]):"v"(vb),"i"(d0*4096+ks*1024+512):"memory");}
    asm volatile("s_waitcnt lgkmcnt(0)":::"memory");SBAR();
    #define PK(k) (bf16x8){lo[k][0],lo[k][1],lo[k][2],lo[k][3],hi[k][0],hi[k][1],hi[k][2],hi[k][3]}
    o[d0]=__builtin_amdgcn_mfma_f32_32x32x16_bf16(pa0,PK(0),o[d0],0,0,0);
    o[d0]=__builtin_amdgcn_mfma_f32_32x32x16_bf16(pa1,PK(1),o[d0],0,0,0);
    o[d0]=__builtin_amdgcn_mfma_f32_32x32x16_bf16(pa2,PK(2),o[d0],0,0,0);
    o[d0]=__builtin_amdgcn_mfma_f32_32x32x16_bf16(pa3,PK(3),o[d0],0,0,0);
    #undef PK
  }
}

#ifndef ATTN_STORE16
#define ATTN_STORE16(p,v) (*(u32x4*)(p)=(v))
#endif
template<int THRL> __device__ __forceinline__ void attn_unit(int rowbase_i,int S,int qb,int qcol,int kcol,int vcol,int ocol,const bf16*Q,const bf16*__restrict__ K,const bf16*__restrict__ V,bf16*O,char*shm){
  int tid_o=threadIdx.x; asm volatile("":"+v"(tid_o)); const int tid=tid_o,lane=tid&63,r32=lane&31,hi=lane>>5; const int wid=__builtin_amdgcn_readfirstlane(tid>>6);
  const long rowbase=(long)rowbase_i; const int q0=qb*QB;
  const bf16*Qw=Q+(rowbase+q0+wid*QBLK)*QP+qcol;
  const bf16*Kh=K+rowbase*KP+kcol,*Vh=V+rowbase*VP+vcol;
  const unsigned lds0=(unsigned)(uintptr_t)shm;
  float*wsf=(float*)(shm+LDS_WS)+wid*64;
  const bf16*ksrc=Kh+(long)lane*KP+wid*8;
  const bf16*vsrc=Vh+(long)(16*(wid&3)+(lane>>2))*VP+(wid>>2)*32+(lane&3)*8;
  const unsigned kdst=lds0+LDS_K+wid*1024, vdst=lds0+LDS_V+wid*1024;
  #define DMA_K(t,slot) glds16(ksrc+(long)(t)*KVBLK*KP,(unsigned)__builtin_amdgcn_readfirstlane(kdst+(slot)))
  #define DMA_V(t,slot) glds16(vsrc+(long)(t)*KVBLK*VP,(unsigned)__builtin_amdgcn_readfirstlane(vdst+(slot)))
  const int vb0=(int)(lds0+LDS_V)+((lane>>4)&1)*32+(lane&3)*8+(4*hi+((lane&15)>>2))*64;
  const char*Kbase=shm+LDS_K; bf16x8 kf[8];
  const lds_cptr shm3=(lds_cptr)shm; const lds_cptr kp0=shm3+LDS_K+hi*1024+r32*16; const lds_cptr vp0=shm3+LDS_V+((lane>>4)&1)*32+(lane&3)*8+(4*hi+((lane&15)>>2))*64;
  const int NT=S/KVBLK;
  DMA_K(0,0);DMA_V(0,0);DMA_K(1,SLOTB);
  bf16x8 qr[4];
  #pragma unroll
  for(int d0=0;d0<4;++d0)qr[d0]=*reinterpret_cast<const bf16x8*>(&Qw[(long)r32*QP+d0*16+hi*8]);
  float mhat=0.f,l_reg=0.f;f32x16 o[2];o[0]=f32x16{};o[1]=f32x16{};f32x16 negm=f32x16{};asm volatile("":"+v"(negm));
  const int qrel=wid*QBLK+r32;
  #define CMASK(P0,P1,t) do{}while(0)
  bool resc=false;
  #define START(P0,P1) do{ const float rm=rowmax(P0,P1); resc=false; \
    { const float dl=rm; mhat=fadd_s(mhat,dl); \
      _Pragma("unroll") for(int r=0;r<16;++r){P0[r]=fsub_s(P0[r],dl);P1[r]=fsub_s(P1[r],dl);} \
      _Pragma("unroll") for(int r=0;r<16;++r)negm[r]=-mhat; asm volatile("":"+v"(negm)); } \
    _Pragma("unroll") for(int r=0;r<16;++r)P0[r]=__builtin_amdgcn_exp2f(P0[r]); }while(0)
  #define RESC() do{ if(resc){ asm volatile("s_waitcnt lgkmcnt(0)":::"memory"); \
      _Pragma("unroll") for(int d_=0;d_<2;++d_) _Pragma("unroll") for(int r=0;r<16;++r)o[d_][r]*=wsf[crow(r,hi)]; } }while(0)
  f32x16 pA0,pA1,pB0,pB1;
  int sl_prev=0,sl_cur=0,sl_next=SLOTB;
  #define ROT() do{sl_prev=sl_cur;sl_cur=sl_next;sl_next=(sl_next==(NSLOT-1)*SLOTB)?0:sl_next+SLOTB;}while(0)
  DMA_K(2,2*SLOTB);
  WAIT_BAR(3);
  qkt(pA0,pA1,Kbase,qr,negm,r32,hi);asm volatile("s_nop 15\n\ts_nop 7":"+v"(pA0),"+v"(pA1));CMASK(pA0,pA1,0);
  START(pA0,pA1);
  _Pragma("unroll") for(int r=0;r<16;++r)pA1[r]=__builtin_amdgcn_exp2f(pA1[r]);
  WAIT_BAR(0);
  DMA_K(3,0);DMA_V(1,SLOTB);
  ROT();
  kload8(kf,kp0+sl_cur);
  WAIT_BAR(2);
  s16x4 vlo[8],vhi[8]; u32x4 pw0,pw1,pw2,pw3;
  #define PKW(P,B) cvtpk_s(P[B],P[B+1])
  #define PAF(k) __builtin_bit_cast(bf16x8,pw##k)
  #define VFR(i) (bf16x8){vlo[i][0],vlo[i][1],vlo[i][2],vlo[i][3],vhi[i][0],vhi[i][1],vhi[i][2],vhi[i][3]}
  #define PIN(x) asm volatile("":"+v"(x))
  #define MX3(a,b,c) __builtin_fmaxf(__builtin_fmaxf((a),(b)),(c))
  #define GAPA(MF,A0,A1,A2,A3,W0,W1,PW) do{ MF; sacc+=A0; sacc+=A1; sacc+=A2; sacc+=A3; PIN(sacc); W0; W1; PIN(PW); SBAR(); }while(0)
  #define EX(v) __builtin_amdgcn_exp2f(v)
  #define GAPB(MF,X,B) do{ MF; X[B]=EX(X[B]); X[B+1]=EX(X[B+1]); X[B+2]=EX(X[B+2]); X[B+3]=EX(X[B+3]); PIN(X); SBAR(); }while(0)
  #define VRD(i) do{ vlo[i]=vtr(vp_+(((i)>>2)*4096+((i)&3)*1024)); vhi[i]=vtr(vp_+(((i)>>2)*4096+((i)&3)*1024+512)); }while(0)
  #define KRD(G,j) do{ if(G){ kload2(kf,kp0+sl_next,j); SBAR(); } }while(0)
  #define STEP(C0,C1,P0,P1,t,GK,GV,GL) do{ SBAR(); \
    const lds_cptr vp_=vp0+sl_prev; \
    VRD(0); SBAR(); float sacc=(P0[0]+P0[1]); \
    GAPA(C0=__builtin_amdgcn_mfma_f32_32x32x16_bf16(kf[0],qr[0],negm,0,0,0), P0[2],P0[3],P0[4],P0[5],     pw0[0]=PKW(P0,0), pw0[1]=PKW(P0,2), pw0); \
    VRD(4); SBAR(); GAPA(C1=__builtin_amdgcn_mfma_f32_32x32x16_bf16(kf[1],qr[0],negm,0,0,0), P0[6],P0[7],P0[8],P0[9],     pw0[2]=PKW(P0,4), pw0[3]=PKW(P0,6), pw0); \
    VRD(1); SBAR(); GAPA(C0=__builtin_amdgcn_mfma_f32_32x32x16_bf16(kf[2],qr[1],C0,0,0,0),   P0[10],P0[11],P0[12],P0[13], pw1[0]=PKW(P0,8), pw1[1]=PKW(P0,10), pw1); \
    VRD(5); SBAR(); GAPA(C1=__builtin_amdgcn_mfma_f32_32x32x16_bf16(kf[3],qr[1],C1,0,0,0),   P0[14],P0[15],P1[0],P1[1],   pw1[2]=PKW(P0,12),pw1[3]=PKW(P0,14), pw1); \
    VRD(2); SBAR(); GAPA(C0=__builtin_amdgcn_mfma_f32_32x32x16_bf16(kf[4],qr[2],C0,0,0,0),   P1[2],P1[3],P1[4],P1[5],     pw2[0]=PKW(P1,0), pw2[1]=PKW(P1,2), pw2); \
    VRD(6); SBAR(); GAPA(C1=__builtin_amdgcn_mfma_f32_32x32x16_bf16(kf[5],qr[2],C1,0,0,0),   P1[6],P1[7],P1[8],P1[9],     pw2[2]=PKW(P1,4), pw2[3]=PKW(P1,6), pw2); \
    VRD(3); SBAR(); GAPA(C0=__builtin_amdgcn_mfma_f32_32x32x16_bf16(kf[6],qr[3],C0,0,0,0),   P1[10],P1[11],P1[12],P1[13], pw3[0]=PKW(P1,8), pw3[1]=PKW(P1,10), pw3); \
    VRD(7); SBAR(); GAPA(C1=__builtin_amdgcn_mfma_f32_32x32x16_bf16(kf[7],qr[3],C1,0,0,0),   P1[14],P1[15],0.f,0.f,       pw3[2]=PKW(P1,12),pw3[3]=PKW(P1,14), pw3); \
    l_reg+=sacc; \
    if(GK){DMA_K((t)+3,sl_cur);} if(GV){DMA_V((t)+1,sl_next);} \
    CMASK(C0,C1,t); \
    { float a=MX3(C0[0],C0[1],C1[0]),b=MX3(C0[2],C0[3],C1[1]); a=MX3(a,C1[2],C1[3]); \
      _Pragma("unroll") for(int r=4;r<16;r+=4){a=MX3(a,C0[r],C0[r+1]);b=MX3(b,C0[r+2],C0[r+3]);a=MX3(a,C1[r],C1[r+1]);b=MX3(b,C1[r+2],C1[r+3]);} \
      float rm=__builtin_fmaxf(a,b); { auto rr=__builtin_amdgcn_permlane32_swap(__float_as_uint(rm),__float_as_uint(rm),false,false); rm=__builtin_fmaxf(__uint_as_float(rr[0]),__uint_as_float(rr[1])); } \
      resc=false; \
      if(__builtin_expect(__any(rm>(float)THRL),0)){ const float dl=__builtin_fmaxf(rm,0.f); mhat+=dl; \
        _Pragma("unroll") for(int r=0;r<16;++r){C0[r]-=dl;C1[r]-=dl;} \
        _Pragma("unroll") for(int r=0;r<16;++r)negm[r]=-mhat; asm volatile("":"+v"(negm)); \
        const float f=__builtin_amdgcn_exp2f(-dl); l_reg*=f; if(hi==0)wsf[r32]=f; resc=true; } } \
    SBAR(); \
    GAPB(o[0]=__builtin_amdgcn_mfma_f32_32x32x16_bf16(PAF(0),VFR(0),o[0],0,0,0), C0,0); \
    GAPB(o[1]=__builtin_amdgcn_mfma_f32_32x32x16_bf16(PAF(0),VFR(4),o[1],0,0,0), C0,4); \
    KRD(GL,0); GAPB(o[0]=__builtin_amdgcn_mfma_f32_32x32x16_bf16(PAF(1),VFR(1),o[0],0,0,0), C0,8); \
    KRD(GL,1); GAPB(o[1]=__builtin_amdgcn_mfma_f32_32x32x16_bf16(PAF(1),VFR(5),o[1],0,0,0), C0,12); \
    KRD(GL,2); GAPB(o[0]=__builtin_amdgcn_mfma_f32_32x32x16_bf16(PAF(2),VFR(2),o[0],0,0,0), C1,0); \
    KRD(GL,3); GAPB(o[1]=__builtin_amdgcn_mfma_f32_32x32x16_bf16(PAF(2),VFR(6),o[1],0,0,0), C1,4); \
    GAPB(o[0]=__builtin_amdgcn_mfma_f32_32x32x16_bf16(PAF(3),VFR(3),o[0],0,0,0), C1,8); \
    GAPB(o[1]=__builtin_amdgcn_mfma_f32_32x32x16_bf16(PAF(3),VFR(7),o[1],0,0,0), C1,12); \
    }while(0)
  int t=1;
  #undef CMASK
  #define CMASK(P0,P1,t) do{}while(0)
  for(;t+5<NT;t+=2){
    STEP(pB0,pB1,pA0,pA1,t,true,true,true);     WAIT_BAR(2); RESC(); ROT();
    STEP(pA0,pA1,pB0,pB1,t+1,true,true,true);   WAIT_BAR(2); RESC(); ROT();
  }
  #undef CMASK
  #define CMASK(P0,P1,t) do{}while(0)
  #define ENDW(tt) do{ if((tt)+3<NT){WAIT_BAR(2);} else if((tt)+2<NT){WAIT_BAR(1);} else {WAIT_BAR(0);} }while(0)
  for(;t+1<NT;t+=2){
    STEP(pB0,pB1,pA0,pA1,t,(t+3<NT),(t+1<NT),(t+1<NT));       ENDW(t);   RESC(); ROT();
    STEP(pA0,pA1,pB0,pB1,t+1,(t+4<NT),(t+2<NT),(t+2<NT));     ENDW(t+1); RESC(); ROT();
  }
  STEP(pB0,pB1,pA0,pA1,NT-1,false,false,false); RESC();
  { float sacc=pB0[0]+pB0[1]; _Pragma("unroll") for(int r=2;r<16;++r)sacc+=pB0[r]; _Pragma("unroll") for(int r=0;r<16;++r)sacc+=pB1[r]; l_reg+=sacc;
    pw0=(u32x4){PKW(pB0,0),PKW(pB0,2),PKW(pB0,4),PKW(pB0,6)};pw1=(u32x4){PKW(pB0,8),PKW(pB0,10),PKW(pB0,12),PKW(pB0,14)};pw2=(u32x4){PKW(pB1,0),PKW(pB1,2),PKW(pB1,4),PKW(pB1,6)};pw3=(u32x4){PKW(pB1,8),PKW(pB1,10),PKW(pB1,12),PKW(pB1,14)};
    SBAR(); pv(o,vb0+sl_cur,PAF(0),PAF(1),PAF(2),PAF(3)); }
  #undef PKW
  #undef PAF
  #undef VFR
  #undef PIN
  #undef MX3
  #undef GAPA
  #undef GAPB
  #undef EX
  #undef VRD
  #undef KRD
  #undef STEP
  #undef ENDW
  {auto rr=__builtin_amdgcn_permlane32_swap(__float_as_uint(l_reg),__float_as_uint(l_reg),false,false);l_reg=__uint_as_float(rr[0])+__uint_as_float(rr[1]);}
  if(hi==0)wsf[32+r32]=l_reg;asm volatile("s_waitcnt lgkmcnt(0)":::"memory");
  float rli[16];
  #pragma unroll
  for(int r=0;r<16;++r)rli[r]=__builtin_amdgcn_rcpf(wsf[32+crow(r,hi)]);
  bf16*Ow=O+(rowbase+q0+wid*QBLK)*OP+ocol;
  { bf16*stg=(bf16*)(shm+LDS_OST)+wid*2048;
    #pragma unroll
    for(int r=0;r<16;++r){const int orow=crow(r,hi);
      #pragma unroll
      for(int d0=0;d0<2;++d0)stg[orow*64+d0*32+r32]=__float2bfloat16(o[d0][r]*rli[r]);}
    asm volatile("s_waitcnt lgkmcnt(0)":::"memory");
    #pragma unroll
    for(int i=0;i<4;++i){const int row=i*8+(lane>>3),ch=lane&7; const u32x4 v=*(const u32x4*)(stg+row*64+ch*8); ATTN_STORE16(Ow+(long)row*OP+ch*8,v);} }
  asm volatile("s_waitcnt lgkmcnt(0)\n\ts_barrier":::"memory");
  #undef DMA_K
  #undef DMA_V
  #undef CMASK
  #undef START
  #undef RESC
  #undef ROT
}
constexpr int ATTN_LDS_BYTES=LDS_BYTES;
#undef SBAR
#undef WAIT_BAR
}

#define LAS __attribute__((address_space(3)))
#define LDS_BARRIER() asm volatile("s_waitcnt lgkmcnt(0)\n\ts_barrier" ::: "memory")
typedef unsigned short bf16;
typedef unsigned u32x4_t __attribute__((ext_vector_type(4)));
typedef unsigned u32x2_t __attribute__((ext_vector_type(2)));
typedef float f32x4_t __attribute__((ext_vector_type(4)));
typedef float f32x2_t __attribute__((ext_vector_type(2)));

constexpr int DM = 1024, MTOK = 49152, NSEQ = 20, DFF = 2816, NFF = 5632, NMIXP = 2560, NMIX = 2432, ZP = 1792;
constexpr int NTHR = 512;
constexpr float QSCALE = 0.125f * 1.4426950408889634f;
constexpr size_t MiB = 1u << 20;
constexpr size_t ZERO_BYTES = 8 * MiB;
constexpr size_t OFF_CTR = 0, OFF_ROPE = 32768, OFF_SS = 65536, OFF_MOD = 2 * MiB, OFF_BIAS = 4 * MiB, OFF_GV = 7 * MiB, OFF_GATE = 7 * MiB + 512 * 1024;
constexpr size_t OFF_W = 8 * MiB, W_LAYER = 40 * MiB;
constexpr size_t WO_IN = 0, WO_OUT = 22 * MiB, WO_MI = 33 * MiB, WO_MO = 38 * MiB;
constexpr size_t OFF_XN = 88 * MiB, OFF_YF = 88 * MiB, OFF_YB = 136 * MiB;
constexpr size_t OFF_HID = 184 * MiB, OFF_Z = 184 * MiB, OFF_QK = 352 * MiB, OFF_VR = 400 * MiB, OFF_OMIX = 412 * MiB, WS_END = 508 * MiB;
constexpr size_t OFF_SMID = 508 * MiB;
constexpr int LDS_BYTES = 147456, MISC_OFF = 131072;

struct KP { const float* in[31]; float* out; unsigned char* ws; };

__device__ __forceinline__ int seq_of_row(int m) { return m < 16384 ? (m >> 12) : 4 + ((m - 16384) >> 11); }
__device__ __forceinline__ int seq_start(int s) { return s < 4 ? s * 4096 : 16384 + (s - 4) * 2048; }
__device__ __forceinline__ int seq_len(int s) { return s < 4 ? 4096 : 2048; }
__device__ __forceinline__ unsigned f2bf(float f) { unsigned u = __builtin_bit_cast(unsigned, f); return (u + 0x7fffu + ((u >> 16) & 1u)) >> 16; }
__device__ __forceinline__ unsigned pk2(float lo, float hi) { return f2bf(lo) | (f2bf(hi) << 16); }
__device__ __forceinline__ float bf2f(unsigned short b) { return __builtin_bit_cast(float, (unsigned)b << 16); }
__device__ __forceinline__ float sigmoidf_(float x) { return 1.0f / (1.0f + __expf(-x)); }
#define DPP_ADD(v, CTRL) ((v) + __builtin_bit_cast(float, __builtin_amdgcn_update_dpp(0, __builtin_bit_cast(int, (v)), (CTRL), 0xf, 0xf, false)))
__device__ __forceinline__ float wave_sum(float v) {
    v = DPP_ADD(v, 0xB1);
    v = DPP_ADD(v, 0x4E);
    v = DPP_ADD(v, 0x141);
    v = DPP_ADD(v, 0x140);
    const f32x4_t d = __builtin_amdgcn_mfma_f32_16x16x4f32(1.0f, v, (f32x4_t){0.f, 0.f, 0.f, 0.f}, 0, 0, 0);
    return d[0];
}
__device__ __forceinline__ float tanh_fast(float x) { const float e = __expf(2.0f * x); return 1.0f - 2.0f * __builtin_amdgcn_rcpf(e + 1.0f); }
__host__ __device__ __forceinline__ int map_ffn(int n) { const int half = n >= DFF ? 1 : 0; const int n2 = half ? n - DFF : n; return 256 * (n2 >> 7) + 128 * half + (n2 & 127); }
__host__ __device__ __forceinline__ int map_mix(int n) {
    if (n < 1792 || n >= 2304) return n;
    const int hh = (n - 1792) >> 6, d = (n - 1792) & 63;
    return 256 * (7 + (hh >> 2)) + 128 * (d >> 5) + 32 * (hh & 3) + 8 * ((d & 15) >> 2) + 4 * ((d >> 4) & 1) + (d & 3);
}

namespace pg8 {
struct EpiSwiglu {
    static constexpr bool PERM = true, AFTER_DRAIN = false;
    bf16_t* H; const float* ss; const float* bias;
    __device__ __forceinline__ void operator()(const f32x4 (&acc)[2][2][4][2], const Unit& u, int wr, int wc, int fr, int fq) const {
        const int row0 = u.pm * BM + wr * 64 + fr; const int s = seq_of_row(u.pm * BM);
        const float* bp = bias + (size_t)s * NFF + u.pn * 256 + wc * 32 + 8 * fq;
        f32x4 bg[2], bu[2];
#pragma unroll
        for (int n = 0; n < 2; ++n) { bg[n] = *(const f32x4*)(bp + 4 * n); bu[n] = *(const f32x4*)(bp + 128 + 4 * n); }
#pragma unroll
        for (int ai = 0; ai < 2; ++ai)
#pragma unroll
            for (int m = 0; m < 4; ++m) {
                const int row = row0 + ai * HALF + m * 16;
                const float rs = rsqrtf(ss[row] * (1.0f / 1024.0f) + 1e-6f);
                float h[8];
#pragma unroll
                for (int n = 0; n < 2; ++n) {
                    const f32x4 g = acc[ai][0][m][n] * rs + bg[n], up = acc[ai][1][m][n] * rs + bu[n];
#pragma unroll
                    for (int i = 0; i < 4; ++i) h[4 * n + i] = g[i] * sigmoidf_(g[i]) * up[i];
                }
                u32x4 w; w.x = cvt_pk_bf16(h[0], h[1]); w.y = cvt_pk_bf16(h[2], h[3]); w.z = cvt_pk_bf16(h[4], h[5]); w.w = cvt_pk_bf16(h[6], h[7]);
                *(u32x4*)(H + (size_t)row * DFF + u.pn * 128 + wc * 32 + 8 * fq) = w;
            }
    }
};
struct EpiZ {
    static constexpr bool PERM = true, AFTER_DRAIN = false;
    bf16_t* Z; bf16_t* QK; bf16_t* VR; const float* ss; const float* bias; const float* qg; const float* kg; const float* rope;
    __device__ __forceinline__ void operator()(const f32x4 (&acc)[2][2][4][2], const Unit& u, int wr, int wc, int fr, int fq) const {
        const int row0 = u.pm * BM + wr * 64 + fr; const int s = seq_of_row(u.pm * BM); const int t0 = row0 - seq_start(s);
        const float* bp = bias + (size_t)s * NFF + u.pn * 256 + wc * 32 + 8 * fq;
        f32x4 bv[2][2];
#pragma unroll
        for (int bj = 0; bj < 2; ++bj)
#pragma unroll
            for (int n = 0; n < 2; ++n) bv[bj][n] = *(const f32x4*)(bp + bj * 128 + 4 * n);
        if (u.pn < 7 || u.pn == 9) {
#pragma unroll
            for (int ai = 0; ai < 2; ++ai)
#pragma unroll
                for (int m = 0; m < 4; ++m) {
                    const int row = row0 + ai * HALF + m * 16;
                    const float rs = rsqrtf(ss[row] * (1.0f / 1024.0f) + 1e-6f);
#pragma unroll
                    for (int bj = 0; bj < 2; ++bj) {
                        const f32x4 v0 = acc[ai][bj][m][0] * rs + bv[bj][0], v1 = acc[ai][bj][m][1] * rs + bv[bj][1];
                        u32x4 w; w.x = cvt_pk_bf16(v0[0], v0[1]); w.y = cvt_pk_bf16(v0[2], v0[3]); w.z = cvt_pk_bf16(v1[0], v1[1]); w.w = cvt_pk_bf16(v1[2], v1[3]);
                        if (u.pn < 7) *(u32x4*)(Z + (size_t)row * ZP + u.pn * 256 + bj * 128 + wc * 32 + 8 * fq) = w;
                        else if (bj == 0) *(u32x4*)(VR + (size_t)row * 128 + wc * 32 + 8 * fq) = w;
                    }
                }
        } else {
            const int hh = (u.pn - 7) * 4 + wc; const bool isq = hh < 6; const float* gp = isq ? qg : kg; const float osc = isq ? QSCALE : 1.0f;
            f32x4 gn[2][2];
#pragma unroll
            for (int bj = 0; bj < 2; ++bj)
#pragma unroll
                for (int n = 0; n < 2; ++n) gn[bj][n] = *(const f32x4*)(gp + 32 * bj + 16 * n + 4 * fq);
#pragma unroll
            for (int ai = 0; ai < 2; ++ai)
#pragma unroll
                for (int m = 0; m < 4; ++m) {
                    const int row = row0 + ai * HALF + m * 16; const int t = t0 + ai * HALF + m * 16;
                    const float rs = rsqrtf(ss[row] * (1.0f / 1024.0f) + 1e-6f);
                    f32x4 v[2][2]; float q = 0.f;
#pragma unroll
                    for (int bj = 0; bj < 2; ++bj)
#pragma unroll
                        for (int n = 0; n < 2; ++n) { v[bj][n] = acc[ai][bj][m][n] * rs + bv[bj][n]; q += (v[bj][n][0] * v[bj][n][0] + v[bj][n][1] * v[bj][n][1]) + (v[bj][n][2] * v[bj][n][2] + v[bj][n][3] * v[bj][n][3]); }
                    q += __shfl_xor(q, 16); q += __shfl_xor(q, 32);
                    const float r = rsqrtf(q * (1.0f / 64.0f) + 1e-6f);
#pragma unroll
                    for (int bj = 0; bj < 2; ++bj) {
                        const int pos = bj == 0 ? (t >> 6) : (t & 63);
                        const f32x4 x1 = v[bj][0] * r * gn[bj][0], x2 = v[bj][1] * r * gn[bj][1];
                        const float* rp = rope + (pos * 16 + 4 * fq) * 2;
                        const f32x4 cs0 = *(const f32x4*)(rp), cs1 = *(const f32x4*)(rp + 4);
                        const float c[4] = {cs0[0], cs0[2], cs1[0], cs1[2]}, sn[4] = {cs0[1], cs0[3], cs1[1], cs1[3]};
                        float o1[4], o2[4];
#pragma unroll
                        for (int i = 0; i < 4; ++i) { o1[i] = (x1[i] * c[i] - x2[i] * sn[i]) * osc; o2[i] = (x2[i] * c[i] + x1[i] * sn[i]) * osc; }
                        u32x4 w; w.x = cvt_pk_bf16(o1[0], o1[1]); w.y = cvt_pk_bf16(o1[2], o1[3]); w.z = cvt_pk_bf16(o2[0], o2[1]); w.w = cvt_pk_bf16(o2[2], o2[3]);
                        *(u32x4*)(QK + (size_t)row * 512 + hh * 64 + 32 * bj + 8 * fq) = w;
                    }
                }
        }
    }
};
struct EpiResid {
    static constexpr bool PERM = false, AFTER_DRAIN = false;
    const float* xin_p; const float* xin_s; float* out; bf16_t* xn; float* ssn; const float* gate; const float* gvn;
    __device__ __forceinline__ void operator()(const f32x4 (&acc)[2][2][4][2], const Unit& u, int wr, int wc, int fr, int fq) const {
        const int rowt = u.pm * BM; const int s = seq_of_row(rowt);
        const float* xb = rowt < 16384 ? xin_p : xin_s - (size_t)16384 * DM;
        const int row0 = rowt + wr * 64 + fr; const int col0 = u.pn * BM + wc * 32 + 4 * fq;
        f32x4 gt[2][2];
#pragma unroll
        for (int bj = 0; bj < 2; ++bj)
#pragma unroll
            for (int n = 0; n < 2; ++n) gt[bj][n] = *(const f32x4*)(gate + (size_t)s * DM + col0 + bj * HALF + n * 16);
#pragma unroll
        for (int ai = 0; ai < 2; ++ai)
#pragma unroll
            for (int m = 0; m < 4; ++m) {
                const int row = row0 + ai * HALF + m * 16; const size_t off = (size_t)row * DM + col0; float q = 0.f;
#pragma unroll
                for (int bj = 0; bj < 2; ++bj)
#pragma unroll
                    for (int n = 0; n < 2; ++n) {
                        const f32x4 xo = *(const f32x4*)(xb + off + bj * HALF + n * 16);
                        const f32x4 val = xo + gt[bj][n] * acc[ai][bj][m][n];
                        *(f32x4*)(out + off + bj * HALF + n * 16) = val;
                        if (gvn) {
                            q += (val[0] * val[0] + val[1] * val[1]) + (val[2] * val[2] + val[3] * val[3]);
                            const f32x4 gv = *(const f32x4*)(gvn + (size_t)s * DM + col0 + bj * HALF + n * 16);
                            const f32x4 o = val * gv; unsigned long long w = (unsigned long long)cvt_pk_bf16(o[0], o[1]) | ((unsigned long long)cvt_pk_bf16(o[2], o[3]) << 32);
                            *(unsigned long long*)(xn + off + bj * HALF + n * 16) = w;
                        }
                    }
                if (gvn) { q += __shfl_xor(q, 16); q += __shfl_xor(q, 32); if (fq == 0) atomicAdd(ssn + row, q); }
            }
    }
};
}

template <int MAP> __device__ __forceinline__ void transpose_item(const float* W, int K, int N, bf16* WT, float* scr, int item, int lane) {
    const int nblk = N / 32, kb = item / nblk, nb = item % nblk, k0 = 64 * kb, n0 = 32 * nb;
#pragma unroll 8
    for (int i = 0; i < 32; ++i) { const int kk = 2 * i + (lane >> 5); scr[kk * 33 + (lane & 31)] = W[(size_t)(k0 + kk) * N + n0 + (lane & 31)]; }
    __builtin_amdgcn_wave_barrier(); asm volatile("s_waitcnt lgkmcnt(0)" ::: "memory");
    const int c = lane & 7;
#pragma unroll
    for (int j = 0; j < 4; ++j) { const int n = (lane >> 3) + 8 * j; const float* sp = scr + (8 * c) * 33 + n;
        u32x4_t o; o.x = pk2(sp[0 * 33], sp[1 * 33]); o.y = pk2(sp[2 * 33], sp[3 * 33]); o.z = pk2(sp[4 * 33], sp[5 * 33]); o.w = pk2(sp[6 * 33], sp[7 * 33]);
        const int nsrc = n0 + n; const int nd = MAP == 1 ? map_ffn(nsrc) : (MAP == 2 ? map_mix(nsrc) : nsrc);
        *(u32x4_t*)(WT + (size_t)nd * K + k0 + 8 * c) = o; }
    __builtin_amdgcn_wave_barrier(); asm volatile("s_waitcnt lgkmcnt(0)" ::: "memory");
}

template <int MODE, int MAP> __device__ __forceinline__ void smallm_unit(const KP& p, float* sA, int l, int j, const float* W, int ldw, int nvalid, float* dest, int ldd, int nchunk, int kchunk) {
    int tid_o = threadIdx.x; asm volatile("" : "+v"(tid_o)); const int tid = tid_o; const int k0 = kchunk * 128;
    __syncthreads();
    for (int e = tid; e < 128 * NSEQ; e += NTHR) {
        const int k = e / NSEQ, s = e % NSEQ; float v;
        if (MODE == 0) { const float c = s < 4 ? p.in[2][s * DM + k0 + k] : p.in[3][(s - 4) * DM + k0 + k]; v = c * sigmoidf_(c); }
        else { const float* mod = (const float*)(p.ws + OFF_MOD) + ((size_t)l * NSEQ + s) * 9216 + 3 * j * 1024 + k0 + k; v = *mod + p.in[5][l * 9216 + 3 * j * 1024 + k0 + k]; }
        sA[k * NSEQ + s] = v;
    }
    __syncthreads();
    const int n = nchunk * 256 + (tid & 255), kh = tid >> 8;
    float acc[NSEQ];
#pragma unroll
    for (int s = 0; s < NSEQ; ++s) acc[s] = 0.f;
    if (n < nvalid) {
        for (int kb = 0; kb < 64; kb += 16) {
            float wv[16];
#pragma unroll
            for (int u = 0; u < 16; ++u) wv[u] = W[(size_t)(k0 + kh * 64 + kb + u) * ldw + n];
#pragma unroll
            for (int u = 0; u < 16; ++u) { const int k = kh * 64 + kb + u; const float w = wv[u];
                const f32x4_t* ap = (const f32x4_t*)(sA + k * NSEQ);
#pragma unroll
                for (int q = 0; q < 5; ++q) { const f32x4_t a = ap[q]; acc[4 * q] += a[0] * w; acc[4 * q + 1] += a[1] * w; acc[4 * q + 2] += a[2] * w; acc[4 * q + 3] += a[3] * w; } }
        }
        const int nd = MAP == 1 ? map_ffn(n) : (MAP == 2 ? map_mix(n) : n);
#pragma unroll
        for (int s = 0; s < NSEQ; ++s) atomicAdd(dest + (size_t)s * ldd + nd, acc[s]);
    }
}

#define DPP_FMAC(acc, x, s, J) asm volatile("v_fmac_f32_dpp %0, %1, %2 row_newbcast:" #J " row_mask:0xf bank_mask:0xf" : "+v"(acc) : "v"(x), "v"(s))
#define DPP_FMAC_N(acc, x, s, J) asm volatile("s_nop 1\n\tv_fmac_f32_dpp %0, %1, %2 row_newbcast:" #J " row_mask:0xf bank_mask:0xf" : "+v"(acc) : "v"(x), "v"(s))
#define DPP_MUL(s, x, J) asm volatile("v_mul_f32_dpp %0, %1, %0 row_newbcast:" #J " row_mask:0xf bank_mask:0xf" : "+v"(s) : "v"(x))
#define DPP_MUL_N(s, x, J) asm volatile("s_nop 1\n\tv_mul_f32_dpp %0, %1, %0 row_newbcast:" #J " row_mask:0xf bank_mask:0xf" : "+v"(s) : "v"(x))
#define REP15(M, X) M(1, X) M(2, X) M(3, X) M(4, X) M(5, X) M(6, X) M(7, X) M(8, X) M(9, X) M(10, X) M(11, X) M(12, X) M(13, X) M(14, X) M(15, X)
__device__ __forceinline__ float row4_sum(float x) {
    auto r1 = __builtin_amdgcn_permlane16_swap(__float_as_uint(x), __float_as_uint(x), false, false); x = __uint_as_float(r1[0]) + __uint_as_float(r1[1]);
    auto r2 = __builtin_amdgcn_permlane32_swap(__float_as_uint(x), __float_as_uint(x), false, false); return __uint_as_float(r2[0]) + __uint_as_float(r2[1]);
}
__device__ __forceinline__ void rwkv_unit(const KP& p, unsigned char* lds, int l, int s, int h, int d, int mode) {
    int tid_o = threadIdx.x; asm volatile("" : "+v"(tid_o)); const int tid = tid_o, lane = tid & 63; const int wid = __builtin_amdgcn_readfirstlane(tid >> 6);
    constexpr int TB = 16;
    f32x2_t* W2 = (f32x2_t*)lds;
    float* OPS = (float*)(lds + 32768);
    float* YBUF = (float*)(lds + 32768 + 49152);
    float* PWS = (float*)(lds + 32768 + 49152 + 8192) + (wid & 3) * 1024;
    const bf16* Z = (const bf16*)(p.ws + OFF_Z);
    float* Y = (float*)(p.ws + (d == 0 ? OFF_YF : OFF_YB));
    const float* mu = p.in[18] + l * 1024;
    const float* w_up = p.in[19] + ((size_t)l * 2 + d) * 64 * 256;
    const float* a_up = p.in[21] + (size_t)l * 64 * 256;
    const int S = seq_len(s), start = seq_start(s); const int NS = mode == 0 ? S : S / 2, s0 = mode >= 2 ? S / 2 : 0; const int NB = NS / TB;
    __syncthreads();
    for (int e = tid; e < 4096; e += NTHR) { const int i = e >> 6, j = e & 63; W2[e] = (f32x2_t){w_up[i * 256 + 64 * h + j], a_up[i * 256 + 64 * h + j]}; }
    __syncthreads();
    if (wid >= 4) {
        const int pw = wid - 4;
        unsigned short* XWb = (unsigned short*)PWS; unsigned short* XAb = XWb + 256; float* KK = PWS + 256; float* UA = PWS + 512;
        typedef short bf16x8_t __attribute__((ext_vector_type(8)));
        bf16x8_t Bf[2][4][2];
        { const int kg = lane >> 4, cl = 64 * h + (lane & 15);
          _Pragma("unroll") for (int m = 0; m < 2; ++m) _Pragma("unroll") for (int ct = 0; ct < 4; ++ct) _Pragma("unroll") for (int ks = 0; ks < 2; ++ks) {
              const float* Wm = (m == 0 ? w_up : a_up) + (size_t)(32 * ks + 8 * kg) * 256 + cl + 16 * ct; u32x4_t pq;
              pq.x = pk2(Wm[0], Wm[256]); pq.y = pk2(Wm[512], Wm[768]); pq.z = pk2(Wm[1024], Wm[1280]); pq.w = pk2(Wm[1536], Wm[1792]); Bf[m][ct][ks] = __builtin_bit_cast(bf16x8_t, pq); } }
        const float w0 = p.in[20][(l * 2 + d) * 256 + 64 * h + lane], a0 = p.in[22][(l * 2 + d) * 256 + 64 * h + lane];
        const float k_k = p.in[24][l * 256 + 64 * h + lane], k_a = p.in[25][l * 256 + 64 * h + lane];
        int it_t[3], it_zc[3], it_g[3], it_w[3]; f32x4_t mu0[3], mu1[3];
#pragma unroll
        for (int i = 0; i < 3; ++i) { int e = lane + 64 * i; if (e > 159) e = 159; const int t = e / 40, c = e % 40, g = c >> 3, wi = (c & 7) * 8;
            it_t[i] = t; it_g[i] = g; it_w[i] = wi; it_zc[i] = (g == 0 ? 64 * h : g == 1 ? 256 + 64 * h : g == 2 ? 512 + 64 * h : 768 + (g - 3) * 64) + wi;
            mu0[i] = *(const f32x4_t*)(mu + it_zc[i]); mu1[i] = *(const f32x4_t*)(mu + it_zc[i] + 4); }
        u32x4_t rc[3], rp[3], rn[3];
#define RW_ISSUE(b_) do { _Pragma("unroll") for (int i = 0; i < 3; ++i) { const int si = s0 + (b_) * TB + 4 * pw + it_t[i]; const int tt = d == 0 ? si : S - 1 - si; const bf16* zp = Z + (size_t)(start + tt) * ZP + 768 + it_zc[i]; \
                rc[i] = *(const u32x4_t*)zp; rp[i] = tt > 0 ? *(const u32x4_t*)(zp - ZP) : (u32x4_t){0u, 0u, 0u, 0u}; rn[i] = tt < S - 1 ? *(const u32x4_t*)(zp + ZP) : (u32x4_t){0u, 0u, 0u, 0u}; } } while (0)
#define RW_PREP(b_) do { \
            float* ops = OPS + ((b_) & 1) * (TB * 384); \
            _Pragma("unroll") for (int i = 0; i < 3; ++i) if (lane + 64 * i < 160) { \
                float fs[8]; \
                _Pragma("unroll") for (int q = 0; q < 4; ++q) { \
                    const float c0 = __builtin_bit_cast(float, rc[i][q] << 16), c1 = __builtin_bit_cast(float, rc[i][q] & 0xffff0000u); \
                    const float p0 = __builtin_bit_cast(float, rp[i][q] << 16), p1 = __builtin_bit_cast(float, rp[i][q] & 0xffff0000u); \
                    const float n0 = __builtin_bit_cast(float, rn[i][q] << 16), n1 = __builtin_bit_cast(float, rn[i][q] & 0xffff0000u); \
                    const float m0 = q < 2 ? mu0[i][2 * q] : mu1[i][2 * q - 4], m1 = q < 2 ? mu0[i][2 * q + 1] : mu1[i][2 * q - 3]; \
                    fs[2 * q] = c0 + m0 * (0.5f * (p0 + n0) - c0); fs[2 * q + 1] = c1 + m1 * (0.5f * (p1 + n1) - c1); \
                } \
                const int t = it_t[i], tl = 4 * pw + t, g = it_g[i], wi = it_w[i]; \
                if (g == 0) { *(f32x4_t*)(ops + tl * 384 + 256 + wi) = (f32x4_t){fs[0], fs[1], fs[2], fs[3]}; *(f32x4_t*)(ops + tl * 384 + 256 + wi + 4) = (f32x4_t){fs[4], fs[5], fs[6], fs[7]}; } \
                else if (g == 2) { if (mode == 3) { _Pragma("unroll") for (int q = 0; q < 8; ++q) fs[q] = 0.f; } *(f32x4_t*)(ops + tl * 384 + 320 + wi) = (f32x4_t){fs[0], fs[1], fs[2], fs[3]}; *(f32x4_t*)(ops + tl * 384 + 320 + wi + 4) = (f32x4_t){fs[4], fs[5], fs[6], fs[7]}; } \
                else if (g == 1) { *(f32x4_t*)(KK + t * 64 + wi) = (f32x4_t){fs[0], fs[1], fs[2], fs[3]}; *(f32x4_t*)(KK + t * 64 + wi + 4) = (f32x4_t){fs[4], fs[5], fs[6], fs[7]}; } \
                else if (g == 3) { u32x4_t pq; pq.x = pk2(tanh_fast(fs[0]), tanh_fast(fs[1])); pq.y = pk2(tanh_fast(fs[2]), tanh_fast(fs[3])); pq.z = pk2(tanh_fast(fs[4]), tanh_fast(fs[5])); pq.w = pk2(tanh_fast(fs[6]), tanh_fast(fs[7])); *(u32x4_t*)(XWb + t * 64 + wi) = pq; } \
                else { u32x4_t pq; pq.x = pk2(fs[0], fs[1]); pq.y = pk2(fs[2], fs[3]); pq.z = pk2(fs[4], fs[5]); pq.w = pk2(fs[6], fs[7]); *(u32x4_t*)(XAb + t * 64 + wi) = pq; } \
            } \
            if ((b_) + 1 < NB) RW_ISSUE((b_) + 1); \
            { const int arow = lane & 15, akg = lane >> 4; \
              _Pragma("unroll") for (int m = 0; m < 2; ++m) { \
                bf16x8_t Af[2]; \
                _Pragma("unroll") for (int ks = 0; ks < 2; ++ks) { u32x4_t raw = *(const u32x4_t*)((m ? XAb : XWb) + (arow & 3) * 64 + 32 * ks + 8 * akg); if (arow >= 4) raw = (u32x4_t){0u, 0u, 0u, 0u}; Af[ks] = __builtin_bit_cast(bf16x8_t, raw); } \
                _Pragma("unroll") for (int ct = 0; ct < 4; ++ct) { f32x4_t am = (f32x4_t){0.f, 0.f, 0.f, 0.f}; \
                    am = __builtin_amdgcn_mfma_f32_16x16x32_bf16(Af[0], Bf[m][ct][0], am, 0, 0, 0); am = __builtin_amdgcn_mfma_f32_16x16x32_bf16(Af[1], Bf[m][ct][1], am, 0, 0, 0); \
                    if (lane < 16) { UA[(m * 4 + 0) * 64 + 16 * ct + lane] = am[0]; UA[(m * 4 + 1) * 64 + 16 * ct + lane] = am[1]; UA[(m * 4 + 2) * 64 + 16 * ct + lane] = am[2]; UA[(m * 4 + 3) * 64 + 16 * ct + lane] = am[3]; } } } } \
            _Pragma("unroll") for (int t = 0; t < 4; ++t) { \
                const int tl = 4 * pw + t; const float k = KK[t * 64 + lane]; const float kkv = k * k_k; \
                const float n2 = wave_sum(kkv * kkv); const float kk = kkv / fmaxf(sqrtf(n2), 1e-12f); \
                const float wdec = __expf(-0.6065306597126334f * sigmoidf_(w0 + UA[t * 64 + lane])); const float a = sigmoidf_(a0 + UA[(4 + t) * 64 + lane]); \
                float* o = ops + tl * 384 + lane; o[0] = -kk; o[64] = wdec; o[128] = kk * a; o[192] = k * (1.0f + (a - 1.0f) * k_a); \
            } } while (0)
#define RW_YFLUSH(b_) do { const float* ybp = YBUF + ((b_) & 1) * (TB * 64); \
            _Pragma("unroll") for (int t = 0; t < 4; ++t) { const int si = s0 + (b_) * TB + 4 * pw + t; const int tt = d == 0 ? si : S - 1 - si; float* yp_ = Y + (size_t)(start + tt) * 256 + 64 * h; const float yv_ = ybp[(4 * pw + t) * 64 + lane]; \
                if (mode < 2) yp_[lane] = yv_; else ((unsigned short*)yp_)[(mode == 3 ? 64 : 0) + lane] = (unsigned short)f2bf(yv_); } } while (0)
        RW_ISSUE(0); RW_PREP(0);
        LDS_BARRIER();
        for (int b = 0; b < NB; ++b) {
            if (b > 0) RW_YFLUSH(b - 1);
            if (b + 1 < NB) RW_PREP(b + 1);
            LDS_BARRIER();
        }
        RW_YFLUSH(NB - 1);
#undef RW_ISSUE
#undef RW_PREP
#undef RW_YFLUSH
    } else {
        float st[16];
#pragma unroll
        for (int i = 0; i < 16; ++i) st[i] = (mode == 3 && 16 * (lane >> 4) + i == 16 * wid + (lane & 15)) ? 1.0f : 0.f;
        const int vofs = 320 + 16 * wid + (lane & 15);
        LDS_BARRIER();
        for (int b = 0; b < NB; ++b) {
            const float* ops = OPS + (b & 1) * (TB * 384); float* yb = YBUF + (b & 1) * (TB * 64);
            float xn = ops[lane], xw = ops[64 + lane], xb = ops[128 + lane], xk = ops[192 + lane], xr = ops[256 + lane], vv = ops[vofs];
#pragma unroll 2
            for (int t = 0; t < TB; ++t) {
                const float* nx = ops + (t + 1 < TB ? t + 1 : t) * 384;
                const float nxn = nx[lane], nxw = nx[64 + lane], nxb = nx[128 + lane], nxk = nx[192 + lane], nxr = nx[256 + lane], nvv = nx[vofs];
                float sa0 = 0.f, sa1 = 0.f, sa2 = 0.f, sa3 = 0.f;
                DPP_FMAC_N(sa0, xn, st[0], 0); DPP_FMAC(sa1, xn, st[1], 1); DPP_FMAC(sa2, xn, st[2], 2); DPP_FMAC(sa3, xn, st[3], 3);
                DPP_FMAC(sa0, xn, st[4], 4); DPP_FMAC(sa1, xn, st[5], 5); DPP_FMAC(sa2, xn, st[6], 6); DPP_FMAC(sa3, xn, st[7], 7);
                DPP_FMAC(sa0, xn, st[8], 8); DPP_FMAC(sa1, xn, st[9], 9); DPP_FMAC(sa2, xn, st[10], 10); DPP_FMAC(sa3, xn, st[11], 11);
                DPP_FMAC(sa0, xn, st[12], 12); DPP_FMAC(sa1, xn, st[13], 13); DPP_FMAC(sa2, xn, st[14], 14); DPP_FMAC(sa3, xn, st[15], 15);
                float sa = (sa0 + sa1) + (sa2 + sa3);
                { const f32x4_t da = __builtin_amdgcn_mfma_f32_16x16x4f32(1.0f, sa, (f32x4_t){0.f, 0.f, 0.f, 0.f}, 0, 0, 0); sa = da[0]; asm volatile("s_nop 15\n\ts_nop 3" : "+v"(sa)); }
                DPP_MUL_N(st[0], xw, 0);
#define M_MUL(J, X) DPP_MUL(st[J], X, J);
                REP15(M_MUL, xw)
#undef M_MUL
                DPP_FMAC_N(st[0], xb, sa, 0);
#define M_FB(J, X) DPP_FMAC(st[J], X, sa, J);
                REP15(M_FB, xb)
#undef M_FB
                DPP_FMAC_N(st[0], xk, vv, 0);
#define M_FK(J, X) DPP_FMAC(st[J], X, vv, J);
                REP15(M_FK, xk)
#undef M_FK
                float y0 = 0.f, y1 = 0.f, y2 = 0.f, y3 = 0.f;
                DPP_FMAC_N(y0, xr, st[0], 0); DPP_FMAC(y1, xr, st[1], 1); DPP_FMAC(y2, xr, st[2], 2); DPP_FMAC(y3, xr, st[3], 3);
                DPP_FMAC(y0, xr, st[4], 4); DPP_FMAC(y1, xr, st[5], 5); DPP_FMAC(y2, xr, st[6], 6); DPP_FMAC(y3, xr, st[7], 7);
                DPP_FMAC(y0, xr, st[8], 8); DPP_FMAC(y1, xr, st[9], 9); DPP_FMAC(y2, xr, st[10], 10); DPP_FMAC(y3, xr, st[11], 11);
                DPP_FMAC(y0, xr, st[12], 12); DPP_FMAC(y1, xr, st[13], 13); DPP_FMAC(y2, xr, st[14], 14); DPP_FMAC(y3, xr, st[15], 15);
                const float yp = (y0 + y1) + (y2 + y3);
                const f32x4_t dy = __builtin_amdgcn_mfma_f32_16x16x4f32(1.0f, yp, (f32x4_t){0.f, 0.f, 0.f, 0.f}, 0, 0, 0);
                if (lane < 16) yb[t * 64 + 16 * wid + lane] = dy[0];
                xn = nxn; xw = nxw; xb = nxb; xk = nxk; xr = nxr; vv = nvv;
            }
            LDS_BARRIER();
        }
        if (mode == 1) { float* sm = (float*)(p.ws + OFF_SMID) + (size_t)((s * 4 + h) * 2 + d) * 4096 + 16 * wid + (lane & 15);
#pragma unroll
            for (int i = 0; i < 16; ++i) sm[(16 * (lane >> 4) + i) * 64] = st[i]; }
    }
}

__device__ __forceinline__ float gelu_tanh(float x) { const float u = 0.7978845608028654f * (x + 0.044715f * x * x * x); return 0.5f * x * (1.0f + tanhf(u)); }

__device__ __forceinline__ void lru_unit(const KP& p, unsigned char* lds, int l, int s, int n) {
    typedef short bf16x8_t __attribute__((ext_vector_type(8)));
    typedef float f32x16_t __attribute__((ext_vector_type(16)));
    int tid_o = threadIdx.x; asm volatile("" : "+v"(tid_o)); const int tid = tid_o, lane = tid & 63; const int wid = __builtin_amdgcn_readfirstlane(tid >> 6);
    float* XC = (float*)lds;
    unsigned short* XCb = (unsigned short*)(lds + 16384);
    float* GG = (float*)(lds + 24576);
    float* HF = (float*)(lds + 57344);
    float* YG = (float*)(lds + 73728);
    float* HO = (float*)(lds + 90112);
    float* SEG = (float*)(lds + 106496);
    const bf16* Z = (const bf16*)(p.ws + OFF_Z);
    bf16* OM = (bf16*)(p.ws + OFF_OMIX);
    const int S = seq_len(s), start = seq_start(s); const int NB = S / 64;
    const int t_ = tid >> 3, c8 = (tid & 7) * 8;
    const int r32 = lane & 31, hi = lane >> 5; const int gm = wid & 1, gth = (wid >> 1) & 1, gch = wid >> 2;
    f32x4_t cw0[4], cw1[4];
#pragma unroll
    for (int j = 0; j < 4; ++j) { cw0[j] = *(const f32x4_t*)(p.in[11] + l * 4 * 384 + j * 384 + 64 * n + c8); cw1[j] = *(const f32x4_t*)(p.in[11] + l * 4 * 384 + j * 384 + 64 * n + c8 + 4); }
    const f32x4_t cb0 = *(const f32x4_t*)(p.in[12] + l * 384 + 64 * n + c8), cb1 = *(const f32x4_t*)(p.in[12] + l * 384 + 64 * n + c8 + 4);
    for (int d = 0; d < 2; ++d) {
        const float* wg = (gm == 0 ? p.in[13] : p.in[15]) + (((size_t)l * 2 + d) * 6 + n) * 4096;
        const float gbias = (gm == 0 ? p.in[14] : p.in[16])[(l * 2 + d) * 384 + 64 * n + 32 * gch + r32];
        const float lm = -p.in[17][(l * 2 + d) * 384 + 64 * n + lane]; const float sp8 = -8.0f * (lm > 20.f ? lm : log1pf(__expf(lm)));
        bf16x8_t Bf[4];
#pragma unroll
        for (int ks = 0; ks < 4; ++ks) { const float* wp = wg + (size_t)(16 * ks + 8 * hi) * 64 + 32 * gch + r32; u32x4_t pq;
            pq.x = pk2(wp[0], wp[64]); pq.y = pk2(wp[128], wp[192]); pq.z = pk2(wp[256], wp[320]); pq.w = pk2(wp[384], wp[448]); Bf[ks] = __builtin_bit_cast(bf16x8_t, pq); }
        __threadfence();
        __syncthreads();
        float hcarry = 0.f;
        u32x4_t rr[4], rh, ry;
#define LRU_ISSUE(blk_) do { const int tt = d == 0 ? (blk_) * 64 + t_ : S - 1 - ((blk_) * 64 + t_); \
            _Pragma("unroll") for (int j = 0; j < 4; ++j) { const int t2 = tt - 2 + j; rr[j] = (t2 >= 0 && t2 < S) ? *(const u32x4_t*)(Z + (size_t)(start + t2) * ZP + 64 * n + c8) : (u32x4_t){0u, 0u, 0u, 0u}; } \
            if (d == 1) { rh = *(const u32x4_t*)(OM + (size_t)(start + tt) * DM + 64 * n + c8); ry = *(const u32x4_t*)(Z + (size_t)(start + tt) * ZP + 384 + 64 * n + c8); } } while (0)
        LRU_ISSUE(0);
        for (int blk = 0; blk < NB; ++blk) {
            LDS_BARRIER();
            {
                f32x4_t x0 = cb0, x1 = cb1;
#pragma unroll
                for (int j = 0; j < 4; ++j) {
                    const f32x4_t a = (f32x4_t){__builtin_bit_cast(float, rr[j][0] << 16), __builtin_bit_cast(float, rr[j][0] & 0xffff0000u), __builtin_bit_cast(float, rr[j][1] << 16), __builtin_bit_cast(float, rr[j][1] & 0xffff0000u)};
                    const f32x4_t b = (f32x4_t){__builtin_bit_cast(float, rr[j][2] << 16), __builtin_bit_cast(float, rr[j][2] & 0xffff0000u), __builtin_bit_cast(float, rr[j][3] << 16), __builtin_bit_cast(float, rr[j][3] & 0xffff0000u)};
                    x0 += cw0[j] * a; x1 += cw1[j] * b;
                }
                *(f32x4_t*)(XC + t_ * 64 + c8) = x0; *(f32x4_t*)(XC + t_ * 64 + c8 + 4) = x1;
                { u32x4_t pq; pq.x = pk2(x0[0], x0[1]); pq.y = pk2(x0[2], x0[3]); pq.z = pk2(x1[0], x1[1]); pq.w = pk2(x1[2], x1[3]); *(u32x4_t*)(XCb + t_ * 64 + c8) = pq; }
                if (d == 1) {
                    float hf[8], yg[8];
#pragma unroll
                    for (int q = 0; q < 4; ++q) { hf[2 * q] = __builtin_bit_cast(float, rh[q] << 16); hf[2 * q + 1] = __builtin_bit_cast(float, rh[q] & 0xffff0000u);
                        yg[2 * q] = gelu_tanh(__builtin_bit_cast(float, ry[q] << 16)); yg[2 * q + 1] = gelu_tanh(__builtin_bit_cast(float, ry[q] & 0xffff0000u)); }
                    *(f32x4_t*)(HF + t_ * 64 + c8) = (f32x4_t){hf[0], hf[1], hf[2], hf[3]}; *(f32x4_t*)(HF + t_ * 64 + c8 + 4) = (f32x4_t){hf[4], hf[5], hf[6], hf[7]};
                    *(f32x4_t*)(YG + t_ * 64 + c8) = (f32x4_t){yg[0], yg[1], yg[2], yg[3]}; *(f32x4_t*)(YG + t_ * 64 + c8 + 4) = (f32x4_t){yg[4], yg[5], yg[6], yg[7]};
                }
                if (blk + 1 < NB) LRU_ISSUE(blk + 1);
            }
            LDS_BARRIER();
            {
                f32x16_t acc = {};
#pragma unroll
                for (int ks = 0; ks < 4; ++ks) { const bf16x8_t af = *(const bf16x8_t*)(XCb + (32 * gth + r32) * 64 + 16 * ks + 8 * hi); acc = __builtin_amdgcn_mfma_f32_32x32x16_bf16(af, Bf[ks], acc, 0, 0, 0); }
#pragma unroll
                for (int r = 0; r < 16; ++r) { const int trow = 32 * gth + (r & 3) + 8 * (r >> 2) + 4 * hi; GG[(gm * 64 + trow) * 64 + 32 * gch + r32] = sigmoidf_(acc[r] + gbias); }
            }
            LDS_BARRIER();
            float Pp[8], hl[8];
            {
                float pp = 1.f, hh = 0.f;
#pragma unroll
                for (int q = 0; q < 8; ++q) { const int t = 8 * wid + q; const float ra = GG[t * 64 + lane], ix = GG[(64 + t) * 64 + lane], xc = XC[t * 64 + lane];
                    const float la = sp8 * ra; const float a = __expf(la); const float uu = sqrtf(fmaxf(-expm1f(2.0f * la), 0.f)) * ix * xc;
                    pp *= a; hh = a * hh + uu; Pp[q] = pp; hl[q] = hh; }
                SEG[(wid * 2) * 64 + lane] = pp; SEG[(wid * 2 + 1) * 64 + lane] = hh;
            }
            LDS_BARRIER();
            {
                float sa[8], sh[8];
#pragma unroll
                for (int w = 0; w < 8; ++w) { sa[w] = SEG[(w * 2) * 64 + lane]; sh[w] = SEG[(w * 2 + 1) * 64 + lane]; }
                float carry = hcarry, mine = 0.f;
#pragma unroll
                for (int w = 0; w < 8; ++w) { if (w == wid) mine = carry; carry = sa[w] * carry + sh[w]; }
                hcarry = carry;
#pragma unroll
                for (int q = 0; q < 8; ++q) { const int t = 8 * wid + q; const float hv = Pp[q] * mine + hl[q]; HO[t * 64 + lane] = d == 0 ? hv : (HF[t * 64 + lane] + hv) * YG[t * 64 + lane]; }
            }
            LDS_BARRIER();
            {   const int tt = d == 0 ? blk * 64 + t_ : S - 1 - (blk * 64 + t_);
                const f32x4_t a = *(const f32x4_t*)(HO + t_ * 64 + c8), b = *(const f32x4_t*)(HO + t_ * 64 + c8 + 4);
                u32x4_t w; w.x = pk2(a[0], a[1]); w.y = pk2(a[2], a[3]); w.z = pk2(b[0], b[1]); w.w = pk2(b[2], b[3]);
                *(u32x4_t*)(OM + (size_t)(start + tt) * DM + 64 * n + c8) = w; }
        }
#undef LRU_ISSUE
    }
}

__device__ __forceinline__ void rwkv_post_tile(const KP& p, unsigned char* lds, int l, int tile) {
    int tid_o = threadIdx.x; asm volatile("" : "+v"(tid_o)); const int tid = tid_o, lane = tid & 63;
    float* SG = (float*)lds;
    float* GO = SG + 4096;
    const bf16* Z = (const bf16*)(p.ws + OFF_Z); bf16* OM = (bf16*)(p.ws + OFF_OMIX);
    const float* YF = (const float*)(p.ws + OFF_YF); const float* YBk = (const float*)(p.ws + OFF_YB);
    const float* mu = p.in[18] + l * 1024; const float* g_up = p.in[23] + (size_t)l * 128 * 256;
    const int m0 = tile * 32; const int s = seq_of_row(m0); const int S = seq_len(s), start = seq_start(s);
    __syncthreads();
    for (int e = tid; e < 4096; e += NTHR) {
        const int t = e >> 7, c = e & 127; const int m = m0 + t, tt = m - start; const bf16* zp = Z + (size_t)m * ZP + 768 + 896 + c;
        const float f = bf2f(zp[0]); const float pv = tt > 0 ? bf2f(zp[-ZP]) : 0.f; const float nx = tt < S - 1 ? bf2f(zp[ZP]) : 0.f;
        SG[e] = sigmoidf_(f + mu[896 + c] * (0.5f * (pv + nx) - f));
    }
    __syncthreads();
    const int c = tid & 255, tg = tid >> 8;
    {
        float acc[16];
#pragma unroll
        for (int t = 0; t < 16; ++t) acc[t] = 0.f;
        for (int ib = 0; ib < 128; ib += 16) {
            float wv[16];
#pragma unroll
            for (int u = 0; u < 16; ++u) wv[u] = g_up[(ib + u) * 256 + c];
#pragma unroll
            for (int u4 = 0; u4 < 16; u4 += 4)
#pragma unroll
                for (int t = 0; t < 16; ++t) { const f32x4_t x = *(const f32x4_t*)(SG + (tg * 16 + t) * 128 + ib + u4); acc[t] += x[0] * wv[u4] + x[1] * wv[u4 + 1] + x[2] * wv[u4 + 2] + x[3] * wv[u4 + 3]; }
        }
#pragma unroll
        for (int t = 0; t < 16; ++t) GO[(tg * 16 + t) * 256 + c] = acc[t];
    }
    const int dc = (s < 4) ? ((m0 - start) >= S / 2 ? 0 : 1) : -1;
    if (dc >= 0) {
        float* SM = (float*)(lds + 49152); unsigned short* YPs = (unsigned short*)(lds + 114688);
        const float* Ydc = dc == 0 ? YF : YBk; float* Yw = (float*)(p.ws + (dc == 0 ? OFF_YF : OFF_YB));
        for (int e = tid; e < 4096; e += NTHR) { const int hh = e >> 10, r4 = (e & 1023) * 4; *(f32x4_t*)(SM + hh * 4096 + r4) = *(const f32x4_t*)((const float*)(p.ws + OFF_SMID) + (size_t)((s * 4 + hh) * 2 + dc) * 4096 + r4); }
        for (int e = tid; e < 1024; e += NTHR) { const int t = e >> 5, hh = (e >> 3) & 3, ch = e & 7; *(u32x4_t*)(YPs + t * 256 + hh * 64 + ch * 8) = *(const u32x4_t*)((const unsigned short*)(Ydc + (size_t)(m0 + t) * 256 + 64 * hh) + 64 + ch * 8); }
        __syncthreads();
        const int hh = c >> 6, v = c & 63; const float* smp = SM + hh * 4096 + v;
#pragma unroll 1
        for (int t = 0; t < 16; ++t) {
            const int tk = tg * 16 + t; const size_t mrow = (size_t)(m0 + tk) * 256;
            float accv = bf2f(((const unsigned short*)(Ydc + mrow + 64 * hh))[v]);
#pragma unroll
            for (int i0 = 0; i0 < 64; i0 += 8) { const u32x4_t w = *(const u32x4_t*)(YPs + tk * 256 + hh * 64 + i0);
                accv += smp[(i0 + 0) * 64] * __builtin_bit_cast(float, w[0] << 16) + smp[(i0 + 1) * 64] * __builtin_bit_cast(float, w[0] & 0xffff0000u) + smp[(i0 + 2) * 64] * __builtin_bit_cast(float, w[1] << 16) + smp[(i0 + 3) * 64] * __builtin_bit_cast(float, w[1] & 0xffff0000u)
                      + smp[(i0 + 4) * 64] * __builtin_bit_cast(float, w[2] << 16) + smp[(i0 + 5) * 64] * __builtin_bit_cast(float, w[2] & 0xffff0000u) + smp[(i0 + 6) * 64] * __builtin_bit_cast(float, w[3] << 16) + smp[(i0 + 7) * 64] * __builtin_bit_cast(float, w[3] & 0xffff0000u); }
            Yw[mrow + c] = accv;
        }
        __threadfence();
        __syncthreads();
    }
    const float rk = p.in[26][l * 256 + c], lg = p.in[27][l * 256 + c], lb = p.in[28][l * 256 + c];
    const float mr = mu[c], mk = mu[256 + c], mv = mu[512 + c];
    for (int t = 0; t < 16; ++t) {
        const int m = m0 + tg * 16 + t, tt = m - start; const bf16* zp = Z + (size_t)m * ZP + 768 + c;
        const bool hp = tt > 0, hn = tt < S - 1;
        float f = bf2f(zp[0]), pv = hp ? bf2f(zp[-ZP]) : 0.f, nx = hn ? bf2f(zp[ZP]) : 0.f; const float r = f + mr * (0.5f * (pv + nx) - f);
        f = bf2f(zp[256]); pv = hp ? bf2f(zp[256 - ZP]) : 0.f; nx = hn ? bf2f(zp[256 + ZP]) : 0.f; const float k = f + mk * (0.5f * (pv + nx) - f);
        f = bf2f(zp[512]); pv = hp ? bf2f(zp[512 - ZP]) : 0.f; nx = hn ? bf2f(zp[512 + ZP]) : 0.f; const float v = f + mv * (0.5f * (pv + nx) - f);
        float yf = YF[(size_t)m * 256 + c], ybv = YBk[(size_t)m * 256 + c];
        const float y = yf + ybv;
        const float mean = wave_sum(y) * (1.0f / 64.0f); const float dv = y - mean; const float var = wave_sum(dv * dv) * (1.0f / 64.0f);
        const float yn = dv * rsqrtf(var + 64e-5f) * lg + lb;
        const float bon = wave_sum(r * k * rk);
        const float outv = (yn + bon * v) * GO[(tg * 16 + t) * 256 + c];
        OM[(size_t)m * DM + 384 + c] = (bf16)f2bf(outv);
    }
    (void)lane;
}

__global__ void __launch_bounds__(NTHR, 2) fwd_megakernel(KP p) {
    extern __shared__ __attribute__((aligned(16))) unsigned char lds[];
    cg::grid_group grid = cg::this_grid();
    const int tid = threadIdx.x, lane = tid & 63, wid = tid >> 6;
    const int G = gridDim.x, bx = blockIdx.x;
    const int gw = bx * 8 + wid, NGW = G * 8;
    unsigned char* ws = p.ws;
    volatile int* misc = (volatile int*)(lds + MISC_OFF);
    PG8_LAS unsigned char* ldsg = (PG8_LAS unsigned char*)lds;

    {
        float* scr = (float*)(lds + wid * 16384);
        for (int l = 0; l < 2; ++l) {
            unsigned char* wl = ws + OFF_W + l * W_LAYER;
            constexpr int I_IN = 16 * 176, I_OUT = 44 * 32, I_MI = 16 * 76, I_MO = 16 * 32, I_TOT = 2 * I_IN + 2 * I_OUT + I_MI + I_MO;
            for (int it = gw; it < I_TOT; it += NGW) {
                int r = it;
                if (r < 2 * I_IN) { const int f = r / I_IN; transpose_item<1>(p.in[7] + ((size_t)l * 2 + f) * DM * NFF, DM, NFF, (bf16*)(wl + WO_IN + f * 11 * MiB), scr, r % I_IN, lane); continue; } r -= 2 * I_IN;
                if (r < 2 * I_OUT) { const int f = r / I_OUT; transpose_item<0>(p.in[8] + ((size_t)l * 2 + f) * DFF * DM, DFF, DM, (bf16*)(wl + WO_OUT + f * (11 * MiB / 2)), scr, r % I_OUT, lane); continue; } r -= 2 * I_OUT;
                if (r < I_MI) { transpose_item<2>(p.in[9] + (size_t)l * DM * NMIX, DM, NMIX, (bf16*)(wl + WO_MI), scr, r, lane); continue; } r -= I_MI;
                transpose_item<0>(p.in[10] + (size_t)l * DM * DM, DM, DM, (bf16*)(wl + WO_MO), scr, r, lane);
            }
            u32x4_t* padp = (u32x4_t*)(wl + WO_MI + (size_t)NMIX * DM * 2);
            for (int e = bx * NTHR + tid; e < 128 * DM * 2 / 16; e += G * NTHR) padp[e] = (u32x4_t){0u, 0u, 0u, 0u};
        }
        __syncthreads();
        for (int u = bx; u < 2 * 36 * 8; u += G) { const int l = u / 288, r = u % 288;
            smallm_unit<0, 0>(p, (float*)lds, l, 0, p.in[4] + (size_t)l * DM * 9216, 9216, 9216, (float*)(ws + OFF_MOD) + (size_t)l * NSEQ * 9216, 9216, r / 8, r % 8); }
        if (bx == 0) { float* rope = (float*)(ws + OFF_ROPE);
            for (int e = tid; e < 1024; e += NTHR) { const int pos = e >> 4, pp = e & 15; const float inv = exp2f(-(float)pp * (13.287712379549449f / 16.0f)); const float a = (float)pos * inv; const float kr = rintf(a * 0.15915494309189535f); float rr = fmaf(-kr, 6.2831854820251465f, a); rr = fmaf(-kr, -1.7484555e-7f, rr); rope[2 * e] = __cosf(rr); rope[2 * e + 1] = __sinf(rr); } }
    }
    grid.sync();
    {
        const float* MOD = (const float*)(ws + OFF_MOD); float* GV = (float*)(ws + OFF_GV); float* GT = (float*)(ws + OFF_GATE);
        for (int e = bx * NTHR + tid; e < 6 * NSEQ * DM; e += G * NTHR) {
            const int c = e & 1023, s = (e >> 10) % NSEQ, inst = e / (NSEQ * DM); const int l = inst / 3, j = inst % 3;
            const float* mr = MOD + ((size_t)l * NSEQ + s) * 9216; const float* ba = p.in[5] + l * 9216;
            const float sc = mr[(3 * j + 1) * 1024 + c] + ba[(3 * j + 1) * 1024 + c], gg = mr[(3 * j + 2) * 1024 + c] + ba[(3 * j + 2) * 1024 + c];
            GV[e] = p.in[6][(l * 3 + j) * DM + c] * (1.0f + sc); GT[e] = (j == 1 ? 1.0f : 0.5f) * gg;
        }
        for (int u = bx; u < 2 * 432; u += G) { const int l = u / 432, r = u % 432; float* bdst = (float*)(ws + OFF_BIAS);
            if (r < 176) smallm_unit<1, 1>(p, (float*)lds, l, 0, p.in[7] + ((size_t)l * 2 + 0) * DM * NFF, NFF, NFF, bdst + (size_t)(l * 3 + 0) * NSEQ * NFF, NFF, r / 8, r % 8);
            else if (r < 256) smallm_unit<1, 2>(p, (float*)lds, l, 1, p.in[9] + (size_t)l * DM * NMIX, NMIX, NMIX, bdst + (size_t)(l * 3 + 1) * NSEQ * NFF, NFF, (r - 176) / 8, (r - 176) % 8);
            else smallm_unit<1, 1>(p, (float*)lds, l, 2, p.in[7] + ((size_t)l * 2 + 1) * DM * NFF, NFF, NFF, bdst + (size_t)(l * 3 + 2) * NSEQ * NFF, NFF, (r - 256) / 8, (r - 256) % 8); }
        bf16* XN = (bf16*)(ws + OFF_XN); float* SS0 = (float*)(ws + OFF_SS);
        for (int m = gw; m < MTOK; m += NGW) {
            const int s = seq_of_row(m); const float* xr = m < 16384 ? p.in[0] + (size_t)m * DM : p.in[1] + (size_t)(m - 16384) * DM;
            const float* mr = MOD + (size_t)s * 9216 + 1024; const float* ba = p.in[5] + 1024; const float* ng = p.in[6];
            float q = 0.f;
#pragma unroll
            for (int j = 0; j < 4; ++j) { const int c = 4 * lane + 256 * j; const f32x4_t v = *(const f32x4_t*)(xr + c); const f32x4_t sc = *(const f32x4_t*)(mr + c) + *(const f32x4_t*)(ba + c); const f32x4_t g = *(const f32x4_t*)(ng + c) * (sc + 1.0f);
                q += (v[0] * v[0] + v[1] * v[1]) + (v[2] * v[2] + v[3] * v[3]); const f32x4_t o = v * g;
                *(unsigned long long*)(XN + (size_t)m * DM + c) = (unsigned long long)pk2(o[0], o[1]) | ((unsigned long long)pk2(o[2], o[3]) << 32); }
            q = wave_sum(q); if (lane == 0) SS0[m] = q;
        }
    }
    grid.sync();

    for (int l = 0; l < 2; ++l) {
        unsigned char* wl = ws + OFF_W + l * W_LAYER;
        const float* GV = (const float*)(ws + OFF_GV); const float* GT = (const float*)(ws + OFF_GATE); const float* BI = (const float*)(ws + OFF_BIAS); float* SS = (float*)(ws + OFF_SS);
        bf16* XN = (bf16*)(ws + OFF_XN); bf16* HID = (bf16*)(ws + OFF_HID); bf16* OMIX = (bf16*)(ws + OFF_OMIX);
        for (int f = 0; f < 2; ++f) {
            const int j = f == 0 ? 0 : 2; const int inst = l * 3 + j;
            if (f == 1) {
                {
                    pg8::Gemm g{XN, (const pg8::bf16_t*)(wl + WO_MI), MTOK, NMIXP, DM}; pg8::StaticOrder S; S.init(MTOK, NMIXP, G, bx);
                    pg8::EpiZ E{(bf16*)(ws + OFF_Z), (bf16*)(ws + OFF_QK), (bf16*)(ws + OFF_VR), SS + (size_t)(l * 3 + 1) * MTOK, BI + (size_t)(l * 3 + 1) * NSEQ * NFF, p.in[29] + l * 64, p.in[30] + l * 64, (const float*)(ws + OFF_ROPE)};
                    pg8::gemm_phase<pg8::EpiZ, pg8::StaticOrder, true, true>(ldsg, g, S, E);
                }
                grid.sync();
                {
                    unsigned* ctr = (unsigned*)(ws + OFF_CTR) + 64 * l;
                    constexpr int NU_R = 224, NU_L = 120, NU_A = 1152, NU = NU_R + NU_L + NU_A;
                    for (;;) {
                        __syncthreads(); if (tid == 0) misc[0] = (int)atomicAdd(ctr, 1u); __syncthreads();
                        const int u = misc[0]; if (u >= NU) break;
                        if (u < 224) { int s_, h_, d_, md_;
                            if (u < 96) { const int c = u & 31; md_ = 1 + (u >> 5); s_ = c >> 3; h_ = (c >> 1) & 3; d_ = c & 1; } else { const int i2 = u - 96; md_ = 0; s_ = 4 + (i2 >> 3); h_ = (i2 >> 1) & 3; d_ = i2 & 1; }
                            rwkv_unit(p, lds, l, s_, h_, d_, md_); }
                        else if (u < 248) { const int i3 = u - 224; lru_unit(p, lds, l, i3 / 6, i3 % 6); }
                        else if (u < 344) { const int i4 = u - 248; lru_unit(p, lds, l, 4 + i4 / 6, i4 % 6); }
                        else { const int i5 = u - 344; int s_, hq, qb;
                            if (i5 < 384) { s_ = i5 / 96; const int r = i5 % 96; hq = (r / 48) * 3 + (r % 48) / 16; qb = r & 15; }
                            else { const int i6 = i5 - 384; s_ = 4 + i6 / 48; const int r = i6 % 48; hq = (r / 24) * 3 + (r % 24) / 8; qb = r & 7; }
                            const int g_ = hq / 3;
                            attn_body::attn_unit<8>(seq_start(s_), seq_len(s_), qb, 64 * hq, 384 + 64 * g_, 64 * g_, 640 + 64 * hq, (const attn_body::bf16*)(ws + OFF_QK), (const attn_body::bf16*)(ws + OFF_QK), (const attn_body::bf16*)(ws + OFF_VR), (attn_body::bf16*)(ws + OFF_OMIX), (char*)lds); }
                    }
                }
                grid.sync();
                for (int t = bx; t < MTOK / 32; t += G) rwkv_post_tile(p, lds, l, t);
                grid.sync();
                {
                    pg8::Gemm g{OMIX, (const pg8::bf16_t*)(wl + WO_MO), MTOK, DM, DM}; pg8::StaticOrder S; S.init(MTOK, DM, G, bx);
                    pg8::EpiResid E{p.out, p.out + (size_t)16384 * DM, p.out, XN, SS + (size_t)(l * 3 + 2) * MTOK, GT + (size_t)(l * 3 + 1) * NSEQ * DM, GV + (size_t)(l * 3 + 2) * NSEQ * DM};
                    pg8::gemm_phase<pg8::EpiResid, pg8::StaticOrder, true, true>(ldsg, g, S, E);
                }
                grid.sync();
            }
            {
                pg8::Gemm g{XN, (const pg8::bf16_t*)(wl + WO_IN + f * 11 * MiB), MTOK, NFF, DM}; pg8::StaticOrder S; S.init(MTOK, NFF, G, bx);
                pg8::EpiSwiglu E{HID, SS + (size_t)inst * MTOK, BI + (size_t)inst * NSEQ * NFF};
                pg8::gemm_phase<pg8::EpiSwiglu, pg8::StaticOrder, true, true>(ldsg, g, S, E);
            }
            grid.sync();
            {
                const bool first = (l == 0 && f == 0), last = (l == 1 && f == 1);
                const int ninst = inst + 1;
                pg8::Gemm g{HID, (const pg8::bf16_t*)(wl + WO_OUT + f * (11 * MiB / 2)), MTOK, DM, DFF}; pg8::StaticOrder S; S.init(MTOK, DM, G, bx);
                pg8::EpiResid E{first ? p.in[0] : p.out, first ? p.in[1] : p.out + (size_t)16384 * DM, p.out, XN, last ? nullptr : SS + (size_t)ninst * MTOK, GT + (size_t)inst * NSEQ * DM, last ? nullptr : GV + (size_t)ninst * NSEQ * DM};
                pg8::gemm_phase<pg8::EpiResid, pg8::StaticOrder, true, true>(ldsg, g, S, E);
            }
            if (!(l == 1 && f == 1)) grid.sync();
        }
    }
}

extern "C" void kernel_launch(void* const* d_in, const int* in_sizes, int n_in, void* d_out, int out_size, void* d_ws, size_t ws_size, hipStream_t stream) {
    static int grid = 0;
    if (grid == 0) {
        if (n_in != 31 || ws_size < WS_END + 1 * MiB) { fprintf(stderr, "kernel_launch: unexpected n_in %d / ws %zu\n", n_in, ws_size); grid = -1; return; }
        int dev = 0, cus = 0, per_cu = 0;
        hipGetDevice(&dev); hipDeviceGetAttribute(&cus, hipDeviceAttributeMultiprocessorCount, dev);
        hipFuncSetAttribute((const void*)fwd_megakernel, hipFuncAttributeMaxDynamicSharedMemorySize, LDS_BYTES);
        hipOccupancyMaxActiveBlocksPerMultiprocessor(&per_cu, (const void*)fwd_megakernel, NTHR, LDS_BYTES);
        if (per_cu < 1) per_cu = 1;
        grid = cus * per_cu;
        (void)hipGetLastError();
    }
    if (grid < 0) return;
    hipMemsetAsync(d_ws, 0, ZERO_BYTES, stream);
    KP p{};
    for (int i = 0; i < 31; ++i) p.in[i] = (const float*)d_in[i];
    p.out = (float*)d_out; p.ws = (unsigned char*)d_ws;
    void* args[] = {&p};
    hipError_t e = hipLaunchCooperativeKernel((const void*)fwd_megakernel, dim3(grid), dim3(NTHR), args, LDS_BYTES, stream);
    if (e != hipSuccess) fprintf(stderr, "cooperative launch failed: %s (grid %d)\n", hipGetErrorString(e), grid);
}
```

```cpp
#include <hip/hip_runtime.h>
#include <hip/hip_cooperative_groups.h>
#include <cstdio>
#include <cstdint>
namespace cg = cooperative_groups;
namespace pg8 {
#define PG8_LAS __attribute__((address_space(3)))
typedef unsigned short bf16_t;
typedef short bf16x8 __attribute__((ext_vector_type(8)));
typedef float f32x4 __attribute__((ext_vector_type(4)));
typedef unsigned u32x4 __attribute__((ext_vector_type(4)));
constexpr int BM = 256, BK = 64, HALF = 128, HTB = HALF * BK * 2  , STAGE_BYTES = 8 * HTB, NXCD = 8, WGM = 8;

__host__ __device__ __forceinline__ int lds_byte(int r, int c) { const int st = (r >> 4) * 2 + (c >> 5), rr = r & 15, cc = c & 31, ob = rr * 64 + cc * 2; return st * 1024 + (ob ^ (((ob >> 9) & 1) << 5)); }
__host__ __device__ __forceinline__ void stage_rc(int b, int& R, int& C) { const int st = b / 1024, sb = b % 1024, swz = sb ^ (((sb >> 9) & 1) << 5); R = (st >> 1) * 16 + swz / 64; C = (st & 1) * 32 + (swz % 64) / 2; }
__host__ __device__ __forceinline__ int perm32(int rho) { const int n = rho >> 4, i = rho & 15; return 8 * (i >> 2) + 4 * n + (i & 3); }

struct Unit { int pm, pn; };
struct Gemm { const bf16_t* A; const bf16_t* Bt; int M, N, K; };

struct StaticOrder {
    int nM, nN, nwg, G, c;
    __host__ __device__ void init(int M, int N, int G_, int c_) { nM = M / BM; nN = N / BM; nwg = nM * nN; G = G_; c = c_; }
    __host__ __device__ bool next(int i, Unit& u) const {
        const long L = (long)i * G + c; if (L >= nwg) return false;
        int wgid = (int)L; { const int q = nwg / NXCD, r = nwg % NXCD, xcd = wgid % NXCD, off = wgid / NXCD; wgid = (xcd < r ? xcd * (q + 1) : r * (q + 1) + (xcd - r) * q) + off; }
        const int nig = WGM * nN, gid = wgid / nig, fm = gid * WGM, gsz = (nM - fm) < WGM ? (nM - fm) : WGM;
        u.pm = fm + ((wgid % nig) % gsz); u.pn = (wgid % nig) / gsz; return true;
    }
    __device__ __forceinline__ void a_ready(const Unit&) const {}
    __device__ __forceinline__ void done(const Unit&) const {}
};

__device__ __forceinline__ unsigned cvt_pk_bf16(float lo, float hi) { unsigned r; asm volatile("v_cvt_pk_bf16_f32 %0, %1, %2" : "=v"(r) : "v"(lo), "v"(hi)); return r; }
typedef float f32x2 __attribute__((ext_vector_type(2)));
__device__ __forceinline__ f32x2 gelu_pk(f32x2 v) {
    const f32x2 av = __builtin_elementwise_abs(v), d = av * 0.2316418882f + 1.0f;
    f32x2 t; t.x = __builtin_amdgcn_rcpf(d.x); t.y = __builtin_amdgcn_rcpf(d.y);
    f32x2 q = t * 0.5307027145f + (-0.7265760135f); q = q * t + 0.7107068705f; q = q * t + (-0.142248368f); q = q * t + 0.127414796f; q = q * t;
    const f32x2 s = (v * v) * (-0.72134752044f);
    f32x2 e; e.x = __builtin_amdgcn_exp2f(s.x); e.y = __builtin_amdgcn_exp2f(s.y);
    const f32x2 m = v * (q * e), r = v - m;
    f32x2 o; o.x = v.x < 0.f ? m.x : r.x; o.y = v.y < 0.f ? m.y : r.y; return o;
}

template <int ACT  > struct EpiBf16 {
    static constexpr bool PERM = true, AFTER_DRAIN = false; static_assert(ACT == 0 || ACT == 1, "EpiBf16: ACT is 0 (none) or 1 (gelu_pk)");
    bf16_t* O; int ldc; const float* bias; int split_cols; size_t split_stride; float scale0;
    __device__ __forceinline__ void operator()(const f32x4 (&acc)[2][2][4][2], const Unit& u, int wr, int wc, int fr, int fq) const {
        const int row0 = u.pm * BM + wr * 64 + fr; int colt = u.pn * BM; bf16_t* base = O;
        float sc = 1.f; if (split_cols) { const int t = colt / split_cols; base += (size_t)t * split_stride; colt -= t * split_cols; if (t == 0) sc = scale0; }
        const int col0 = colt + wc * 32 + 8 * fq, bcol0 = u.pn * BM + wc * 32 + 8 * fq;
        f32x4 bv[2][2];
#pragma unroll
        for (int bj = 0; bj < 2; ++bj)
#pragma unroll
            for (int n = 0; n < 2; ++n) bv[bj][n] = bias ? *(const f32x4*)(bias + bcol0 + bj * HALF + 4 * n) : (f32x4){0.f, 0.f, 0.f, 0.f};
#pragma unroll
        for (int ai = 0; ai < 2; ++ai)
#pragma unroll
            for (int m = 0; m < 4; ++m) { bf16_t* rowp = base + (size_t)(row0 + ai * HALF + m * 16) * ldc + col0;
#pragma unroll
                for (int bj = 0; bj < 2; ++bj) { f32x4 v0 = acc[ai][bj][m][0] + bv[bj][0], v1 = acc[ai][bj][m][1] + bv[bj][1];
                    if (ACT == 1) { f32x2 a = gelu_pk((f32x2){v0[0], v0[1]}), b = gelu_pk((f32x2){v0[2], v0[3]}), c = gelu_pk((f32x2){v1[0], v1[1]}), d = gelu_pk((f32x2){v1[2], v1[3]});
                        v0 = (f32x4){a.x, a.y, b.x, b.y}; v1 = (f32x4){c.x, c.y, d.x, d.y}; }
                    v0 = v0 * sc; v1 = v1 * sc; u32x4 w; w.x = cvt_pk_bf16(v0[0], v0[1]); w.y = cvt_pk_bf16(v0[2], v0[3]); w.z = cvt_pk_bf16(v1[0], v1[1]); w.w = cvt_pk_bf16(v1[2], v1[3]);
                    *(u32x4*)(rowp + bj * HALF) = w; } }
    }
};
template <class Epi, class Sched, bool ALIGN_EPI = false, bool SP2 = false>
__device__ __forceinline__ void gemm_phase(PG8_LAS unsigned char* lds, const Gemm g, const Sched& S, const Epi& E) {
    int tid_o = threadIdx.x; asm volatile("" : "+v"(tid_o)); const int tid = tid_o, wid = __builtin_amdgcn_readfirstlane(tid >> 6), lane = tid & 63, wr = wid >> 2, wc = wid & 3, fr = lane & 15, fq = lane >> 4;
    const int K = g.K, nt = K / BK;
    unsigned voffA[2], voffB[2];
#pragma unroll
    for (int i = 0; i < 2; ++i) { int R, C; stage_rc(tid * 16 + i * 8192, R, C); const int Rb = Epi::PERM ? ((R & ~31) + perm32(R & 31)) : R;
        voffA[i] = (unsigned)(R * K + C) * 2u; voffB[i] = (unsigned)(Rb * K + C) * 2u; }
    const size_t kstep = (size_t)(BK * 2);
    const size_t hstep = (size_t)HALF * K * 2;
    const size_t tstep = 2 * hstep;
    const unsigned ldsw = (unsigned)wid * 1024u;
    const int aoff = lds_byte(wr * 64 + fr, fq * 8), boff = lds_byte(wc * 32 + fr, fq * 8);
#define PG8_SA(b, h) (((b) * 2 + (h)) * HTB)
#define PG8_SB(b, h) ((4 + (b) * 2 + (h)) * HTB)
#define PG8_STAGE(bufoff, gbase, voff) do { _Pragma("unroll") for (int _i = 0; _i < 2; ++_i) \
        __builtin_amdgcn_global_load_lds((const unsigned*)((const char*)(gbase) + (voff)[_i]), (PG8_LAS unsigned*)(lds + (bufoff) + ldsw + _i * 8192), 16, 0, 0); } while (0)
#define PG8_LDA(dst, b, h) do { _Pragma("unroll") for (int m = 0; m < 4; ++m) _Pragma("unroll") for (int k = 0; k < 2; ++k) dst[m][k] = *(const PG8_LAS bf16x8*)(lds + PG8_SA(b, h) + aoff + m * 2048 + k * 1024); } while (0)
#define PG8_LDB(dst, b, h) do { _Pragma("unroll") for (int n = 0; n < 2; ++n) _Pragma("unroll") for (int k = 0; k < 2; ++k) dst[n][k] = *(const PG8_LAS bf16x8*)(lds + PG8_SB(b, h) + boff + n * 2048 + k * 1024); } while (0)
#define PG8_MMA(ai, bj, At, Bt) do { __builtin_amdgcn_s_setprio(1); _Pragma("unroll") for (int m = 0; m < 4; ++m) _Pragma("unroll") for (int n = 0; n < 2; ++n) _Pragma("unroll") for (int k = 0; k < 2; ++k) \
        acc[ai][bj][m][n] = __builtin_amdgcn_mfma_f32_16x16x32_bf16(Bt[n][k], At[m][k], acc[ai][bj][m][n], 0, 0, 0); __builtin_amdgcn_s_setprio(0); } while (0)
#define PG8_WAIT_V(n) asm volatile("s_waitcnt vmcnt(" #n ")" ::: "memory")
#define PG8_WAIT_L(n) asm volatile("s_waitcnt lgkmcnt(" #n ")" ::: "memory")
#define PG8_BAR __builtin_amdgcn_s_barrier()
#define PG8_SCHED __builtin_amdgcn_sched_barrier(0)
    Unit cur, nxt; int ui = 0;
    if (!S.next(0, cur)) return;
    f32x4 acc[2][2][4][2];
#pragma unroll
    for (int a = 0; a < 2; ++a)
#pragma unroll
        for (int b = 0; b < 2; ++b)
#pragma unroll
            for (int m = 0; m < 4; ++m)
#pragma unroll
                for (int n = 0; n < 2; ++n) acc[a][b][m][n] = (f32x4){0.f, 0.f, 0.f, 0.f};
    bf16x8 At[4][2], B0[2][2], B1[2][2];
    const char* cA = (const char*)g.A + (size_t)cur.pm * tstep; const char* cB = (const char*)g.Bt + (size_t)cur.pn * tstep;
    S.a_ready(cur);
    if constexpr (SP2) {
        PG8_STAGE(PG8_SB(0, 0), cB, voffB); PG8_STAGE(PG8_SB(0, 1), cB + hstep, voffB); PG8_STAGE(PG8_SA(0, 0), cA, voffA); PG8_STAGE(PG8_SA(0, 1), cA + hstep, voffA);
        if (wr == 1) PG8_BAR;
        PG8_WAIT_V(2); PG8_BAR;
        PG8_STAGE(PG8_SB(1, 0), cB + kstep, voffB); PG8_STAGE(PG8_SA(1, 0), cA + kstep, voffA); PG8_STAGE(PG8_SB(1, 1), cB + hstep + kstep, voffB);
        PG8_WAIT_V(6); PG8_BAR;
    } else {
        PG8_STAGE(PG8_SB(0, 0), cB, voffB); PG8_STAGE(PG8_SA(0, 0), cA, voffA); PG8_STAGE(PG8_SB(0, 1), cB + hstep, voffB); PG8_STAGE(PG8_SA(0, 1), cA + hstep, voffA);
        if (wr == 1) PG8_BAR;
        PG8_WAIT_V(4); PG8_BAR;
        PG8_STAGE(PG8_SB(1, 0), cB + kstep, voffB); PG8_STAGE(PG8_SA(1, 0), cA + kstep, voffA); PG8_STAGE(PG8_SB(1, 1), cB + hstep + kstep, voffB);
        PG8_WAIT_V(6); PG8_BAR;
    }
    for (;;) {
        const bool has_next = S.next(ui + 1, nxt);
        const char* nA = has_next ? (const char*)g.A + (size_t)nxt.pm * tstep : cA; const char* nB = has_next ? (const char*)g.Bt + (size_t)nxt.pn * tstep : cB;
        for (int t = 0; t < nt; t += 2) {
            const bool last = (t == nt - 2);
            const char* a1 = cA + (size_t)(t + 1) * kstep;
            const char* a2 = last ? nA : cA + (size_t)(t + 2) * kstep; const char* b2 = last ? nB : cB + (size_t)(t + 2) * kstep;
            const char* a3 = a2 + kstep; const char* b3 = b2 + kstep;
            if (last && has_next) S.a_ready(nxt);
            if constexpr (SP2) {
            PG8_LDB(B0, 0, 0); PG8_LDB(B1, 0, 1); PG8_SCHED; PG8_LDA(At, 0, 0); PG8_STAGE(PG8_SA(1, 1), a1 + hstep, voffA);
            PG8_WAIT_V(8); PG8_WAIT_L(0); PG8_BAR; PG8_MMA(0, 0, At, B0); PG8_MMA(0, 1, At, B1); PG8_BAR; PG8_SCHED;
            PG8_LDA(At, 0, 1); PG8_STAGE(PG8_SB(0, 0), b2, voffB); PG8_STAGE(PG8_SB(0, 1), b2 + hstep, voffB); PG8_STAGE(PG8_SA(0, 0), a2, voffA);
            PG8_WAIT_V(8); PG8_WAIT_L(0); PG8_BAR; PG8_MMA(1, 0, At, B0); PG8_MMA(1, 1, At, B1); PG8_BAR; PG8_SCHED;
            PG8_LDB(B0, 1, 0); PG8_LDB(B1, 1, 1); PG8_SCHED; PG8_LDA(At, 1, 0); PG8_STAGE(PG8_SA(0, 1), a2 + hstep, voffA);
            PG8_WAIT_V(8); PG8_WAIT_L(0); PG8_BAR; PG8_MMA(0, 0, At, B0); PG8_MMA(0, 1, At, B1); PG8_BAR; PG8_SCHED;
            PG8_LDA(At, 1, 1); PG8_STAGE(PG8_SB(1, 0), b3, voffB); PG8_STAGE(PG8_SB(1, 1), b3 + hstep, voffB); PG8_STAGE(PG8_SA(1, 0), a3, voffA);
            PG8_WAIT_V(8); PG8_WAIT_L(0); PG8_BAR; PG8_MMA(1, 0, At, B0); PG8_MMA(1, 1, At, B1); PG8_BAR; PG8_SCHED;
            } else {
            PG8_LDB(B0, 0, 0); PG8_SCHED; PG8_LDA(At, 0, 0); PG8_STAGE(PG8_SA(1, 1), a1 + hstep, voffA);
            PG8_WAIT_L(8); PG8_BAR; PG8_WAIT_L(0); PG8_MMA(0, 0, At, B0); PG8_BAR; PG8_SCHED;
            PG8_LDB(B1, 0, 1); PG8_STAGE(PG8_SB(0, 0), b2, voffB);
            PG8_BAR; PG8_WAIT_L(0); PG8_MMA(0, 1, At, B1); PG8_BAR;
            PG8_LDA(At, 0, 1); PG8_STAGE(PG8_SA(0, 0), a2, voffA);
            PG8_BAR; PG8_WAIT_L(0); PG8_MMA(1, 0, At, B0); PG8_BAR; PG8_SCHED;
            PG8_STAGE(PG8_SB(0, 1), b2 + hstep, voffB);
            PG8_WAIT_V(6); PG8_BAR; PG8_MMA(1, 1, At, B1); PG8_BAR;
            PG8_LDB(B0, 1, 0); PG8_SCHED; PG8_LDA(At, 1, 0); PG8_STAGE(PG8_SA(0, 1), a2 + hstep, voffA);
            PG8_WAIT_L(8); PG8_BAR; PG8_WAIT_L(0); PG8_MMA(0, 0, At, B0); PG8_BAR; PG8_SCHED;
            PG8_LDB(B1, 1, 1); PG8_STAGE(PG8_SB(1, 0), b3, voffB);
            PG8_BAR; PG8_WAIT_L(0); PG8_MMA(0, 1, At, B1); PG8_BAR;
            PG8_LDA(At, 1, 1); PG8_STAGE(PG8_SA(1, 0), a3, voffA);
            PG8_BAR; PG8_WAIT_L(0); PG8_MMA(1, 0, At, B0); PG8_BAR; PG8_SCHED;
            PG8_STAGE(PG8_SB(1, 1), b3 + hstep, voffB);
            PG8_WAIT_V(6); PG8_BAR; PG8_MMA(1, 1, At, B1); PG8_BAR;
            }
        }
        if constexpr (ALIGN_EPI) { if (wr == 0) PG8_BAR; }
        if constexpr (!Epi::AFTER_DRAIN) { E(acc, cur, wr, wc, fr, fq); S.done(cur); }
        if (!has_next) break;
#pragma unroll
        for (int a = 0; a < 2; ++a)
#pragma unroll
            for (int b = 0; b < 2; ++b)
#pragma unroll
                for (int m = 0; m < 4; ++m)
#pragma unroll
                    for (int n = 0; n < 2; ++n) acc[a][b][m][n] = (f32x4){0.f, 0.f, 0.f, 0.f};
        cur = nxt; cA = nA; cB = nB; ++ui;
        if constexpr (ALIGN_EPI) { if (wr == 1) PG8_BAR; }
    }
    PG8_WAIT_V(0);
    if constexpr (!ALIGN_EPI) { if (wr == 0) PG8_BAR; }
    PG8_BAR;
    if constexpr (Epi::AFTER_DRAIN) { E.fused(acc, cur, wr, wc, fr, fq, lds, wid, lane); S.done(cur); }
#undef PG8_SA
#undef PG8_SB
#undef PG8_STAGE
#undef PG8_LDA
#undef PG8_LDB
#undef PG8_MMA
#undef PG8_WAIT_V
#undef PG8_WAIT_L
#undef PG8_BAR
#undef PG8_SCHED
}
}
#include <hip/hip_bf16.h>
#include <cmath>
namespace attn_body {
using bf16=__hip_bfloat16;
using bf16x8=__attribute__((ext_vector_type(8)))short;
using s16x4=__attribute__((ext_vector_type(4)))short;
using f32x16=__attribute__((ext_vector_type(16)))float;
using u32x4=__attribute__((ext_vector_type(4)))unsigned;
constexpr int D=64,QP=512,KP=512,VP=128,OP=1024;
constexpr int NW=8,QBLK=32,QB=QBLK*NW,KVBLK=64;
constexpr int ATTN_UNIT_ROWS=QB;
__device__ __forceinline__ int crow(int r,int hi){return (r&3)+8*(r>>2)+4*hi;}
#define SBAR() __builtin_amdgcn_sched_barrier(0)
__device__ __forceinline__ void cmask(f32x16&p0,f32x16&p1,int jb,int qrel,int hi){
  const float NEG=-INFINITY; int kb=64*jb+4*hi;
  #pragma unroll
  for(int r=0;r<16;++r){int kv=kb+(r&3)+8*(r>>2); if(kv>qrel)p0[r]=NEG; if(kv+32>qrel)p1[r]=NEG;}
}

constexpr int NSLOT=3, SLOTB=8192;
constexpr int LDS_K=0, LDS_V=NSLOT*SLOTB, LDS_WS=2*NSLOT*SLOTB, LDS_OST=LDS_WS+NW*64*4, LDS_BYTES=LDS_OST+NW*4096;
constexpr float C2=0.125f*1.4426950408889634f;
__device__ __forceinline__ void glds16(const void*gsrc,unsigned lds_dst){unsigned keep;
  asm volatile("s_mov_b32 %0, m0\n\ts_mov_b32 m0, %2\n\ts_nop 0\n\tglobal_load_lds_dwordx4 %1, off\n\ts_mov_b32 m0, %0":"=&s"(keep):"v"(gsrc),"s"(lds_dst):"memory");}
__device__ __forceinline__ float max3f(float a,float b,float c){float r;asm("v_max3_f32 %0, %1, %2, %3":"=v"(r):"v"(a),"v"(b),"v"(c));return r;}
__device__ __forceinline__ float max2f(float a,float b){float r;asm("v_max_f32_e32 %0, %1, %2":"=v"(r):"v"(a),"v"(b));return r;}
__device__ __forceinline__ float fadd_s(float a,float b){float r;asm("v_add_f32_e32 %0, %1, %2":"=v"(r):"v"(a),"v"(b));return r;}
__device__ __forceinline__ float fsub_s(float a,float b){float r;asm("v_sub_f32_e32 %0, %1, %2":"=v"(r):"v"(a),"v"(b));return r;}
typedef float f32x2_t __attribute__((ext_vector_type(2))); typedef __bf16 bf16x2_t __attribute__((ext_vector_type(2)));
__device__ __forceinline__ unsigned cvtpk_s(float lo,float hi){f32x2_t v={lo,hi};bf16x2_t b=__builtin_convertvector(v,bf16x2_t);return __builtin_bit_cast(unsigned,b);}
#define WAIT_BAR(N) asm volatile("s_waitcnt vmcnt(" #N ") lgkmcnt(0)\n\ts_barrier":::"memory")

__device__ __forceinline__ void qkt(f32x16&p0,f32x16&p1,const char*Kslot,const bf16x8*qr,const f32x16&negm,int r32,int hi){
  const char*kb=Kslot+hi*1024+r32*16;
  #pragma unroll
  for(int d0=0;d0<4;++d0){
    const bf16x8 b0=*reinterpret_cast<const bf16x8*>(kb+d0*2048);
    const bf16x8 b1=*reinterpret_cast<const bf16x8*>(kb+d0*2048+512);
    if(d0==0){p0=__builtin_amdgcn_mfma_f32_32x32x16_bf16(b0,qr[0],negm,0,0,0);p1=__builtin_amdgcn_mfma_f32_32x32x16_bf16(b1,qr[0],negm,0,0,0);}
    else{p0=__builtin_amdgcn_mfma_f32_32x32x16_bf16(b0,qr[d0],p0,0,0,0);p1=__builtin_amdgcn_mfma_f32_32x32x16_bf16(b1,qr[d0],p1,0,0,0);}}
}
typedef __attribute__((address_space(3))) const char* lds_cptr;
typedef short v4i16_t __attribute__((ext_vector_type(4)));
__device__ __forceinline__ void kload8(bf16x8*kf,lds_cptr kp){
  kf[0]=*(const __attribute__((address_space(3))) bf16x8*)(kp);      kf[1]=*(const __attribute__((address_space(3))) bf16x8*)(kp+512);
  kf[2]=*(const __attribute__((address_space(3))) bf16x8*)(kp+2048); kf[3]=*(const __attribute__((address_space(3))) bf16x8*)(kp+2560);
  kf[4]=*(const __attribute__((address_space(3))) bf16x8*)(kp+4096); kf[5]=*(const __attribute__((address_space(3))) bf16x8*)(kp+4608);
  kf[6]=*(const __attribute__((address_space(3))) bf16x8*)(kp+6144); kf[7]=*(const __attribute__((address_space(3))) bf16x8*)(kp+6656);
}
__device__ __forceinline__ void kload2(bf16x8*kf,lds_cptr kp,int j){ kf[2*j]=*(const __attribute__((address_space(3))) bf16x8*)(kp+j*2048); kf[2*j+1]=*(const __attribute__((address_space(3))) bf16x8*)(kp+j*2048+512); }
__device__ __forceinline__ s16x4 vtr(lds_cptr p){ return __builtin_bit_cast(s16x4,__builtin_amdgcn_ds_read_tr16_b64_v4i16((__attribute__((address_space(3))) v4i16_t*)p)); }
__device__ __forceinline__ float rowmax(const f32x16&p0,const f32x16&p1){
  float a=max3f(p0[0],p0[1],p1[0]),b=max3f(p0[2],p0[3],p1[1]);a=max3f(a,p1[2],p1[3]);
  #pragma unroll
  for(int r=4;r<16;r+=4){a=max3f(a,p0[r],p0[r+1]);b=max3f(b,p0[r+2],p0[r+3]);a=max3f(a,p1[r],p1[r+1]);b=max3f(b,p1[r+2],p1[r+3]);}
  const float m=max2f(a,b);
  auto rr=__builtin_amdgcn_permlane32_swap(__float_as_uint(m),__float_as_uint(m),false,false);
  return max2f(__uint_as_float(rr[0]),__uint_as_float(rr[1]));
}
__device__ __forceinline__ void pv(f32x16*o,int vb,bf16x8 pa0,bf16x8 pa1,bf16x8 pa2,bf16x8 pa3){
  #pragma unroll
  for(int d0=0;d0<2;++d0){s16x4 lo[4],hi[4];
    #pragma unroll
    for(int ks=0;ks<4;++ks){
      asm volatile("ds_read_b64_tr_b16 %0,%1 offset:%c2":"=&v"(lo[ks]):"v"(vb),"i"(d0*4096+ks*1024):"memory");
      asm volatile("ds_read_b64_tr_b16 %0,%1 offset:%c2":"=&v"(hi[ks]):"v"(vb),"i"(d0*4096+ks*1024+512):"memory");}
    asm volatile("s_waitcnt lgkmcnt(0)":::"memory");SBAR();
    #define PK(k) (bf16x8){lo[k][0],lo[k][1],lo[k][2],lo[k][3],hi[k][0],hi[k][1],hi[k][2],hi[k][3]}
    o[d0]=__builtin_amdgcn_mfma_f32_32x32x16_bf16(pa0,PK(0),o[d0],0,0,0);
    o[d0]=__builtin_amdgcn_mfma_f32_32x32x16_bf16(pa1,PK(1),o[d0],0,0,0);
    o[d0]=__builtin_amdgcn_mfma_f32_32x32x16_bf16(pa2,PK(2),o[d0],0,0,0);
    o[d0]=__builtin_amdgcn_mfma_f32_32x32x16_bf16(pa3,PK(3),o[d0],0,0,0);
    #undef PK
  }
}

#ifndef ATTN_STORE16
#define ATTN_STORE16(p,v) (*(u32x4*)(p)=(v))
#endif
template<int THRL> __device__ __forceinline__ void attn_unit(int rowbase_i,int S,int qb,int qcol,int kcol,int vcol,int ocol,const bf16*Q,const bf16*__restrict__ K,const bf16*__restrict__ V,bf16*O,char*shm){
  int tid_o=threadIdx.x; asm volatile("":"+v"(tid_o)); const int tid=tid_o,lane=tid&63,r32=lane&31,hi=lane>>5; const int wid=__builtin_amdgcn_readfirstlane(tid>>6);
  const long rowbase=(long)rowbase_i; const int q0=qb*QB;
  const bf16*Qw=Q+(rowbase+q0+wid*QBLK)*QP+qcol;
  const bf16*Kh=K+rowbase*KP+kcol,*Vh=V+rowbase*VP+vcol;
  const unsigned lds0=(unsigned)(uintptr_t)shm;
  float*wsf=(float*)(shm+LDS_WS)+wid*64;
  const bf16*ksrc=Kh+(long)lane*KP+wid*8;
  const bf16*vsrc=Vh+(long)(16*(wid&3)+(lane>>2))*VP+(wid>>2)*32+(lane&3)*8;
  const unsigned kdst=lds0+LDS_K+wid*1024, vdst=lds0+LDS_V+wid*1024;
  #define DMA_K(t,slot) glds16(ksrc+(long)(t)*KVBLK*KP,(unsigned)__builtin_amdgcn_readfirstlane(kdst+(slot)))
  #define DMA_V(t,slot) glds16(vsrc+(long)(t)*KVBLK*VP,(unsigned)__builtin_amdgcn_readfirstlane(vdst+(slot)))
  const int vb0=(int)(lds0+LDS_V)+((lane>>4)&1)*32+(lane&3)*8+(4*hi+((lane&15)>>2))*64;
  const char*Kbase=shm+LDS_K; bf16x8 kf[8];
  const lds_cptr shm3=(lds_cptr)shm; const lds_cptr kp0=shm3+LDS_K+hi*1024+r32*16; const lds_cptr vp0=shm3+LDS_V+((lane>>4)&1)*32+(lane&3)*8+(4*hi+((lane&15)>>2))*64;
  const int NT=S/KVBLK;
  DMA_K(0,0);DMA_V(0,0);DMA_K(1,SLOTB);
  bf16x8 qr[4];
  #pragma unroll
  for(int d0=0;d0<4;++d0)qr[d0]=*reinterpret_cast<const bf16x8*>(&Qw[(long)r32*QP+d0*16+hi*8]);
  float mhat=0.f,l_reg=0.f;f32x16 o[2];o[0]=f32x16{};o[1]=f32x16{};f32x16 negm=f32x16{};asm volatile("":"+v"(negm));
  const int qrel=wid*QBLK+r32;
  #define CMASK(P0,P1,t) do{}while(0)
  bool resc=false;
  #define START(P0,P1) do{ const float rm=rowmax(P0,P1); resc=false; \
    { const float dl=rm; mhat=fadd_s(mhat,dl); \
      _Pragma("unroll") for(int r=0;r<16;++r){P0[r]=fsub_s(P0[r],dl);P1[r]=fsub_s(P1[r],dl);} \
      _Pragma("unroll") for(int r=0;r<16;++r)negm[r]=-mhat; asm volatile("":"+v"(negm)); } \
    _Pragma("unroll") for(int r=0;r<16;++r)P0[r]=__builtin_amdgcn_exp2f(P0[r]); }while(0)
  #define RESC() do{ if(resc){ asm volatile("s_waitcnt lgkmcnt(0)":::"memory"); \
      _Pragma("unroll") for(int d_=0;d_<2;++d_) _Pragma("unroll") for(int r=0;r<16;++r)o[d_][r]*=wsf[crow(r,hi)]; } }while(0)
  f32x16 pA0,pA1,pB0,pB1;
  int sl_prev=0,sl_cur=0,sl_next=SLOTB;
  #define ROT() do{sl_prev=sl_cur;sl_cur=sl_next;sl_next=(sl_next==(NSLOT-1)*SLOTB)?0:sl_next+SLOTB;}while(0)
  DMA_K(2,2*SLOTB);
  WAIT_BAR(3);
  qkt(pA0,pA1,Kbase,qr,negm,r32,hi);asm volatile("s_nop 15\n\ts_nop 7":"+v"(pA0),"+v"(pA1));CMASK(pA0,pA1,0);
  START(pA0,pA1);
  _Pragma("unroll") for(int r=0;r<16;++r)pA1[r]=__builtin_amdgcn_exp2f(pA1[r]);
  WAIT_BAR(0);
  DMA_K(3,0);DMA_V(1,SLOTB);
  ROT();
  kload8(kf,kp0+sl_cur);
  WAIT_BAR(2);
  s16x4 vlo[8],vhi[8]; u32x4 pw0,pw1,pw2,pw3;
  #define PKW(P,B) cvtpk_s(P[B],P[B+1])
  #define PAF(k) __builtin_bit_cast(bf16x8,pw##k)
  #define VFR(i) (bf16x8){vlo[i][0],vlo[i][1],vlo[i][2],vlo[i][3],vhi[i][0],vhi[i][1],vhi[i][2],vhi[i][3]}
  #define PIN(x) asm volatile("":"+v"(x))
  #define MX3(a,b,c) __builtin_fmaxf(__builtin_fmaxf((a),(b)),(c))
  #define GAPA(MF,A0,A1,A2,A3,W0,W1,PW) do{ MF; sacc+=A0; sacc+=A1; sacc+=A2; sacc+=A3; PIN(sacc); W0; W1; PIN(PW); SBAR(); }while(0)
  #define EX(v) __builtin_amdgcn_exp2f(v)
  #define GAPB(MF,X,B) do{ MF; X[B]=EX(X[B]); X[B+1]=EX(X[B+1]); X[B+2]=EX(X[B+2]); X[B+3]=EX(X[B+3]); PIN(X); SBAR(); }while(0)
  #define VRD(i) do{ vlo[i]=vtr(vp_+(((i)>>2)*4096+((i)&3)*1024)); vhi[i]=vtr(vp_+(((i)>>2)*4096+((i)&3)*1024+512)); }while(0)
  #define KRD(G,j) do{ if(G){ kload2(kf,kp0+sl_next,j); SBAR(); } }while(0)
  #define STEP(C0,C1,P0,P1,t,GK,GV,GL) do{ SBAR(); \
    const lds_cptr vp_=vp0+sl_prev; \
    VRD(0); SBAR(); float sacc=(P0[0]+P0[1]); \
    GAPA(C0=__builtin_amdgcn_mfma_f32_32x32x16_bf16(kf[0],qr[0],negm,0,0,0), P0[2],P0[3],P0[4],P0[5],     pw0[0]=PKW(P0,0), pw0[1]=PKW(P0,2), pw0); \
    VRD(4); SBAR(); GAPA(C1=__builtin_amdgcn_mfma_f32_32x32x16_bf16(kf[1],qr[0],negm,0,0,0), P0[6],P0[7],P0[8],P0[9],     pw0[2]=PKW(P0,4), pw0[3]=PKW(P0,6), pw0); \
    VRD(1); SBAR(); GAPA(C0=__builtin_amdgcn_mfma_f32_32x32x16_bf16(kf[2],qr[1],C0,0,0,0),   P0[10],P0[11],P0[12],P0[13], pw1[0]=PKW(P0,8), pw1[1]=PKW(P0,10), pw1); \
    VRD(5); SBAR(); GAPA(C1=__builtin_amdgcn_mfma_f32_32x32x16_bf16(kf[3],qr[1],C1,0,0,0),   P0[14],P0[15],P1[0],P1[1],   pw1[2]=PKW(P0,12),pw1[3]=PKW(P0,14), pw1); \
    VRD(2); SBAR(); GAPA(C0=__builtin_amdgcn_mfma_f32_32x32x16_bf16(kf[4],qr[2],C0,0,0,0),   P1[2],P1[3],P1[4],P1[5],     pw2[0]=PKW(P1,0), pw2[1]=PKW(P1,2), pw2); \
    VRD(6); SBAR(); GAPA(C1=__builtin_amdgcn_mfma_f32_32x32x16_bf16(kf[5],qr[2],C1,0,0,0),   P1[6],P1[7],P1[8],P1[9],     pw2[2]=PKW(P1,4), pw2[3]=PKW(P1,6), pw2); \
    VRD(3); SBAR(); GAPA(C0=__builtin_amdgcn_mfma_f32_32x32x16_bf16(kf[6],qr[3],C0,0,0,0),   P1[10],P1[11],P1[12],P1[13], pw3[0]=PKW(P1,8), pw3[1]=PKW(P1,10), pw3); \
    VRD(7); SBAR(); GAPA(C1=__builtin_amdgcn_mfma_f32_32x32x16_bf16(kf[7],qr[3],C1,0,0,0),   P1[14],P1[15],0.f,0.f,       pw3[2]=PKW(P1,12),pw3[3]=PKW(P1,14), pw3); \
    l_reg+=sacc; \
    if(GK){DMA_K((t)+3,sl_cur);} if(GV){DMA_V((t)+1,sl_next);} \
    CMASK(C0,C1,t); \
    { float a=MX3(C0[0],C0[1],C1[0]),b=MX3(C0[2],C0[3],C1[1]); a=MX3(a,C1[2],C1[3]); \
      _Pragma("unroll") for(int r=4;r<16;r+=4){a=MX3(a,C0[r],C0[r+1]);b=MX3(b,C0[r+2],C0[r+3]);a=MX3(a,C1[r],C1[r+1]);b=MX3(b,C1[r+2],C1[r+3]);} \
      float rm=__builtin_fmaxf(a,b); { auto rr=__builtin_amdgcn_permlane32_swap(__float_as_uint(rm),__float_as_uint(rm),false,false); rm=__builtin_fmaxf(__uint_as_float(rr[0]),__uint_as_float(rr[1])); } \
      resc=false; \
      if(__builtin_expect(__any(rm>(float)THRL),0)){ const float dl=__builtin_fmaxf(rm,0.f); mhat+=dl; \
        _Pragma("unroll") for(int r=0;r<16;++r){C0[r]-=dl;C1[r]-=dl;} \
        _Pragma("unroll") for(int r=0;r<16;++r)negm[r]=-mhat; asm volatile("":"+v"(negm)); \
        const float f=__builtin_amdgcn_exp2f(-dl); l_reg*=f; if(hi==0)wsf[r32]=f; resc=true; } } \
    SBAR(); \
    GAPB(o[0]=__builtin_amdgcn_mfma_f32_32x32x16_bf16(PAF(0),VFR(0),o[0],0,0,0), C0,0); \
    GAPB(o[1]=__builtin_amdgcn_mfma_f32_32x32x16_bf16(PAF(0),VFR(4),o[1],0,0,0), C0,4); \
    KRD(GL,0); GAPB(o[0]=__builtin_amdgcn_mfma_f32_32x32x16_bf16(PAF(1),VFR(1),o[0],0,0,0), C0,8); \
    KRD(GL,1); GAPB(o[1]=__builtin_amdgcn_mfma_f32_32x32x16_bf16(PAF(1),VFR(5),o[1],0,0,0), C0,12); \
    KRD(GL,2); GAPB(o[0]=__builtin_amdgcn_mfma_f32_32x32x16_bf16(PAF(2),VFR(2),o[0],0,0,0), C1,0); \
    KRD(GL,3); GAPB(o[1]=__builtin_amdgcn_mfma_f32_32x32x16_bf16(PAF(2),VFR(6),o[1],0,0,0), C1,4); \
    GAPB(o[0]=__builtin_amdgcn_mfma_f32_32x32x16_bf16(PAF(3),VFR(3),o[0],0,0,0), C1,8); \
    GAPB(o[1]=__builtin_amdgcn_mfma_f32_32x32x16_bf16(PAF(3),VFR(7),o[1],0,0,0), C1,12); \
    }while(0)
  int t=1;
  #undef CMASK
  #define CMASK(P0,P1,t) do{}while(0)
  for(;t+5<NT;t+=2){
    STEP(pB0,pB1,pA0,pA1,t,true,true,true);     WAIT_BAR(2); RESC(); ROT();
    STEP(pA0,pA1,pB0,pB1,t+1,true,true,true);   WAIT_BAR(2); RESC(); ROT();
  }
  #undef CMASK
  #define CMASK(P0,P1,t) do{}while(0)
  #define ENDW(tt) do{ if((tt)+3<NT){WAIT_BAR(2);} else if((tt)+2<NT){WAIT_BAR(1);} else {WAIT_BAR(0);} }while(0)
  for(;t+1<NT;t+=2){
    STEP(pB0,pB1,pA0,pA1,t,(t+3<NT),(t+1<NT),(t+1<NT));       ENDW(t);   RESC(); ROT();
    STEP(pA0,pA1,pB0,pB1,t+1,(t+4<NT),(t+2<NT),(t+2<NT));     ENDW(t+1); RESC(); ROT();
  }
  STEP(pB0,pB1,pA0,pA1,NT-1,false,false,false); RESC();
  { float sacc=pB0[0]+pB0[1]; _Pragma("unroll") for(int r=2;r<16;++r)sacc+=pB0[r]; _Pragma("unroll") for(int r=0;r<16;++r)sacc+=pB1[r]; l_reg+=sacc;
    pw0=(u32x4){PKW(pB0,0),PKW(pB0,2),PKW(pB0,4),PKW(pB0,6)};pw1=(u32x4){PKW(pB0,8),PKW(pB0,10),PKW(pB0,12),PKW(pB0,14)};pw2=(u32x4){PKW(pB1,0),PKW(pB1,2),PKW(pB1,4),PKW(pB1,6)};pw3=(u32x4){PKW(pB1,8),PKW(pB1,10),PKW(pB1,12),PKW(pB1,14)};
    SBAR(); pv(o,vb0+sl_cur,PAF(0),PAF(1),PAF(2),PAF(3)); }
  #undef PKW
  #undef PAF
  #undef VFR
  #undef PIN
  #undef MX3
  #undef GAPA
  #undef GAPB
  #undef EX
  #undef VRD
  #undef KRD
  #undef STEP
  #undef ENDW
  {auto rr=__builtin_amdgcn_permlane32_swap(__float_as_uint(l_reg),__float_as_uint(l_reg),false,false);l_reg=__uint_as_float(rr[0])+__uint_as_float(rr[1]);}
  if(hi==0)wsf[32+r32]=l_reg;asm volatile("s_waitcnt lgkmcnt(0)":::"memory");
  float rli[16];
  #pragma unroll
  for(int r=0;r<16;++r)rli[r]=__builtin_amdgcn_rcpf(wsf[32+crow(r,hi)]);
  bf16*Ow=O+(rowbase+q0+wid*QBLK)*OP+ocol;
  { bf16*stg=(bf16*)(shm+LDS_OST)+wid*2048;
    #pragma unroll
    for(int r=0;r<16;++r){const int orow=crow(r,hi);
      #pragma unroll
      for(int d0=0;d0<2;++d0)stg[orow*64+d0*32+r32]=__float2bfloat16(o[d0][r]*rli[r]);}
    asm volatile("s_waitcnt lgkmcnt(0)":::"memory");
    #pragma unroll
    for(int i=0;i<4;++i){const int row=i*8+(lane>>3),ch=lane&7; const u32x4 v=*(const u32x4*)(stg+row*64+ch*8); ATTN_STORE16(Ow+(long)row*OP+ch*8,v);} }
  asm volatile("s_waitcnt lgkmcnt(0)\n\ts_barrier":::"memory");
  #undef DMA_K
  #undef DMA_V
  #undef CMASK
  #undef START
  #undef RESC
  #undef ROT
}
constexpr int ATTN_LDS_BYTES=LDS_BYTES;
#undef SBAR
#undef WAIT_BAR
}

#define LAS __attribute__((address_space(3)))
#define LDS_BARRIER() asm volatile("s_waitcnt lgkmcnt(0)\n\ts_barrier" ::: "memory")
typedef unsigned short bf16;
typedef unsigned u32x4_t __attribute__((ext_vector_type(4)));
typedef unsigned u32x2_t __attribute__((ext_vector_type(2)));
typedef float f32x4_t __attribute__((ext_vector_type(4)));
typedef float f32x2_t __attribute__((ext_vector_type(2)));

constexpr int DM = 1024, MTOK = 49152, NSEQ = 20, DFF = 2816, NFF = 5632, NMIXP = 2560, NMIX = 2432, ZP = 1792;
constexpr int NTHR = 512;
constexpr float QSCALE = 0.125f * 1.4426950408889634f;
constexpr size_t MiB = 1u << 20;
constexpr size_t ZERO_BYTES = 8 * MiB;
constexpr size_t OFF_CTR = 0, OFF_ROPE = 32768, OFF_SS = 65536, OFF_MOD = 2 * MiB, OFF_BIAS = 4 * MiB, OFF_GV = 7 * MiB, OFF_GATE = 7 * MiB + 512 * 1024;
constexpr size_t OFF_W = 8 * MiB, W_LAYER = 40 * MiB;
constexpr size_t WO_IN = 0, WO_OUT = 22 * MiB, WO_MI = 33 * MiB, WO_MO = 38 * MiB;
constexpr size_t OFF_XN = 88 * MiB, OFF_YF = 88 * MiB, OFF_YB = 136 * MiB;
constexpr size_t OFF_HID = 184 * MiB, OFF_Z = 184 * MiB, OFF_QK = 352 * MiB, OFF_VR = 400 * MiB, OFF_OMIX = 412 * MiB, WS_END = 508 * MiB;
constexpr size_t OFF_SMID = 508 * MiB;
constexpr int LDS_BYTES = 147456, MISC_OFF = 131072;

struct KP { const float* in[31]; float* out; unsigned char* ws; };

__device__ __forceinline__ int seq_of_row(int m) { return m < 16384 ? (m >> 12) : 4 + ((m - 16384) >> 11); }
__device__ __forceinline__ int seq_start(int s) { return s < 4 ? s * 4096 : 16384 + (s - 4) * 2048; }
__device__ __forceinline__ int seq_len(int s) { return s < 4 ? 4096 : 2048; }
__device__ __forceinline__ unsigned f2bf(float f) { unsigned u = __builtin_bit_cast(unsigned, f); return (u + 0x7fffu + ((u >> 16) & 1u)) >> 16; }
__device__ __forceinline__ unsigned pk2(float lo, float hi) { return f2bf(lo) | (f2bf(hi) << 16); }
__device__ __forceinline__ float bf2f(unsigned short b) { return __builtin_bit_cast(float, (unsigned)b << 16); }
__device__ __forceinline__ float sigmoidf_(float x) { return __builtin_amdgcn_rcpf(1.0f + __builtin_amdgcn_exp2f(-1.4426950408889634f * x)); }
#define DPP_ADD(v, CTRL) ((v) + __builtin_bit_cast(float, __builtin_amdgcn_update_dpp(0, __builtin_bit_cast(int, (v)), (CTRL), 0xf, 0xf, false)))
__device__ __forceinline__ float wave_sum(float v) {
    v = DPP_ADD(v, 0xB1);
    v = DPP_ADD(v, 0x4E);
    v = DPP_ADD(v, 0x141);
    v = DPP_ADD(v, 0x140);
    const f32x4_t d = __builtin_amdgcn_mfma_f32_16x16x4f32(1.0f, v, (f32x4_t){0.f, 0.f, 0.f, 0.f}, 0, 0, 0);
    return d[0];
}
__device__ __forceinline__ float tanh_fast(float x) { const float e = __expf(2.0f * x); return 1.0f - 2.0f * __builtin_amdgcn_rcpf(e + 1.0f); }
__host__ __device__ __forceinline__ int map_ffn(int n) { const int half = n >= DFF ? 1 : 0; const int n2 = half ? n - DFF : n; return 256 * (n2 >> 7) + 128 * half + (n2 & 127); }
__host__ __device__ __forceinline__ int map_mix(int n) {
    if (n < 1792 || n >= 2304) return n;
    const int hh = (n - 1792) >> 6, d = (n - 1792) & 63;
    return 256 * (7 + (hh >> 2)) + 128 * (d >> 5) + 32 * (hh & 3) + 8 * ((d & 15) >> 2) + 4 * ((d >> 4) & 1) + (d & 3);
}

namespace pg8 {
struct EpiSwiglu {
    static constexpr bool PERM = true, AFTER_DRAIN = false;
    bf16_t* H; const float* ss; const float* bias;
    __device__ __forceinline__ void operator()(const f32x4 (&acc)[2][2][4][2], const Unit& u, int wr, int wc, int fr, int fq) const {
        const int row0 = u.pm * BM + wr * 64 + fr; const int s = seq_of_row(u.pm * BM);
        const float* bp = bias + (size_t)s * NFF + u.pn * 256 + wc * 32 + 8 * fq;
        f32x4 bg[2], bu[2];
#pragma unroll
        for (int n = 0; n < 2; ++n) { bg[n] = *(const f32x4*)(bp + 4 * n); bu[n] = *(const f32x4*)(bp + 128 + 4 * n); }
#pragma unroll
        for (int ai = 0; ai < 2; ++ai)
#pragma unroll
            for (int m = 0; m < 4; ++m) {
                const int row = row0 + ai * HALF + m * 16;
                const float rs = rsqrtf(ss[row] * (1.0f / 1024.0f) + 1e-6f);
                float h[8];
#pragma unroll
                for (int n = 0; n < 2; ++n) {
                    const f32x4 g = acc[ai][0][m][n] * rs + bg[n], up = acc[ai][1][m][n] * rs + bu[n];
#pragma unroll
                    for (int i = 0; i < 4; ++i) h[4 * n + i] = g[i] * sigmoidf_(g[i]) * up[i];
                }
                u32x4 w; w.x = cvt_pk_bf16(h[0], h[1]); w.y = cvt_pk_bf16(h[2], h[3]); w.z = cvt_pk_bf16(h[4], h[5]); w.w = cvt_pk_bf16(h[6], h[7]);
                *(u32x4*)(H + (size_t)row * DFF + u.pn * 128 + wc * 32 + 8 * fq) = w;
            }
    }
};
struct EpiZ {
    static constexpr bool PERM = true, AFTER_DRAIN = false;
    bf16_t* Z; bf16_t* QK; bf16_t* VR; const float* ss; const float* bias; const float* qg; const float* kg; const float* rope;
    __device__ __forceinline__ void operator()(const f32x4 (&acc)[2][2][4][2], const Unit& u, int wr, int wc, int fr, int fq) const {
        const int row0 = u.pm * BM + wr * 64 + fr; const int s = seq_of_row(u.pm * BM); const int t0 = row0 - seq_start(s);
        const float* bp = bias + (size_t)s * NFF + u.pn * 256 + wc * 32 + 8 * fq;
        f32x4 bv[2][2];
#pragma unroll
        for (int bj = 0; bj < 2; ++bj)
#pragma unroll
            for (int n = 0; n < 2; ++n) bv[bj][n] = *(const f32x4*)(bp + bj * 128 + 4 * n);
        if (u.pn < 7 || u.pn == 9) {
#pragma unroll
            for (int ai = 0; ai < 2; ++ai)
#pragma unroll
                for (int m = 0; m < 4; ++m) {
                    const int row = row0 + ai * HALF + m * 16;
                    const float rs = rsqrtf(ss[row] * (1.0f / 1024.0f) + 1e-6f);
#pragma unroll
                    for (int bj = 0; bj < 2; ++bj) {
                        const f32x4 v0 = acc[ai][bj][m][0] * rs + bv[bj][0], v1 = acc[ai][bj][m][1] * rs + bv[bj][1];
                        u32x4 w; w.x = cvt_pk_bf16(v0[0], v0[1]); w.y = cvt_pk_bf16(v0[2], v0[3]); w.z = cvt_pk_bf16(v1[0], v1[1]); w.w = cvt_pk_bf16(v1[2], v1[3]);
                        if (u.pn < 7) *(u32x4*)(Z + (size_t)row * ZP + u.pn * 256 + bj * 128 + wc * 32 + 8 * fq) = w;
                        else if (bj == 0) *(u32x4*)(VR + (size_t)row * 128 + wc * 32 + 8 * fq) = w;
                    }
                }
        } else {
            const int hh = (u.pn - 7) * 4 + wc; const bool isq = hh < 6; const float* gp = isq ? qg : kg; const float osc = isq ? QSCALE : 1.0f;
            f32x4 gn[2][2];
#pragma unroll
            for (int bj = 0; bj < 2; ++bj)
#pragma unroll
                for (int n = 0; n < 2; ++n) gn[bj][n] = *(const f32x4*)(gp + 32 * bj + 16 * n + 4 * fq);
#pragma unroll
            for (int ai = 0; ai < 2; ++ai)
#pragma unroll
                for (int m = 0; m < 4; ++m) {
                    const int row = row0 + ai * HALF + m * 16; const int t = t0 + ai * HALF + m * 16;
                    const float rs = rsqrtf(ss[row] * (1.0f / 1024.0f) + 1e-6f);
                    f32x4 v[2][2]; float q = 0.f;
#pragma unroll
                    for (int bj = 0; bj < 2; ++bj)
#pragma unroll
                        for (int n = 0; n < 2; ++n) { v[bj][n] = acc[ai][bj][m][n] * rs + bv[bj][n]; q += (v[bj][n][0] * v[bj][n][0] + v[bj][n][1] * v[bj][n][1]) + (v[bj][n][2] * v[bj][n][2] + v[bj][n][3] * v[bj][n][3]); }
                    q += __shfl_xor(q, 16); q += __shfl_xor(q, 32);
                    const float r = rsqrtf(q * (1.0f / 64.0f) + 1e-6f);
#pragma unroll
                    for (int bj = 0; bj < 2; ++bj) {
                        const int pos = bj == 0 ? (t >> 6) : (t & 63);
                        const f32x4 x1 = v[bj][0] * r * gn[bj][0], x2 = v[bj][1] * r * gn[bj][1];
                        const float* rp = rope + (pos * 16 + 4 * fq) * 2;
                        const f32x4 cs0 = *(const f32x4*)(rp), cs1 = *(const f32x4*)(rp + 4);
                        const float c[4] = {cs0[0], cs0[2], cs1[0], cs1[2]}, sn[4] = {cs0[1], cs0[3], cs1[1], cs1[3]};
                        float o1[4], o2[4];
#pragma unroll
                        for (int i = 0; i < 4; ++i) { o1[i] = (x1[i] * c[i] - x2[i] * sn[i]) * osc; o2[i] = (x2[i] * c[i] + x1[i] * sn[i]) * osc; }
                        u32x4 w; w.x = cvt_pk_bf16(o1[0], o1[1]); w.y = cvt_pk_bf16(o1[2], o1[3]); w.z = cvt_pk_bf16(o2[0], o2[1]); w.w = cvt_pk_bf16(o2[2], o2[3]);
                        *(u32x4*)(QK + (size_t)row * 512 + hh * 64 + 32 * bj + 8 * fq) = w;
                    }
                }
        }
    }
};
struct EpiResid {
    static constexpr bool PERM = false, AFTER_DRAIN = false;
    const float* xin_p; const float* xin_s; float* out; bf16_t* xn; float* ssn; const float* gate; const float* gvn;
    __device__ __forceinline__ void operator()(const f32x4 (&acc)[2][2][4][2], const Unit& u, int wr, int wc, int fr, int fq) const {
        const int rowt = u.pm * BM; const int s = seq_of_row(rowt);
        const float* xb = rowt < 16384 ? xin_p : xin_s - (size_t)16384 * DM;
        const int row0 = rowt + wr * 64 + fr; const int col0 = u.pn * BM + wc * 32 + 4 * fq;
        f32x4 gt[2][2];
#pragma unroll
        for (int bj = 0; bj < 2; ++bj)
#pragma unroll
            for (int n = 0; n < 2; ++n) gt[bj][n] = *(const f32x4*)(gate + (size_t)s * DM + col0 + bj * HALF + n * 16);
#pragma unroll
        for (int ai = 0; ai < 2; ++ai)
#pragma unroll
            for (int m = 0; m < 4; ++m) {
                const int row = row0 + ai * HALF + m * 16; const size_t off = (size_t)row * DM + col0; float q = 0.f;
#pragma unroll
                for (int bj = 0; bj < 2; ++bj)
#pragma unroll
                    for (int n = 0; n < 2; ++n) {
                        const f32x4 xo = *(const f32x4*)(xb + off + bj * HALF + n * 16);
                        const f32x4 val = xo + gt[bj][n] * acc[ai][bj][m][n];
                        *(f32x4*)(out + off + bj * HALF + n * 16) = val;
                        if (gvn) {
                            q += (val[0] * val[0] + val[1] * val[1]) + (val[2] * val[2] + val[3] * val[3]);
                            const f32x4 gv = *(const f32x4*)(gvn + (size_t)s * DM + col0 + bj * HALF + n * 16);
                            const f32x4 o = val * gv; unsigned long long w = (unsigned long long)cvt_pk_bf16(o[0], o[1]) | ((unsigned long long)cvt_pk_bf16(o[2], o[3]) << 32);
                            *(unsigned long long*)(xn + off + bj * HALF + n * 16) = w;
                        }
                    }
                if (gvn) { q += __shfl_xor(q, 16); q += __shfl_xor(q, 32); if (fq == 0) atomicAdd(ssn + row, q); }
            }
    }
};
}

template <int MAP> __device__ __forceinline__ void transpose_item(const float* W, int K, int N, bf16* WT, float* scr, int item, int lane) {
    const int nblk = N / 32, kb = item / nblk, nb = item % nblk, k0 = 64 * kb, n0 = 32 * nb;
#pragma unroll 8
    for (int i = 0; i < 32; ++i) { const int kk = 2 * i + (lane >> 5); scr[kk * 33 + (lane & 31)] = W[(size_t)(k0 + kk) * N + n0 + (lane & 31)]; }
    __builtin_amdgcn_wave_barrier(); asm volatile("s_waitcnt lgkmcnt(0)" ::: "memory");
    const int c = lane & 7;
#pragma unroll
    for (int j = 0; j < 4; ++j) { const int n = (lane >> 3) + 8 * j; const float* sp = scr + (8 * c) * 33 + n;
        u32x4_t o; o.x = pk2(sp[0 * 33], sp[1 * 33]); o.y = pk2(sp[2 * 33], sp[3 * 33]); o.z = pk2(sp[4 * 33], sp[5 * 33]); o.w = pk2(sp[6 * 33], sp[7 * 33]);
        const int nsrc = n0 + n; const int nd = MAP == 1 ? map_ffn(nsrc) : (MAP == 2 ? map_mix(nsrc) : nsrc);
        *(u32x4_t*)(WT + (size_t)nd * K + k0 + 8 * c) = o; }
    __builtin_amdgcn_wave_barrier(); asm volatile("s_waitcnt lgkmcnt(0)" ::: "memory");
}

template <int MODE, int MAP> __device__ __forceinline__ void smallm_unit(const KP& p, float* sA, int l, int j, const float* W, int ldw, int nvalid, float* dest, int ldd, int nchunk, int kchunk) {
    int tid_o = threadIdx.x; asm volatile("" : "+v"(tid_o)); const int tid = tid_o; const int k0 = kchunk * 128;
    __syncthreads();
    for (int e = tid; e < 128 * NSEQ; e += NTHR) {
        const int k = e / NSEQ, s = e % NSEQ; float v;
        if (MODE == 0) { const float c = s < 4 ? p.in[2][s * DM + k0 + k] : p.in[3][(s - 4) * DM + k0 + k]; v = c * sigmoidf_(c); }
        else { const float* mod = (const float*)(p.ws + OFF_MOD) + ((size_t)l * NSEQ + s) * 9216 + 3 * j * 1024 + k0 + k; v = *mod + p.in[5][l * 9216 + 3 * j * 1024 + k0 + k]; }
        sA[k * NSEQ + s] = v;
    }
    __syncthreads();
    const int n = nchunk * 256 + (tid & 255), kh = tid >> 8;
    float acc[NSEQ];
#pragma unroll
    for (int s = 0; s < NSEQ; ++s) acc[s] = 0.f;
    if (n < nvalid) {
        for (int kb = 0; kb < 64; kb += 16) {
            float wv[16];
#pragma unroll
            for (int u = 0; u < 16; ++u) wv[u] = W[(size_t)(k0 + kh * 64 + kb + u) * ldw + n];
#pragma unroll
            for (int u = 0; u < 16; ++u) { const int k = kh * 64 + kb + u; const float w = wv[u];
                const f32x4_t* ap = (const f32x4_t*)(sA + k * NSEQ);
#pragma unroll
                for (int q = 0; q < 5; ++q) { const f32x4_t a = ap[q]; acc[4 * q] += a[0] * w; acc[4 * q + 1] += a[1] * w; acc[4 * q + 2] += a[2] * w; acc[4 * q + 3] += a[3] * w; } }
        }
        const int nd = MAP == 1 ? map_ffn(n) : (MAP == 2 ? map_mix(n) : n);
#pragma unroll
        for (int s = 0; s < NSEQ; ++s) atomicAdd(dest + (size_t)s * ldd + nd, acc[s]);
    }
}

#define DPP_FMAC(acc, x, s, J) asm volatile("v_fmac_f32_dpp %0, %1, %2 row_newbcast:" #J " row_mask:0xf bank_mask:0xf" : "+v"(acc) : "v"(x), "v"(s))
#define DPP_FMAC_N(acc, x, s, J) asm volatile("s_nop 1\n\tv_fmac_f32_dpp %0, %1, %2 row_newbcast:" #J " row_mask:0xf bank_mask:0xf" : "+v"(acc) : "v"(x), "v"(s))
#define DPP_MUL(s, x, J) asm volatile("v_mul_f32_dpp %0, %1, %0 row_newbcast:" #J " row_mask:0xf bank_mask:0xf" : "+v"(s) : "v"(x))
#define DPP_MUL_N(s, x, J) asm volatile("s_nop 1\n\tv_mul_f32_dpp %0, %1, %0 row_newbcast:" #J " row_mask:0xf bank_mask:0xf" : "+v"(s) : "v"(x))
#define REP15(M, X) M(1, X) M(2, X) M(3, X) M(4, X) M(5, X) M(6, X) M(7, X) M(8, X) M(9, X) M(10, X) M(11, X) M(12, X) M(13, X) M(14, X) M(15, X)
__device__ __forceinline__ float row4_sum(float x) {
    auto r1 = __builtin_amdgcn_permlane16_swap(__float_as_uint(x), __float_as_uint(x), false, false); x = __uint_as_float(r1[0]) + __uint_as_float(r1[1]);
    auto r2 = __builtin_amdgcn_permlane32_swap(__float_as_uint(x), __float_as_uint(x), false, false); return __uint_as_float(r2[0]) + __uint_as_float(r2[1]);
}
__device__ __forceinline__ void rwkv_unit(const KP& p, unsigned char* lds, int l, int s, int h, int d, int mode) {
    int tid_o = threadIdx.x; asm volatile("" : "+v"(tid_o)); const int tid = tid_o, lane = tid & 63; const int wid = __builtin_amdgcn_readfirstlane(tid >> 6);
    constexpr int TB = 16;
    f32x2_t* W2 = (f32x2_t*)lds;
    float* OPS = (float*)(lds + 32768);
    float* YBUF = (float*)(lds + 32768 + 49152);
    float* PWS = (float*)(lds + 32768 + 49152 + 8192) + (wid & 3) * 1024;
    const bf16* Z = (const bf16*)(p.ws + OFF_Z);
    float* Y = (float*)(p.ws + (d == 0 ? OFF_YF : OFF_YB));
    const float* mu = p.in[18] + l * 1024;
    const float* w_up = p.in[19] + ((size_t)l * 2 + d) * 64 * 256;
    const float* a_up = p.in[21] + (size_t)l * 64 * 256;
    const int S = seq_len(s), start = seq_start(s); const int NS = mode == 0 ? S : S / 2, s0 = mode >= 2 ? S / 2 : 0; const int NB = NS / TB;
    __syncthreads();
    for (int e = tid; e < 4096; e += NTHR) { const int i = e >> 6, j = e & 63; W2[e] = (f32x2_t){w_up[i * 256 + 64 * h + j], a_up[i * 256 + 64 * h + j]}; }
    __syncthreads();
    if (wid >= 4) {
        const int pw = wid - 4;
        unsigned short* XWb = (unsigned short*)PWS; unsigned short* XAb = XWb + 256; float* KK = PWS + 256; float* UA = PWS + 512;
        typedef short bf16x8_t __attribute__((ext_vector_type(8)));
        bf16x8_t Bf[2][4][2];
        { const int kg = lane >> 4, cl = 64 * h + (lane & 15);
          _Pragma("unroll") for (int m = 0; m < 2; ++m) _Pragma("unroll") for (int ct = 0; ct < 4; ++ct) _Pragma("unroll") for (int ks = 0; ks < 2; ++ks) {
              const float* Wm = (m == 0 ? w_up : a_up) + (size_t)(32 * ks + 8 * kg) * 256 + cl + 16 * ct; u32x4_t pq;
              pq.x = pk2(Wm[0], Wm[256]); pq.y = pk2(Wm[512], Wm[768]); pq.z = pk2(Wm[1024], Wm[1280]); pq.w = pk2(Wm[1536], Wm[1792]); Bf[m][ct][ks] = __builtin_bit_cast(bf16x8_t, pq); } }
        const float w0 = p.in[20][(l * 2 + d) * 256 + 64 * h + lane], a0 = p.in[22][(l * 2 + d) * 256 + 64 * h + lane];
        const float k_k = p.in[24][l * 256 + 64 * h + lane], k_a = p.in[25][l * 256 + 64 * h + lane];
        int it_t[3], it_zc[3], it_g[3], it_w[3]; f32x4_t mu0[3], mu1[3];
#pragma unroll
        for (int i = 0; i < 3; ++i) { int e = lane + 64 * i; if (e > 159) e = 159; const int t = e / 40, c = e % 40, g = c >> 3, wi = (c & 7) * 8;
            it_t[i] = t; it_g[i] = g; it_w[i] = wi; it_zc[i] = (g == 0 ? 64 * h : g == 1 ? 256 + 64 * h : g == 2 ? 512 + 64 * h : 768 + (g - 3) * 64) + wi;
            mu0[i] = *(const f32x4_t*)(mu + it_zc[i]); mu1[i] = *(const f32x4_t*)(mu + it_zc[i] + 4); }
        u32x4_t rc[3], rp[3], rn[3];
#define RW_ISSUE(b_) do { _Pragma("unroll") for (int i = 0; i < 3; ++i) { const int si = s0 + (b_) * TB + 4 * pw + it_t[i]; const int tt = d == 0 ? si : S - 1 - si; const bf16* zp = Z + (size_t)(start + tt) * ZP + 768 + it_zc[i]; \
                rc[i] = *(const u32x4_t*)zp; rp[i] = tt > 0 ? *(const u32x4_t*)(zp - ZP) : (u32x4_t){0u, 0u, 0u, 0u}; rn[i] = tt < S - 1 ? *(const u32x4_t*)(zp + ZP) : (u32x4_t){0u, 0u, 0u, 0u}; } } while (0)
#define RW_PREP(b_) do { \
            float* ops = OPS + ((b_) & 1) * (TB * 384); \
            _Pragma("unroll") for (int i = 0; i < 3; ++i) if (lane + 64 * i < 160) { \
                float fs[8]; \
                _Pragma("unroll") for (int q = 0; q < 4; ++q) { \
                    const float c0 = __builtin_bit_cast(float, rc[i][q] << 16), c1 = __builtin_bit_cast(float, rc[i][q] & 0xffff0000u); \
                    const float p0 = __builtin_bit_cast(float, rp[i][q] << 16), p1 = __builtin_bit_cast(float, rp[i][q] & 0xffff0000u); \
                    const float n0 = __builtin_bit_cast(float, rn[i][q] << 16), n1 = __builtin_bit_cast(float, rn[i][q] & 0xffff0000u); \
                    const float m0 = q < 2 ? mu0[i][2 * q] : mu1[i][2 * q - 4], m1 = q < 2 ? mu0[i][2 * q + 1] : mu1[i][2 * q - 3]; \
                    fs[2 * q] = c0 + m0 * (0.5f * (p0 + n0) - c0); fs[2 * q + 1] = c1 + m1 * (0.5f * (p1 + n1) - c1); \
                } \
                const int t = it_t[i], tl = 4 * pw + t, g = it_g[i], wi = it_w[i]; \
                if (g == 0) { *(f32x4_t*)(ops + tl * 384 + 256 + wi) = (f32x4_t){fs[0], fs[1], fs[2], fs[3]}; *(f32x4_t*)(ops + tl * 384 + 256 + wi + 4) = (f32x4_t){fs[4], fs[5], fs[6], fs[7]}; } \
                else if (g == 2) { if (mode == 3) { _Pragma("unroll") for (int q = 0; q < 8; ++q) fs[q] = 0.f; } *(f32x4_t*)(ops + tl * 384 + 320 + wi) = (f32x4_t){fs[0], fs[1], fs[2], fs[3]}; *(f32x4_t*)(ops + tl * 384 + 320 + wi + 4) = (f32x4_t){fs[4], fs[5], fs[6], fs[7]}; } \
                else if (g == 1) { *(f32x4_t*)(KK + t * 64 + wi) = (f32x4_t){fs[0], fs[1], fs[2], fs[3]}; *(f32x4_t*)(KK + t * 64 + wi + 4) = (f32x4_t){fs[4], fs[5], fs[6], fs[7]}; } \
                else if (g == 3) { u32x4_t pq; pq.x = pk2(tanh_fast(fs[0]), tanh_fast(fs[1])); pq.y = pk2(tanh_fast(fs[2]), tanh_fast(fs[3])); pq.z = pk2(tanh_fast(fs[4]), tanh_fast(fs[5])); pq.w = pk2(tanh_fast(fs[6]), tanh_fast(fs[7])); *(u32x4_t*)(XWb + t * 64 + wi) = pq; } \
                else { u32x4_t pq; pq.x = pk2(fs[0], fs[1]); pq.y = pk2(fs[2], fs[3]); pq.z = pk2(fs[4], fs[5]); pq.w = pk2(fs[6], fs[7]); *(u32x4_t*)(XAb + t * 64 + wi) = pq; } \
            } \
            if ((b_) + 1 < NB) RW_ISSUE((b_) + 1); \
            { const int arow = lane & 15, akg = lane >> 4; \
              _Pragma("unroll") for (int m = 0; m < 2; ++m) { \
                bf16x8_t Af[2]; \
                _Pragma("unroll") for (int ks = 0; ks < 2; ++ks) { u32x4_t raw = *(const u32x4_t*)((m ? XAb : XWb) + (arow & 3) * 64 + 32 * ks + 8 * akg); if (arow >= 4) raw = (u32x4_t){0u, 0u, 0u, 0u}; Af[ks] = __builtin_bit_cast(bf16x8_t, raw); } \
                _Pragma("unroll") for (int ct = 0; ct < 4; ++ct) { f32x4_t am = (f32x4_t){0.f, 0.f, 0.f, 0.f}; \
                    am = __builtin_amdgcn_mfma_f32_16x16x32_bf16(Af[0], Bf[m][ct][0], am, 0, 0, 0); am = __builtin_amdgcn_mfma_f32_16x16x32_bf16(Af[1], Bf[m][ct][1], am, 0, 0, 0); \
                    if (lane < 16) { UA[(m * 4 + 0) * 64 + 16 * ct + lane] = am[0]; UA[(m * 4 + 1) * 64 + 16 * ct + lane] = am[1]; UA[(m * 4 + 2) * 64 + 16 * ct + lane] = am[2]; UA[(m * 4 + 3) * 64 + 16 * ct + lane] = am[3]; } } } } \
            _Pragma("unroll") for (int t = 0; t < 4; ++t) { \
                const int tl = 4 * pw + t; const float k = KK[t * 64 + lane]; const float kkv = k * k_k; \
                const float n2 = wave_sum(kkv * kkv); const float kk = kkv * __builtin_amdgcn_rsqf(fmaxf(n2, 1e-24f)); \
                const float wdec = __expf(-0.6065306597126334f * sigmoidf_(w0 + UA[t * 64 + lane])); const float a = sigmoidf_(a0 + UA[(4 + t) * 64 + lane]); \
                float* o = ops + tl * 384 + lane; o[0] = -kk; o[64] = wdec; o[128] = kk * a; o[192] = k * (1.0f + (a - 1.0f) * k_a); \
            } } while (0)
#define RW_YFLUSH(b_) do { const float* ybp = YBUF + ((b_) & 1) * (TB * 64); \
            _Pragma("unroll") for (int t = 0; t < 4; ++t) { const int si = s0 + (b_) * TB + 4 * pw + t; const int tt = d == 0 ? si : S - 1 - si; float* yp_ = Y + (size_t)(start + tt) * 256 + 64 * h; const float yv_ = ybp[(4 * pw + t) * 64 + lane]; \
                if (mode < 2) yp_[lane] = yv_; else ((unsigned short*)yp_)[(mode == 3 ? 64 : 0) + lane] = (unsigned short)f2bf(yv_); } } while (0)
        RW_ISSUE(0); RW_PREP(0);
        LDS_BARRIER();
        for (int b = 0; b < NB; ++b) {
            if (b > 0) RW_YFLUSH(b - 1);
            if (b + 1 < NB) RW_PREP(b + 1);
            LDS_BARRIER();
        }
        RW_YFLUSH(NB - 1);
#undef RW_ISSUE
#undef RW_PREP
#undef RW_YFLUSH
    } else {
        float st[16];
#pragma unroll
        for (int i = 0; i < 16; ++i) st[i] = (mode == 3 && 16 * (lane >> 4) + i == 16 * wid + (lane & 15)) ? 1.0f : 0.f;
        const int vofs = 320 + 16 * wid + (lane & 15);
        LDS_BARRIER();
        for (int b = 0; b < NB; ++b) {
            const float* ops = OPS + (b & 1) * (TB * 384); float* yb = YBUF + (b & 1) * (TB * 64);
            float xn = ops[lane], xw = ops[64 + lane], xb = ops[128 + lane], xk = ops[192 + lane], xr = ops[256 + lane], vv = ops[vofs];
#pragma unroll 2
            for (int t = 0; t < TB; ++t) {
                const float* nx = ops + (t + 1 < TB ? t + 1 : t) * 384;
                const float nxn = nx[lane], nxw = nx[64 + lane], nxb = nx[128 + lane], nxk = nx[192 + lane], nxr = nx[256 + lane], nvv = nx[vofs];
                float sa0 = 0.f, sa1 = 0.f, sa2 = 0.f, sa3 = 0.f;
                DPP_FMAC_N(sa0, xn, st[0], 0); DPP_FMAC(sa1, xn, st[1], 1); DPP_FMAC(sa2, xn, st[2], 2); DPP_FMAC(sa3, xn, st[3], 3);
                DPP_FMAC(sa0, xn, st[4], 4); DPP_FMAC(sa1, xn, st[5], 5); DPP_FMAC(sa2, xn, st[6], 6); DPP_FMAC(sa3, xn, st[7], 7);
                DPP_FMAC(sa0, xn, st[8], 8); DPP_FMAC(sa1, xn, st[9], 9); DPP_FMAC(sa2, xn, st[10], 10); DPP_FMAC(sa3, xn, st[11], 11);
                DPP_FMAC(sa0, xn, st[12], 12); DPP_FMAC(sa1, xn, st[13], 13); DPP_FMAC(sa2, xn, st[14], 14); DPP_FMAC(sa3, xn, st[15], 15);
                float sa = (sa0 + sa1) + (sa2 + sa3);
                { const f32x4_t da = __builtin_amdgcn_mfma_f32_16x16x4f32(1.0f, sa, (f32x4_t){0.f, 0.f, 0.f, 0.f}, 0, 0, 0); sa = da[0]; asm volatile("s_nop 15\n\ts_nop 3" : "+v"(sa)); }
                DPP_MUL_N(st[0], xw, 0);
#define M_MUL(J, X) DPP_MUL(st[J], X, J);
                REP15(M_MUL, xw)
#undef M_MUL
                DPP_FMAC_N(st[0], xb, sa, 0);
#define M_FB(J, X) DPP_FMAC(st[J], X, sa, J);
                REP15(M_FB, xb)
#undef M_FB
                DPP_FMAC_N(st[0], xk, vv, 0);
#define M_FK(J, X) DPP_FMAC(st[J], X, vv, J);
                REP15(M_FK, xk)
#undef M_FK
                float y0 = 0.f, y1 = 0.f, y2 = 0.f, y3 = 0.f;
                DPP_FMAC_N(y0, xr, st[0], 0); DPP_FMAC(y1, xr, st[1], 1); DPP_FMAC(y2, xr, st[2], 2); DPP_FMAC(y3, xr, st[3], 3);
                DPP_FMAC(y0, xr, st[4], 4); DPP_FMAC(y1, xr, st[5], 5); DPP_FMAC(y2, xr, st[6], 6); DPP_FMAC(y3, xr, st[7], 7);
                DPP_FMAC(y0, xr, st[8], 8); DPP_FMAC(y1, xr, st[9], 9); DPP_FMAC(y2, xr, st[10], 10); DPP_FMAC(y3, xr, st[11], 11);
                DPP_FMAC(y0, xr, st[12], 12); DPP_FMAC(y1, xr, st[13], 13); DPP_FMAC(y2, xr, st[14], 14); DPP_FMAC(y3, xr, st[15], 15);
                const float yp = (y0 + y1) + (y2 + y3);
                const f32x4_t dy = __builtin_amdgcn_mfma_f32_16x16x4f32(1.0f, yp, (f32x4_t){0.f, 0.f, 0.f, 0.f}, 0, 0, 0);
                if (lane < 16) yb[t * 64 + 16 * wid + lane] = dy[0];
                xn = nxn; xw = nxw; xb = nxb; xk = nxk; xr = nxr; vv = nvv;
            }
            LDS_BARRIER();
        }
        if (mode == 1) { float* sm = (float*)(p.ws + OFF_SMID) + (size_t)((s * 4 + h) * 2 + d) * 4096 + 16 * wid + (lane & 15);
#pragma unroll
            for (int i = 0; i < 16; ++i) sm[(16 * (lane >> 4) + i) * 64] = st[i]; }
    }
}

__device__ __forceinline__ float gelu_tanh(float x) { const float u = 0.7978845608028654f * (x + 0.044715f * x * x * x); return x * __builtin_amdgcn_rcpf(1.0f + __builtin_amdgcn_exp2f(-2.885390081777927f * u)); }
__device__ __forceinline__ float neg_expm1_fast(float t) { const float ser = -t * (1.0f + t * (0.5f + t * (0.16666667f + t * (0.041666668f + t * 0.0083333338f)))); return t > -0.25f ? ser : 1.0f - __expf(t); }

__device__ __forceinline__ void lru_unit(const KP& p, unsigned char* lds, int l, int s, int n) {
    typedef short bf16x8_t __attribute__((ext_vector_type(8)));
    typedef float f32x16_t __attribute__((ext_vector_type(16)));
    int tid_o = threadIdx.x; asm volatile("" : "+v"(tid_o)); const int tid = tid_o, lane = tid & 63; const int wid = __builtin_amdgcn_readfirstlane(tid >> 6);
    float* XC = (float*)lds;
    unsigned short* XCb = (unsigned short*)(lds + 16384);
    float* GG = (float*)(lds + 24576);
    float* HF = (float*)(lds + 57344);
    float* YG = (float*)(lds + 73728);
    float* HO = (float*)(lds + 90112);
    float* SEG = (float*)(lds + 106496);
    const bf16* Z = (const bf16*)(p.ws + OFF_Z);
    bf16* OM = (bf16*)(p.ws + OFF_OMIX);
    const int S = seq_len(s), start = seq_start(s); const int NB = S / 64;
    const int t_ = tid >> 3, c8 = (tid & 7) * 8;
    const int r32 = lane & 31, hi = lane >> 5; const int gm = wid & 1, gth = (wid >> 1) & 1, gch = wid >> 2;
    f32x4_t cw0[4], cw1[4];
#pragma unroll
    for (int j = 0; j < 4; ++j) { cw0[j] = *(const f32x4_t*)(p.in[11] + l * 4 * 384 + j * 384 + 64 * n + c8); cw1[j] = *(const f32x4_t*)(p.in[11] + l * 4 * 384 + j * 384 + 64 * n + c8 + 4); }
    const f32x4_t cb0 = *(const f32x4_t*)(p.in[12] + l * 384 + 64 * n + c8), cb1 = *(const f32x4_t*)(p.in[12] + l * 384 + 64 * n + c8 + 4);
    for (int d = 0; d < 2; ++d) {
        const float* wg = (gm == 0 ? p.in[13] : p.in[15]) + (((size_t)l * 2 + d) * 6 + n) * 4096;
        const float gbias = (gm == 0 ? p.in[14] : p.in[16])[(l * 2 + d) * 384 + 64 * n + 32 * gch + r32];
        const float lm = -p.in[17][(l * 2 + d) * 384 + 64 * n + lane]; const float sp8 = -8.0f * (lm > 20.f ? lm : log1pf(__expf(lm)));
        bf16x8_t Bf[4];
#pragma unroll
        for (int ks = 0; ks < 4; ++ks) { const float* wp = wg + (size_t)(16 * ks + 8 * hi) * 64 + 32 * gch + r32; u32x4_t pq;
            pq.x = pk2(wp[0], wp[64]); pq.y = pk2(wp[128], wp[192]); pq.z = pk2(wp[256], wp[320]); pq.w = pk2(wp[384], wp[448]); Bf[ks] = __builtin_bit_cast(bf16x8_t, pq); }
        __threadfence();
        __syncthreads();
        float hcarry = 0.f;
        u32x4_t rr[4], rh, ry;
#define LRU_ISSUE(blk_) do { const int tt = d == 0 ? (blk_) * 64 + t_ : S - 1 - ((blk_) * 64 + t_); \
            _Pragma("unroll") for (int j = 0; j < 4; ++j) { const int t2 = tt - 2 + j; rr[j] = (t2 >= 0 && t2 < S) ? *(const u32x4_t*)(Z + (size_t)(start + t2) * ZP + 64 * n + c8) : (u32x4_t){0u, 0u, 0u, 0u}; } \
            if (d == 1) { rh = *(const u32x4_t*)(OM + (size_t)(start + tt) * DM + 64 * n + c8); ry = *(const u32x4_t*)(Z + (size_t)(start + tt) * ZP + 384 + 64 * n + c8); } } while (0)
        LRU_ISSUE(0);
        for (int blk = 0; blk < NB; ++blk) {
            LDS_BARRIER();
            {
                f32x4_t x0 = cb0, x1 = cb1;
#pragma unroll
                for (int j = 0; j < 4; ++j) {
                    const f32x4_t a = (f32x4_t){__builtin_bit_cast(float, rr[j][0] << 16), __builtin_bit_cast(float, rr[j][0] & 0xffff0000u), __builtin_bit_cast(float, rr[j][1] << 16), __builtin_bit_cast(float, rr[j][1] & 0xffff0000u)};
                    const f32x4_t b = (f32x4_t){__builtin_bit_cast(float, rr[j][2] << 16), __builtin_bit_cast(float, rr[j][2] & 0xffff0000u), __builtin_bit_cast(float, rr[j][3] << 16), __builtin_bit_cast(float, rr[j][3] & 0xffff0000u)};
                    x0 += cw0[j] * a; x1 += cw1[j] * b;
                }
                *(f32x4_t*)(XC + t_ * 64 + c8) = x0; *(f32x4_t*)(XC + t_ * 64 + c8 + 4) = x1;
                { u32x4_t pq; pq.x = pk2(x0[0], x0[1]); pq.y = pk2(x0[2], x0[3]); pq.z = pk2(x1[0], x1[1]); pq.w = pk2(x1[2], x1[3]); *(u32x4_t*)(XCb + t_ * 64 + c8) = pq; }
                if (d == 1) {
                    float hf[8], yg[8];
#pragma unroll
                    for (int q = 0; q < 4; ++q) { hf[2 * q] = __builtin_bit_cast(float, rh[q] << 16); hf[2 * q + 1] = __builtin_bit_cast(float, rh[q] & 0xffff0000u);
                        yg[2 * q] = gelu_tanh(__builtin_bit_cast(float, ry[q] << 16)); yg[2 * q + 1] = gelu_tanh(__builtin_bit_cast(float, ry[q] & 0xffff0000u)); }
                    *(f32x4_t*)(HF + t_ * 64 + c8) = (f32x4_t){hf[0], hf[1], hf[2], hf[3]}; *(f32x4_t*)(HF + t_ * 64 + c8 + 4) = (f32x4_t){hf[4], hf[5], hf[6], hf[7]};
                    *(f32x4_t*)(YG + t_ * 64 + c8) = (f32x4_t){yg[0], yg[1], yg[2], yg[3]}; *(f32x4_t*)(YG + t_ * 64 + c8 + 4) = (f32x4_t){yg[4], yg[5], yg[6], yg[7]};
                }
                if (blk + 1 < NB) LRU_ISSUE(blk + 1);
            }
            LDS_BARRIER();
            {
                f32x16_t acc = {};
#pragma unroll
                for (int ks = 0; ks < 4; ++ks) { const bf16x8_t af = *(const bf16x8_t*)(XCb + (32 * gth + r32) * 64 + 16 * ks + 8 * hi); acc = __builtin_amdgcn_mfma_f32_32x32x16_bf16(af, Bf[ks], acc, 0, 0, 0); }
#pragma unroll
                for (int r = 0; r < 16; ++r) { const int trow = 32 * gth + (r & 3) + 8 * (r >> 2) + 4 * hi; GG[(gm * 64 + trow) * 64 + 32 * gch + r32] = sigmoidf_(acc[r] + gbias); }
            }
            LDS_BARRIER();
            float Pp[8], hl[8];
            {
                float pp = 1.f, hh = 0.f;
#pragma unroll
                for (int q = 0; q < 8; ++q) { const int t = 8 * wid + q; const float ra = GG[t * 64 + lane], ix = GG[(64 + t) * 64 + lane], xc = XC[t * 64 + lane];
                    const float la = sp8 * ra; const float a = __expf(la); const float uu = __builtin_amdgcn_sqrtf(fmaxf(neg_expm1_fast(2.0f * la), 0.f)) * ix * xc;
                    pp *= a; hh = a * hh + uu; Pp[q] = pp; hl[q] = hh; }
                SEG[(wid * 2) * 64 + lane] = pp; SEG[(wid * 2 + 1) * 64 + lane] = hh;
            }
            LDS_BARRIER();
            {
                float sa[8], sh[8];
#pragma unroll
                for (int w = 0; w < 8; ++w) { sa[w] = SEG[(w * 2) * 64 + lane]; sh[w] = SEG[(w * 2 + 1) * 64 + lane]; }
                float carry = hcarry, mine = 0.f;
#pragma unroll
                for (int w = 0; w < 8; ++w) { if (w == wid) mine = carry; carry = sa[w] * carry + sh[w]; }
                hcarry = carry;
#pragma unroll
                for (int q = 0; q < 8; ++q) { const int t = 8 * wid + q; const float hv = Pp[q] * mine + hl[q]; HO[t * 64 + lane] = d == 0 ? hv : (HF[t * 64 + lane] + hv) * YG[t * 64 + lane]; }
            }
            LDS_BARRIER();
            {   const int tt = d == 0 ? blk * 64 + t_ : S - 1 - (blk * 64 + t_);
                const f32x4_t a = *(const f32x4_t*)(HO + t_ * 64 + c8), b = *(const f32x4_t*)(HO + t_ * 64 + c8 + 4);
                u32x4_t w; w.x = pk2(a[0], a[1]); w.y = pk2(a[2], a[3]); w.z = pk2(b[0], b[1]); w.w = pk2(b[2], b[3]);
                *(u32x4_t*)(OM + (size_t)(start + tt) * DM + 64 * n + c8) = w; }
        }
#undef LRU_ISSUE
    }
}

__device__ __forceinline__ void rwkv_post_tile(const KP& p, unsigned char* lds, int l, int tile) {
    int tid_o = threadIdx.x; asm volatile("" : "+v"(tid_o)); const int tid = tid_o, lane = tid & 63;
    float* SG = (float*)lds;
    float* GO = SG + 4096;
    const bf16* Z = (const bf16*)(p.ws + OFF_Z); bf16* OM = (bf16*)(p.ws + OFF_OMIX);
    const float* YF = (const float*)(p.ws + OFF_YF); const float* YBk = (const float*)(p.ws + OFF_YB);
    const float* mu = p.in[18] + l * 1024; const float* g_up = p.in[23] + (size_t)l * 128 * 256;
    const int m0 = tile * 32; const int s = seq_of_row(m0); const int S = seq_len(s), start = seq_start(s);
    __syncthreads();
    for (int e = tid; e < 4096; e += NTHR) {
        const int t = e >> 7, c = e & 127; const int m = m0 + t, tt = m - start; const bf16* zp = Z + (size_t)m * ZP + 768 + 896 + c;
        const float f = bf2f(zp[0]); const float pv = tt > 0 ? bf2f(zp[-ZP]) : 0.f; const float nx = tt < S - 1 ? bf2f(zp[ZP]) : 0.f;
        SG[e] = sigmoidf_(f + mu[896 + c] * (0.5f * (pv + nx) - f));
    }
    __syncthreads();
    const int c = tid & 255, tg = tid >> 8;
    {
        float acc[16];
#pragma unroll
        for (int t = 0; t < 16; ++t) acc[t] = 0.f;
        for (int ib = 0; ib < 128; ib += 16) {
            float wv[16];
#pragma unroll
            for (int u = 0; u < 16; ++u) wv[u] = g_up[(ib + u) * 256 + c];
#pragma unroll
            for (int u4 = 0; u4 < 16; u4 += 4)
#pragma unroll
                for (int t = 0; t < 16; ++t) { const f32x4_t x = *(const f32x4_t*)(SG + (tg * 16 + t) * 128 + ib + u4); acc[t] += x[0] * wv[u4] + x[1] * wv[u4 + 1] + x[2] * wv[u4 + 2] + x[3] * wv[u4 + 3]; }
        }
#pragma unroll
        for (int t = 0; t < 16; ++t) GO[(tg * 16 + t) * 256 + c] = acc[t];
    }
    const int dc = (s < 4) ? ((m0 - start) >= S / 2 ? 0 : 1) : -1;
    if (dc >= 0) {
        float* SM = (float*)(lds + 49152); unsigned short* YPs = (unsigned short*)(lds + 114688);
        const float* Ydc = dc == 0 ? YF : YBk; float* Yw = (float*)(p.ws + (dc == 0 ? OFF_YF : OFF_YB));
        for (int e = tid; e < 4096; e += NTHR) { const int hh = e >> 10, r4 = (e & 1023) * 4; *(f32x4_t*)(SM + hh * 4096 + r4) = *(const f32x4_t*)((const float*)(p.ws + OFF_SMID) + (size_t)((s * 4 + hh) * 2 + dc) * 4096 + r4); }
        for (int e = tid; e < 1024; e += NTHR) { const int t = e >> 5, hh = (e >> 3) & 3, ch = e & 7; *(u32x4_t*)(YPs + t * 256 + hh * 64 + ch * 8) = *(const u32x4_t*)((const unsigned short*)(Ydc + (size_t)(m0 + t) * 256 + 64 * hh) + 64 + ch * 8); }
        __syncthreads();
        const int hh = c >> 6, v = c & 63; const float* smp = SM + hh * 4096 + v;
#pragma unroll 1
        for (int t = 0; t < 16; ++t) {
            const int tk = tg * 16 + t; const size_t mrow = (size_t)(m0 + tk) * 256;
            float accv = bf2f(((const unsigned short*)(Ydc + mrow + 64 * hh))[v]);
#pragma unroll
            for (int i0 = 0; i0 < 64; i0 += 8) { const u32x4_t w = *(const u32x4_t*)(YPs + tk * 256 + hh * 64 + i0);
                accv += smp[(i0 + 0) * 64] * __builtin_bit_cast(float, w[0] << 16) + smp[(i0 + 1) * 64] * __builtin_bit_cast(float, w[0] & 0xffff0000u) + smp[(i0 + 2) * 64] * __builtin_bit_cast(float, w[1] << 16) + smp[(i0 + 3) * 64] * __builtin_bit_cast(float, w[1] & 0xffff0000u)
                      + smp[(i0 + 4) * 64] * __builtin_bit_cast(float, w[2] << 16) + smp[(i0 + 5) * 64] * __builtin_bit_cast(float, w[2] & 0xffff0000u) + smp[(i0 + 6) * 64] * __builtin_bit_cast(float, w[3] << 16) + smp[(i0 + 7) * 64] * __builtin_bit_cast(float, w[3] & 0xffff0000u); }
            Yw[mrow + c] = accv;
        }
        __threadfence();
        __syncthreads();
    }
    const float rk = p.in[26][l * 256 + c], lg = p.in[27][l * 256 + c], lb = p.in[28][l * 256 + c];
    const float mr = mu[c], mk = mu[256 + c], mv = mu[512 + c];
    for (int t = 0; t < 16; ++t) {
        const int m = m0 + tg * 16 + t, tt = m - start; const bf16* zp = Z + (size_t)m * ZP + 768 + c;
        const bool hp = tt > 0, hn = tt < S - 1;
        float f = bf2f(zp[0]), pv = hp ? bf2f(zp[-ZP]) : 0.f, nx = hn ? bf2f(zp[ZP]) : 0.f; const float r = f + mr * (0.5f * (pv + nx) - f);
        f = bf2f(zp[256]); pv = hp ? bf2f(zp[256 - ZP]) : 0.f; nx = hn ? bf2f(zp[256 + ZP]) : 0.f; const float k = f + mk * (0.5f * (pv + nx) - f);
        f = bf2f(zp[512]); pv = hp ? bf2f(zp[512 - ZP]) : 0.f; nx = hn ? bf2f(zp[512 + ZP]) : 0.f; const float v = f + mv * (0.5f * (pv + nx) - f);
        float yf = YF[(size_t)m * 256 + c], ybv = YBk[(size_t)m * 256 + c];
        const float y = yf + ybv;
        const float mean = wave_sum(y) * (1.0f / 64.0f); const float dv = y - mean; const float var = wave_sum(dv * dv) * (1.0f / 64.0f);
        const float yn = dv * rsqrtf(var + 64e-5f) * lg + lb;
        const float bon = wave_sum(r * k * rk);
        const float outv = (yn + bon * v) * GO[(tg * 16 + t) * 256 + c];
        OM[(size_t)m * DM + 384 + c] = (bf16)f2bf(outv);
    }
    (void)lane;
}

__global__ void __launch_bounds__(NTHR, 2) fwd_megakernel(KP p) {
    extern __shared__ __attribute__((aligned(16))) unsigned char lds[];
    cg::grid_group grid = cg::this_grid();
    const int tid = threadIdx.x, lane = tid & 63, wid = tid >> 6;
    const int G = gridDim.x, bx = blockIdx.x;
    const int gw = bx * 8 + wid, NGW = G * 8;
    unsigned char* ws = p.ws;
    volatile int* misc = (volatile int*)(lds + MISC_OFF);
    PG8_LAS unsigned char* ldsg = (PG8_LAS unsigned char*)lds;

    {
        float* scr = (float*)(lds + wid * 16384);
        for (int l = 0; l < 2; ++l) {
            unsigned char* wl = ws + OFF_W + l * W_LAYER;
            constexpr int I_IN = 16 * 176, I_OUT = 44 * 32, I_MI = 16 * 76, I_MO = 16 * 32, I_TOT = 2 * I_IN + 2 * I_OUT + I_MI + I_MO;
            for (int it = gw; it < I_TOT; it += NGW) {
                int r = it;
                if (r < 2 * I_IN) { const int f = r / I_IN; transpose_item<1>(p.in[7] + ((size_t)l * 2 + f) * DM * NFF, DM, NFF, (bf16*)(wl + WO_IN + f * 11 * MiB), scr, r % I_IN, lane); continue; } r -= 2 * I_IN;
                if (r < 2 * I_OUT) { const int f = r / I_OUT; transpose_item<0>(p.in[8] + ((size_t)l * 2 + f) * DFF * DM, DFF, DM, (bf16*)(wl + WO_OUT + f * (11 * MiB / 2)), scr, r % I_OUT, lane); continue; } r -= 2 * I_OUT;
                if (r < I_MI) { transpose_item<2>(p.in[9] + (size_t)l * DM * NMIX, DM, NMIX, (bf16*)(wl + WO_MI), scr, r, lane); continue; } r -= I_MI;
                transpose_item<0>(p.in[10] + (size_t)l * DM * DM, DM, DM, (bf16*)(wl + WO_MO), scr, r, lane);
            }
            u32x4_t* padp = (u32x4_t*)(wl + WO_MI + (size_t)NMIX * DM * 2);
            for (int e = bx * NTHR + tid; e < 128 * DM * 2 / 16; e += G * NTHR) padp[e] = (u32x4_t){0u, 0u, 0u, 0u};
        }
        __syncthreads();
        for (int u = bx; u < 2 * 36 * 8; u += G) { const int l = u / 288, r = u % 288;
            smallm_unit<0, 0>(p, (float*)lds, l, 0, p.in[4] + (size_t)l * DM * 9216, 9216, 9216, (float*)(ws + OFF_MOD) + (size_t)l * NSEQ * 9216, 9216, r / 8, r % 8); }
        if (bx == 0) { float* rope = (float*)(ws + OFF_ROPE);
            for (int e = tid; e < 1024; e += NTHR) { const int pos = e >> 4, pp = e & 15; const float inv = exp2f(-(float)pp * (13.287712379549449f / 16.0f)); const float a = (float)pos * inv; const float kr = rintf(a * 0.15915494309189535f); float rr = fmaf(-kr, 6.2831854820251465f, a); rr = fmaf(-kr, -1.7484555e-7f, rr); rope[2 * e] = __cosf(rr); rope[2 * e + 1] = __sinf(rr); } }
    }
    grid.sync();
    {
        const float* MOD = (const float*)(ws + OFF_MOD); float* GV = (float*)(ws + OFF_GV); float* GT = (float*)(ws + OFF_GATE);
        for (int e = bx * NTHR + tid; e < 6 * NSEQ * DM; e += G * NTHR) {
            const int c = e & 1023, s = (e >> 10) % NSEQ, inst = e / (NSEQ * DM); const int l = inst / 3, j = inst % 3;
            const float* mr = MOD + ((size_t)l * NSEQ + s) * 9216; const float* ba = p.in[5] + l * 9216;
            const float sc = mr[(3 * j + 1) * 1024 + c] + ba[(3 * j + 1) * 1024 + c], gg = mr[(3 * j + 2) * 1024 + c] + ba[(3 * j + 2) * 1024 + c];
            GV[e] = p.in[6][(l * 3 + j) * DM + c] * (1.0f + sc); GT[e] = (j == 1 ? 1.0f : 0.5f) * gg;
        }
        for (int u = bx; u < 2 * 432; u += G) { const int l = u / 432, r = u % 432; float* bdst = (float*)(ws + OFF_BIAS);
            if (r < 176) smallm_unit<1, 1>(p, (float*)lds, l, 0, p.in[7] + ((size_t)l * 2 + 0) * DM * NFF, NFF, NFF, bdst + (size_t)(l * 3 + 0) * NSEQ * NFF, NFF, r / 8, r % 8);
            else if (r < 256) smallm_unit<1, 2>(p, (float*)lds, l, 1, p.in[9] + (size_t)l * DM * NMIX, NMIX, NMIX, bdst + (size_t)(l * 3 + 1) * NSEQ * NFF, NFF, (r - 176) / 8, (r - 176) % 8);
            else smallm_unit<1, 1>(p, (float*)lds, l, 2, p.in[7] + ((size_t)l * 2 + 1) * DM * NFF, NFF, NFF, bdst + (size_t)(l * 3 + 2) * NSEQ * NFF, NFF, (r - 256) / 8, (r - 256) % 8); }
        bf16* XN = (bf16*)(ws + OFF_XN); float* SS0 = (float*)(ws + OFF_SS);
        for (int m = gw; m < MTOK; m += NGW) {
            const int s = seq_of_row(m); const float* xr = m < 16384 ? p.in[0] + (size_t)m * DM : p.in[1] + (size_t)(m - 16384) * DM;
            const float* mr = MOD + (size_t)s * 9216 + 1024; const float* ba = p.in[5] + 1024; const float* ng = p.in[6];
            float q = 0.f;
#pragma unroll
            for (int j = 0; j < 4; ++j) { const int c = 4 * lane + 256 * j; const f32x4_t v = *(const f32x4_t*)(xr + c); const f32x4_t sc = *(const f32x4_t*)(mr + c) + *(const f32x4_t*)(ba + c); const f32x4_t g = *(const f32x4_t*)(ng + c) * (sc + 1.0f);
                q += (v[0] * v[0] + v[1] * v[1]) + (v[2] * v[2] + v[3] * v[3]); const f32x4_t o = v * g;
                *(unsigned long long*)(XN + (size_t)m * DM + c) = (unsigned long long)pk2(o[0], o[1]) | ((unsigned long long)pk2(o[2], o[3]) << 32); }
            q = wave_sum(q); if (lane == 0) SS0[m] = q;
        }
    }
    grid.sync();

    for (int l = 0; l < 2; ++l) {
        unsigned char* wl = ws + OFF_W + l * W_LAYER;
        const float* GV = (const float*)(ws + OFF_GV); const float* GT = (const float*)(ws + OFF_GATE); const float* BI = (const float*)(ws + OFF_BIAS); float* SS = (float*)(ws + OFF_SS);
        bf16* XN = (bf16*)(ws + OFF_XN); bf16* HID = (bf16*)(ws + OFF_HID); bf16* OMIX = (bf16*)(ws + OFF_OMIX);
        for (int f = 0; f < 2; ++f) {
            const int j = f == 0 ? 0 : 2; const int inst = l * 3 + j;
            if (f == 1) {
                {
                    pg8::Gemm g{XN, (const pg8::bf16_t*)(wl + WO_MI), MTOK, NMIXP, DM}; pg8::StaticOrder S; S.init(MTOK, NMIXP, G, bx);
                    pg8::EpiZ E{(bf16*)(ws + OFF_Z), (bf16*)(ws + OFF_QK), (bf16*)(ws + OFF_VR), SS + (size_t)(l * 3 + 1) * MTOK, BI + (size_t)(l * 3 + 1) * NSEQ * NFF, p.in[29] + l * 64, p.in[30] + l * 64, (const float*)(ws + OFF_ROPE)};
                    pg8::gemm_phase<pg8::EpiZ, pg8::StaticOrder, true, true>(ldsg, g, S, E);
                }
                grid.sync();
                {
                    unsigned* ctr = (unsigned*)(ws + OFF_CTR) + 64 * l;
                    constexpr int NU_R = 224, NU_L = 120, NU_A = 1152, NU = NU_R + NU_L + NU_A;
                    for (;;) {
                        __syncthreads(); if (tid == 0) misc[0] = (int)atomicAdd(ctr, 1u); __syncthreads();
                        const int u = misc[0]; if (u >= NU) break;
                        if (u < 224) { int s_, h_, d_, md_;
                            if (u < 96) { const int c = u & 31; md_ = 1 + (u >> 5); s_ = c >> 3; h_ = (c >> 1) & 3; d_ = c & 1; } else { const int i2 = u - 96; md_ = 0; s_ = 4 + (i2 >> 3); h_ = (i2 >> 1) & 3; d_ = i2 & 1; }
                            rwkv_unit(p, lds, l, s_, h_, d_, md_); }
                        else if (u < 248) { const int i3 = u - 224; lru_unit(p, lds, l, i3 / 6, i3 % 6); }
                        else if (u < 344) { const int i4 = u - 248; lru_unit(p, lds, l, 4 + i4 / 6, i4 % 6); }
                        else { const int i5 = u - 344; int s_, hq, qb;
                            if (i5 < 384) { s_ = i5 / 96; const int r = i5 % 96; hq = (r / 48) * 3 + (r % 48) / 16; qb = r & 15; }
                            else { const int i6 = i5 - 384; s_ = 4 + i6 / 48; const int r = i6 % 48; hq = (r / 24) * 3 + (r % 24) / 8; qb = r & 7; }
                            const int g_ = hq / 3;
                            attn_body::attn_unit<8>(seq_start(s_), seq_len(s_), qb, 64 * hq, 384 + 64 * g_, 64 * g_, 640 + 64 * hq, (const attn_body::bf16*)(ws + OFF_QK), (const attn_body::bf16*)(ws + OFF_QK), (const attn_body::bf16*)(ws + OFF_VR), (attn_body::bf16*)(ws + OFF_OMIX), (char*)lds); }
                    }
                }
                grid.sync();
                for (int t = bx; t < MTOK / 32; t += G) rwkv_post_tile(p, lds, l, t);
                grid.sync();
                {
                    pg8::Gemm g{OMIX, (const pg8::bf16_t*)(wl + WO_MO), MTOK, DM, DM}; pg8::StaticOrder S; S.init(MTOK, DM, G, bx);
                    pg8::EpiResid E{p.out, p.out + (size_t)16384 * DM, p.out, XN, SS + (size_t)(l * 3 + 2) * MTOK, GT + (size_t)(l * 3 + 1) * NSEQ * DM, GV + (size_t)(l * 3 + 2) * NSEQ * DM};
                    pg8::gemm_phase<pg8::EpiResid, pg8::StaticOrder, true, true>(ldsg, g, S, E);
                }
                grid.sync();
            }
            {
                pg8::Gemm g{XN, (const pg8::bf16_t*)(wl + WO_IN + f * 11 * MiB), MTOK, NFF, DM}; pg8::StaticOrder S; S.init(MTOK, NFF, G, bx);
                pg8::EpiSwiglu E{HID, SS + (size_t)inst * MTOK, BI + (size_t)inst * NSEQ * NFF};
                pg8::gemm_phase<pg8::EpiSwiglu, pg8::StaticOrder, true, true>(ldsg, g, S, E);
            }
            grid.sync();
            {
                const bool first = (l == 0 && f == 0), last = (l == 1 && f == 1);
                const int ninst = inst + 1;
                pg8::Gemm g{HID, (const pg8::bf16_t*)(wl + WO_OUT + f * (11 * MiB / 2)), MTOK, DM, DFF}; pg8::StaticOrder S; S.init(MTOK, DM, G, bx);
                pg8::EpiResid E{first ? p.in[0] : p.out, first ? p.in[1] : p.out + (size_t)16384 * DM, p.out, XN, last ? nullptr : SS + (size_t)ninst * MTOK, GT + (size_t)inst * NSEQ * DM, last ? nullptr : GV + (size_t)ninst * NSEQ * DM};
                pg8::gemm_phase<pg8::EpiResid, pg8::StaticOrder, true, true>(ldsg, g, S, E);
            }
            if (!(l == 1 && f == 1)) grid.sync();
        }
    }
}

extern "C" void kernel_launch(void* const* d_in, const int* in_sizes, int n_in, void* d_out, int out_size, void* d_ws, size_t ws_size, hipStream_t stream) {
    static int grid = 0;
    if (grid == 0) {
        if (n_in != 31 || ws_size < WS_END + 1 * MiB) { fprintf(stderr, "kernel_launch: unexpected n_in %d / ws %zu\n", n_in, ws_size); grid = -1; return; }
        int dev = 0, cus = 0, per_cu = 0;
        hipGetDevice(&dev); hipDeviceGetAttribute(&cus, hipDeviceAttributeMultiprocessorCount, dev);
        hipFuncSetAttribute((const void*)fwd_megakernel, hipFuncAttributeMaxDynamicSharedMemorySize, LDS_BYTES);
        hipOccupancyMaxActiveBlocksPerMultiprocessor(&per_cu, (const void*)fwd_megakernel, NTHR, LDS_BYTES);
        if (per_cu < 1) per_cu = 1;
        grid = cus * per_cu;
        (void)hipGetLastError();
    }
    if (grid < 0) return;
    hipMemsetAsync(d_ws, 0, ZERO_BYTES, stream);
    KP p{};
    for (int i = 0; i < 31; ++i) p.in[i] = (const float*)d_in[i];
    p.out = (float*)d_out; p.ws = (unsigned char*)d_ws;
    void* args[] = {&p};
    hipError_t e = hipLaunchCooperativeKernel((const void*)fwd_megakernel, dim3(grid), dim3(NTHR), args, LDS_BYTES, stream);
    if (e != hipSuccess) fprintf(stderr, "cooperative launch failed: %s (grid %d)\n", hipGetErrorString(e), grid);
}
```

```cpp
#include <hip/hip_runtime.h>
#include <hip/hip_cooperative_groups.h>
#include <cstdio>
#include <cstdint>
namespace cg = cooperative_groups;
namespace pg8 {
#define PG8_LAS __attribute__((address_space(3)))
typedef unsigned short bf16_t;
typedef short bf16x8 __attribute__((ext_vector_type(8)));
typedef float f32x4 __attribute__((ext_vector_type(4)));
typedef unsigned u32x4 __attribute__((ext_vector_type(4)));
constexpr int BM = 256, BK = 64, HALF = 128, HTB = HALF * BK * 2  , STAGE_BYTES = 8 * HTB, NXCD = 8, WGM = 8;

__host__ __device__ __forceinline__ int lds_byte(int r, int c) { const int st = (r >> 4) * 2 + (c >> 5), rr = r & 15, cc = c & 31, ob = rr * 64 + cc * 2; return st * 1024 + (ob ^ (((ob >> 9) & 1) << 5)); }
__host__ __device__ __forceinline__ void stage_rc(int b, int& R, int& C) { const int st = b / 1024, sb = b % 1024, swz = sb ^ (((sb >> 9) & 1) << 5); R = (st >> 1) * 16 + swz / 64; C = (st & 1) * 32 + (swz % 64) / 2; }
__host__ __device__ __forceinline__ int perm32(int rho) { const int n = rho >> 4, i = rho & 15; return 8 * (i >> 2) + 4 * n + (i & 3); }

struct Unit { int pm, pn; };
struct Gemm { const bf16_t* A; const bf16_t* Bt; int M, N, K; };

struct StaticOrder {
    int nM, nN, nwg, G, c;
    __host__ __device__ void init(int M, int N, int G_, int c_) { nM = M / BM; nN = N / BM; nwg = nM * nN; G = G_; c = c_; }
    __host__ __device__ bool next(int i, Unit& u) const {
        const long L = (long)i * G + c; if (L >= nwg) return false;
        int wgid = (int)L; { const int q = nwg / NXCD, r = nwg % NXCD, xcd = wgid % NXCD, off = wgid / NXCD; wgid = (xcd < r ? xcd * (q + 1) : r * (q + 1) + (xcd - r) * q) + off; }
        const int nig = WGM * nN, gid = wgid / nig, fm = gid * WGM, gsz = (nM - fm) < WGM ? (nM - fm) : WGM;
        u.pm = fm + ((wgid % nig) % gsz); u.pn = (wgid % nig) / gsz; return true;
    }
    __device__ __forceinline__ void a_ready(const Unit&) const {}
    __device__ __forceinline__ void done(const Unit&) const {}
};

__device__ __forceinline__ unsigned cvt_pk_bf16(float lo, float hi) { unsigned r; asm volatile("v_cvt_pk_bf16_f32 %0, %1, %2" : "=v"(r) : "v"(lo), "v"(hi)); return r; }
typedef float f32x2 __attribute__((ext_vector_type(2)));
__device__ __forceinline__ f32x2 gelu_pk(f32x2 v) {
    const f32x2 av = __builtin_elementwise_abs(v), d = av * 0.2316418882f + 1.0f;
    f32x2 t; t.x = __builtin_amdgcn_rcpf(d.x); t.y = __builtin_amdgcn_rcpf(d.y);
    f32x2 q = t * 0.5307027145f + (-0.7265760135f); q = q * t + 0.7107068705f; q = q * t + (-0.142248368f); q = q * t + 0.127414796f; q = q * t;
    const f32x2 s = (v * v) * (-0.72134752044f);
    f32x2 e; e.x = __builtin_amdgcn_exp2f(s.x); e.y = __builtin_amdgcn_exp2f(s.y);
    const f32x2 m = v * (q * e), r = v - m;
    f32x2 o; o.x = v.x < 0.f ? m.x : r.x; o.y = v.y < 0.f ? m.y : r.y; return o;
}

template <int ACT  > struct EpiBf16 {
    static constexpr bool PERM = true, AFTER_DRAIN = false; static_assert(ACT == 0 || ACT == 1, "EpiBf16: ACT is 0 (none) or 1 (gelu_pk)");
    bf16_t* O; int ldc; const float* bias; int split_cols; size_t split_stride; float scale0;
    __device__ __forceinline__ void operator()(const f32x4 (&acc)[2][2][4][2], const Unit& u, int wr, int wc, int fr, int fq) const {
        const int row0 = u.pm * BM + wr * 64 + fr; int colt = u.pn * BM; bf16_t* base = O;
        float sc = 1.f; if (split_cols) { const int t = colt / split_cols; base += (size_t)t * split_stride; colt -= t * split_cols; if (t == 0) sc = scale0; }
        const int col0 = colt + wc * 32 + 8 * fq, bcol0 = u.pn * BM + wc * 32 + 8 * fq;
        f32x4 bv[2][2];
#pragma unroll
        for (int bj = 0; bj < 2; ++bj)
#pragma unroll
            for (int n = 0; n < 2; ++n) bv[bj][n] = bias ? *(const f32x4*)(bias + bcol0 + bj * HALF + 4 * n) : (f32x4){0.f, 0.f, 0.f, 0.f};
#pragma unroll
        for (int ai = 0; ai < 2; ++ai)
#pragma unroll
            for (int m = 0; m < 4; ++m) { bf16_t* rowp = base + (size_t)(row0 + ai * HALF + m * 16) * ldc + col0;
#pragma unroll
                for (int bj = 0; bj < 2; ++bj) { f32x4 v0 = acc[ai][bj][m][0] + bv[bj][0], v1 = acc[ai][bj][m][1] + bv[bj][1];
                    if (ACT == 1) { f32x2 a = gelu_pk((f32x2){v0[0], v0[1]}), b = gelu_pk((f32x2){v0[2], v0[3]}), c = gelu_pk((f32x2){v1[0], v1[1]}), d = gelu_pk((f32x2){v1[2], v1[3]});
                        v0 = (f32x4){a.x, a.y, b.x, b.y}; v1 = (f32x4){c.x, c.y, d.x, d.y}; }
                    v0 = v0 * sc; v1 = v1 * sc; u32x4 w; w.x = cvt_pk_bf16(v0[0], v0[1]); w.y = cvt_pk_bf16(v0[2], v0[3]); w.z = cvt_pk_bf16(v1[0], v1[1]); w.w = cvt_pk_bf16(v1[2], v1[3]);
                    *(u32x4*)(rowp + bj * HALF) = w; } }
    }
};
template <class Epi, class Sched, bool ALIGN_EPI = false, bool SP2 = false>
__device__ __forceinline__ void gemm_phase(PG8_LAS unsigned char* lds, const Gemm g, const Sched& S, const Epi& E) {
    int tid_o = threadIdx.x; asm volatile("" : "+v"(tid_o)); const int tid = tid_o, wid = __builtin_amdgcn_readfirstlane(tid >> 6), lane = tid & 63, wr = wid >> 2, wc = wid & 3, fr = lane & 15, fq = lane >> 4;
    const int K = g.K, nt = K / BK;
    unsigned voffA[2], voffB[2];
#pragma unroll
    for (int i = 0; i < 2; ++i) { int R, C; stage_rc(tid * 16 + i * 8192, R, C); const int Rb = Epi::PERM ? ((R & ~31) + perm32(R & 31)) : R;
        voffA[i] = (unsigned)(R * K + C) * 2u; voffB[i] = (unsigned)(Rb * K + C) * 2u; }
    const size_t kstep = (size_t)(BK * 2);
    const size_t hstep = (size_t)HALF * K * 2;
    const size_t tstep = 2 * hstep;
    const unsigned ldsw = (unsigned)wid * 1024u;
    const int aoff = lds_byte(wr * 64 + fr, fq * 8), boff = lds_byte(wc * 32 + fr, fq * 8);
#define PG8_SA(b, h) (((b) * 2 + (h)) * HTB)
#define PG8_SB(b, h) ((4 + (b) * 2 + (h)) * HTB)
#define PG8_STAGE(bufoff, gbase, voff) do { _Pragma("unroll") for (int _i = 0; _i < 2; ++_i) \
        __builtin_amdgcn_global_load_lds((const unsigned*)((const char*)(gbase) + (voff)[_i]), (PG8_LAS unsigned*)(lds + (bufoff) + ldsw + _i * 8192), 16, 0, 0); } while (0)
#define PG8_LDA(dst, b, h) do { _Pragma("unroll") for (int m = 0; m < 4; ++m) _Pragma("unroll") for (int k = 0; k < 2; ++k) dst[m][k] = *(const PG8_LAS bf16x8*)(lds + PG8_SA(b, h) + aoff + m * 2048 + k * 1024); } while (0)
#define PG8_LDB(dst, b, h) do { _Pragma("unroll") for (int n = 0; n < 2; ++n) _Pragma("unroll") for (int k = 0; k < 2; ++k) dst[n][k] = *(const PG8_LAS bf16x8*)(lds + PG8_SB(b, h) + boff + n * 2048 + k * 1024); } while (0)
#define PG8_MMA(ai, bj, At, Bt) do { __builtin_amdgcn_s_setprio(1); _Pragma("unroll") for (int m = 0; m < 4; ++m) _Pragma("unroll") for (int n = 0; n < 2; ++n) _Pragma("unroll") for (int k = 0; k < 2; ++k) \
        acc[ai][bj][m][n] = __builtin_amdgcn_mfma_f32_16x16x32_bf16(Bt[n][k], At[m][k], acc[ai][bj][m][n], 0, 0, 0); __builtin_amdgcn_s_setprio(0); } while (0)
#define PG8_WAIT_V(n) asm volatile("s_waitcnt vmcnt(" #n ")" ::: "memory")
#define PG8_WAIT_L(n) asm volatile("s_waitcnt lgkmcnt(" #n ")" ::: "memory")
#define PG8_BAR __builtin_amdgcn_s_barrier()
#define PG8_SCHED __builtin_amdgcn_sched_barrier(0)
    Unit cur, nxt; int ui = 0;
    if (!S.next(0, cur)) return;
    f32x4 acc[2][2][4][2];
#pragma unroll
    for (int a = 0; a < 2; ++a)
#pragma unroll
        for (int b = 0; b < 2; ++b)
#pragma unroll
            for (int m = 0; m < 4; ++m)
#pragma unroll
                for (int n = 0; n < 2; ++n) acc[a][b][m][n] = (f32x4){0.f, 0.f, 0.f, 0.f};
    bf16x8 At[4][2], B0[2][2], B1[2][2];
    const char* cA = (const char*)g.A + (size_t)cur.pm * tstep; const char* cB = (const char*)g.Bt + (size_t)cur.pn * tstep;
    S.a_ready(cur);
    if constexpr (SP2) {
        PG8_STAGE(PG8_SB(0, 0), cB, voffB); PG8_STAGE(PG8_SB(0, 1), cB + hstep, voffB); PG8_STAGE(PG8_SA(0, 0), cA, voffA); PG8_STAGE(PG8_SA(0, 1), cA + hstep, voffA);
        if (wr == 1) PG8_BAR;
        PG8_WAIT_V(2); PG8_BAR;
        PG8_STAGE(PG8_SB(1, 0), cB + kstep, voffB); PG8_STAGE(PG8_SA(1, 0), cA + kstep, voffA); PG8_STAGE(PG8_SB(1, 1), cB + hstep + kstep, voffB);
        PG8_WAIT_V(6); PG8_BAR;
    } else {
        PG8_STAGE(PG8_SB(0, 0), cB, voffB); PG8_STAGE(PG8_SA(0, 0), cA, voffA); PG8_STAGE(PG8_SB(0, 1), cB + hstep, voffB); PG8_STAGE(PG8_SA(0, 1), cA + hstep, voffA);
        if (wr == 1) PG8_BAR;
        PG8_WAIT_V(4); PG8_BAR;
        PG8_STAGE(PG8_SB(1, 0), cB + kstep, voffB); PG8_STAGE(PG8_SA(1, 0), cA + kstep, voffA); PG8_STAGE(PG8_SB(1, 1), cB + hstep + kstep, voffB);
        PG8_WAIT_V(6); PG8_BAR;
    }
    for (;;) {
        const bool has_next = S.next(ui + 1, nxt);
        const char* nA = has_next ? (const char*)g.A + (size_t)nxt.pm * tstep : cA; const char* nB = has_next ? (const char*)g.Bt + (size_t)nxt.pn * tstep : cB;
        for (int t = 0; t < nt; t += 2) {
            const bool last = (t == nt - 2);
            const char* a1 = cA + (size_t)(t + 1) * kstep;
            const char* a2 = last ? nA : cA + (size_t)(t + 2) * kstep; const char* b2 = last ? nB : cB + (size_t)(t + 2) * kstep;
            const char* a3 = a2 + kstep; const char* b3 = b2 + kstep;
            if (last && has_next) S.a_ready(nxt);
            if constexpr (SP2) {
            PG8_LDB(B0, 0, 0); PG8_LDB(B1, 0, 1); PG8_SCHED; PG8_LDA(At, 0, 0); PG8_STAGE(PG8_SA(1, 1), a1 + hstep, voffA);
            PG8_WAIT_V(8); PG8_WAIT_L(0); PG8_BAR; PG8_MMA(0, 0, At, B0); PG8_MMA(0, 1, At, B1); PG8_BAR; PG8_SCHED;
            PG8_LDA(At, 0, 1); PG8_STAGE(PG8_SB(0, 0), b2, voffB); PG8_STAGE(PG8_SB(0, 1), b2 + hstep, voffB); PG8_STAGE(PG8_SA(0, 0), a2, voffA);
            PG8_WAIT_V(8); PG8_WAIT_L(0); PG8_BAR; PG8_MMA(1, 0, At, B0); PG8_MMA(1, 1, At, B1); PG8_BAR; PG8_SCHED;
            PG8_LDB(B0, 1, 0); PG8_LDB(B1, 1, 1); PG8_SCHED; PG8_LDA(At, 1, 0); PG8_STAGE(PG8_SA(0, 1), a2 + hstep, voffA);
            PG8_WAIT_V(8); PG8_WAIT_L(0); PG8_BAR; PG8_MMA(0, 0, At, B0); PG8_MMA(0, 1, At, B1); PG8_BAR; PG8_SCHED;
            PG8_LDA(At, 1, 1); PG8_STAGE(PG8_SB(1, 0), b3, voffB); PG8_STAGE(PG8_SB(1, 1), b3 + hstep, voffB); PG8_STAGE(PG8_SA(1, 0), a3, voffA);
            PG8_WAIT_V(8); PG8_WAIT_L(0); PG8_BAR; PG8_MMA(1, 0, At, B0); PG8_MMA(1, 1, At, B1); PG8_BAR; PG8_SCHED;
            } else {
            PG8_LDB(B0, 0, 0); PG8_SCHED; PG8_LDA(At, 0, 0); PG8_STAGE(PG8_SA(1, 1), a1 + hstep, voffA);
            PG8_WAIT_L(8); PG8_BAR; PG8_WAIT_L(0); PG8_MMA(0, 0, At, B0); PG8_BAR; PG8_SCHED;
            PG8_LDB(B1, 0, 1); PG8_STAGE(PG8_SB(0, 0), b2, voffB);
            PG8_BAR; PG8_WAIT_L(0); PG8_MMA(0, 1, At, B1); PG8_BAR;
            PG8_LDA(At, 0, 1); PG8_STAGE(PG8_SA(0, 0), a2, voffA);
            PG8_BAR; PG8_WAIT_L(0); PG8_MMA(1, 0, At, B0); PG8_BAR; PG8_SCHED;
            PG8_STAGE(PG8_SB(0, 1), b2 + hstep, voffB);
            PG8_WAIT_V(6); PG8_BAR; PG8_MMA(1, 1, At, B1); PG8_BAR;
            PG8_LDB(B0, 1, 0); PG8_SCHED; PG8_LDA(At, 1, 0); PG8_STAGE(PG8_SA(0, 1), a2 + hstep, voffA);
            PG8_WAIT_L(8); PG8_BAR; PG8_WAIT_L(0); PG8_MMA(0, 0, At, B0); PG8_BAR; PG8_SCHED;
            PG8_LDB(B1, 1, 1); PG8_STAGE(PG8_SB(1, 0), b3, voffB);
            PG8_BAR; PG8_WAIT_L(0); PG8_MMA(0, 1, At, B1); PG8_BAR;
            PG8_LDA(At, 1, 1); PG8_STAGE(PG8_SA(1, 0), a3, voffA);
            PG8_BAR; PG8_WAIT_L(0); PG8_MMA(1, 0, At, B0); PG8_BAR; PG8_SCHED;
            PG8_STAGE(PG8_SB(1, 1), b3 + hstep, voffB);
            PG8_WAIT_V(6); PG8_BAR; PG8_MMA(1, 1, At, B1); PG8_BAR;
            }
        }
        if constexpr (ALIGN_EPI) { if (wr == 0) PG8_BAR; }
        if constexpr (!Epi::AFTER_DRAIN) { E(acc, cur, wr, wc, fr, fq); S.done(cur); }
        if (!has_next) break;
#pragma unroll
        for (int a = 0; a < 2; ++a)
#pragma unroll
            for (int b = 0; b < 2; ++b)
#pragma unroll
                for (int m = 0; m < 4; ++m)
#pragma unroll
                    for (int n = 0; n < 2; ++n) acc[a][b][m][n] = (f32x4){0.f, 0.f, 0.f, 0.f};
        cur = nxt; cA = nA; cB = nB; ++ui;
        if constexpr (ALIGN_EPI) { if (wr == 1) PG8_BAR; }
    }
    PG8_WAIT_V(0);
    if constexpr (!ALIGN_EPI) { if (wr == 0) PG8_BAR; }
    PG8_BAR;
    if constexpr (Epi::AFTER_DRAIN) { E.fused(acc, cur, wr, wc, fr, fq, lds, wid, lane); S.done(cur); }
#undef PG8_SA
#undef PG8_SB
#undef PG8_STAGE
#undef PG8_LDA
#undef PG8_LDB
#undef PG8_MMA
#undef PG8_WAIT_V
#undef PG8_WAIT_L
#undef PG8_BAR
#undef PG8_SCHED
}
}
#include <hip/hip_bf16.h>
#include <cmath>
namespace attn_body {
using bf16=__hip_bfloat16;
using bf16x8=__attribute__((ext_vector_type(8)))short;
using s16x4=__attribute__((ext_vector_type(4)))short;
using f32x16=__attribute__((ext_vector_type(16)))float;
using u32x4=__attribute__((ext_vector_type(4)))unsigned;
constexpr int D=64,QP=512,KP=512,VP=128,OP=1024;
constexpr int NW=8,QBLK=32,QB=QBLK*NW,KVBLK=64;
constexpr int ATTN_UNIT_ROWS=QB;
__device__ __forceinline__ int crow(int r,int hi){return (r&3)+8*(r>>2)+4*hi;}
#define SBAR() __builtin_amdgcn_sched_barrier(0)
__device__ __forceinline__ void cmask(f32x16&p0,f32x16&p1,int jb,int qrel,int hi){
  const float NEG=-INFINITY; int kb=64*jb+4*hi;
  #pragma unroll
  for(int r=0;r<16;++r){int kv=kb+(r&3)+8*(r>>2); if(kv>qrel)p0[r]=NEG; if(kv+32>qrel)p1[r]=NEG;}
}

constexpr int NSLOT=3, SLOTB=8192;
constexpr int LDS_K=0, LDS_V=NSLOT*SLOTB, LDS_WS=2*NSLOT*SLOTB, LDS_OST=LDS_WS+NW*64*4, LDS_BYTES=LDS_OST+NW*4096;
constexpr float C2=0.125f*1.4426950408889634f;
__device__ __forceinline__ void glds16(const void*gsrc,unsigned lds_dst){unsigned keep;
  asm volatile("s_mov_b32 %0, m0\n\ts_mov_b32 m0, %2\n\ts_nop 0\n\tglobal_load_lds_dwordx4 %1, off\n\ts_mov_b32 m0, %0":"=&s"(keep):"v"(gsrc),"s"(lds_dst):"memory");}
__device__ __forceinline__ float max3f(float a,float b,float c){float r;asm("v_max3_f32 %0, %1, %2, %3":"=v"(r):"v"(a),"v"(b),"v"(c));return r;}
__device__ __forceinline__ float max2f(float a,float b){float r;asm("v_max_f32_e32 %0, %1, %2":"=v"(r):"v"(a),"v"(b));return r;}
__device__ __forceinline__ float fadd_s(float a,float b){float r;asm("v_add_f32_e32 %0, %1, %2":"=v"(r):"v"(a),"v"(b));return r;}
__device__ __forceinline__ float fsub_s(float a,float b){float r;asm("v_sub_f32_e32 %0, %1, %2":"=v"(r):"v"(a),"v"(b));return r;}
typedef float f32x2_t __attribute__((ext_vector_type(2))); typedef __bf16 bf16x2_t __attribute__((ext_vector_type(2)));
__device__ __forceinline__ unsigned cvtpk_s(float lo,float hi){f32x2_t v={lo,hi};bf16x2_t b=__builtin_convertvector(v,bf16x2_t);return __builtin_bit_cast(unsigned,b);}
#define WAIT_BAR(N) asm volatile("s_waitcnt vmcnt(" #N ") lgkmcnt(0)\n\ts_barrier":::"memory")

__device__ __forceinline__ void qkt(f32x16&p0,f32x16&p1,const char*Kslot,const bf16x8*qr,const f32x16&negm,int r32,int hi){
  const char*kb=Kslot+hi*1024+r32*16;
  #pragma unroll
  for(int d0=0;d0<4;++d0){
    const bf16x8 b0=*reinterpret_cast<const bf16x8*>(kb+d0*2048);
    const bf16x8 b1=*reinterpret_cast<const bf16x8*>(kb+d0*2048+512);
    if(d0==0){p0=__builtin_amdgcn_mfma_f32_32x32x16_bf16(b0,qr[0],negm,0,0,0);p1=__builtin_amdgcn_mfma_f32_32x32x16_bf16(b1,qr[0],negm,0,0,0);}
    else{p0=__builtin_amdgcn_mfma_f32_32x32x16_bf16(b0,qr[d0],p0,0,0,0);p1=__builtin_amdgcn_mfma_f32_32x32x16_bf16(b1,qr[d0],p1,0,0,0);}}
}
typedef __attribute__((address_space(3))) const char* lds_cptr;
typedef short v4i16_t __attribute__((ext_vector_type(4)));
__device__ __forceinline__ void kload8(bf16x8*kf,lds_cptr kp){
  kf[0]=*(const __attribute__((address_space(3))) bf16x8*)(kp);      kf[1]=*(const __attribute__((address_space(3))) bf16x8*)(kp+512);
  kf[2]=*(const __attribute__((address_space(3))) bf16x8*)(kp+2048); kf[3]=*(const __attribute__((address_space(3))) bf16x8*)(kp+2560);
  kf[4]=*(const __attribute__((address_space(3))) bf16x8*)(kp+4096); kf[5]=*(const __attribute__((address_space(3))) bf16x8*)(kp+4608);
  kf[6]=*(const __attribute__((address_space(3))) bf16x8*)(kp+6144); kf[7]=*(const __attribute__((address_space(3))) bf16x8*)(kp+6656);
}
__device__ __forceinline__ void kload2(bf16x8*kf,lds_cptr kp,int j){ kf[2*j]=*(const __attribute__((address_space(3))) bf16x8*)(kp+j*2048); kf[2*j+1]=*(const __attribute__((address_space(3))) bf16x8*)(kp+j*2048+512); }
__device__ __forceinline__ s16x4 vtr(lds_cptr p){ return __builtin_bit_cast(s16x4,__builtin_amdgcn_ds_read_tr16_b64_v4i16((__attribute__((address_space(3))) v4i16_t*)p)); }
__device__ __forceinline__ float rowmax(const f32x16&p0,const f32x16&p1){
  float a=max3f(p0[0],p0[1],p1[0]),b=max3f(p0[2],p0[3],p1[1]);a=max3f(a,p1[2],p1[3]);
  #pragma unroll
  for(int r=4;r<16;r+=4){a=max3f(a,p0[r],p0[r+1]);b=max3f(b,p0[r+2],p0[r+3]);a=max3f(a,p1[r],p1[r+1]);b=max3f(b,p1[r+2],p1[r+3]);}
  const float m=max2f(a,b);
  auto rr=__builtin_amdgcn_permlane32_swap(__float_as_uint(m),__float_as_uint(m),false,false);
  return max2f(__uint_as_float(rr[0]),__uint_as_float(rr[1]));
}
__device__ __forceinline__ void pv(f32x16*o,int vb,bf16x8 pa0,bf16x8 pa1,bf16x8 pa2,bf16x8 pa3){
  #pragma unroll
  for(int d0=0;d0<2;++d0){s16x4 lo[4],hi[4];
    #pragma unroll
    for(int ks=0;ks<4;++ks){
      asm volatile("ds_read_b64_tr_b16 %0,%1 offset:%c2":"=&v"(lo[ks]):"v"(vb),"i"(d0*4096+ks*1024):"memory");
      asm volatile("ds_read_b64_tr_b16 %0,%1 offset:%c2":"=&v"(hi[ks]):"v"(vb),"i"(d0*4096+ks*1024+512):"memory");}
    asm volatile("s_waitcnt lgkmcnt(0)":::"memory");SBAR();
    #define PK(k) (bf16x8){lo[k][0],lo[k][1],lo[k][2],lo[k][3],hi[k][0],hi[k][1],hi[k][2],hi[k][3]}
    o[d0]=__builtin_amdgcn_mfma_f32_32x32x16_bf16(pa0,PK(0),o[d0],0,0,0);
    o[d0]=__builtin_amdgcn_mfma_f32_32x32x16_bf16(pa1,PK(1),o[d0],0,0,0);
    o[d0]=__builtin_amdgcn_mfma_f32_32x32x16_bf16(pa2,PK(2),o[d0],0,0,0);
    o[d0]=__builtin_amdgcn_mfma_f32_32x32x16_bf16(pa3,PK(3),o[d0],0,0,0);
    #undef PK
  }
}

#ifndef ATTN_STORE16
#define ATTN_STORE16(p,v) (*(u32x4*)(p)=(v))
#endif
template<int THRL> __device__ __forceinline__ void attn_unit(int rowbase_i,int S,int qb,int qcol,int kcol,int vcol,int ocol,const bf16*Q,const bf16*__restrict__ K,const bf16*__restrict__ V,bf16*O,char*shm){
  int tid_o=threadIdx.x; asm volatile("":"+v"(tid_o)); const int tid=tid_o,lane=tid&63,r32=lane&31,hi=lane>>5; const int wid=__builtin_amdgcn_readfirstlane(tid>>6);
  const long rowbase=(long)rowbase_i; const int q0=qb*QB;
  const bf16*Qw=Q+(rowbase+q0+wid*QBLK)*QP+qcol;
  const bf16*Kh=K+rowbase*KP+kcol,*Vh=V+rowbase*VP+vcol;
  const unsigned lds0=(unsigned)(uintptr_t)shm;
  float*wsf=(float*)(shm+LDS_WS)+wid*64;
  const bf16*ksrc=Kh+(long)lane*KP+wid*8;
  const bf16*vsrc=Vh+(long)(16*(wid&3)+(lane>>2))*VP+(wid>>2)*32+(lane&3)*8;
  const unsigned kdst=lds0+LDS_K+wid*1024, vdst=lds0+LDS_V+wid*1024;
  #define DMA_K(t,slot) glds16(ksrc+(long)(t)*KVBLK*KP,(unsigned)__builtin_amdgcn_readfirstlane(kdst+(slot)))
  #define DMA_V(t,slot) glds16(vsrc+(long)(t)*KVBLK*VP,(unsigned)__builtin_amdgcn_readfirstlane(vdst+(slot)))
  const int vb0=(int)(lds0+LDS_V)+((lane>>4)&1)*32+(lane&3)*8+(4*hi+((lane&15)>>2))*64;
  const char*Kbase=shm+LDS_K; bf16x8 kf[8];
  const lds_cptr shm3=(lds_cptr)shm; const lds_cptr kp0=shm3+LDS_K+hi*1024+r32*16; const lds_cptr vp0=shm3+LDS_V+((lane>>4)&1)*32+(lane&3)*8+(4*hi+((lane&15)>>2))*64;
  const int NT=S/KVBLK;
  DMA_K(0,0);DMA_V(0,0);DMA_K(1,SLOTB);
  bf16x8 qr[4];
  #pragma unroll
  for(int d0=0;d0<4;++d0)qr[d0]=*reinterpret_cast<const bf16x8*>(&Qw[(long)r32*QP+d0*16+hi*8]);
  float mhat=0.f,l_reg=0.f;f32x16 o[2];o[0]=f32x16{};o[1]=f32x16{};f32x16 negm=f32x16{};asm volatile("":"+v"(negm));
  const int qrel=wid*QBLK+r32;
  #define CMASK(P0,P1,t) do{}while(0)
  bool resc=false;
  #define START(P0,P1) do{ const float rm=rowmax(P0,P1); resc=false; \
    { const float dl=rm; mhat=fadd_s(mhat,dl); \
      _Pragma("unroll") for(int r=0;r<16;++r){P0[r]=fsub_s(P0[r],dl);P1[r]=fsub_s(P1[r],dl);} \
      _Pragma("unroll") for(int r=0;r<16;++r)negm[r]=-mhat; asm volatile("":"+v"(negm)); } \
    _Pragma("unroll") for(int r=0;r<16;++r)P0[r]=__builtin_amdgcn_exp2f(P0[r]); }while(0)
  #define RESC() do{ if(resc){ asm volatile("s_waitcnt lgkmcnt(0)":::"memory"); \
      _Pragma("unroll") for(int d_=0;d_<2;++d_) _Pragma("unroll") for(int r=0;r<16;++r)o[d_][r]*=wsf[crow(r,hi)]; } }while(0)
  f32x16 pA0,pA1,pB0,pB1;
  int sl_prev=0,sl_cur=0,sl_next=SLOTB;
  #define ROT() do{sl_prev=sl_cur;sl_cur=sl_next;sl_next=(sl_next==(NSLOT-1)*SLOTB)?0:sl_next+SLOTB;}while(0)
  DMA_K(2,2*SLOTB);
  WAIT_BAR(3);
  qkt(pA0,pA1,Kbase,qr,negm,r32,hi);asm volatile("s_nop 15\n\ts_nop 7":"+v"(pA0),"+v"(pA1));CMASK(pA0,pA1,0);
  START(pA0,pA1);
  _Pragma("unroll") for(int r=0;r<16;++r)pA1[r]=__builtin_amdgcn_exp2f(pA1[r]);
  WAIT_BAR(0);
  DMA_K(3,0);DMA_V(1,SLOTB);
  ROT();
  kload8(kf,kp0+sl_cur);
  WAIT_BAR(2);
  s16x4 vlo[8],vhi[8]; u32x4 pw0,pw1,pw2,pw3;
  #define PKW(P,B) cvtpk_s(P[B],P[B+1])
  #define PAF(k) __builtin_bit_cast(bf16x8,pw##k)
  #define VFR(i) (bf16x8){vlo[i][0],vlo[i][1],vlo[i][2],vlo[i][3],vhi[i][0],vhi[i][1],vhi[i][2],vhi[i][3]}
  #define PIN(x) asm volatile("":"+v"(x))
  #define MX3(a,b,c) __builtin_fmaxf(__builtin_fmaxf((a),(b)),(c))
  #define GAPA(MF,A0,A1,A2,A3,W0,W1,PW) do{ MF; sacc+=A0; sacc+=A1; sacc+=A2; sacc+=A3; PIN(sacc); W0; W1; PIN(PW); SBAR(); }while(0)
  #define EX(v) __builtin_amdgcn_exp2f(v)
  #define GAPB(MF,X,B) do{ MF; X[B]=EX(X[B]); X[B+1]=EX(X[B+1]); X[B+2]=EX(X[B+2]); X[B+3]=EX(X[B+3]); PIN(X); SBAR(); }while(0)
  #define VRD(i) do{ vlo[i]=vtr(vp_+(((i)>>2)*4096+((i)&3)*1024)); vhi[i]=vtr(vp_+(((i)>>2)*4096+((i)&3)*1024+512)); }while(0)
  #define KRD(G,j) do{ if(G){ kload2(kf,kp0+sl_next,j); SBAR(); } }while(0)
  #define STEP(C0,C1,P0,P1,t,GK,GV,GL) do{ SBAR(); \
    const lds_cptr vp_=vp0+sl_prev; \
    VRD(0); SBAR(); float sacc=(P0[0]+P0[1]); \
    GAPA(C0=__builtin_amdgcn_mfma_f32_32x32x16_bf16(kf[0],qr[0],negm,0,0,0), P0[2],P0[3],P0[4],P0[5],     pw0[0]=PKW(P0,0), pw0[1]=PKW(P0,2), pw0); \
    VRD(4); SBAR(); GAPA(C1=__builtin_amdgcn_mfma_f32_32x32x16_bf16(kf[1],qr[0],negm,0,0,0), P0[6],P0[7],P0[8],P0[9],     pw0[2]=PKW(P0,4), pw0[3]=PKW(P0,6), pw0); \
    VRD(1); SBAR(); GAPA(C0=__builtin_amdgcn_mfma_f32_32x32x16_bf16(kf[2],qr[1],C0,0,0,0),   P0[10],P0[11],P0[12],P0[13], pw1[0]=PKW(P0,8), pw1[1]=PKW(P0,10), pw1); \
    VRD(5); SBAR(); GAPA(C1=__builtin_amdgcn_mfma_f32_32x32x16_bf16(kf[3],qr[1],C1,0,0,0),   P0[14],P0[15],P1[0],P1[1],   pw1[2]=PKW(P0,12),pw1[3]=PKW(P0,14), pw1); \
    VRD(2); SBAR(); GAPA(C0=__builtin_amdgcn_mfma_f32_32x32x16_bf16(kf[4],qr[2],C0,0,0,0),   P1[2],P1[3],P1[4],P1[5],     pw2[0]=PKW(P1,0), pw2[1]=PKW(P1,2), pw2); \
    VRD(6); SBAR(); GAPA(C1=__builtin_amdgcn_mfma_f32_32x32x16_bf16(kf[5],qr[2],C1,0,0,0),   P1[6],P1[7],P1[8],P1[9],     pw2[2]=PKW(P1,4), pw2[3]=PKW(P1,6), pw2); \
    VRD(3); SBAR(); GAPA(C0=__builtin_amdgcn_mfma_f32_32x32x16_bf16(kf[6],qr[3],C0,0,0,0),   P1[10],P1[11],P1[12],P1[13], pw3[0]=PKW(P1,8), pw3[1]=PKW(P1,10), pw3); \
    VRD(7); SBAR(); GAPA(C1=__builtin_amdgcn_mfma_f32_32x32x16_bf16(kf[7],qr[3],C1,0,0,0),   P1[14],P1[15],0.f,0.f,       pw3[2]=PKW(P1,12),pw3[3]=PKW(P1,14), pw3); \
    l_reg+=sacc; \
    if(GK){DMA_K((t)+3,sl_cur);} if(GV){DMA_V((t)+1,sl_next);} \
    CMASK(C0,C1,t); \
    { float a=MX3(C0[0],C0[1],C1[0]),b=MX3(C0[2],C0[3],C1[1]); a=MX3(a,C1[2],C1[3]); \
      _Pragma("unroll") for(int r=4;r<16;r+=4){a=MX3(a,C0[r],C0[r+1]);b=MX3(b,C0[r+2],C0[r+3]);a=MX3(a,C1[r],C1[r+1]);b=MX3(b,C1[r+2],C1[r+3]);} \
      float rm=__builtin_fmaxf(a,b); { auto rr=__builtin_amdgcn_permlane32_swap(__float_as_uint(rm),__float_as_uint(rm),false,false); rm=__builtin_fmaxf(__uint_as_float(rr[0]),__uint_as_float(rr[1])); } \
      resc=false; \
      if(__builtin_expect(__any(rm>(float)THRL),0)){ const float dl=__builtin_fmaxf(rm,0.f); mhat+=dl; \
        _Pragma("unroll") for(int r=0;r<16;++r){C0[r]-=dl;C1[r]-=dl;} \
        _Pragma("unroll") for(int r=0;r<16;++r)negm[r]=-mhat; asm volatile("":"+v"(negm)); \
        const float f=__builtin_amdgcn_exp2f(-dl); l_reg*=f; if(hi==0)wsf[r32]=f; resc=true; } } \
    SBAR(); \
    GAPB(o[0]=__builtin_amdgcn_mfma_f32_32x32x16_bf16(PAF(0),VFR(0),o[0],0,0,0), C0,0); \
    GAPB(o[1]=__builtin_amdgcn_mfma_f32_32x32x16_bf16(PAF(0),VFR(4),o[1],0,0,0), C0,4); \
    KRD(GL,0); GAPB(o[0]=__builtin_amdgcn_mfma_f32_32x32x16_bf16(PAF(1),VFR(1),o[0],0,0,0), C0,8); \
    KRD(GL,1); GAPB(o[1]=__builtin_amdgcn_mfma_f32_32x32x16_bf16(PAF(1),VFR(5),o[1],0,0,0), C0,12); \
    KRD(GL,2); GAPB(o[0]=__builtin_amdgcn_mfma_f32_32x32x16_bf16(PAF(2),VFR(2),o[0],0,0,0), C1,0); \
    KRD(GL,3); GAPB(o[1]=__builtin_amdgcn_mfma_f32_32x32x16_bf16(PAF(2),VFR(6),o[1],0,0,0), C1,4); \
    GAPB(o[0]=__builtin_amdgcn_mfma_f32_32x32x16_bf16(PAF(3),VFR(3),o[0],0,0,0), C1,8); \
    GAPB(o[1]=__builtin_amdgcn_mfma_f32_32x32x16_bf16(PAF(3),VFR(7),o[1],0,0,0), C1,12); \
    }while(0)
  int t=1;
  #undef CMASK
  #define CMASK(P0,P1,t) do{}while(0)
  for(;t+5<NT;t+=2){
    STEP(pB0,pB1,pA0,pA1,t,true,true,true);     WAIT_BAR(2); RESC(); ROT();
    STEP(pA0,pA1,pB0,pB1,t+1,true,true,true);   WAIT_BAR(2); RESC(); ROT();
  }
  #undef CMASK
  #define CMASK(P0,P1,t) do{}while(0)
  #define ENDW(tt) do{ if((tt)+3<NT){WAIT_BAR(2);} else if((tt)+2<NT){WAIT_BAR(1);} else {WAIT_BAR(0);} }while(0)
  for(;t+1<NT;t+=2){
    STEP(pB0,pB1,pA0,pA1,t,(t+3<NT),(t+1<NT),(t+1<NT));       ENDW(t);   RESC(); ROT();
    STEP(pA0,pA1,pB0,pB1,t+1,(t+4<NT),(t+2<NT),(t+2<NT));     ENDW(t+1); RESC(); ROT();
  }
  STEP(pB0,pB1,pA0,pA1,NT-1,false,false,false); RESC();
  { float sacc=pB0[0]+pB0[1]; _Pragma("unroll") for(int r=2;r<16;++r)sacc+=pB0[r]; _Pragma("unroll") for(int r=0;r<16;++r)sacc+=pB1[r]; l_reg+=sacc;
    pw0=(u32x4){PKW(pB0,0),PKW(pB0,2),PKW(pB0,4),PKW(pB0,6)};pw1=(u32x4){PKW(pB0,8),PKW(pB0,10),PKW(pB0,12),PKW(pB0,14)};pw2=(u32x4){PKW(pB1,0),PKW(pB1,2),PKW(pB1,4),PKW(pB1,6)};pw3=(u32x4){PKW(pB1,8),PKW(pB1,10),PKW(pB1,12),PKW(pB1,14)};
    SBAR(); pv(o,vb0+sl_cur,PAF(0),PAF(1),PAF(2),PAF(3)); }
  #undef PKW
  #undef PAF
  #undef VFR
  #undef PIN
  #undef MX3
  #undef GAPA
  #undef GAPB
  #undef EX
  #undef VRD
  #undef KRD
  #undef STEP
  #undef ENDW
  {auto rr=__builtin_amdgcn_permlane32_swap(__float_as_uint(l_reg),__float_as_uint(l_reg),false,false);l_reg=__uint_as_float(rr[0])+__uint_as_float(rr[1]);}
  if(hi==0)wsf[32+r32]=l_reg;asm volatile("s_waitcnt lgkmcnt(0)":::"memory");
  float rli[16];
  #pragma unroll
  for(int r=0;r<16;++r)rli[r]=__builtin_amdgcn_rcpf(wsf[32+crow(r,hi)]);
  bf16*Ow=O+(rowbase+q0+wid*QBLK)*OP+ocol;
  { bf16*stg=(bf16*)(shm+LDS_OST)+wid*2048;
    #pragma unroll
    for(int r=0;r<16;++r){const int orow=crow(r,hi);
      #pragma unroll
      for(int d0=0;d0<2;++d0)stg[orow*64+d0*32+r32]=__float2bfloat16(o[d0][r]*rli[r]);}
    asm volatile("s_waitcnt lgkmcnt(0)":::"memory");
    #pragma unroll
    for(int i=0;i<4;++i){const int row=i*8+(lane>>3),ch=lane&7; const u32x4 v=*(const u32x4*)(stg+row*64+ch*8); ATTN_STORE16(Ow+(long)row*OP+ch*8,v);} }
  asm volatile("s_waitcnt lgkmcnt(0)\n\ts_barrier":::"memory");
  #undef DMA_K
  #undef DMA_V
  #undef CMASK
  #undef START
  #undef RESC
  #undef ROT
}
constexpr int ATTN_LDS_BYTES=LDS_BYTES;
#undef SBAR
#undef WAIT_BAR
}

#define LAS __attribute__((address_space(3)))
#define LDS_BARRIER() asm volatile("s_waitcnt lgkmcnt(0)\n\ts_barrier" ::: "memory")
typedef unsigned short bf16;
typedef unsigned u32x4_t __attribute__((ext_vector_type(4)));
typedef unsigned u32x2_t __attribute__((ext_vector_type(2)));
typedef float f32x4_t __attribute__((ext_vector_type(4)));
typedef float f32x2_t __attribute__((ext_vector_type(2)));

constexpr int DM = 1024, MTOK = 49152, NSEQ = 20, DFF = 2816, NFF = 5632, NMIXP = 2560, NMIX = 2432, ZP = 1792;
constexpr int NTHR = 512;
constexpr float QSCALE = 0.125f * 1.4426950408889634f;
constexpr size_t MiB = 1u << 20;
constexpr size_t ZERO_BYTES = 8 * MiB;
constexpr size_t OFF_CTR = 0, OFF_ROPE = 32768, OFF_SS = 65536, OFF_MOD = 2 * MiB, OFF_BIAS = 4 * MiB, OFF_GV = 7 * MiB, OFF_GATE = 7 * MiB + 512 * 1024;
constexpr size_t OFF_W = 8 * MiB, W_LAYER = 40 * MiB;
constexpr size_t WO_IN = 0, WO_OUT = 22 * MiB, WO_MI = 33 * MiB, WO_MO = 38 * MiB;
constexpr size_t OFF_XN = 88 * MiB, OFF_YF = 88 * MiB, OFF_YB = 136 * MiB;
constexpr size_t OFF_HID = 184 * MiB, OFF_Z = 184 * MiB, OFF_QK = 352 * MiB, OFF_VR = 400 * MiB, OFF_OMIX = 412 * MiB, WS_END = 508 * MiB;
constexpr size_t OFF_SMID = 508 * MiB;
constexpr int LDS_BYTES = 147456, MISC_OFF = 131072;

struct KP { const float* in[31]; float* out; unsigned char* ws; };

__device__ __forceinline__ int seq_of_row(int m) { return m < 16384 ? (m >> 12) : 4 + ((m - 16384) >> 11); }
__device__ __forceinline__ int seq_start(int s) { return s < 4 ? s * 4096 : 16384 + (s - 4) * 2048; }
__device__ __forceinline__ int seq_len(int s) { return s < 4 ? 4096 : 2048; }
__device__ __forceinline__ unsigned f2bf(float f) { unsigned u = __builtin_bit_cast(unsigned, f); return (u + 0x7fffu + ((u >> 16) & 1u)) >> 16; }
__device__ __forceinline__ unsigned pk2(float lo, float hi) { return f2bf(lo) | (f2bf(hi) << 16); }
__device__ __forceinline__ float bf2f(unsigned short b) { return __builtin_bit_cast(float, (unsigned)b << 16); }
__device__ __forceinline__ float sigmoidf_(float x) { return __builtin_amdgcn_rcpf(1.0f + __builtin_amdgcn_exp2f(-1.4426950408889634f * x)); }
#define DPP_ADD(v, CTRL) ((v) + __builtin_bit_cast(float, __builtin_amdgcn_update_dpp(0, __builtin_bit_cast(int, (v)), (CTRL), 0xf, 0xf, false)))
__device__ __forceinline__ float wave_sum(float v) {
    v = DPP_ADD(v, 0xB1);
    v = DPP_ADD(v, 0x4E);
    v = DPP_ADD(v, 0x141);
    v = DPP_ADD(v, 0x140);
    const f32x4_t d = __builtin_amdgcn_mfma_f32_16x16x4f32(1.0f, v, (f32x4_t){0.f, 0.f, 0.f, 0.f}, 0, 0, 0);
    return d[0];
}
__device__ __forceinline__ float tanh_fast(float x) { const float e = __expf(2.0f * x); return 1.0f - 2.0f * __builtin_amdgcn_rcpf(e + 1.0f); }
__host__ __device__ __forceinline__ int map_ffn(int n) { const int half = n >= DFF ? 1 : 0; const int n2 = half ? n - DFF : n; return 256 * (n2 >> 7) + 128 * half + (n2 & 127); }
__host__ __device__ __forceinline__ int map_mix(int n) {
    if (n < 1792 || n >= 2304) return n;
    const int hh = (n - 1792) >> 6, d = (n - 1792) & 63;
    return 256 * (7 + (hh >> 2)) + 128 * (d >> 5) + 32 * (hh & 3) + 8 * ((d & 15) >> 2) + 4 * ((d >> 4) & 1) + (d & 3);
}

namespace pg8 {
struct EpiSwiglu {
    static constexpr bool PERM = true, AFTER_DRAIN = false;
    bf16_t* H; const float* ss; const float* bias;
    __device__ __forceinline__ void operator()(const f32x4 (&acc)[2][2][4][2], const Unit& u, int wr, int wc, int fr, int fq) const {
        const int row0 = u.pm * BM + wr * 64 + fr; const int s = seq_of_row(u.pm * BM);
        const float* bp = bias + (size_t)s * NFF + u.pn * 256 + wc * 32 + 8 * fq;
        f32x4 bg[2], bu[2];
#pragma unroll
        for (int n = 0; n < 2; ++n) { bg[n] = *(const f32x4*)(bp + 4 * n); bu[n] = *(const f32x4*)(bp + 128 + 4 * n); }
        float rsv[2][4];
#pragma unroll
        for (int ai = 0; ai < 2; ++ai)
#pragma unroll
            for (int m = 0; m < 4; ++m) rsv[ai][m] = ss[row0 + ai * HALF + m * 16];
        asm volatile("" ::: "memory");
#pragma unroll
        for (int ai = 0; ai < 2; ++ai)
#pragma unroll
            for (int m = 0; m < 4; ++m) {
                const int row = row0 + ai * HALF + m * 16;
                const float rs = rsqrtf(rsv[ai][m] * (1.0f / 1024.0f) + 1e-6f);
                float h[8];
#pragma unroll
                for (int n = 0; n < 2; ++n) {
                    const f32x4 g = acc[ai][0][m][n] * rs + bg[n], up = acc[ai][1][m][n] * rs + bu[n];
#pragma unroll
                    for (int i = 0; i < 4; ++i) h[4 * n + i] = g[i] * sigmoidf_(g[i]) * up[i];
                }
                u32x4 w; w.x = cvt_pk_bf16(h[0], h[1]); w.y = cvt_pk_bf16(h[2], h[3]); w.z = cvt_pk_bf16(h[4], h[5]); w.w = cvt_pk_bf16(h[6], h[7]);
                *(u32x4*)(H + (size_t)row * DFF + u.pn * 128 + wc * 32 + 8 * fq) = w;
            }
    }
};
struct EpiZ {
    static constexpr bool PERM = true, AFTER_DRAIN = false;
    bf16_t* Z; bf16_t* QK; bf16_t* VR; const float* ss; const float* bias; const float* qg; const float* kg; const float* rope;
    __device__ __forceinline__ void operator()(const f32x4 (&acc)[2][2][4][2], const Unit& u, int wr, int wc, int fr, int fq) const {
        const int row0 = u.pm * BM + wr * 64 + fr; const int s = seq_of_row(u.pm * BM); const int t0 = row0 - seq_start(s);
        const float* bp = bias + (size_t)s * NFF + u.pn * 256 + wc * 32 + 8 * fq;
        f32x4 bv[2][2];
#pragma unroll
        for (int bj = 0; bj < 2; ++bj)
#pragma unroll
            for (int n = 0; n < 2; ++n) bv[bj][n] = *(const f32x4*)(bp + bj * 128 + 4 * n);
        if (u.pn < 7 || u.pn == 9) {
            float rsv[2][4];
#pragma unroll
            for (int ai = 0; ai < 2; ++ai)
#pragma unroll
                for (int m = 0; m < 4; ++m) rsv[ai][m] = ss[row0 + ai * HALF + m * 16];
            asm volatile("" ::: "memory");
#pragma unroll
            for (int ai = 0; ai < 2; ++ai)
#pragma unroll
                for (int m = 0; m < 4; ++m) {
                    const int row = row0 + ai * HALF + m * 16;
                    const float rs = rsqrtf(rsv[ai][m] * (1.0f / 1024.0f) + 1e-6f);
#pragma unroll
                    for (int bj = 0; bj < 2; ++bj) {
                        const f32x4 v0 = acc[ai][bj][m][0] * rs + bv[bj][0], v1 = acc[ai][bj][m][1] * rs + bv[bj][1];
                        u32x4 w; w.x = cvt_pk_bf16(v0[0], v0[1]); w.y = cvt_pk_bf16(v0[2], v0[3]); w.z = cvt_pk_bf16(v1[0], v1[1]); w.w = cvt_pk_bf16(v1[2], v1[3]);
                        if (u.pn < 7) *(u32x4*)(Z + (size_t)row * ZP + u.pn * 256 + bj * 128 + wc * 32 + 8 * fq) = w;
                        else if (bj == 0) *(u32x4*)(VR + (size_t)row * 128 + wc * 32 + 8 * fq) = w;
                    }
                }
        } else {
            const int hh = (u.pn - 7) * 4 + wc; const bool isq = hh < 6; const float* gp = isq ? qg : kg; const float osc = isq ? QSCALE : 1.0f;
            f32x4 gn[2][2];
#pragma unroll
            for (int bj = 0; bj < 2; ++bj)
#pragma unroll
                for (int n = 0; n < 2; ++n) gn[bj][n] = *(const f32x4*)(gp + 32 * bj + 16 * n + 4 * fq);
#pragma unroll
            for (int ai = 0; ai < 2; ++ai)
#pragma unroll
                for (int m = 0; m < 4; ++m) {
                    const int row = row0 + ai * HALF + m * 16; const int t = t0 + ai * HALF + m * 16;
                    const float rs = rsqrtf(ss[row] * (1.0f / 1024.0f) + 1e-6f);
                    f32x4 v[2][2]; float q = 0.f;
#pragma unroll
                    for (int bj = 0; bj < 2; ++bj)
#pragma unroll
                        for (int n = 0; n < 2; ++n) { v[bj][n] = acc[ai][bj][m][n] * rs + bv[bj][n]; q += (v[bj][n][0] * v[bj][n][0] + v[bj][n][1] * v[bj][n][1]) + (v[bj][n][2] * v[bj][n][2] + v[bj][n][3] * v[bj][n][3]); }
                    q += __shfl_xor(q, 16); q += __shfl_xor(q, 32);
                    const float r = rsqrtf(q * (1.0f / 64.0f) + 1e-6f);
#pragma unroll
                    for (int bj = 0; bj < 2; ++bj) {
                        const int pos = bj == 0 ? (t >> 6) : (t & 63);
                        const f32x4 x1 = v[bj][0] * r * gn[bj][0], x2 = v[bj][1] * r * gn[bj][1];
                        const float* rp = rope + (pos * 16 + 4 * fq) * 2;
                        const f32x4 cs0 = *(const f32x4*)(rp), cs1 = *(const f32x4*)(rp + 4);
                        const float c[4] = {cs0[0], cs0[2], cs1[0], cs1[2]}, sn[4] = {cs0[1], cs0[3], cs1[1], cs1[3]};
                        float o1[4], o2[4];
#pragma unroll
                        for (int i = 0; i < 4; ++i) { o1[i] = (x1[i] * c[i] - x2[i] * sn[i]) * osc; o2[i] = (x2[i] * c[i] + x1[i] * sn[i]) * osc; }
                        u32x4 w; w.x = cvt_pk_bf16(o1[0], o1[1]); w.y = cvt_pk_bf16(o1[2], o1[3]); w.z = cvt_pk_bf16(o2[0], o2[1]); w.w = cvt_pk_bf16(o2[2], o2[3]);
                        *(u32x4*)(QK + (size_t)row * 512 + hh * 64 + 32 * bj + 8 * fq) = w;
                    }
                }
        }
    }
};
struct EpiResid {
    static constexpr bool PERM = false, AFTER_DRAIN = false;
    const float* xin_p; const float* xin_s; float* out; bf16_t* xn; float* ssn; const float* gate; const float* gvn;
    __device__ __forceinline__ void operator()(const f32x4 (&acc)[2][2][4][2], const Unit& u, int wr, int wc, int fr, int fq) const {
        const int rowt = u.pm * BM; const int s = seq_of_row(rowt);
        const float* xb = rowt < 16384 ? xin_p : xin_s - (size_t)16384 * DM;
        const int row0 = rowt + wr * 64 + fr; const int col0 = u.pn * BM + wc * 32 + 4 * fq;
        f32x4 gt[2][2], gv[2][2];
#pragma unroll
        for (int bj = 0; bj < 2; ++bj)
#pragma unroll
            for (int n = 0; n < 2; ++n) { gt[bj][n] = *(const f32x4*)(gate + (size_t)s * DM + col0 + bj * HALF + n * 16); gv[bj][n] = gvn ? *(const f32x4*)(gvn + (size_t)s * DM + col0 + bj * HALF + n * 16) : (f32x4){0.f, 0.f, 0.f, 0.f}; }
        f32x4 xo[2][2][2];
#define ER_LOAD(G, BUF) do { const unsigned off_ = (unsigned)(row0 + ((G) >> 2) * HALF + ((G) & 3) * 16) * DM + col0; \
            _Pragma("unroll") for (int bj = 0; bj < 2; ++bj) _Pragma("unroll") for (int n = 0; n < 2; ++n) xo[BUF][bj][n] = *(const f32x4*)(xb + off_ + bj * HALF + n * 16); } while (0)
        ER_LOAD(0, 0);
#pragma unroll
        for (int gi = 0; gi < 8; ++gi) {
            const int ai = gi >> 2, m = gi & 3;
            if (gi < 7) ER_LOAD(gi + 1, (gi + 1) & 1);
            asm volatile("" ::: "memory");
            const int row = row0 + ai * HALF + m * 16; const unsigned off = (unsigned)row * DM + col0; float q = 0.f;
#pragma unroll
            for (int bj = 0; bj < 2; ++bj)
#pragma unroll
                for (int n = 0; n < 2; ++n) {
                    const f32x4 val = xo[gi & 1][bj][n] + gt[bj][n] * acc[ai][bj][m][n];
                    *(f32x4*)(out + off + bj * HALF + n * 16) = val;
                    if (gvn) {
                        q += (val[0] * val[0] + val[1] * val[1]) + (val[2] * val[2] + val[3] * val[3]);
                        const f32x4 o = val * gv[bj][n]; unsigned long long w = (unsigned long long)cvt_pk_bf16(o[0], o[1]) | ((unsigned long long)cvt_pk_bf16(o[2], o[3]) << 32);
                        *(unsigned long long*)(xn + off + bj * HALF + n * 16) = w;
                    }
                }
            if (gvn) { q += __shfl_xor(q, 16); q += __shfl_xor(q, 32); if (fq == 0) atomicAdd(ssn + row, q); }
        }
#undef ER_LOAD
    }
};
}

template <int MAP> __device__ __forceinline__ void transpose_item(const float* W, int K, int N, bf16* WT, float* scr, int item, int lane) {
    const int nblk = N / 32, kb = item / nblk, nb = item % nblk, k0 = 64 * kb, n0 = 32 * nb;
#pragma unroll 8
    for (int i = 0; i < 32; ++i) { const int kk = 2 * i + (lane >> 5); scr[kk * 33 + (lane & 31)] = W[(size_t)(k0 + kk) * N + n0 + (lane & 31)]; }
    __builtin_amdgcn_wave_barrier(); asm volatile("s_waitcnt lgkmcnt(0)" ::: "memory");
    const int c = lane & 7;
#pragma unroll
    for (int j = 0; j < 4; ++j) { const int n = (lane >> 3) + 8 * j; const float* sp = scr + (8 * c) * 33 + n;
        u32x4_t o; o.x = pk2(sp[0 * 33], sp[1 * 33]); o.y = pk2(sp[2 * 33], sp[3 * 33]); o.z = pk2(sp[4 * 33], sp[5 * 33]); o.w = pk2(sp[6 * 33], sp[7 * 33]);
        const int nsrc = n0 + n; const int nd = MAP == 1 ? map_ffn(nsrc) : (MAP == 2 ? map_mix(nsrc) : nsrc);
        *(u32x4_t*)(WT + (size_t)nd * K + k0 + 8 * c) = o; }
    __builtin_amdgcn_wave_barrier(); asm volatile("s_waitcnt lgkmcnt(0)" ::: "memory");
}

template <int MODE, int MAP> __device__ __forceinline__ void smallm_unit(const KP& p, float* sA, int l, int j, const float* W, int ldw, int nvalid, float* dest, int ldd, int nchunk, int kchunk) {
    int tid_o = threadIdx.x; asm volatile("" : "+v"(tid_o)); const int tid = tid_o; const int k0 = kchunk * 128;
    __syncthreads();
    for (int e = tid; e < 128 * NSEQ; e += NTHR) {
        const int k = e / NSEQ, s = e % NSEQ; float v;
        if (MODE == 0) { const float c = s < 4 ? p.in[2][s * DM + k0 + k] : p.in[3][(s - 4) * DM + k0 + k]; v = c * sigmoidf_(c); }
        else { const float* mod = (const float*)(p.ws + OFF_MOD) + ((size_t)l * NSEQ + s) * 9216 + 3 * j * 1024 + k0 + k; v = *mod + p.in[5][l * 9216 + 3 * j * 1024 + k0 + k]; }
        sA[k * NSEQ + s] = v;
    }
    __syncthreads();
    const int n = nchunk * 256 + (tid & 255), kh = tid >> 8;
    float acc[NSEQ];
#pragma unroll
    for (int s = 0; s < NSEQ; ++s) acc[s] = 0.f;
    if (n < nvalid) {
        for (int kb = 0; kb < 64; kb += 16) {
            float wv[16];
#pragma unroll
            for (int u = 0; u < 16; ++u) wv[u] = W[(size_t)(k0 + kh * 64 + kb + u) * ldw + n];
#pragma unroll
            for (int u = 0; u < 16; ++u) { const int k = kh * 64 + kb + u; const float w = wv[u];
                const f32x4_t* ap = (const f32x4_t*)(sA + k * NSEQ);
#pragma unroll
                for (int q = 0; q < 5; ++q) { const f32x4_t a = ap[q]; acc[4 * q] += a[0] * w; acc[4 * q + 1] += a[1] * w; acc[4 * q + 2] += a[2] * w; acc[4 * q + 3] += a[3] * w; } }
        }
        const int nd = MAP == 1 ? map_ffn(n) : (MAP == 2 ? map_mix(n) : n);
#pragma unroll
        for (int s = 0; s < NSEQ; ++s) atomicAdd(dest + (size_t)s * ldd + nd, acc[s]);
    }
}

#define DPP_FMAC(acc, x, s, J) asm volatile("v_fmac_f32_dpp %0, %1, %2 row_newbcast:" #J " row_mask:0xf bank_mask:0xf" : "+v"(acc) : "v"(x), "v"(s))
#define DPP_FMAC_N(acc, x, s, J) asm volatile("s_nop 1\n\tv_fmac_f32_dpp %0, %1, %2 row_newbcast:" #J " row_mask:0xf bank_mask:0xf" : "+v"(acc) : "v"(x), "v"(s))
#define DPP_MUL(s, x, J) asm volatile("v_mul_f32_dpp %0, %1, %0 row_newbcast:" #J " row_mask:0xf bank_mask:0xf" : "+v"(s) : "v"(x))
#define DPP_MUL_N(s, x, J) asm volatile("s_nop 1\n\tv_mul_f32_dpp %0, %1, %0 row_newbcast:" #J " row_mask:0xf bank_mask:0xf" : "+v"(s) : "v"(x))
#define REP15(M, X) M(1, X) M(2, X) M(3, X) M(4, X) M(5, X) M(6, X) M(7, X) M(8, X) M(9, X) M(10, X) M(11, X) M(12, X) M(13, X) M(14, X) M(15, X)
__device__ __forceinline__ float row4_sum(float x) {
    auto r1 = __builtin_amdgcn_permlane16_swap(__float_as_uint(x), __float_as_uint(x), false, false); x = __uint_as_float(r1[0]) + __uint_as_float(r1[1]);
    auto r2 = __builtin_amdgcn_permlane32_swap(__float_as_uint(x), __float_as_uint(x), false, false); return __uint_as_float(r2[0]) + __uint_as_float(r2[1]);
}
__device__ __forceinline__ void rwkv_unit(const KP& p, unsigned char* lds, int l, int s, int h, int d, int mode) {
    int tid_o = threadIdx.x; asm volatile("" : "+v"(tid_o)); const int tid = tid_o, lane = tid & 63; const int wid = __builtin_amdgcn_readfirstlane(tid >> 6);
    constexpr int TB = 16;
    f32x2_t* W2 = (f32x2_t*)lds;
    float* OPS = (float*)(lds + 32768);
    float* YBUF = (float*)(lds + 32768 + 49152);
    float* PWS = (float*)(lds + 32768 + 49152 + 8192) + (wid & 3) * 1024;
    const bf16* Z = (const bf16*)(p.ws + OFF_Z);
    float* Y = (float*)(p.ws + (d == 0 ? OFF_YF : OFF_YB));
    const float* mu = p.in[18] + l * 1024;
    const float* w_up = p.in[19] + ((size_t)l * 2 + d) * 64 * 256;
    const float* a_up = p.in[21] + (size_t)l * 64 * 256;
    const int S = seq_len(s), start = seq_start(s); const int NS = mode == 0 ? S : S / 2, s0 = mode >= 2 ? S / 2 : 0; const int NB = NS / TB;
    __syncthreads();
    for (int e = tid; e < 4096; e += NTHR) { const int i = e >> 6, j = e & 63; W2[e] = (f32x2_t){w_up[i * 256 + 64 * h + j], a_up[i * 256 + 64 * h + j]}; }
    __syncthreads();
    if (wid >= 4) {
        const int pw = wid - 4;
        unsigned short* XWb = (unsigned short*)PWS; unsigned short* XAb = XWb + 256; float* KK = PWS + 256; float* UA = PWS + 512;
        typedef short bf16x8_t __attribute__((ext_vector_type(8)));
        bf16x8_t Bf[2][4][2];
        { const int kg = lane >> 4, cl = 64 * h + (lane & 15);
          _Pragma("unroll") for (int m = 0; m < 2; ++m) _Pragma("unroll") for (int ct = 0; ct < 4; ++ct) _Pragma("unroll") for (int ks = 0; ks < 2; ++ks) {
              const float* Wm = (m == 0 ? w_up : a_up) + (size_t)(32 * ks + 8 * kg) * 256 + cl + 16 * ct; u32x4_t pq;
              pq.x = pk2(Wm[0], Wm[256]); pq.y = pk2(Wm[512], Wm[768]); pq.z = pk2(Wm[1024], Wm[1280]); pq.w = pk2(Wm[1536], Wm[1792]); Bf[m][ct][ks] = __builtin_bit_cast(bf16x8_t, pq); } }
        const float w0 = p.in[20][(l * 2 + d) * 256 + 64 * h + lane], a0 = p.in[22][(l * 2 + d) * 256 + 64 * h + lane];
        const float k_k = p.in[24][l * 256 + 64 * h + lane], k_a = p.in[25][l * 256 + 64 * h + lane];
        int it_t[3], it_zc[3], it_g[3], it_w[3]; f32x4_t mu0[3], mu1[3];
#pragma unroll
        for (int i = 0; i < 3; ++i) { int e = lane + 64 * i; if (e > 159) e = 159; const int t = e / 40, c = e % 40, g = c >> 3, wi = (c & 7) * 8;
            it_t[i] = t; it_g[i] = g; it_w[i] = wi; it_zc[i] = (g == 0 ? 64 * h : g == 1 ? 256 + 64 * h : g == 2 ? 512 + 64 * h : 768 + (g - 3) * 64) + wi;
            mu0[i] = *(const f32x4_t*)(mu + it_zc[i]); mu1[i] = *(const f32x4_t*)(mu + it_zc[i] + 4); }
        u32x4_t rc[3], rp[3], rn[3];
#define RW_ISSUE(b_) do { _Pragma("unroll") for (int i = 0; i < 3; ++i) { const int si = s0 + (b_) * TB + 4 * pw + it_t[i]; const int tt = d == 0 ? si : S - 1 - si; const bf16* zp = Z + (size_t)(start + tt) * ZP + 768 + it_zc[i]; \
                rc[i] = *(const u32x4_t*)zp; rp[i] = tt > 0 ? *(const u32x4_t*)(zp - ZP) : (u32x4_t){0u, 0u, 0u, 0u}; rn[i] = tt < S - 1 ? *(const u32x4_t*)(zp + ZP) : (u32x4_t){0u, 0u, 0u, 0u}; } } while (0)
#define RW_PREP(b_) do { \
            float* ops = OPS + ((b_) & 1) * (TB * 384); \
            _Pragma("unroll") for (int i = 0; i < 3; ++i) if (lane + 64 * i < 160) { \
                float fs[8]; \
                _Pragma("unroll") for (int q = 0; q < 4; ++q) { \
                    const float c0 = __builtin_bit_cast(float, rc[i][q] << 16), c1 = __builtin_bit_cast(float, rc[i][q] & 0xffff0000u); \
                    const float p0 = __builtin_bit_cast(float, rp[i][q] << 16), p1 = __builtin_bit_cast(float, rp[i][q] & 0xffff0000u); \
                    const float n0 = __builtin_bit_cast(float, rn[i][q] << 16), n1 = __builtin_bit_cast(float, rn[i][q] & 0xffff0000u); \
                    const float m0 = q < 2 ? mu0[i][2 * q] : mu1[i][2 * q - 4], m1 = q < 2 ? mu0[i][2 * q + 1] : mu1[i][2 * q - 3]; \
                    fs[2 * q] = c0 + m0 * (0.5f * (p0 + n0) - c0); fs[2 * q + 1] = c1 + m1 * (0.5f * (p1 + n1) - c1); \
                } \
                const int t = it_t[i], tl = 4 * pw + t, g = it_g[i], wi = it_w[i]; \
                if (g == 0) { *(f32x4_t*)(ops + tl * 384 + 256 + wi) = (f32x4_t){fs[0], fs[1], fs[2], fs[3]}; *(f32x4_t*)(ops + tl * 384 + 256 + wi + 4) = (f32x4_t){fs[4], fs[5], fs[6], fs[7]}; } \
                else if (g == 2) { if (mode == 3) { _Pragma("unroll") for (int q = 0; q < 8; ++q) fs[q] = 0.f; } *(f32x4_t*)(ops + tl * 384 + 320 + wi) = (f32x4_t){fs[0], fs[1], fs[2], fs[3]}; *(f32x4_t*)(ops + tl * 384 + 320 + wi + 4) = (f32x4_t){fs[4], fs[5], fs[6], fs[7]}; } \
                else if (g == 1) { *(f32x4_t*)(KK + t * 64 + wi) = (f32x4_t){fs[0], fs[1], fs[2], fs[3]}; *(f32x4_t*)(KK + t * 64 + wi + 4) = (f32x4_t){fs[4], fs[5], fs[6], fs[7]}; } \
                else if (g == 3) { u32x4_t pq; pq.x = pk2(tanh_fast(fs[0]), tanh_fast(fs[1])); pq.y = pk2(tanh_fast(fs[2]), tanh_fast(fs[3])); pq.z = pk2(tanh_fast(fs[4]), tanh_fast(fs[5])); pq.w = pk2(tanh_fast(fs[6]), tanh_fast(fs[7])); *(u32x4_t*)(XWb + t * 64 + wi) = pq; } \
                else { u32x4_t pq; pq.x = pk2(fs[0], fs[1]); pq.y = pk2(fs[2], fs[3]); pq.z = pk2(fs[4], fs[5]); pq.w = pk2(fs[6], fs[7]); *(u32x4_t*)(XAb + t * 64 + wi) = pq; } \
            } \
            if ((b_) + 1 < NB) RW_ISSUE((b_) + 1); \
            { const int arow = lane & 15, akg = lane >> 4; \
              _Pragma("unroll") for (int m = 0; m < 2; ++m) { \
                bf16x8_t Af[2]; \
                _Pragma("unroll") for (int ks = 0; ks < 2; ++ks) { u32x4_t raw = *(const u32x4_t*)((m ? XAb : XWb) + (arow & 3) * 64 + 32 * ks + 8 * akg); if (arow >= 4) raw = (u32x4_t){0u, 0u, 0u, 0u}; Af[ks] = __builtin_bit_cast(bf16x8_t, raw); } \
                _Pragma("unroll") for (int ct = 0; ct < 4; ++ct) { f32x4_t am = (f32x4_t){0.f, 0.f, 0.f, 0.f}; \
                    am = __builtin_amdgcn_mfma_f32_16x16x32_bf16(Af[0], Bf[m][ct][0], am, 0, 0, 0); am = __builtin_amdgcn_mfma_f32_16x16x32_bf16(Af[1], Bf[m][ct][1], am, 0, 0, 0); \
                    if (lane < 16) { UA[(m * 4 + 0) * 64 + 16 * ct + lane] = am[0]; UA[(m * 4 + 1) * 64 + 16 * ct + lane] = am[1]; UA[(m * 4 + 2) * 64 + 16 * ct + lane] = am[2]; UA[(m * 4 + 3) * 64 + 16 * ct + lane] = am[3]; } } } } \
            _Pragma("unroll") for (int t = 0; t < 4; ++t) { \
                const int tl = 4 * pw + t; const float k = KK[t * 64 + lane]; const float kkv = k * k_k; \
                const float n2 = wave_sum(kkv * kkv); const float kk = kkv * __builtin_amdgcn_rsqf(fmaxf(n2, 1e-24f)); \
                const float wdec = __expf(-0.6065306597126334f * sigmoidf_(w0 + UA[t * 64 + lane])); const float a = sigmoidf_(a0 + UA[(4 + t) * 64 + lane]); \
                float* o = ops + tl * 384 + lane; o[0] = -kk; o[64] = wdec; o[128] = kk * a; o[192] = k * (1.0f + (a - 1.0f) * k_a); \
            } } while (0)
#define RW_YFLUSH(b_) do { const float* ybp = YBUF + ((b_) & 1) * (TB * 64); \
            _Pragma("unroll") for (int t = 0; t < 4; ++t) { const int si = s0 + (b_) * TB + 4 * pw + t; const int tt = d == 0 ? si : S - 1 - si; float* yp_ = Y + (size_t)(start + tt) * 256 + 64 * h; const float yv_ = ybp[(4 * pw + t) * 64 + lane]; \
                if (mode < 2) yp_[lane] = yv_; else ((unsigned short*)yp_)[(mode == 3 ? 64 : 0) + lane] = (unsigned short)f2bf(yv_); } } while (0)
        RW_ISSUE(0); RW_PREP(0);
        LDS_BARRIER();
        for (int b = 0; b < NB; ++b) {
            if (b > 0) RW_YFLUSH(b - 1);
            if (b + 1 < NB) RW_PREP(b + 1);
            LDS_BARRIER();
        }
        RW_YFLUSH(NB - 1);
#undef RW_ISSUE
#undef RW_PREP
#undef RW_YFLUSH
    } else {
        float st[16];
#pragma unroll
        for (int i = 0; i < 16; ++i) st[i] = (mode == 3 && 16 * (lane >> 4) + i == 16 * wid + (lane & 15)) ? 1.0f : 0.f;
        const int vofs = 320 + 16 * wid + (lane & 15);
        LDS_BARRIER();
        for (int b = 0; b < NB; ++b) {
            const float* ops = OPS + (b & 1) * (TB * 384); float* yb = YBUF + (b & 1) * (TB * 64);
            float xn = ops[lane], xw = ops[64 + lane], xb = ops[128 + lane], xk = ops[192 + lane], xr = ops[256 + lane], vv = ops[vofs];
#pragma unroll 2
            for (int t = 0; t < TB; ++t) {
                const float* nx = ops + (t + 1 < TB ? t + 1 : t) * 384;
                const float nxn = nx[lane], nxw = nx[64 + lane], nxb = nx[128 + lane], nxk = nx[192 + lane], nxr = nx[256 + lane], nvv = nx[vofs];
                float sa0 = 0.f, sa1 = 0.f, sa2 = 0.f, sa3 = 0.f;
                DPP_FMAC_N(sa0, xn, st[0], 0); DPP_FMAC(sa1, xn, st[1], 1); DPP_FMAC(sa2, xn, st[2], 2); DPP_FMAC(sa3, xn, st[3], 3);
                DPP_FMAC(sa0, xn, st[4], 4); DPP_FMAC(sa1, xn, st[5], 5); DPP_FMAC(sa2, xn, st[6], 6); DPP_FMAC(sa3, xn, st[7], 7);
                DPP_FMAC(sa0, xn, st[8], 8); DPP_FMAC(sa1, xn, st[9], 9); DPP_FMAC(sa2, xn, st[10], 10); DPP_FMAC(sa3, xn, st[11], 11);
                DPP_FMAC(sa0, xn, st[12], 12); DPP_FMAC(sa1, xn, st[13], 13); DPP_FMAC(sa2, xn, st[14], 14); DPP_FMAC(sa3, xn, st[15], 15);
                float sa = (sa0 + sa1) + (sa2 + sa3);
                { const f32x4_t da = __builtin_amdgcn_mfma_f32_16x16x4f32(1.0f, sa, (f32x4_t){0.f, 0.f, 0.f, 0.f}, 0, 0, 0); sa = da[0]; asm volatile("s_nop 15\n\ts_nop 3" : "+v"(sa)); }
                DPP_MUL_N(st[0], xw, 0);
#define M_MUL(J, X) DPP_MUL(st[J], X, J);
                REP15(M_MUL, xw)
#undef M_MUL
                DPP_FMAC_N(st[0], xb, sa, 0);
#define M_FB(J, X) DPP_FMAC(st[J], X, sa, J);
                REP15(M_FB, xb)
#undef M_FB
                DPP_FMAC_N(st[0], xk, vv, 0);
#define M_FK(J, X) DPP_FMAC(st[J], X, vv, J);
                REP15(M_FK, xk)
#undef M_FK
                float y0 = 0.f, y1 = 0.f, y2 = 0.f, y3 = 0.f;
                DPP_FMAC_N(y0, xr, st[0], 0); DPP_FMAC(y1, xr, st[1], 1); DPP_FMAC(y2, xr, st[2], 2); DPP_FMAC(y3, xr, st[3], 3);
                DPP_FMAC(y0, xr, st[4], 4); DPP_FMAC(y1, xr, st[5], 5); DPP_FMAC(y2, xr, st[6], 6); DPP_FMAC(y3, xr, st[7], 7);
                DPP_FMAC(y0, xr, st[8], 8); DPP_FMAC(y1, xr, st[9], 9); DPP_FMAC(y2, xr, st[10], 10); DPP_FMAC(y3, xr, st[11], 11);
                DPP_FMAC(y0, xr, st[12], 12); DPP_FMAC(y1, xr, st[13], 13); DPP_FMAC(y2, xr, st[14], 14); DPP_FMAC(y3, xr, st[15], 15);
                const float yp = (y0 + y1) + (y2 + y3);
                const f32x4_t dy = __builtin_amdgcn_mfma_f32_16x16x4f32(1.0f, yp, (f32x4_t){0.f, 0.f, 0.f, 0.f}, 0, 0, 0);
                if (lane < 16) yb[t * 64 + 16 * wid + lane] = dy[0];
                xn = nxn; xw = nxw; xb = nxb; xk = nxk; xr = nxr; vv = nvv;
            }
            LDS_BARRIER();
        }
        if (mode == 1) { float* sm = (float*)(p.ws + OFF_SMID) + (size_t)((s * 4 + h) * 2 + d) * 4096 + 16 * wid + (lane & 15);
#pragma unroll
            for (int i = 0; i < 16; ++i) sm[(16 * (lane >> 4) + i) * 64] = st[i]; }
    }
}

__device__ __forceinline__ float gelu_tanh(float x) { const float u = 0.7978845608028654f * (x + 0.044715f * x * x * x); return x * __builtin_amdgcn_rcpf(1.0f + __builtin_amdgcn_exp2f(-2.885390081777927f * u)); }
__device__ __forceinline__ float neg_expm1_fast(float t) { const float ser = -t * (1.0f + t * (0.5f + t * (0.16666667f + t * (0.041666668f + t * 0.0083333338f)))); return t > -0.25f ? ser : 1.0f - __expf(t); }

__device__ __forceinline__ void lru_unit(const KP& p, unsigned char* lds, int l, int s, int n) {
    typedef short bf16x8_t __attribute__((ext_vector_type(8)));
    typedef float f32x16_t __attribute__((ext_vector_type(16)));
    int tid_o = threadIdx.x; asm volatile("" : "+v"(tid_o)); const int tid = tid_o, lane = tid & 63; const int wid = __builtin_amdgcn_readfirstlane(tid >> 6);
    float* XC = (float*)lds;
    unsigned short* XCb = (unsigned short*)(lds + 16384);
    float* GG = (float*)(lds + 24576);
    float* HF = (float*)(lds + 57344);
    float* YG = (float*)(lds + 73728);
    float* HO = (float*)(lds + 90112);
    float* SEG = (float*)(lds + 106496);
    const bf16* Z = (const bf16*)(p.ws + OFF_Z);
    bf16* OM = (bf16*)(p.ws + OFF_OMIX);
    const int S = seq_len(s), start = seq_start(s); const int NB = S / 64;
    const int t_ = tid >> 3, c8 = (tid & 7) * 8;
    const int r32 = lane & 31, hi = lane >> 5; const int gm = wid & 1, gth = (wid >> 1) & 1, gch = wid >> 2;
    f32x4_t cw0[4], cw1[4];
#pragma unroll
    for (int j = 0; j < 4; ++j) { cw0[j] = *(const f32x4_t*)(p.in[11] + l * 4 * 384 + j * 384 + 64 * n + c8); cw1[j] = *(const f32x4_t*)(p.in[11] + l * 4 * 384 + j * 384 + 64 * n + c8 + 4); }
    const f32x4_t cb0 = *(const f32x4_t*)(p.in[12] + l * 384 + 64 * n + c8), cb1 = *(const f32x4_t*)(p.in[12] + l * 384 + 64 * n + c8 + 4);
    for (int d = 0; d < 2; ++d) {
        const float* wg = (gm == 0 ? p.in[13] : p.in[15]) + (((size_t)l * 2 + d) * 6 + n) * 4096;
        const float gbias = (gm == 0 ? p.in[14] : p.in[16])[(l * 2 + d) * 384 + 64 * n + 32 * gch + r32];
        const float lm = -p.in[17][(l * 2 + d) * 384 + 64 * n + lane]; const float sp8 = -8.0f * (lm > 20.f ? lm : log1pf(__expf(lm)));
        bf16x8_t Bf[4];
#pragma unroll
        for (int ks = 0; ks < 4; ++ks) { const float* wp = wg + (size_t)(16 * ks + 8 * hi) * 64 + 32 * gch + r32; u32x4_t pq;
            pq.x = pk2(wp[0], wp[64]); pq.y = pk2(wp[128], wp[192]); pq.z = pk2(wp[256], wp[320]); pq.w = pk2(wp[384], wp[448]); Bf[ks] = __builtin_bit_cast(bf16x8_t, pq); }
        __threadfence();
        __syncthreads();
        float hcarry = 0.f;
        u32x4_t rr[4], rh, ry;
#define LRU_ISSUE(blk_) do { const int tt = d == 0 ? (blk_) * 64 + t_ : S - 1 - ((blk_) * 64 + t_); \
            _Pragma("unroll") for (int j = 0; j < 4; ++j) { const int t2 = tt - 2 + j; rr[j] = (t2 >= 0 && t2 < S) ? *(const u32x4_t*)(Z + (size_t)(start + t2) * ZP + 64 * n + c8) : (u32x4_t){0u, 0u, 0u, 0u}; } \
            if (d == 1) { rh = *(const u32x4_t*)(OM + (size_t)(start + tt) * DM + 64 * n + c8); ry = *(const u32x4_t*)(Z + (size_t)(start + tt) * ZP + 384 + 64 * n + c8); } } while (0)
        LRU_ISSUE(0);
        for (int blk = 0; blk < NB; ++blk) {
            LDS_BARRIER();
            {
                f32x4_t x0 = cb0, x1 = cb1;
#pragma unroll
                for (int j = 0; j < 4; ++j) {
                    const f32x4_t a = (f32x4_t){__builtin_bit_cast(float, rr[j][0] << 16), __builtin_bit_cast(float, rr[j][0] & 0xffff0000u), __builtin_bit_cast(float, rr[j][1] << 16), __builtin_bit_cast(float, rr[j][1] & 0xffff0000u)};
                    const f32x4_t b = (f32x4_t){__builtin_bit_cast(float, rr[j][2] << 16), __builtin_bit_cast(float, rr[j][2] & 0xffff0000u), __builtin_bit_cast(float, rr[j][3] << 16), __builtin_bit_cast(float, rr[j][3] & 0xffff0000u)};
                    x0 += cw0[j] * a; x1 += cw1[j] * b;
                }
                *(f32x4_t*)(XC + t_ * 64 + c8) = x0; *(f32x4_t*)(XC + t_ * 64 + c8 + 4) = x1;
                { u32x4_t pq; pq.x = pk2(x0[0], x0[1]); pq.y = pk2(x0[2], x0[3]); pq.z = pk2(x1[0], x1[1]); pq.w = pk2(x1[2], x1[3]); *(u32x4_t*)(XCb + t_ * 64 + c8) = pq; }
                if (d == 1) {
                    float hf[8], yg[8];
#pragma unroll
                    for (int q = 0; q < 4; ++q) { hf[2 * q] = __builtin_bit_cast(float, rh[q] << 16); hf[2 * q + 1] = __builtin_bit_cast(float, rh[q] & 0xffff0000u);
                        yg[2 * q] = gelu_tanh(__builtin_bit_cast(float, ry[q] << 16)); yg[2 * q + 1] = gelu_tanh(__builtin_bit_cast(float, ry[q] & 0xffff0000u)); }
                    *(f32x4_t*)(HF + t_ * 64 + c8) = (f32x4_t){hf[0], hf[1], hf[2], hf[3]}; *(f32x4_t*)(HF + t_ * 64 + c8 + 4) = (f32x4_t){hf[4], hf[5], hf[6], hf[7]};
                    *(f32x4_t*)(YG + t_ * 64 + c8) = (f32x4_t){yg[0], yg[1], yg[2], yg[3]}; *(f32x4_t*)(YG + t_ * 64 + c8 + 4) = (f32x4_t){yg[4], yg[5], yg[6], yg[7]};
                }
                if (blk + 1 < NB) LRU_ISSUE(blk + 1);
            }
            LDS_BARRIER();
            {
                f32x16_t acc = {};
#pragma unroll
                for (int ks = 0; ks < 4; ++ks) { const bf16x8_t af = *(const bf16x8_t*)(XCb + (32 * gth + r32) * 64 + 16 * ks + 8 * hi); acc = __builtin_amdgcn_mfma_f32_32x32x16_bf16(af, Bf[ks], acc, 0, 0, 0); }
#pragma unroll
                for (int r = 0; r < 16; ++r) { const int trow = 32 * gth + (r & 3) + 8 * (r >> 2) + 4 * hi; GG[(gm * 64 + trow) * 64 + 32 * gch + r32] = sigmoidf_(acc[r] + gbias); }
            }
            LDS_BARRIER();
            float Pp[8], hl[8];
            {
                float pp = 1.f, hh = 0.f;
#pragma unroll
                for (int q = 0; q < 8; ++q) { const int t = 8 * wid + q; const float ra = GG[t * 64 + lane], ix = GG[(64 + t) * 64 + lane], xc = XC[t * 64 + lane];
                    const float la = sp8 * ra; const float a = __expf(la); const float uu = __builtin_amdgcn_sqrtf(fmaxf(neg_expm1_fast(2.0f * la), 0.f)) * ix * xc;
                    pp *= a; hh = a * hh + uu; Pp[q] = pp; hl[q] = hh; }
                SEG[(wid * 2) * 64 + lane] = pp; SEG[(wid * 2 + 1) * 64 + lane] = hh;
            }
            LDS_BARRIER();
            {
                float sa[8], sh[8];
#pragma unroll
                for (int w = 0; w < 8; ++w) { sa[w] = SEG[(w * 2) * 64 + lane]; sh[w] = SEG[(w * 2 + 1) * 64 + lane]; }
                float carry = hcarry, mine = 0.f;
#pragma unroll
                for (int w = 0; w < 8; ++w) { if (w == wid) mine = carry; carry = sa[w] * carry + sh[w]; }
                hcarry = carry;
#pragma unroll
                for (int q = 0; q < 8; ++q) { const int t = 8 * wid + q; const float hv = Pp[q] * mine + hl[q]; HO[t * 64 + lane] = d == 0 ? hv : (HF[t * 64 + lane] + hv) * YG[t * 64 + lane]; }
            }
            LDS_BARRIER();
            {   const int tt = d == 0 ? blk * 64 + t_ : S - 1 - (blk * 64 + t_);
                const f32x4_t a = *(const f32x4_t*)(HO + t_ * 64 + c8), b = *(const f32x4_t*)(HO + t_ * 64 + c8 + 4);
                u32x4_t w; w.x = pk2(a[0], a[1]); w.y = pk2(a[2], a[3]); w.z = pk2(b[0], b[1]); w.w = pk2(b[2], b[3]);
                *(u32x4_t*)(OM + (size_t)(start + tt) * DM + 64 * n + c8) = w; }
        }
#undef LRU_ISSUE
    }
}

__device__ __forceinline__ void rwkv_post_tile(const KP& p, unsigned char* lds, int l, int tile) {
    int tid_o = threadIdx.x; asm volatile("" : "+v"(tid_o)); const int tid = tid_o, lane = tid & 63;
    float* SG = (float*)lds;
    float* GO = SG + 4096;
    const bf16* Z = (const bf16*)(p.ws + OFF_Z); bf16* OM = (bf16*)(p.ws + OFF_OMIX);
    const float* YF = (const float*)(p.ws + OFF_YF); const float* YBk = (const float*)(p.ws + OFF_YB);
    const float* mu = p.in[18] + l * 1024; const float* g_up = p.in[23] + (size_t)l * 128 * 256;
    const int m0 = tile * 32; const int s = seq_of_row(m0); const int S = seq_len(s), start = seq_start(s);
    __syncthreads();
    {   const float muc = mu[896 + (tid & 127)];
#pragma unroll 1
        for (int ih = 0; ih < 2; ++ih) {
            unsigned short zc_[4], zp_[4], zn_[4];
#pragma unroll
            for (int i = 0; i < 4; ++i) { const int e = tid + NTHR * (4 * ih + i); const int t = e >> 7, c = e & 127; const int m = m0 + t, tt = m - start; const bf16* zp = Z + (size_t)m * ZP + 768 + 896 + c;
                zc_[i] = zp[0]; zp_[i] = zp[tt > 0 ? -ZP : 0]; zn_[i] = zp[tt < S - 1 ? ZP : 0]; }
            asm volatile("" ::: "memory");
#pragma unroll
            for (int i = 0; i < 4; ++i) { const int e = tid + NTHR * (4 * ih + i); const int t = e >> 7; const int tt = m0 + t - start;
                const float f = bf2f(zc_[i]); const float pv = tt > 0 ? bf2f(zp_[i]) : 0.f; const float nx = tt < S - 1 ? bf2f(zn_[i]) : 0.f;
                SG[e] = sigmoidf_(f + muc * (0.5f * (pv + nx) - f)); }
        }
    }
    __syncthreads();
    const int c = tid & 255, tg = tid >> 8;
#pragma unroll 1
    for (int hf = 0; hf < 2; ++hf) {
        float acc[8];
#pragma unroll
        for (int t = 0; t < 8; ++t) acc[t] = 0.f;
#pragma unroll 1
        for (int ib = 0; ib < 128; ib += 16) {
            float wv[16];
#pragma unroll
            for (int u = 0; u < 16; ++u) wv[u] = g_up[(ib + u) * 256 + c];
#pragma unroll
            for (int u4 = 0; u4 < 16; u4 += 4) {
#pragma unroll
                for (int t = 0; t < 8; ++t) { const f32x4_t x = *(const f32x4_t*)(SG + (tg * 16 + hf * 8 + t) * 128 + ib + u4); acc[t] = fmaf(x[0], wv[u4], acc[t]); acc[t] = fmaf(x[1], wv[u4 + 1], acc[t]); acc[t] = fmaf(x[2], wv[u4 + 2], acc[t]); acc[t] = fmaf(x[3], wv[u4 + 3], acc[t]); } }
        }
#pragma unroll
        for (int t = 0; t < 8; ++t) GO[(tg * 16 + hf * 8 + t) * 256 + c] = acc[t];
    }
    const int dc = (s < 4) ? ((m0 - start) >= S / 2 ? 0 : 1) : -1;
    if (dc >= 0) {
        float* SM = (float*)(lds + 49152); unsigned short* YPs = (unsigned short*)(lds + 114688);
        const float* Ydc = dc == 0 ? YF : YBk; float* Yw = (float*)(p.ws + (dc == 0 ? OFF_YF : OFF_YB));
        for (int e = tid; e < 4096; e += NTHR) { const int hh = e >> 10, r4 = (e & 1023) * 4; *(f32x4_t*)(SM + hh * 4096 + r4) = *(const f32x4_t*)((const float*)(p.ws + OFF_SMID) + (size_t)((s * 4 + hh) * 2 + dc) * 4096 + r4); }
        for (int e = tid; e < 1024; e += NTHR) { const int t = e >> 5, hh = (e >> 3) & 3, ch = e & 7; *(u32x4_t*)(YPs + t * 256 + hh * 64 + ch * 8) = *(const u32x4_t*)((const unsigned short*)(Ydc + (size_t)(m0 + t) * 256 + 64 * hh) + 64 + ch * 8); }
        __syncthreads();
        const int hh = c >> 6, v = c & 63; const float* smp = SM + hh * 4096 + v;
#pragma unroll 1
        for (int t = 0; t < 16; ++t) {
            const int tk = tg * 16 + t; const size_t mrow = (size_t)(m0 + tk) * 256;
            float accv = bf2f(((const unsigned short*)(Ydc + mrow + 64 * hh))[v]);
#pragma unroll
            for (int i0 = 0; i0 < 64; i0 += 8) { const u32x4_t w = *(const u32x4_t*)(YPs + tk * 256 + hh * 64 + i0);
                accv += smp[(i0 + 0) * 64] * __builtin_bit_cast(float, w[0] << 16) + smp[(i0 + 1) * 64] * __builtin_bit_cast(float, w[0] & 0xffff0000u) + smp[(i0 + 2) * 64] * __builtin_bit_cast(float, w[1] << 16) + smp[(i0 + 3) * 64] * __builtin_bit_cast(float, w[1] & 0xffff0000u)
                      + smp[(i0 + 4) * 64] * __builtin_bit_cast(float, w[2] << 16) + smp[(i0 + 5) * 64] * __builtin_bit_cast(float, w[2] & 0xffff0000u) + smp[(i0 + 6) * 64] * __builtin_bit_cast(float, w[3] << 16) + smp[(i0 + 7) * 64] * __builtin_bit_cast(float, w[3] & 0xffff0000u); }
            Yw[mrow + c] = accv;
        }
        __threadfence();
        __syncthreads();
    }
    const float rk = p.in[26][l * 256 + c], lg = p.in[27][l * 256 + c], lb = p.in[28][l * 256 + c];
    const float mr = mu[c], mk = mu[256 + c], mv = mu[512 + c];
    unsigned short zc_[9]; float yc_[2];
#define PT_LOAD(T_, ZD, YD) do { const int m_ = m0 + tg * 16 + (T_), tt_ = m_ - start; const bf16* zp_ = Z + (size_t)m_ * ZP + 768 + c; const bf16* zpp_ = zp_ + (tt_ > 0 ? -ZP : 0); const bf16* zpn_ = zp_ + (tt_ < S - 1 ? ZP : 0); \
        _Pragma("unroll") for (int j = 0; j < 3; ++j) { ZD[3 * j] = zp_[256 * j]; ZD[3 * j + 1] = zpp_[256 * j]; ZD[3 * j + 2] = zpn_[256 * j]; } \
        YD[0] = YF[(size_t)m_ * 256 + c]; YD[1] = YBk[(size_t)m_ * 256 + c]; } while (0)
    PT_LOAD(0, zc_, yc_);
#pragma unroll 1
    for (int t = 0; t < 16; ++t) {
        unsigned short zn_[9]; float yn_[2];
        PT_LOAD((t < 15 ? t + 1 : 15), zn_, yn_);
        asm volatile("" ::: "memory");
        const int m = m0 + tg * 16 + t, tt = m - start;
        const bool hp = tt > 0, hn = tt < S - 1;
        float f = bf2f(zc_[0]), pv = hp ? bf2f(zc_[1]) : 0.f, nx = hn ? bf2f(zc_[2]) : 0.f; const float r = f + mr * (0.5f * (pv + nx) - f);
        f = bf2f(zc_[3]); pv = hp ? bf2f(zc_[4]) : 0.f; nx = hn ? bf2f(zc_[5]) : 0.f; const float k = f + mk * (0.5f * (pv + nx) - f);
        f = bf2f(zc_[6]); pv = hp ? bf2f(zc_[7]) : 0.f; nx = hn ? bf2f(zc_[8]) : 0.f; const float v = f + mv * (0.5f * (pv + nx) - f);
        const float y = yc_[0] + yc_[1];
#pragma unroll
        for (int j = 0; j < 9; ++j) zc_[j] = zn_[j];
        yc_[0] = yn_[0]; yc_[1] = yn_[1];
        const float mean = wave_sum(y) * (1.0f / 64.0f); const float dv = y - mean; const float var = wave_sum(dv * dv) * (1.0f / 64.0f);
        const float yn = dv * rsqrtf(var + 64e-5f) * lg + lb;
        const float bon = wave_sum(r * k * rk);
        const float outv = (yn + bon * v) * GO[(tg * 16 + t) * 256 + c];
        OM[(size_t)m * DM + 384 + c] = (bf16)f2bf(outv);
    }
#undef PT_LOAD
    (void)lane;
}

__global__ void __launch_bounds__(NTHR, 2) fwd_megakernel(KP p) {
    extern __shared__ __attribute__((aligned(16))) unsigned char lds[];
    cg::grid_group grid = cg::this_grid();
    const int tid = threadIdx.x, lane = tid & 63, wid = tid >> 6;
    const int G = gridDim.x, bx = blockIdx.x;
    const int gw = bx * 8 + wid, NGW = G * 8;
    unsigned char* ws = p.ws;
    volatile LAS int* misc = (volatile LAS int*)((LAS unsigned char*)lds + MISC_OFF);
    PG8_LAS unsigned char* ldsg = (PG8_LAS unsigned char*)lds;

    {
        float* scr = (float*)(lds + wid * 16384);
        for (int l = 0; l < 2; ++l) {
            unsigned char* wl = ws + OFF_W + l * W_LAYER;
            constexpr int I_IN = 16 * 176, I_OUT = 44 * 32, I_MI = 16 * 76, I_MO = 16 * 32, I_TOT = 2 * I_IN + 2 * I_OUT + I_MI + I_MO;
            for (int it = gw; it < I_TOT; it += NGW) {
                int r = it;
                if (r < 2 * I_IN) { const int f = r / I_IN; transpose_item<1>(p.in[7] + ((size_t)l * 2 + f) * DM * NFF, DM, NFF, (bf16*)(wl + WO_IN + f * 11 * MiB), scr, r % I_IN, lane); continue; } r -= 2 * I_IN;
                if (r < 2 * I_OUT) { const int f = r / I_OUT; transpose_item<0>(p.in[8] + ((size_t)l * 2 + f) * DFF * DM, DFF, DM, (bf16*)(wl + WO_OUT + f * (11 * MiB / 2)), scr, r % I_OUT, lane); continue; } r -= 2 * I_OUT;
                if (r < I_MI) { transpose_item<2>(p.in[9] + (size_t)l * DM * NMIX, DM, NMIX, (bf16*)(wl + WO_MI), scr, r, lane); continue; } r -= I_MI;
                transpose_item<0>(p.in[10] + (size_t)l * DM * DM, DM, DM, (bf16*)(wl + WO_MO), scr, r, lane);
            }
            u32x4_t* padp = (u32x4_t*)(wl + WO_MI + (size_t)NMIX * DM * 2);
            for (int e = bx * NTHR + tid; e < 128 * DM * 2 / 16; e += G * NTHR) padp[e] = (u32x4_t){0u, 0u, 0u, 0u};
        }
        __syncthreads();
        for (int u = bx; u < 2 * 36 * 8; u += G) { const int l = u / 288, r = u % 288;
            smallm_unit<0, 0>(p, (float*)lds, l, 0, p.in[4] + (size_t)l * DM * 9216, 9216, 9216, (float*)(ws + OFF_MOD) + (size_t)l * NSEQ * 9216, 9216, r / 8, r % 8); }
        if (bx == 0) { float* rope = (float*)(ws + OFF_ROPE);
            for (int e = tid; e < 1024; e += NTHR) { const int pos = e >> 4, pp = e & 15; const float inv = exp2f(-(float)pp * (13.287712379549449f / 16.0f)); const float a = (float)pos * inv; const float kr = rintf(a * 0.15915494309189535f); float rr = fmaf(-kr, 6.2831854820251465f, a); rr = fmaf(-kr, -1.7484555e-7f, rr); rope[2 * e] = __cosf(rr); rope[2 * e + 1] = __sinf(rr); } }
    }
    grid.sync();
    {
        const float* MOD = (const float*)(ws + OFF_MOD); float* GV = (float*)(ws + OFF_GV); float* GT = (float*)(ws + OFF_GATE);
        for (int e = bx * NTHR + tid; e < 6 * NSEQ * DM; e += G * NTHR) {
            const int c = e & 1023, s = (e >> 10) % NSEQ, inst = e / (NSEQ * DM); const int l = inst / 3, j = inst % 3;
            const float* mr = MOD + ((size_t)l * NSEQ + s) * 9216; const float* ba = p.in[5] + l * 9216;
            const float sc = mr[(3 * j + 1) * 1024 + c] + ba[(3 * j + 1) * 1024 + c], gg = mr[(3 * j + 2) * 1024 + c] + ba[(3 * j + 2) * 1024 + c];
            GV[e] = p.in[6][(l * 3 + j) * DM + c] * (1.0f + sc); GT[e] = (j == 1 ? 1.0f : 0.5f) * gg;
        }
        for (int u = bx; u < 2 * 432; u += G) { const int l = u / 432, r = u % 432; float* bdst = (float*)(ws + OFF_BIAS);
            if (r < 176) smallm_unit<1, 1>(p, (float*)lds, l, 0, p.in[7] + ((size_t)l * 2 + 0) * DM * NFF, NFF, NFF, bdst + (size_t)(l * 3 + 0) * NSEQ * NFF, NFF, r / 8, r % 8);
            else if (r < 256) smallm_unit<1, 2>(p, (float*)lds, l, 1, p.in[9] + (size_t)l * DM * NMIX, NMIX, NMIX, bdst + (size_t)(l * 3 + 1) * NSEQ * NFF, NFF, (r - 176) / 8, (r - 176) % 8);
            else smallm_unit<1, 1>(p, (float*)lds, l, 2, p.in[7] + ((size_t)l * 2 + 1) * DM * NFF, NFF, NFF, bdst + (size_t)(l * 3 + 2) * NSEQ * NFF, NFF, (r - 256) / 8, (r - 256) % 8); }
        bf16* XN = (bf16*)(ws + OFF_XN); float* SS0 = (float*)(ws + OFF_SS);
        for (int m = gw; m < MTOK; m += NGW) {
            const int s = seq_of_row(m); const float* xr = m < 16384 ? p.in[0] + (size_t)m * DM : p.in[1] + (size_t)(m - 16384) * DM;
            const float* mr = MOD + (size_t)s * 9216 + 1024; const float* ba = p.in[5] + 1024; const float* ng = p.in[6];
            float q = 0.f;
#pragma unroll
            for (int j = 0; j < 4; ++j) { const int c = 4 * lane + 256 * j; const f32x4_t v = *(const f32x4_t*)(xr + c); const f32x4_t sc = *(const f32x4_t*)(mr + c) + *(const f32x4_t*)(ba + c); const f32x4_t g = *(const f32x4_t*)(ng + c) * (sc + 1.0f);
                q += (v[0] * v[0] + v[1] * v[1]) + (v[2] * v[2] + v[3] * v[3]); const f32x4_t o = v * g;
                *(unsigned long long*)(XN + (size_t)m * DM + c) = (unsigned long long)pk2(o[0], o[1]) | ((unsigned long long)pk2(o[2], o[3]) << 32); }
            q = wave_sum(q); if (lane == 0) SS0[m] = q;
        }
    }
    grid.sync();

    for (int l = 0; l < 2; ++l) {
        unsigned char* wl = ws + OFF_W + l * W_LAYER;
        const float* GV = (const float*)(ws + OFF_GV); const float* GT = (const float*)(ws + OFF_GATE); const float* BI = (const float*)(ws + OFF_BIAS); float* SS = (float*)(ws + OFF_SS);
        bf16* XN = (bf16*)(ws + OFF_XN); bf16* HID = (bf16*)(ws + OFF_HID); bf16* OMIX = (bf16*)(ws + OFF_OMIX);
        for (int f = 0; f < 2; ++f) {
            const int j = f == 0 ? 0 : 2; const int inst = l * 3 + j;
            if (f == 1) {
                {
                    pg8::Gemm g{XN, (const pg8::bf16_t*)(wl + WO_MI), MTOK, NMIXP, DM}; pg8::StaticOrder S; S.init(MTOK, NMIXP, G, bx);
                    pg8::EpiZ E{(bf16*)(ws + OFF_Z), (bf16*)(ws + OFF_QK), (bf16*)(ws + OFF_VR), SS + (size_t)(l * 3 + 1) * MTOK, BI + (size_t)(l * 3 + 1) * NSEQ * NFF, p.in[29] + l * 64, p.in[30] + l * 64, (const float*)(ws + OFF_ROPE)};
                    pg8::gemm_phase<pg8::EpiZ, pg8::StaticOrder, true, true>(ldsg, g, S, E);
                }
                grid.sync();
                {
                    unsigned* ctr = (unsigned*)(ws + OFF_CTR) + 64 * l;
                    constexpr int NU_R = 224, NU_L = 120, NU_A = 1152, NU = NU_R + NU_L + NU_A;
                    for (;;) {
                        __syncthreads(); if (tid == 0) misc[0] = (int)atomicAdd(ctr, 1u); __syncthreads();
                        const int u = misc[0]; if (u >= NU) break;
                        if (u < 224) { int s_, h_, d_, md_;
                            if (u < 96) { const int c = u & 31; md_ = 1 + (u >> 5); s_ = c >> 3; h_ = (c >> 1) & 3; d_ = c & 1; } else { const int i2 = u - 96; md_ = 0; s_ = 4 + (i2 >> 3); h_ = (i2 >> 1) & 3; d_ = i2 & 1; }
                            rwkv_unit(p, lds, l, s_, h_, d_, md_); }
                        else if (u < 248) { const int i3 = u - 224; lru_unit(p, lds, l, i3 / 6, i3 % 6); }
                        else if (u < 344) { const int i4 = u - 248; lru_unit(p, lds, l, 4 + i4 / 6, i4 % 6); }
                        else { const int i5 = u - 344; int s_, hq, qb;
                            if (i5 < 384) { s_ = i5 / 96; const int r = i5 % 96; hq = (r / 48) * 3 + (r % 48) / 16; qb = r & 15; }
                            else { const int i6 = i5 - 384; s_ = 4 + i6 / 48; const int r = i6 % 48; hq = (r / 24) * 3 + (r % 24) / 8; qb = r & 7; }
                            const int g_ = hq / 3;
                            attn_body::attn_unit<8>(seq_start(s_), seq_len(s_), qb, 64 * hq, 384 + 64 * g_, 64 * g_, 640 + 64 * hq, (const attn_body::bf16*)(ws + OFF_QK), (const attn_body::bf16*)(ws + OFF_QK), (const attn_body::bf16*)(ws + OFF_VR), (attn_body::bf16*)(ws + OFF_OMIX), (char*)lds); }
                    }
                }
                grid.sync();
                for (int t = bx; t < MTOK / 32; t += G) rwkv_post_tile(p, lds, l, t);
                grid.sync();
                {
                    pg8::Gemm g{OMIX, (const pg8::bf16_t*)(wl + WO_MO), MTOK, DM, DM}; pg8::StaticOrder S; S.init(MTOK, DM, G, bx);
                    pg8::EpiResid E{p.out, p.out + (size_t)16384 * DM, p.out, XN, SS + (size_t)(l * 3 + 2) * MTOK, GT + (size_t)(l * 3 + 1) * NSEQ * DM, GV + (size_t)(l * 3 + 2) * NSEQ * DM};
                    pg8::gemm_phase<pg8::EpiResid, pg8::StaticOrder, true, true>(ldsg, g, S, E);
                }
                grid.sync();
            }
            {
                pg8::Gemm g{XN, (const pg8::bf16_t*)(wl + WO_IN + f * 11 * MiB), MTOK, NFF, DM}; pg8::StaticOrder S; S.init(MTOK, NFF, G, bx);
                pg8::EpiSwiglu E{HID, SS + (size_t)inst * MTOK, BI + (size_t)inst * NSEQ * NFF};
                pg8::gemm_phase<pg8::EpiSwiglu, pg8::StaticOrder, true, true>(ldsg, g, S, E);
            }
            grid.sync();
            {
                const bool first = (l == 0 && f == 0), last = (l == 1 && f == 1);
                const int ninst = inst + 1;
                pg8::Gemm g{HID, (const pg8::bf16_t*)(wl + WO_OUT + f * (11 * MiB / 2)), MTOK, DM, DFF}; pg8::StaticOrder S; S.init(MTOK, DM, G, bx);
                pg8::EpiResid E{first ? p.in[0] : p.out, first ? p.in[1] : p.out + (size_t)16384 * DM, p.out, XN, last ? nullptr : SS + (size_t)ninst * MTOK, GT + (size_t)inst * NSEQ * DM, last ? nullptr : GV + (size_t)ninst * NSEQ * DM};
                pg8::gemm_phase<pg8::EpiResid, pg8::StaticOrder, true, true>(ldsg, g, S, E);
            }
            if (!(l == 1 && f == 1)) grid.sync();
        }
    }
}

extern "C" void kernel_launch(void* const* d_in, const int* in_sizes, int n_in, void* d_out, int out_size, void* d_ws, size_t ws_size, hipStream_t stream) {
    static int grid = 0;
    if (grid == 0) {
        if (n_in != 31 || ws_size < WS_END + 1 * MiB) { fprintf(stderr, "kernel_launch: unexpected n_in %d / ws %zu\n", n_in, ws_size); grid = -1; return; }
        int dev = 0, cus = 0, per_cu = 0;
        hipGetDevice(&dev); hipDeviceGetAttribute(&cus, hipDeviceAttributeMultiprocessorCount, dev);
        hipFuncSetAttribute((const void*)fwd_megakernel, hipFuncAttributeMaxDynamicSharedMemorySize, LDS_BYTES);
        hipOccupancyMaxActiveBlocksPerMultiprocessor(&per_cu, (const void*)fwd_megakernel, NTHR, LDS_BYTES);
        if (per_cu < 1) per_cu = 1;
        grid = cus * per_cu;
        (void)hipGetLastError();
    }
    if (grid < 0) return;
    hipMemsetAsync(d_ws, 0, ZERO_BYTES, stream);
    KP p{};
    for (int i = 0; i < 31; ++i) p.in[i] = (const float*)d_in[i];
    p.out = (float*)d_out; p.ws = (unsigned char*)d_ws;
    void* args[] = {&p};
    hipError_t e = hipLaunchCooperativeKernel((const void*)fwd_megakernel, dim3(grid), dim3(NTHR), args, LDS_BYTES, stream);
    if (e != hipSuccess) fprintf(stderr, "cooperative launch failed: %s (grid %d)\n", hipGetErrorString(e), grid);
}
```

```cpp
#include <hip/hip_runtime.h>
#include <hip/hip_cooperative_groups.h>
#include <cstdio>
#include <cstdint>
namespace cg = cooperative_groups;
namespace pg8 {
#define PG8_LAS __attribute__((address_space(3)))
typedef unsigned short bf16_t;
typedef short bf16x8 __attribute__((ext_vector_type(8)));
typedef float f32x4 __attribute__((ext_vector_type(4)));
typedef unsigned u32x4 __attribute__((ext_vector_type(4)));
constexpr int BM = 256, BK = 64, HALF = 128, HTB = HALF * BK * 2  , STAGE_BYTES = 8 * HTB, NXCD = 8, WGM = 8;

__host__ __device__ __forceinline__ int lds_byte(int r, int c) { const int st = (r >> 4) * 2 + (c >> 5), rr = r & 15, cc = c & 31, ob = rr * 64 + cc * 2; return st * 1024 + (ob ^ (((ob >> 9) & 1) << 5)); }
__host__ __device__ __forceinline__ void stage_rc(int b, int& R, int& C) { const int st = b / 1024, sb = b % 1024, swz = sb ^ (((sb >> 9) & 1) << 5); R = (st >> 1) * 16 + swz / 64; C = (st & 1) * 32 + (swz % 64) / 2; }
__host__ __device__ __forceinline__ int perm32(int rho) { const int n = rho >> 4, i = rho & 15; return 8 * (i >> 2) + 4 * n + (i & 3); }

struct Unit { int pm, pn; };
struct Gemm { const bf16_t* A; const bf16_t* Bt; int M, N, K; };

struct StaticOrder {
    int nM, nN, nwg, G, c;
    __host__ __device__ void init(int M, int N, int G_, int c_) { nM = M / BM; nN = N / BM; nwg = nM * nN; G = G_; c = c_; }
    __host__ __device__ bool next(int i, Unit& u) const {
        const long L = (long)i * G + c; if (L >= nwg) return false;
        int wgid = (int)L; { const int q = nwg / NXCD, r = nwg % NXCD, xcd = wgid % NXCD, off = wgid / NXCD; wgid = (xcd < r ? xcd * (q + 1) : r * (q + 1) + (xcd - r) * q) + off; }
        const int nig = WGM * nN, gid = wgid / nig, fm = gid * WGM, gsz = (nM - fm) < WGM ? (nM - fm) : WGM;
        u.pm = fm + ((wgid % nig) % gsz); u.pn = (wgid % nig) / gsz; return true;
    }
    __device__ __forceinline__ void a_ready(const Unit&) const {}
    __device__ __forceinline__ void done(const Unit&) const {}
};

__device__ __forceinline__ unsigned cvt_pk_bf16(float lo, float hi) { unsigned r; asm volatile("v_cvt_pk_bf16_f32 %0, %1, %2" : "=v"(r) : "v"(lo), "v"(hi)); return r; }
typedef float f32x2 __attribute__((ext_vector_type(2)));
__device__ __forceinline__ f32x2 gelu_pk(f32x2 v) {
    const f32x2 av = __builtin_elementwise_abs(v), d = av * 0.2316418882f + 1.0f;
    f32x2 t; t.x = __builtin_amdgcn_rcpf(d.x); t.y = __builtin_amdgcn_rcpf(d.y);
    f32x2 q = t * 0.5307027145f + (-0.7265760135f); q = q * t + 0.7107068705f; q = q * t + (-0.142248368f); q = q * t + 0.127414796f; q = q * t;
    const f32x2 s = (v * v) * (-0.72134752044f);
    f32x2 e; e.x = __builtin_amdgcn_exp2f(s.x); e.y = __builtin_amdgcn_exp2f(s.y);
    const f32x2 m = v * (q * e), r = v - m;
    f32x2 o; o.x = v.x < 0.f ? m.x : r.x; o.y = v.y < 0.f ? m.y : r.y; return o;
}

template <int ACT  > struct EpiBf16 {
    static constexpr bool PERM = true, AFTER_DRAIN = false; static_assert(ACT == 0 || ACT == 1, "EpiBf16: ACT is 0 (none) or 1 (gelu_pk)");
    bf16_t* O; int ldc; const float* bias; int split_cols; size_t split_stride; float scale0;
    __device__ __forceinline__ void operator()(const f32x4 (&acc)[2][2][4][2], const Unit& u, int wr, int wc, int fr, int fq) const {
        const int row0 = u.pm * BM + wr * 64 + fr; int colt = u.pn * BM; bf16_t* base = O;
        float sc = 1.f; if (split_cols) { const int t = colt / split_cols; base += (size_t)t * split_stride; colt -= t * split_cols; if (t == 0) sc = scale0; }
        const int col0 = colt + wc * 32 + 8 * fq, bcol0 = u.pn * BM + wc * 32 + 8 * fq;
        f32x4 bv[2][2];
#pragma unroll
        for (int bj = 0; bj < 2; ++bj)
#pragma unroll
            for (int n = 0; n < 2; ++n) bv[bj][n] = bias ? *(const f32x4*)(bias + bcol0 + bj * HALF + 4 * n) : (f32x4){0.f, 0.f, 0.f, 0.f};
#pragma unroll
        for (int ai = 0; ai < 2; ++ai)
#pragma unroll
            for (int m = 0; m < 4; ++m) { bf16_t* rowp = base + (size_t)(row0 + ai * HALF + m * 16) * ldc + col0;
#pragma unroll
                for (int bj = 0; bj < 2; ++bj) { f32x4 v0 = acc[ai][bj][m][0] + bv[bj][0], v1 = acc[ai][bj][m][1] + bv[bj][1];
                    if (ACT == 1) { f32x2 a = gelu_pk((f32x2){v0[0], v0[1]}), b = gelu_pk((f32x2){v0[2], v0[3]}), c = gelu_pk((f32x2){v1[0], v1[1]}), d = gelu_pk((f32x2){v1[2], v1[3]});
                        v0 = (f32x4){a.x, a.y, b.x, b.y}; v1 = (f32x4){c.x, c.y, d.x, d.y}; }
                    v0 = v0 * sc; v1 = v1 * sc; u32x4 w; w.x = cvt_pk_bf16(v0[0], v0[1]); w.y = cvt_pk_bf16(v0[2], v0[3]); w.z = cvt_pk_bf16(v1[0], v1[1]); w.w = cvt_pk_bf16(v1[2], v1[3]);
                    *(u32x4*)(rowp + bj * HALF) = w; } }
    }
};
template <class Epi, class Sched, bool ALIGN_EPI = false, bool SP2 = false>
__device__ __forceinline__ void gemm_phase(PG8_LAS unsigned char* lds, const Gemm g, const Sched& S, const Epi& E) {
    int tid_o = threadIdx.x; asm volatile("" : "+v"(tid_o)); const int tid = tid_o, wid = __builtin_amdgcn_readfirstlane(tid >> 6), lane = tid & 63, wr = wid >> 2, wc = wid & 3, fr = lane & 15, fq = lane >> 4;
    const int K = g.K, nt = K / BK;
    unsigned voffA[2], voffB[2];
#pragma unroll
    for (int i = 0; i < 2; ++i) { int R, C; stage_rc(tid * 16 + i * 8192, R, C); const int Rb = Epi::PERM ? ((R & ~31) + perm32(R & 31)) : R;
        voffA[i] = (unsigned)(R * K + C) * 2u; voffB[i] = (unsigned)(Rb * K + C) * 2u; }
    const size_t kstep = (size_t)(BK * 2);
    const size_t hstep = (size_t)HALF * K * 2;
    const size_t tstep = 2 * hstep;
    const unsigned ldsw = (unsigned)wid * 1024u;
    const int aoff = lds_byte(wr * 64 + fr, fq * 8), boff = lds_byte(wc * 32 + fr, fq * 8);
#define PG8_SA(b, h) (((b) * 2 + (h)) * HTB)
#define PG8_SB(b, h) ((4 + (b) * 2 + (h)) * HTB)
#define PG8_STAGE(bufoff, gbase, voff) do { _Pragma("unroll") for (int _i = 0; _i < 2; ++_i) \
        __builtin_amdgcn_global_load_lds((const unsigned*)((const char*)(gbase) + (voff)[_i]), (PG8_LAS unsigned*)(lds + (bufoff) + ldsw + _i * 8192), 16, 0, 0); } while (0)
#define PG8_LDA(dst, b, h) do { _Pragma("unroll") for (int m = 0; m < 4; ++m) _Pragma("unroll") for (int k = 0; k < 2; ++k) dst[m][k] = *(const PG8_LAS bf16x8*)(lds + PG8_SA(b, h) + aoff + m * 2048 + k * 1024); } while (0)
#define PG8_LDB(dst, b, h) do { _Pragma("unroll") for (int n = 0; n < 2; ++n) _Pragma("unroll") for (int k = 0; k < 2; ++k) dst[n][k] = *(const PG8_LAS bf16x8*)(lds + PG8_SB(b, h) + boff + n * 2048 + k * 1024); } while (0)
#define PG8_MMA(ai, bj, At, Bt) do { __builtin_amdgcn_s_setprio(1); _Pragma("unroll") for (int m = 0; m < 4; ++m) _Pragma("unroll") for (int n = 0; n < 2; ++n) _Pragma("unroll") for (int k = 0; k < 2; ++k) \
        acc[ai][bj][m][n] = __builtin_amdgcn_mfma_f32_16x16x32_bf16(Bt[n][k], At[m][k], acc[ai][bj][m][n], 0, 0, 0); __builtin_amdgcn_s_setprio(0); } while (0)
#define PG8_WAIT_V(n) asm volatile("s_waitcnt vmcnt(" #n ")" ::: "memory")
#define PG8_WAIT_L(n) asm volatile("s_waitcnt lgkmcnt(" #n ")" ::: "memory")
#define PG8_BAR __builtin_amdgcn_s_barrier()
#define PG8_SCHED __builtin_amdgcn_sched_barrier(0)
    Unit cur, nxt; int ui = 0;
    if (!S.next(0, cur)) return;
    f32x4 acc[2][2][4][2];
#pragma unroll
    for (int a = 0; a < 2; ++a)
#pragma unroll
        for (int b = 0; b < 2; ++b)
#pragma unroll
            for (int m = 0; m < 4; ++m)
#pragma unroll
                for (int n = 0; n < 2; ++n) acc[a][b][m][n] = (f32x4){0.f, 0.f, 0.f, 0.f};
    bf16x8 At[4][2], B0[2][2], B1[2][2];
    const char* cA = (const char*)g.A + (size_t)cur.pm * tstep; const char* cB = (const char*)g.Bt + (size_t)cur.pn * tstep;
    S.a_ready(cur);
    if constexpr (SP2) {
        PG8_STAGE(PG8_SB(0, 0), cB, voffB); PG8_STAGE(PG8_SB(0, 1), cB + hstep, voffB); PG8_STAGE(PG8_SA(0, 0), cA, voffA); PG8_STAGE(PG8_SA(0, 1), cA + hstep, voffA);
        if (wr == 1) PG8_BAR;
        PG8_WAIT_V(2); PG8_BAR;
        PG8_STAGE(PG8_SB(1, 0), cB + kstep, voffB); PG8_STAGE(PG8_SA(1, 0), cA + kstep, voffA); PG8_STAGE(PG8_SB(1, 1), cB + hstep + kstep, voffB);
        PG8_WAIT_V(6); PG8_BAR;
    } else {
        PG8_STAGE(PG8_SB(0, 0), cB, voffB); PG8_STAGE(PG8_SA(0, 0), cA, voffA); PG8_STAGE(PG8_SB(0, 1), cB + hstep, voffB); PG8_STAGE(PG8_SA(0, 1), cA + hstep, voffA);
        if (wr == 1) PG8_BAR;
        PG8_WAIT_V(4); PG8_BAR;
        PG8_STAGE(PG8_SB(1, 0), cB + kstep, voffB); PG8_STAGE(PG8_SA(1, 0), cA + kstep, voffA); PG8_STAGE(PG8_SB(1, 1), cB + hstep + kstep, voffB);
        PG8_WAIT_V(6); PG8_BAR;
    }
    for (;;) {
        const bool has_next = S.next(ui + 1, nxt);
        const char* nA = has_next ? (const char*)g.A + (size_t)nxt.pm * tstep : cA; const char* nB = has_next ? (const char*)g.Bt + (size_t)nxt.pn * tstep : cB;
        for (int t = 0; t < nt; t += 2) {
            const bool last = (t == nt - 2);
            const char* a1 = cA + (size_t)(t + 1) * kstep;
            const char* a2 = last ? nA : cA + (size_t)(t + 2) * kstep; const char* b2 = last ? nB : cB + (size_t)(t + 2) * kstep;
            const char* a3 = a2 + kstep; const char* b3 = b2 + kstep;
            if (last && has_next) S.a_ready(nxt);
            if constexpr (SP2) {
            PG8_LDB(B0, 0, 0); PG8_LDB(B1, 0, 1); PG8_SCHED; PG8_LDA(At, 0, 0); PG8_STAGE(PG8_SA(1, 1), a1 + hstep, voffA);
            PG8_WAIT_V(8); PG8_WAIT_L(0); PG8_BAR; PG8_MMA(0, 0, At, B0); PG8_MMA(0, 1, At, B1); PG8_BAR; PG8_SCHED;
            PG8_LDA(At, 0, 1); PG8_STAGE(PG8_SB(0, 0), b2, voffB); PG8_STAGE(PG8_SB(0, 1), b2 + hstep, voffB); PG8_STAGE(PG8_SA(0, 0), a2, voffA);
            PG8_WAIT_V(8); PG8_WAIT_L(0); PG8_BAR; PG8_MMA(1, 0, At, B0); PG8_MMA(1, 1, At, B1); PG8_BAR; PG8_SCHED;
            PG8_LDB(B0, 1, 0); PG8_LDB(B1, 1, 1); PG8_SCHED; PG8_LDA(At, 1, 0); PG8_STAGE(PG8_SA(0, 1), a2 + hstep, voffA);
            PG8_WAIT_V(8); PG8_WAIT_L(0); PG8_BAR; PG8_MMA(0, 0, At, B0); PG8_MMA(0, 1, At, B1); PG8_BAR; PG8_SCHED;
            PG8_LDA(At, 1, 1); PG8_STAGE(PG8_SB(1, 0), b3, voffB); PG8_STAGE(PG8_SB(1, 1), b3 + hstep, voffB); PG8_STAGE(PG8_SA(1, 0), a3, voffA);
            PG8_WAIT_V(8); PG8_WAIT_L(0); PG8_BAR; PG8_MMA(1, 0, At, B0); PG8_MMA(1, 1, At, B1); PG8_BAR; PG8_SCHED;
            } else {
            PG8_LDB(B0, 0, 0); PG8_SCHED; PG8_LDA(At, 0, 0); PG8_STAGE(PG8_SA(1, 1), a1 + hstep, voffA);
            PG8_WAIT_L(8); PG8_BAR; PG8_WAIT_L(0); PG8_MMA(0, 0, At, B0); PG8_BAR; PG8_SCHED;
            PG8_LDB(B1, 0, 1); PG8_STAGE(PG8_SB(0, 0), b2, voffB);
            PG8_BAR; PG8_WAIT_L(0); PG8_MMA(0, 1, At, B1); PG8_BAR;
            PG8_LDA(At, 0, 1); PG8_STAGE(PG8_SA(0, 0), a2, voffA);
            PG8_BAR; PG8_WAIT_L(0); PG8_MMA(1, 0, At, B0); PG8_BAR; PG8_SCHED;
            PG8_STAGE(PG8_SB(0, 1), b2 + hstep, voffB);
            PG8_WAIT_V(6); PG8_BAR; PG8_MMA(1, 1, At, B1); PG8_BAR;
            PG8_LDB(B0, 1, 0); PG8_SCHED; PG8_LDA(At, 1, 0); PG8_STAGE(PG8_SA(0, 1), a2 + hstep, voffA);
            PG8_WAIT_L(8); PG8_BAR; PG8_WAIT_L(0); PG8_MMA(0, 0, At, B0); PG8_BAR; PG8_SCHED;
            PG8_LDB(B1, 1, 1); PG8_STAGE(PG8_SB(1, 0), b3, voffB);
            PG8_BAR; PG8_WAIT_L(0); PG8_MMA(0, 1, At, B1); PG8_BAR;
            PG8_LDA(At, 1, 1); PG8_STAGE(PG8_SA(1, 0), a3, voffA);
            PG8_BAR; PG8_WAIT_L(0); PG8_MMA(1, 0, At, B0); PG8_BAR; PG8_SCHED;
            PG8_STAGE(PG8_SB(1, 1), b3 + hstep, voffB);
            PG8_WAIT_V(6); PG8_BAR; PG8_MMA(1, 1, At, B1); PG8_BAR;
            }
        }
        if constexpr (ALIGN_EPI) { if (wr == 0) PG8_BAR; }
        if constexpr (!Epi::AFTER_DRAIN) { E(acc, cur, wr, wc, fr, fq); S.done(cur); }
        if (!has_next) break;
#pragma unroll
        for (int a = 0; a < 2; ++a)
#pragma unroll
            for (int b = 0; b < 2; ++b)
#pragma unroll
                for (int m = 0; m < 4; ++m)
#pragma unroll
                    for (int n = 0; n < 2; ++n) acc[a][b][m][n] = (f32x4){0.f, 0.f, 0.f, 0.f};
        cur = nxt; cA = nA; cB = nB; ++ui;
        if constexpr (ALIGN_EPI) { if (wr == 1) PG8_BAR; }
    }
    PG8_WAIT_V(0);
    if constexpr (!ALIGN_EPI) { if (wr == 0) PG8_BAR; }
    PG8_BAR;
    if constexpr (Epi::AFTER_DRAIN) { E.fused(acc, cur, wr, wc, fr, fq, lds, wid, lane); S.done(cur); }
#undef PG8_SA
#undef PG8_SB
#undef PG8_STAGE
#undef PG8_LDA
#undef PG8_LDB
#undef PG8_MMA
#undef PG8_WAIT_V
#undef PG8_WAIT_L
#undef PG8_BAR
#undef PG8_SCHED
}
}
#include <hip/hip_bf16.h>
#include <cmath>
namespace attn_body {
using bf16=__hip_bfloat16;
using bf16x8=__attribute__((ext_vector_type(8)))short;
using s16x4=__attribute__((ext_vector_type(4)))short;
using f32x16=__attribute__((ext_vector_type(16)))float;
using u32x4=__attribute__((ext_vector_type(4)))unsigned;
constexpr int D=64,QP=512,KP=512,VP=128,OP=1024;
constexpr int NW=8,QBLK=32,QB=QBLK*NW,KVBLK=64;
constexpr int ATTN_UNIT_ROWS=QB;
__device__ __forceinline__ int crow(int r,int hi){return (r&3)+8*(r>>2)+4*hi;}
#define SBAR() __builtin_amdgcn_sched_barrier(0)
__device__ __forceinline__ void cmask(f32x16&p0,f32x16&p1,int jb,int qrel,int hi){
  const float NEG=-INFINITY; int kb=64*jb+4*hi;
  #pragma unroll
  for(int r=0;r<16;++r){int kv=kb+(r&3)+8*(r>>2); if(kv>qrel)p0[r]=NEG; if(kv+32>qrel)p1[r]=NEG;}
}

constexpr int NSLOT=3, SLOTB=8192;
constexpr int LDS_K=0, LDS_V=NSLOT*SLOTB, LDS_WS=2*NSLOT*SLOTB, LDS_OST=LDS_WS+NW*64*4, LDS_BYTES=LDS_OST+NW*4096;
constexpr float C2=0.125f*1.4426950408889634f;
__device__ __forceinline__ void glds16(const void*gsrc,unsigned lds_dst){unsigned keep;
  asm volatile("s_mov_b32 %0, m0\n\ts_mov_b32 m0, %2\n\ts_nop 0\n\tglobal_load_lds_dwordx4 %1, off\n\ts_mov_b32 m0, %0":"=&s"(keep):"v"(gsrc),"s"(lds_dst):"memory");}
__device__ __forceinline__ float max3f(float a,float b,float c){float r;asm("v_max3_f32 %0, %1, %2, %3":"=v"(r):"v"(a),"v"(b),"v"(c));return r;}
__device__ __forceinline__ float max2f(float a,float b){float r;asm("v_max_f32_e32 %0, %1, %2":"=v"(r):"v"(a),"v"(b));return r;}
__device__ __forceinline__ float fadd_s(float a,float b){float r;asm("v_add_f32_e32 %0, %1, %2":"=v"(r):"v"(a),"v"(b));return r;}
__device__ __forceinline__ float fsub_s(float a,float b){float r;asm("v_sub_f32_e32 %0, %1, %2":"=v"(r):"v"(a),"v"(b));return r;}
typedef float f32x2_t __attribute__((ext_vector_type(2))); typedef __bf16 bf16x2_t __attribute__((ext_vector_type(2)));
__device__ __forceinline__ unsigned cvtpk_s(float lo,float hi){f32x2_t v={lo,hi};bf16x2_t b=__builtin_convertvector(v,bf16x2_t);return __builtin_bit_cast(unsigned,b);}
#define WAIT_BAR(N) asm volatile("s_waitcnt vmcnt(" #N ") lgkmcnt(0)\n\ts_barrier":::"memory")

__device__ __forceinline__ void qkt(f32x16&p0,f32x16&p1,const char*Kslot,const bf16x8*qr,const f32x16&negm,int r32,int hi){
  const char*kb=Kslot+hi*1024+r32*16;
  #pragma unroll
  for(int d0=0;d0<4;++d0){
    const bf16x8 b0=*reinterpret_cast<const bf16x8*>(kb+d0*2048);
    const bf16x8 b1=*reinterpret_cast<const bf16x8*>(kb+d0*2048+512);
    if(d0==0){p0=__builtin_amdgcn_mfma_f32_32x32x16_bf16(b0,qr[0],negm,0,0,0);p1=__builtin_amdgcn_mfma_f32_32x32x16_bf16(b1,qr[0],negm,0,0,0);}
    else{p0=__builtin_amdgcn_mfma_f32_32x32x16_bf16(b0,qr[d0],p0,0,0,0);p1=__builtin_amdgcn_mfma_f32_32x32x16_bf16(b1,qr[d0],p1,0,0,0);}}
}
typedef __attribute__((address_space(3))) const char* lds_cptr;
typedef short v4i16_t __attribute__((ext_vector_type(4)));
__device__ __forceinline__ void kload8(bf16x8*kf,lds_cptr kp){
  kf[0]=*(const __attribute__((address_space(3))) bf16x8*)(kp);      kf[1]=*(const __attribute__((address_space(3))) bf16x8*)(kp+512);
  kf[2]=*(const __attribute__((address_space(3))) bf16x8*)(kp+2048); kf[3]=*(const __attribute__((address_space(3))) bf16x8*)(kp+2560);
  kf[4]=*(const __attribute__((address_space(3))) bf16x8*)(kp+4096); kf[5]=*(const __attribute__((address_space(3))) bf16x8*)(kp+4608);
  kf[6]=*(const __attribute__((address_space(3))) bf16x8*)(kp+6144); kf[7]=*(const __attribute__((address_space(3))) bf16x8*)(kp+6656);
}
__device__ __forceinline__ void kload2(bf16x8*kf,lds_cptr kp,int j){ kf[2*j]=*(const __attribute__((address_space(3))) bf16x8*)(kp+j*2048); kf[2*j+1]=*(const __attribute__((address_space(3))) bf16x8*)(kp+j*2048+512); }
__device__ __forceinline__ s16x4 vtr(lds_cptr p){ return __builtin_bit_cast(s16x4,__builtin_amdgcn_ds_read_tr16_b64_v4i16((__attribute__((address_space(3))) v4i16_t*)p)); }
__device__ __forceinline__ float rowmax(const f32x16&p0,const f32x16&p1){
  float a=max3f(p0[0],p0[1],p1[0]),b=max3f(p0[2],p0[3],p1[1]);a=max3f(a,p1[2],p1[3]);
  #pragma unroll
  for(int r=4;r<16;r+=4){a=max3f(a,p0[r],p0[r+1]);b=max3f(b,p0[r+2],p0[r+3]);a=max3f(a,p1[r],p1[r+1]);b=max3f(b,p1[r+2],p1[r+3]);}
  const float m=max2f(a,b);
  auto rr=__builtin_amdgcn_permlane32_swap(__float_as_uint(m),__float_as_uint(m),false,false);
  return max2f(__uint_as_float(rr[0]),__uint_as_float(rr[1]));
}
__device__ __forceinline__ void pv(f32x16*o,int vb,bf16x8 pa0,bf16x8 pa1,bf16x8 pa2,bf16x8 pa3){
  #pragma unroll
  for(int d0=0;d0<2;++d0){s16x4 lo[4],hi[4];
    #pragma unroll
    for(int ks=0;ks<4;++ks){
      asm volatile("ds_read_b64_tr_b16 %0,%1 offset:%c2":"=&v"(lo[ks]):"v"(vb),"i"(d0*4096+ks*1024):"memory");
      asm volatile("ds_read_b64_tr_b16 %0,%1 offset:%c2":"=&v"(hi[ks]):"v"(vb),"i"(d0*4096+ks*1024+512):"memory");}
    asm volatile("s_waitcnt lgkmcnt(0)":::"memory");SBAR();
    #define PK(k) (bf16x8){lo[k][0],lo[k][1],lo[k][2],lo[k][3],hi[k][0],hi[k][1],hi[k][2],hi[k][3]}
    o[d0]=__builtin_amdgcn_mfma_f32_32x32x16_bf16(pa0,PK(0),o[d0],0,0,0);
    o[d0]=__builtin_amdgcn_mfma_f32_32x32x16_bf16(pa1,PK(1),o[d0],0,0,0);
    o[d0]=__builtin_amdgcn_mfma_f32_32x32x16_bf16(pa2,PK(2),o[d0],0,0,0);
    o[d0]=__builtin_amdgcn_mfma_f32_32x32x16_bf16(pa3,PK(3),o[d0],0,0,0);
    #undef PK
  }
}

#ifndef ATTN_STORE16
#define ATTN_STORE16(p,v) (*(u32x4*)(p)=(v))
#endif
template<int THRL> __device__ __forceinline__ void attn_unit(int rowbase_i,int S,int qb,int qcol,int kcol,int vcol,int ocol,const bf16*Q,const bf16*__restrict__ K,const bf16*__restrict__ V,bf16*O,char*shm){
  int tid_o=threadIdx.x; asm volatile("":"+v"(tid_o)); const int tid=tid_o,lane=tid&63,r32=lane&31,hi=lane>>5; const int wid=__builtin_amdgcn_readfirstlane(tid>>6);
  const long rowbase=(long)rowbase_i; const int q0=qb*QB;
  const bf16*Qw=Q+(rowbase+q0+wid*QBLK)*QP+qcol;
  const bf16*Kh=K+rowbase*KP+kcol,*Vh=V+rowbase*VP+vcol;
  const unsigned lds0=(unsigned)(uintptr_t)shm;
  float*wsf=(float*)(shm+LDS_WS)+wid*64;
  const bf16*ksrc=Kh+(long)lane*KP+wid*8;
  const bf16*vsrc=Vh+(long)(16*(wid&3)+(lane>>2))*VP+(wid>>2)*32+(lane&3)*8;
  const unsigned kdst=lds0+LDS_K+wid*1024, vdst=lds0+LDS_V+wid*1024;
  #define DMA_K(t,slot) glds16(ksrc+(long)(t)*KVBLK*KP,(unsigned)__builtin_amdgcn_readfirstlane(kdst+(slot)))
  #define DMA_V(t,slot) glds16(vsrc+(long)(t)*KVBLK*VP,(unsigned)__builtin_amdgcn_readfirstlane(vdst+(slot)))
  const int vb0=(int)(lds0+LDS_V)+((lane>>4)&1)*32+(lane&3)*8+(4*hi+((lane&15)>>2))*64;
  const char*Kbase=shm+LDS_K; bf16x8 kf[8];
  const lds_cptr shm3=(lds_cptr)shm; const lds_cptr kp0=shm3+LDS_K+hi*1024+r32*16; const lds_cptr vp0=shm3+LDS_V+((lane>>4)&1)*32+(lane&3)*8+(4*hi+((lane&15)>>2))*64;
  const int NT=S/KVBLK;
  DMA_K(0,0);DMA_V(0,0);DMA_K(1,SLOTB);
  bf16x8 qr[4];
  #pragma unroll
  for(int d0=0;d0<4;++d0)qr[d0]=*reinterpret_cast<const bf16x8*>(&Qw[(long)r32*QP+d0*16+hi*8]);
  float mhat=0.f,l_reg=0.f;f32x16 o[2];o[0]=f32x16{};o[1]=f32x16{};f32x16 negm=f32x16{};asm volatile("":"+v"(negm));
  const int qrel=wid*QBLK+r32;
  #define CMASK(P0,P1,t) do{}while(0)
  bool resc=false;
  #define START(P0,P1) do{ const float rm=rowmax(P0,P1); resc=false; \
    { const float dl=rm; mhat=fadd_s(mhat,dl); \
      _Pragma("unroll") for(int r=0;r<16;++r){P0[r]=fsub_s(P0[r],dl);P1[r]=fsub_s(P1[r],dl);} \
      _Pragma("unroll") for(int r=0;r<16;++r)negm[r]=-mhat; asm volatile("":"+v"(negm)); } \
    _Pragma("unroll") for(int r=0;r<16;++r)P0[r]=__builtin_amdgcn_exp2f(P0[r]); }while(0)
  #define RESC() do{ if(resc){ asm volatile("s_waitcnt lgkmcnt(0)":::"memory"); \
      _Pragma("unroll") for(int d_=0;d_<2;++d_) _Pragma("unroll") for(int r=0;r<16;++r)o[d_][r]*=wsf[crow(r,hi)]; } }while(0)
  f32x16 pA0,pA1,pB0,pB1;
  int sl_prev=0,sl_cur=0,sl_next=SLOTB;
  #define ROT() do{sl_prev=sl_cur;sl_cur=sl_next;sl_next=(sl_next==(NSLOT-1)*SLOTB)?0:sl_next+SLOTB;}while(0)
  DMA_K(2,2*SLOTB);
  WAIT_BAR(3);
  qkt(pA0,pA1,Kbase,qr,negm,r32,hi);asm volatile("s_nop 15\n\ts_nop 7":"+v"(pA0),"+v"(pA1));CMASK(pA0,pA1,0);
  START(pA0,pA1);
  _Pragma("unroll") for(int r=0;r<16;++r)pA1[r]=__builtin_amdgcn_exp2f(pA1[r]);
  WAIT_BAR(0);
  DMA_K(3,0);DMA_V(1,SLOTB);
  ROT();
  kload8(kf,kp0+sl_cur);
  WAIT_BAR(2);
  s16x4 vlo[8],vhi[8]; u32x4 pw0,pw1,pw2,pw3;
  #define PKW(P,B) cvtpk_s(P[B],P[B+1])
  #define PAF(k) __builtin_bit_cast(bf16x8,pw##k)
  #define VFR(i) (bf16x8){vlo[i][0],vlo[i][1],vlo[i][2],vlo[i][3],vhi[i][0],vhi[i][1],vhi[i][2],vhi[i][3]}
  #define PIN(x) asm volatile("":"+v"(x))
  #define MX3(a,b,c) __builtin_fmaxf(__builtin_fmaxf((a),(b)),(c))
  #define GAPA(MF,A0,A1,A2,A3,W0,W1,PW) do{ MF; sacc+=A0; sacc+=A1; sacc+=A2; sacc+=A3; PIN(sacc); W0; W1; PIN(PW); SBAR(); }while(0)
  #define EX(v) __builtin_amdgcn_exp2f(v)
  #define GAPB(MF,X,B) do{ MF; X[B]=EX(X[B]); X[B+1]=EX(X[B+1]); X[B+2]=EX(X[B+2]); X[B+3]=EX(X[B+3]); PIN(X); SBAR(); }while(0)
  #define VRD(i) do{ vlo[i]=vtr(vp_+(((i)>>2)*4096+((i)&3)*1024)); vhi[i]=vtr(vp_+(((i)>>2)*4096+((i)&3)*1024+512)); }while(0)
  #define KRD(G,j) do{ if(G){ kload2(kf,kp0+sl_next,j); SBAR(); } }while(0)
  #define STEP(C0,C1,P0,P1,t,GK,GV,GL) do{ SBAR(); \
    const lds_cptr vp_=vp0+sl_prev; \
    VRD(0); SBAR(); float sacc=(P0[0]+P0[1]); \
    GAPA(C0=__builtin_amdgcn_mfma_f32_32x32x16_bf16(kf[0],qr[0],negm,0,0,0), P0[2],P0[3],P0[4],P0[5],     pw0[0]=PKW(P0,0), pw0[1]=PKW(P0,2), pw0); \
    VRD(4); SBAR(); GAPA(C1=__builtin_amdgcn_mfma_f32_32x32x16_bf16(kf[1],qr[0],negm,0,0,0), P0[6],P0[7],P0[8],P0[9],     pw0[2]=PKW(P0,4), pw0[3]=PKW(P0,6), pw0); \
    VRD(1); SBAR(); GAPA(C0=__builtin_amdgcn_mfma_f32_32x32x16_bf16(kf[2],qr[1],C0,0,0,0),   P0[10],P0[11],P0[12],P0[13], pw1[0]=PKW(P0,8), pw1[1]=PKW(P0,10), pw1); \
    VRD(5); SBAR(); GAPA(C1=__builtin_amdgcn_mfma_f32_32x32x16_bf16(kf[3],qr[1],C1,0,0,0),   P0[14],P0[15],P1[0],P1[1],   pw1[2]=PKW(P0,12),pw1[3]=PKW(P0,14), pw1); \
    VRD(2); SBAR(); GAPA(C0=__builtin_amdgcn_mfma_f32_32x32x16_bf16(kf[4],qr[2],C0,0,0,0),   P1[2],P1[3],P1[4],P1[5],     pw2[0]=PKW(P1,0), pw2[1]=PKW(P1,2), pw2); \
    VRD(6); SBAR(); GAPA(C1=__builtin_amdgcn_mfma_f32_32x32x16_bf16(kf[5],qr[2],C1,0,0,0),   P1[6],P1[7],P1[8],P1[9],     pw2[2]=PKW(P1,4), pw2[3]=PKW(P1,6), pw2); \
    VRD(3); SBAR(); GAPA(C0=__builtin_amdgcn_mfma_f32_32x32x16_bf16(kf[6],qr[3],C0,0,0,0),   P1[10],P1[11],P1[12],P1[13], pw3[0]=PKW(P1,8), pw3[1]=PKW(P1,10), pw3); \
    VRD(7); SBAR(); GAPA(C1=__builtin_amdgcn_mfma_f32_32x32x16_bf16(kf[7],qr[3],C1,0,0,0),   P1[14],P1[15],0.f,0.f,       pw3[2]=PKW(P1,12),pw3[3]=PKW(P1,14), pw3); \
    l_reg+=sacc; \
    if(GK){DMA_K((t)+3,sl_cur);} if(GV){DMA_V((t)+1,sl_next);} \
    CMASK(C0,C1,t); \
    { float a=MX3(C0[0],C0[1],C1[0]),b=MX3(C0[2],C0[3],C1[1]); a=MX3(a,C1[2],C1[3]); \
      _Pragma("unroll") for(int r=4;r<16;r+=4){a=MX3(a,C0[r],C0[r+1]);b=MX3(b,C0[r+2],C0[r+3]);a=MX3(a,C1[r],C1[r+1]);b=MX3(b,C1[r+2],C1[r+3]);} \
      float rm=__builtin_fmaxf(a,b); { auto rr=__builtin_amdgcn_permlane32_swap(__float_as_uint(rm),__float_as_uint(rm),false,false); rm=__builtin_fmaxf(__uint_as_float(rr[0]),__uint_as_float(rr[1])); } \
      resc=false; \
      if(__builtin_expect(__any(rm>(float)THRL),0)){ const float dl=__builtin_fmaxf(rm,0.f); mhat+=dl; \
        _Pragma("unroll") for(int r=0;r<16;++r){C0[r]-=dl;C1[r]-=dl;} \
        _Pragma("unroll") for(int r=0;r<16;++r)negm[r]=-mhat; asm volatile("":"+v"(negm)); \
        const float f=__builtin_amdgcn_exp2f(-dl); l_reg*=f; if(hi==0)wsf[r32]=f; resc=true; } } \
    SBAR(); \
    GAPB(o[0]=__builtin_amdgcn_mfma_f32_32x32x16_bf16(PAF(0),VFR(0),o[0],0,0,0), C0,0); \
    GAPB(o[1]=__builtin_amdgcn_mfma_f32_32x32x16_bf16(PAF(0),VFR(4),o[1],0,0,0), C0,4); \
    KRD(GL,0); GAPB(o[0]=__builtin_amdgcn_mfma_f32_32x32x16_bf16(PAF(1),VFR(1),o[0],0,0,0), C0,8); \
    KRD(GL,1); GAPB(o[1]=__builtin_amdgcn_mfma_f32_32x32x16_bf16(PAF(1),VFR(5),o[1],0,0,0), C0,12); \
    KRD(GL,2); GAPB(o[0]=__builtin_amdgcn_mfma_f32_32x32x16_bf16(PAF(2),VFR(2),o[0],0,0,0), C1,0); \
    KRD(GL,3); GAPB(o[1]=__builtin_amdgcn_mfma_f32_32x32x16_bf16(PAF(2),VFR(6),o[1],0,0,0), C1,4); \
    GAPB(o[0]=__builtin_amdgcn_mfma_f32_32x32x16_bf16(PAF(3),VFR(3),o[0],0,0,0), C1,8); \
    GAPB(o[1]=__builtin_amdgcn_mfma_f32_32x32x16_bf16(PAF(3),VFR(7),o[1],0,0,0), C1,12); \
    }while(0)
  int t=1;
  #undef CMASK
  #define CMASK(P0,P1,t) do{}while(0)
  for(;t+5<NT;t+=2){
    STEP(pB0,pB1,pA0,pA1,t,true,true,true);     WAIT_BAR(2); RESC(); ROT();
    STEP(pA0,pA1,pB0,pB1,t+1,true,true,true);   WAIT_BAR(2); RESC(); ROT();
  }
  #undef CMASK
  #define CMASK(P0,P1,t) do{}while(0)
  #define ENDW(tt) do{ if((tt)+3<NT){WAIT_BAR(2);} else if((tt)+2<NT){WAIT_BAR(1);} else {WAIT_BAR(0);} }while(0)
  for(;t+1<NT;t+=2){
    STEP(pB0,pB1,pA0,pA1,t,(t+3<NT),(t+1<NT),(t+1<NT));       ENDW(t);   RESC(); ROT();
    STEP(pA0,pA1,pB0,pB1,t+1,(t+4<NT),(t+2<NT),(t+2<NT));     ENDW(t+1); RESC(); ROT();
  }
  STEP(pB0,pB1,pA0,pA1,NT-1,false,false,false); RESC();
  { float sacc=pB0[0]+pB0[1]; _Pragma("unroll") for(int r=2;r<16;++r)sacc+=pB0[r]; _Pragma("unroll") for(int r=0;r<16;++r)sacc+=pB1[r]; l_reg+=sacc;
    pw0=(u32x4){PKW(pB0,0),PKW(pB0,2),PKW(pB0,4),PKW(pB0,6)};pw1=(u32x4){PKW(pB0,8),PKW(pB0,10),PKW(pB0,12),PKW(pB0,14)};pw2=(u32x4){PKW(pB1,0),PKW(pB1,2),PKW(pB1,4),PKW(pB1,6)};pw3=(u32x4){PKW(pB1,8),PKW(pB1,10),PKW(pB1,12),PKW(pB1,14)};
    SBAR(); pv(o,vb0+sl_cur,PAF(0),PAF(1),PAF(2),PAF(3)); }
  #undef PKW
  #undef PAF
  #undef VFR
  #undef PIN
  #undef MX3
  #undef GAPA
  #undef GAPB
  #undef EX
  #undef VRD
  #undef KRD
  #undef STEP
  #undef ENDW
  {auto rr=__builtin_amdgcn_permlane32_swap(__float_as_uint(l_reg),__float_as_uint(l_reg),false,false);l_reg=__uint_as_float(rr[0])+__uint_as_float(rr[1]);}
  if(hi==0)wsf[32+r32]=l_reg;asm volatile("s_waitcnt lgkmcnt(0)":::"memory");
  float rli[16];
  #pragma unroll
  for(int r=0;r<16;++r)rli[r]=__builtin_amdgcn_rcpf(wsf[32+crow(r,hi)]);
  bf16*Ow=O+(rowbase+q0+wid*QBLK)*OP+ocol;
  { bf16*stg=(bf16*)(shm+LDS_OST)+wid*2048;
    #pragma unroll
    for(int r=0;r<16;++r){const int orow=crow(r,hi);
      #pragma unroll
      for(int d0=0;d0<2;++d0)stg[orow*64+d0*32+r32]=__float2bfloat16(o[d0][r]*rli[r]);}
    asm volatile("s_waitcnt lgkmcnt(0)":::"memory");
    #pragma unroll
    for(int i=0;i<4;++i){const int row=i*8+(lane>>3),ch=lane&7; const u32x4 v=*(const u32x4*)(stg+row*64+ch*8); ATTN_STORE16(Ow+(long)row*OP+ch*8,v);} }
  asm volatile("s_waitcnt lgkmcnt(0)\n\ts_barrier":::"memory");
  #undef DMA_K
  #undef DMA_V
  #undef CMASK
  #undef START
  #undef RESC
  #undef ROT
}
constexpr int ATTN_LDS_BYTES=LDS_BYTES;
#undef SBAR
#undef WAIT_BAR
}

#define LAS __attribute__((address_space(3)))
#define LDS_BARRIER() asm volatile("s_waitcnt lgkmcnt(0)\n\ts_barrier" ::: "memory")
typedef unsigned short bf16;
typedef unsigned u32x4_t __attribute__((ext_vector_type(4)));
typedef unsigned u32x2_t __attribute__((ext_vector_type(2)));
typedef float f32x4_t __attribute__((ext_vector_type(4)));
typedef float f32x2_t __attribute__((ext_vector_type(2)));

constexpr int DM = 1024, MTOK = 49152, NSEQ = 20, DFF = 2816, NFF = 5632, NMIXP = 2560, NMIX = 2432, ZP = 1792;
constexpr int NTHR = 512;
constexpr float QSCALE = 0.125f * 1.4426950408889634f;
constexpr size_t MiB = 1u << 20;
constexpr size_t ZERO_BYTES = 8 * MiB;
constexpr size_t OFF_CTR = 0, OFF_ROPE = 32768, OFF_SS = 65536, OFF_MOD = 2 * MiB, OFF_BIAS = 4 * MiB, OFF_GV = 7 * MiB, OFF_GATE = 7 * MiB + 512 * 1024;
constexpr size_t OFF_W = 8 * MiB, W_LAYER = 40 * MiB;
constexpr size_t WO_IN = 0, WO_OUT = 22 * MiB, WO_MI = 33 * MiB, WO_MO = 38 * MiB;
constexpr size_t OFF_XN = 88 * MiB, OFF_YF = 88 * MiB, OFF_YB = 136 * MiB;
constexpr size_t OFF_HID = 184 * MiB, OFF_Z = 184 * MiB, OFF_QK = 352 * MiB, OFF_VR = 400 * MiB, OFF_OMIX = 412 * MiB, WS_END = 508 * MiB;
constexpr size_t OFF_SMID = 508 * MiB;
constexpr int LDS_BYTES = 147456, MISC_OFF = 131072;

struct KP { const float* in[31]; float* out; unsigned char* ws; };

__device__ __forceinline__ int seq_of_row(int m) { return m < 16384 ? (m >> 12) : 4 + ((m - 16384) >> 11); }
__device__ __forceinline__ int seq_start(int s) { return s < 4 ? s * 4096 : 16384 + (s - 4) * 2048; }
__device__ __forceinline__ int seq_len(int s) { return s < 4 ? 4096 : 2048; }
__device__ __forceinline__ unsigned f2bf(float f) { unsigned u = __builtin_bit_cast(unsigned, f); return (u + 0x7fffu + ((u >> 16) & 1u)) >> 16; }
__device__ __forceinline__ unsigned pk2(float lo, float hi) { return f2bf(lo) | (f2bf(hi) << 16); }
__device__ __forceinline__ float bf2f(unsigned short b) { return __builtin_bit_cast(float, (unsigned)b << 16); }
__device__ __forceinline__ float sigmoidf_(float x) { return __builtin_amdgcn_rcpf(1.0f + __builtin_amdgcn_exp2f(-1.4426950408889634f * x)); }
#define DPP_ADD(v, CTRL) ((v) + __builtin_bit_cast(float, __builtin_amdgcn_update_dpp(0, __builtin_bit_cast(int, (v)), (CTRL), 0xf, 0xf, false)))
__device__ __forceinline__ float wave_sum(float v) {
    v = DPP_ADD(v, 0xB1);
    v = DPP_ADD(v, 0x4E);
    v = DPP_ADD(v, 0x141);
    v = DPP_ADD(v, 0x140);
    const f32x4_t d = __builtin_amdgcn_mfma_f32_16x16x4f32(1.0f, v, (f32x4_t){0.f, 0.f, 0.f, 0.f}, 0, 0, 0);
    return d[0];
}
__device__ __forceinline__ float tanh_fast(float x) { const float e = __expf(2.0f * x); return 1.0f - 2.0f * __builtin_amdgcn_rcpf(e + 1.0f); }
__host__ __device__ __forceinline__ int map_ffn(int n) { const int half = n >= DFF ? 1 : 0; const int n2 = half ? n - DFF : n; return 256 * (n2 >> 7) + 128 * half + (n2 & 127); }
__host__ __device__ __forceinline__ int map_mix(int n) {
    if (n < 1792 || n >= 2304) return n;
    const int hh = (n - 1792) >> 6, d = (n - 1792) & 63;
    return 256 * (7 + (hh >> 2)) + 128 * (d >> 5) + 32 * (hh & 3) + 8 * ((d & 15) >> 2) + 4 * ((d >> 4) & 1) + (d & 3);
}

namespace pg8 {
struct EpiSwiglu {
    static constexpr bool PERM = true, AFTER_DRAIN = false;
    bf16_t* H; const float* ss; const float* bias;
    __device__ __forceinline__ void operator()(const f32x4 (&acc)[2][2][4][2], const Unit& u, int wr, int wc, int fr, int fq) const {
        const int row0 = u.pm * BM + wr * 64 + fr; const int s = seq_of_row(u.pm * BM);
        const float* bp = bias + (size_t)s * NFF + u.pn * 256 + wc * 32 + 8 * fq;
        f32x4 bg[2], bu[2];
#pragma unroll
        for (int n = 0; n < 2; ++n) { bg[n] = *(const f32x4*)(bp + 4 * n); bu[n] = *(const f32x4*)(bp + 128 + 4 * n); }
        float rsv[2][4];
#pragma unroll
        for (int ai = 0; ai < 2; ++ai)
#pragma unroll
            for (int m = 0; m < 4; ++m) rsv[ai][m] = ss[row0 + ai * HALF + m * 16];
        asm volatile("" ::: "memory");
#pragma unroll
        for (int ai = 0; ai < 2; ++ai)
#pragma unroll
            for (int m = 0; m < 4; ++m) {
                const int row = row0 + ai * HALF + m * 16;
                const float rs = rsqrtf(rsv[ai][m] * (1.0f / 1024.0f) + 1e-6f);
                float h[8];
#pragma unroll
                for (int n = 0; n < 2; ++n) {
                    const f32x4 g = acc[ai][0][m][n] * rs + bg[n], up = acc[ai][1][m][n] * rs + bu[n];
#pragma unroll
                    for (int i = 0; i < 4; ++i) h[4 * n + i] = g[i] * sigmoidf_(g[i]) * up[i];
                }
                u32x4 w; w.x = cvt_pk_bf16(h[0], h[1]); w.y = cvt_pk_bf16(h[2], h[3]); w.z = cvt_pk_bf16(h[4], h[5]); w.w = cvt_pk_bf16(h[6], h[7]);
                *(u32x4*)(H + (size_t)row * DFF + u.pn * 128 + wc * 32 + 8 * fq) = w;
            }
    }
};
struct EpiZ {
    static constexpr bool PERM = true, AFTER_DRAIN = false;
    bf16_t* Z; bf16_t* QK; bf16_t* VR; const float* ss; const float* bias; const float* qg; const float* kg; const float* rope;
    __device__ __forceinline__ void operator()(const f32x4 (&acc)[2][2][4][2], const Unit& u, int wr, int wc, int fr, int fq) const {
        const int row0 = u.pm * BM + wr * 64 + fr; const int s = seq_of_row(u.pm * BM); const int t0 = row0 - seq_start(s);
        const float* bp = bias + (size_t)s * NFF + u.pn * 256 + wc * 32 + 8 * fq;
        f32x4 bv[2][2];
#pragma unroll
        for (int bj = 0; bj < 2; ++bj)
#pragma unroll
            for (int n = 0; n < 2; ++n) bv[bj][n] = *(const f32x4*)(bp + bj * 128 + 4 * n);
        if (u.pn < 7 || u.pn == 9) {
            float rsv[2][4];
#pragma unroll
            for (int ai = 0; ai < 2; ++ai)
#pragma unroll
                for (int m = 0; m < 4; ++m) rsv[ai][m] = ss[row0 + ai * HALF + m * 16];
            asm volatile("" ::: "memory");
#pragma unroll
            for (int ai = 0; ai < 2; ++ai)
#pragma unroll
                for (int m = 0; m < 4; ++m) {
                    const int row = row0 + ai * HALF + m * 16;
                    const float rs = rsqrtf(rsv[ai][m] * (1.0f / 1024.0f) + 1e-6f);
#pragma unroll
                    for (int bj = 0; bj < 2; ++bj) {
                        const f32x4 v0 = acc[ai][bj][m][0] * rs + bv[bj][0], v1 = acc[ai][bj][m][1] * rs + bv[bj][1];
                        u32x4 w; w.x = cvt_pk_bf16(v0[0], v0[1]); w.y = cvt_pk_bf16(v0[2], v0[3]); w.z = cvt_pk_bf16(v1[0], v1[1]); w.w = cvt_pk_bf16(v1[2], v1[3]);
                        if (u.pn < 7) *(u32x4*)(Z + (size_t)row * ZP + u.pn * 256 + bj * 128 + wc * 32 + 8 * fq) = w;
                        else if (bj == 0) *(u32x4*)(VR + (size_t)row * 128 + wc * 32 + 8 * fq) = w;
                    }
                }
        } else {
            const int hh = (u.pn - 7) * 4 + wc; const bool isq = hh < 6; const float* gp = isq ? qg : kg; const float osc = isq ? QSCALE : 1.0f;
            f32x4 gn[2][2];
#pragma unroll
            for (int bj = 0; bj < 2; ++bj)
#pragma unroll
                for (int n = 0; n < 2; ++n) gn[bj][n] = *(const f32x4*)(gp + 32 * bj + 16 * n + 4 * fq);
#pragma unroll
            for (int ai = 0; ai < 2; ++ai)
#pragma unroll
                for (int m = 0; m < 4; ++m) {
                    const int row = row0 + ai * HALF + m * 16; const int t = t0 + ai * HALF + m * 16;
                    const float rs = rsqrtf(ss[row] * (1.0f / 1024.0f) + 1e-6f);
                    f32x4 v[2][2]; float q = 0.f;
#pragma unroll
                    for (int bj = 0; bj < 2; ++bj)
#pragma unroll
                        for (int n = 0; n < 2; ++n) { v[bj][n] = acc[ai][bj][m][n] * rs + bv[bj][n]; q += (v[bj][n][0] * v[bj][n][0] + v[bj][n][1] * v[bj][n][1]) + (v[bj][n][2] * v[bj][n][2] + v[bj][n][3] * v[bj][n][3]); }
                    q += __shfl_xor(q, 16); q += __shfl_xor(q, 32);
                    const float r = rsqrtf(q * (1.0f / 64.0f) + 1e-6f);
#pragma unroll
                    for (int bj = 0; bj < 2; ++bj) {
                        const int pos = bj == 0 ? (t >> 6) : (t & 63);
                        const f32x4 x1 = v[bj][0] * r * gn[bj][0], x2 = v[bj][1] * r * gn[bj][1];
                        const float* rp = rope + (pos * 16 + 4 * fq) * 2;
                        const f32x4 cs0 = *(const f32x4*)(rp), cs1 = *(const f32x4*)(rp + 4);
                        const float c[4] = {cs0[0], cs0[2], cs1[0], cs1[2]}, sn[4] = {cs0[1], cs0[3], cs1[1], cs1[3]};
                        float o1[4], o2[4];
#pragma unroll
                        for (int i = 0; i < 4; ++i) { o1[i] = (x1[i] * c[i] - x2[i] * sn[i]) * osc; o2[i] = (x2[i] * c[i] + x1[i] * sn[i]) * osc; }
                        u32x4 w; w.x = cvt_pk_bf16(o1[0], o1[1]); w.y = cvt_pk_bf16(o1[2], o1[3]); w.z = cvt_pk_bf16(o2[0], o2[1]); w.w = cvt_pk_bf16(o2[2], o2[3]);
                        *(u32x4*)(QK + (size_t)row * 512 + hh * 64 + 32 * bj + 8 * fq) = w;
                    }
                }
        }
    }
};
struct EpiResid {
    static constexpr bool PERM = false, AFTER_DRAIN = false;
    const float* xin_p; const float* xin_s; float* out; bf16_t* xn; float* ssn; const float* gate; const float* gvn;
    __device__ __forceinline__ void operator()(const f32x4 (&acc)[2][2][4][2], const Unit& u, int wr, int wc, int fr, int fq) const {
        const int rowt = u.pm * BM; const int s = seq_of_row(rowt);
        const float* xb = rowt < 16384 ? xin_p : xin_s - (size_t)16384 * DM;
        const int row0 = rowt + wr * 64 + fr; const int col0 = u.pn * BM + wc * 32 + 4 * fq;
        f32x4 gt[2][2], gv[2][2];
#pragma unroll
        for (int bj = 0; bj < 2; ++bj)
#pragma unroll
            for (int n = 0; n < 2; ++n) { gt[bj][n] = *(const f32x4*)(gate + (size_t)s * DM + col0 + bj * HALF + n * 16); gv[bj][n] = gvn ? *(const f32x4*)(gvn + (size_t)s * DM + col0 + bj * HALF + n * 16) : (f32x4){0.f, 0.f, 0.f, 0.f}; }
        f32x4 xo[2][2][2];
#define ER_LOAD(G, BUF) do { const unsigned off_ = (unsigned)(row0 + ((G) >> 2) * HALF + ((G) & 3) * 16) * DM + col0; \
            _Pragma("unroll") for (int bj = 0; bj < 2; ++bj) _Pragma("unroll") for (int n = 0; n < 2; ++n) xo[BUF][bj][n] = *(const f32x4*)(xb + off_ + bj * HALF + n * 16); } while (0)
        ER_LOAD(0, 0);
#pragma unroll
        for (int gi = 0; gi < 8; ++gi) {
            const int ai = gi >> 2, m = gi & 3;
            if (gi < 7) ER_LOAD(gi + 1, (gi + 1) & 1);
            asm volatile("" ::: "memory");
            const int row = row0 + ai * HALF + m * 16; const unsigned off = (unsigned)row * DM + col0; float q = 0.f;
#pragma unroll
            for (int bj = 0; bj < 2; ++bj)
#pragma unroll
                for (int n = 0; n < 2; ++n) {
                    const f32x4 val = xo[gi & 1][bj][n] + gt[bj][n] * acc[ai][bj][m][n];
                    *(f32x4*)(out + off + bj * HALF + n * 16) = val;
                    if (gvn) {
                        q += (val[0] * val[0] + val[1] * val[1]) + (val[2] * val[2] + val[3] * val[3]);
                        const f32x4 o = val * gv[bj][n]; unsigned long long w = (unsigned long long)cvt_pk_bf16(o[0], o[1]) | ((unsigned long long)cvt_pk_bf16(o[2], o[3]) << 32);
                        *(unsigned long long*)(xn + off + bj * HALF + n * 16) = w;
                    }
                }
            if (gvn) { q += __shfl_xor(q, 16); q += __shfl_xor(q, 32); if (fq == 0) atomicAdd(ssn + row, q); }
        }
#undef ER_LOAD
    }
};
}

template <int MAP> __device__ __forceinline__ void transpose_item(const float* W, int K, int N, bf16* WT, float* scr, int item, int lane) {
    const int nblk = N / 32, kb = item / nblk, nb = item % nblk, k0 = 64 * kb, n0 = 32 * nb;
#pragma unroll 8
    for (int i = 0; i < 32; ++i) { const int kk = 2 * i + (lane >> 5); scr[kk * 33 + (lane & 31)] = W[(size_t)(k0 + kk) * N + n0 + (lane & 31)]; }
    __builtin_amdgcn_wave_barrier(); asm volatile("s_waitcnt lgkmcnt(0)" ::: "memory");
    const int c = lane & 7;
#pragma unroll
    for (int j = 0; j < 4; ++j) { const int n = (lane >> 3) + 8 * j; const float* sp = scr + (8 * c) * 33 + n;
        u32x4_t o; o.x = pk2(sp[0 * 33], sp[1 * 33]); o.y = pk2(sp[2 * 33], sp[3 * 33]); o.z = pk2(sp[4 * 33], sp[5 * 33]); o.w = pk2(sp[6 * 33], sp[7 * 33]);
        const int nsrc = n0 + n; const int nd = MAP == 1 ? map_ffn(nsrc) : (MAP == 2 ? map_mix(nsrc) : nsrc);
        *(u32x4_t*)(WT + (size_t)nd * K + k0 + 8 * c) = o; }
    __builtin_amdgcn_wave_barrier(); asm volatile("s_waitcnt lgkmcnt(0)" ::: "memory");
}

template <int MODE, int MAP> __device__ __forceinline__ void smallm_unit(const KP& p, float* sA, int l, int j, const float* W, int ldw, int nvalid, float* dest, int ldd, int nchunk, int kchunk) {
    int tid_o = threadIdx.x; asm volatile("" : "+v"(tid_o)); const int tid = tid_o; const int k0 = kchunk * 128;
    __syncthreads();
    for (int e = tid; e < 128 * NSEQ; e += NTHR) {
        const int k = e / NSEQ, s = e % NSEQ; float v;
        if (MODE == 0) { const float c = s < 4 ? p.in[2][s * DM + k0 + k] : p.in[3][(s - 4) * DM + k0 + k]; v = c * sigmoidf_(c); }
        else { const float* mod = (const float*)(p.ws + OFF_MOD) + ((size_t)l * NSEQ + s) * 9216 + 3 * j * 1024 + k0 + k; v = *mod + p.in[5][l * 9216 + 3 * j * 1024 + k0 + k]; }
        sA[k * NSEQ + s] = v;
    }
    __syncthreads();
    const int n = nchunk * 256 + (tid & 255), kh = tid >> 8;
    float acc[NSEQ];
#pragma unroll
    for (int s = 0; s < NSEQ; ++s) acc[s] = 0.f;
    if (n < nvalid) {
        for (int kb = 0; kb < 64; kb += 16) {
            float wv[16];
#pragma unroll
            for (int u = 0; u < 16; ++u) wv[u] = W[(size_t)(k0 + kh * 64 + kb + u) * ldw + n];
#pragma unroll
            for (int u = 0; u < 16; ++u) { const int k = kh * 64 + kb + u; const float w = wv[u];
                const f32x4_t* ap = (const f32x4_t*)(sA + k * NSEQ);
#pragma unroll
                for (int q = 0; q < 5; ++q) { const f32x4_t a = ap[q]; acc[4 * q] += a[0] * w; acc[4 * q + 1] += a[1] * w; acc[4 * q + 2] += a[2] * w; acc[4 * q + 3] += a[3] * w; } }
        }
        const int nd = MAP == 1 ? map_ffn(n) : (MAP == 2 ? map_mix(n) : n);
#pragma unroll
        for (int s = 0; s < NSEQ; ++s) atomicAdd(dest + (size_t)s * ldd + nd, acc[s]);
    }
}

#define DPP_FMAC(acc, x, s, J) asm volatile("v_fmac_f32_dpp %0, %1, %2 row_newbcast:" #J " row_mask:0xf bank_mask:0xf" : "+v"(acc) : "v"(x), "v"(s))
#define DPP_FMAC_N(acc, x, s, J) asm volatile("s_nop 1\n\tv_fmac_f32_dpp %0, %1, %2 row_newbcast:" #J " row_mask:0xf bank_mask:0xf" : "+v"(acc) : "v"(x), "v"(s))
#define DPP_MUL(s, x, J) asm volatile("v_mul_f32_dpp %0, %1, %0 row_newbcast:" #J " row_mask:0xf bank_mask:0xf" : "+v"(s) : "v"(x))
#define DPP_MUL_N(s, x, J) asm volatile("s_nop 1\n\tv_mul_f32_dpp %0, %1, %0 row_newbcast:" #J " row_mask:0xf bank_mask:0xf" : "+v"(s) : "v"(x))
#define REP15(M, X) M(1, X) M(2, X) M(3, X) M(4, X) M(5, X) M(6, X) M(7, X) M(8, X) M(9, X) M(10, X) M(11, X) M(12, X) M(13, X) M(14, X) M(15, X)
__device__ __forceinline__ float row4_sum(float x) {
    auto r1 = __builtin_amdgcn_permlane16_swap(__float_as_uint(x), __float_as_uint(x), false, false); x = __uint_as_float(r1[0]) + __uint_as_float(r1[1]);
    auto r2 = __builtin_amdgcn_permlane32_swap(__float_as_uint(x), __float_as_uint(x), false, false); return __uint_as_float(r2[0]) + __uint_as_float(r2[1]);
}
__device__ __forceinline__ void rwkv_unit(const KP& p, unsigned char* lds, int l, int s, int h, int d, int mode) {
    int tid_o = threadIdx.x; asm volatile("" : "+v"(tid_o)); const int tid = tid_o, lane = tid & 63; const int wid = __builtin_amdgcn_readfirstlane(tid >> 6);
    constexpr int TB = 16;
    f32x2_t* W2 = (f32x2_t*)lds;
    float* OPS = (float*)(lds + 32768);
    float* YBUF = (float*)(lds + 32768 + 49152);
    float* PWS = (float*)(lds + 32768 + 49152 + 8192) + (wid & 3) * 1024;
    const bf16* Z = (const bf16*)(p.ws + OFF_Z);
    float* Y = (float*)(p.ws + (d == 0 ? OFF_YF : OFF_YB));
    const float* mu = p.in[18] + l * 1024;
    const float* w_up = p.in[19] + ((size_t)l * 2 + d) * 64 * 256;
    const float* a_up = p.in[21] + (size_t)l * 64 * 256;
    const int S = seq_len(s), start = seq_start(s); const int NS = mode == 0 ? S : S / 2, s0 = mode >= 2 ? S / 2 : 0; const int NB = NS / TB;
    __syncthreads();
    for (int e = tid; e < 4096; e += NTHR) { const int i = e >> 6, j = e & 63; W2[e] = (f32x2_t){w_up[i * 256 + 64 * h + j], a_up[i * 256 + 64 * h + j]}; }
    __syncthreads();
    if (wid >= 4) {
        const int pw = wid - 4;
        unsigned short* XWb = (unsigned short*)PWS; unsigned short* XAb = XWb + 256; float* KK = PWS + 256; float* UA = PWS + 512;
        typedef short bf16x8_t __attribute__((ext_vector_type(8)));
        bf16x8_t Bf[2][4][2];
        { const int kg = lane >> 4, cl = 64 * h + (lane & 15);
          _Pragma("unroll") for (int m = 0; m < 2; ++m) _Pragma("unroll") for (int ct = 0; ct < 4; ++ct) _Pragma("unroll") for (int ks = 0; ks < 2; ++ks) {
              const float* Wm = (m == 0 ? w_up : a_up) + (size_t)(32 * ks + 8 * kg) * 256 + cl + 16 * ct; u32x4_t pq;
              pq.x = pk2(Wm[0], Wm[256]); pq.y = pk2(Wm[512], Wm[768]); pq.z = pk2(Wm[1024], Wm[1280]); pq.w = pk2(Wm[1536], Wm[1792]); Bf[m][ct][ks] = __builtin_bit_cast(bf16x8_t, pq); } }
        const float w0 = p.in[20][(l * 2 + d) * 256 + 64 * h + lane], a0 = p.in[22][(l * 2 + d) * 256 + 64 * h + lane];
        const float k_k = p.in[24][l * 256 + 64 * h + lane], k_a = p.in[25][l * 256 + 64 * h + lane];
        int it_t[3], it_zc[3], it_g[3], it_w[3]; f32x4_t mu0[3], mu1[3];
#pragma unroll
        for (int i = 0; i < 3; ++i) { int e = lane + 64 * i; if (e > 159) e = 159; const int t = e / 40, c = e % 40, g = c >> 3, wi = (c & 7) * 8;
            it_t[i] = t; it_g[i] = g; it_w[i] = wi; it_zc[i] = (g == 0 ? 64 * h : g == 1 ? 256 + 64 * h : g == 2 ? 512 + 64 * h : 768 + (g - 3) * 64) + wi;
            mu0[i] = *(const f32x4_t*)(mu + it_zc[i]); mu1[i] = *(const f32x4_t*)(mu + it_zc[i] + 4); }
        u32x4_t rc[3], rp[3], rn[3];
#define RW_ISSUE(b_) do { _Pragma("unroll") for (int i = 0; i < 3; ++i) { const int si = s0 + (b_) * TB + 4 * pw + it_t[i]; const int tt = d == 0 ? si : S - 1 - si; const bf16* zp = Z + (size_t)(start + tt) * ZP + 768 + it_zc[i]; \
                rc[i] = *(const u32x4_t*)zp; rp[i] = tt > 0 ? *(const u32x4_t*)(zp - ZP) : (u32x4_t){0u, 0u, 0u, 0u}; rn[i] = tt < S - 1 ? *(const u32x4_t*)(zp + ZP) : (u32x4_t){0u, 0u, 0u, 0u}; } } while (0)
#define RW_PREP(b_) do { \
            float* ops = OPS + ((b_) & 1) * (TB * 384); \
            _Pragma("unroll") for (int i = 0; i < 3; ++i) if (lane + 64 * i < 160) { \
                float fs[8]; \
                _Pragma("unroll") for (int q = 0; q < 4; ++q) { \
                    const float c0 = __builtin_bit_cast(float, rc[i][q] << 16), c1 = __builtin_bit_cast(float, rc[i][q] & 0xffff0000u); \
                    const float p0 = __builtin_bit_cast(float, rp[i][q] << 16), p1 = __builtin_bit_cast(float, rp[i][q] & 0xffff0000u); \
                    const float n0 = __builtin_bit_cast(float, rn[i][q] << 16), n1 = __builtin_bit_cast(float, rn[i][q] & 0xffff0000u); \
                    const float m0 = q < 2 ? mu0[i][2 * q] : mu1[i][2 * q - 4], m1 = q < 2 ? mu0[i][2 * q + 1] : mu1[i][2 * q - 3]; \
                    fs[2 * q] = c0 + m0 * (0.5f * (p0 + n0) - c0); fs[2 * q + 1] = c1 + m1 * (0.5f * (p1 + n1) - c1); \
                } \
                const int t = it_t[i], tl = 4 * pw + t, g = it_g[i], wi = it_w[i]; \
                if (g == 0) { *(f32x4_t*)(ops + tl * 384 + 256 + wi) = (f32x4_t){fs[0], fs[1], fs[2], fs[3]}; *(f32x4_t*)(ops + tl * 384 + 256 + wi + 4) = (f32x4_t){fs[4], fs[5], fs[6], fs[7]}; } \
                else if (g == 2) { if (mode == 3) { _Pragma("unroll") for (int q = 0; q < 8; ++q) fs[q] = 0.f; } *(f32x4_t*)(ops + tl * 384 + 320 + wi) = (f32x4_t){fs[0], fs[1], fs[2], fs[3]}; *(f32x4_t*)(ops + tl * 384 + 320 + wi + 4) = (f32x4_t){fs[4], fs[5], fs[6], fs[7]}; } \
                else if (g == 1) { *(f32x4_t*)(KK + t * 64 + wi) = (f32x4_t){fs[0], fs[1], fs[2], fs[3]}; *(f32x4_t*)(KK + t * 64 + wi + 4) = (f32x4_t){fs[4], fs[5], fs[6], fs[7]}; } \
                else if (g == 3) { u32x4_t pq; pq.x = pk2(tanh_fast(fs[0]), tanh_fast(fs[1])); pq.y = pk2(tanh_fast(fs[2]), tanh_fast(fs[3])); pq.z = pk2(tanh_fast(fs[4]), tanh_fast(fs[5])); pq.w = pk2(tanh_fast(fs[6]), tanh_fast(fs[7])); *(u32x4_t*)(XWb + t * 64 + wi) = pq; } \
                else { u32x4_t pq; pq.x = pk2(fs[0], fs[1]); pq.y = pk2(fs[2], fs[3]); pq.z = pk2(fs[4], fs[5]); pq.w = pk2(fs[6], fs[7]); *(u32x4_t*)(XAb + t * 64 + wi) = pq; } \
            } \
            if ((b_) + 1 < NB) RW_ISSUE((b_) + 1); \
            { const int arow = lane & 15, akg = lane >> 4; \
              _Pragma("unroll") for (int m = 0; m < 2; ++m) { \
                bf16x8_t Af[2]; \
                _Pragma("unroll") for (int ks = 0; ks < 2; ++ks) { u32x4_t raw = *(const u32x4_t*)((m ? XAb : XWb) + (arow & 3) * 64 + 32 * ks + 8 * akg); if (arow >= 4) raw = (u32x4_t){0u, 0u, 0u, 0u}; Af[ks] = __builtin_bit_cast(bf16x8_t, raw); } \
                _Pragma("unroll") for (int ct = 0; ct < 4; ++ct) { f32x4_t am = (f32x4_t){0.f, 0.f, 0.f, 0.f}; \
                    am = __builtin_amdgcn_mfma_f32_16x16x32_bf16(Af[0], Bf[m][ct][0], am, 0, 0, 0); am = __builtin_amdgcn_mfma_f32_16x16x32_bf16(Af[1], Bf[m][ct][1], am, 0, 0, 0); \
                    if (lane < 16) { UA[(m * 4 + 0) * 64 + 16 * ct + lane] = am[0]; UA[(m * 4 + 1) * 64 + 16 * ct + lane] = am[1]; UA[(m * 4 + 2) * 64 + 16 * ct + lane] = am[2]; UA[(m * 4 + 3) * 64 + 16 * ct + lane] = am[3]; } } } } \
            _Pragma("unroll") for (int t = 0; t < 4; ++t) { \
                const int tl = 4 * pw + t; const float k = KK[t * 64 + lane]; const float kkv = k * k_k; \
                const float n2 = wave_sum(kkv * kkv); const float kk = kkv * __builtin_amdgcn_rsqf(fmaxf(n2, 1e-24f)); \
                const float wdec = __expf(-0.6065306597126334f * sigmoidf_(w0 + UA[t * 64 + lane])); const float a = sigmoidf_(a0 + UA[(4 + t) * 64 + lane]); \
                float* o = ops + tl * 384 + lane; o[0] = -kk; o[64] = wdec; o[128] = kk * a; o[192] = k * (1.0f + (a - 1.0f) * k_a); \
            } } while (0)
#define RW_YFLUSH(b_) do { const float* ybp = YBUF + ((b_) & 1) * (TB * 64); \
            _Pragma("unroll") for (int t = 0; t < 4; ++t) { const int si = s0 + (b_) * TB + 4 * pw + t; const int tt = d == 0 ? si : S - 1 - si; float* yp_ = Y + (size_t)(start + tt) * 256 + 64 * h; const float yv_ = ybp[(4 * pw + t) * 64 + lane]; \
                if (mode < 2) yp_[lane] = yv_; else ((unsigned short*)yp_)[(mode == 3 ? 64 : 0) + lane] = (unsigned short)f2bf(yv_); } } while (0)
        RW_ISSUE(0); RW_PREP(0);
        LDS_BARRIER();
        for (int b = 0; b < NB; ++b) {
            if (b > 0) RW_YFLUSH(b - 1);
            if (b + 1 < NB) RW_PREP(b + 1);
            LDS_BARRIER();
        }
        RW_YFLUSH(NB - 1);
#undef RW_ISSUE
#undef RW_PREP
#undef RW_YFLUSH
    } else {
        __builtin_amdgcn_s_setprio(3);
        float st[16];
#pragma unroll
        for (int i = 0; i < 16; ++i) st[i] = (mode == 3 && 16 * (lane >> 4) + i == 16 * wid + (lane & 15)) ? 1.0f : 0.f;
        const int vofs = 320 + 16 * wid + (lane & 15);
        LDS_BARRIER();
        for (int b = 0; b < NB; ++b) {
            const float* ops = OPS + (b & 1) * (TB * 384); float* yb = YBUF + (b & 1) * (TB * 64);
            float xn = ops[lane], xw = ops[64 + lane], xb = ops[128 + lane], xk = ops[192 + lane], xr = ops[256 + lane], vv = ops[vofs];
#pragma unroll 2
            for (int t = 0; t < TB; ++t) {
                const float* nx = ops + (t + 1 < TB ? t + 1 : t) * 384;
                const float nxn = nx[lane], nxw = nx[64 + lane], nxb = nx[128 + lane], nxk = nx[192 + lane], nxr = nx[256 + lane], nvv = nx[vofs];
                float sa0, sa1, sa2, sa3;
                asm volatile("v_mul_f32_dpp %0, %20, %4 row_newbcast:0 row_mask:0xf bank_mask:0xf\n\tv_mul_f32_dpp %1, %20, %5 row_newbcast:1 row_mask:0xf bank_mask:0xf\n\tv_mul_f32_dpp %2, %20, %6 row_newbcast:2 row_mask:0xf bank_mask:0xf\n\tv_mul_f32_dpp %3, %20, %7 row_newbcast:3 row_mask:0xf bank_mask:0xf\n\tv_fmac_f32_dpp %0, %20, %8 row_newbcast:4 row_mask:0xf bank_mask:0xf\n\tv_fmac_f32_dpp %1, %20, %9 row_newbcast:5 row_mask:0xf bank_mask:0xf\n\tv_fmac_f32_dpp %2, %20, %10 row_newbcast:6 row_mask:0xf bank_mask:0xf\n\tv_fmac_f32_dpp %3, %20, %11 row_newbcast:7 row_mask:0xf bank_mask:0xf\n\tv_fmac_f32_dpp %0, %20, %12 row_newbcast:8 row_mask:0xf bank_mask:0xf\n\tv_fmac_f32_dpp %1, %20, %13 row_newbcast:9 row_mask:0xf bank_mask:0xf\n\tv_fmac_f32_dpp %2, %20, %14 row_newbcast:10 row_mask:0xf bank_mask:0xf\n\tv_fmac_f32_dpp %3, %20, %15 row_newbcast:11 row_mask:0xf bank_mask:0xf\n\tv_fmac_f32_dpp %0, %20, %16 row_newbcast:12 row_mask:0xf bank_mask:0xf\n\tv_fmac_f32_dpp %1, %20, %17 row_newbcast:13 row_mask:0xf bank_mask:0xf\n\tv_fmac_f32_dpp %2, %20, %18 row_newbcast:14 row_mask:0xf bank_mask:0xf\n\tv_fmac_f32_dpp %3, %20, %19 row_newbcast:15 row_mask:0xf bank_mask:0xf" : "=&v"(sa0), "=&v"(sa1), "=&v"(sa2), "=&v"(sa3) : "v"(st[0]), "v"(st[1]), "v"(st[2]), "v"(st[3]), "v"(st[4]), "v"(st[5]), "v"(st[6]), "v"(st[7]), "v"(st[8]), "v"(st[9]), "v"(st[10]), "v"(st[11]), "v"(st[12]), "v"(st[13]), "v"(st[14]), "v"(st[15]), "v"(xn));
                float sa = (sa0 + sa1) + (sa2 + sa3);
                { const f32x4_t da = __builtin_amdgcn_mfma_f32_16x16x4f32(1.0f, sa, (f32x4_t){0.f, 0.f, 0.f, 0.f}, 0, 0, 0); sa = da[0]; asm volatile("s_nop 15\n\ts_nop 3" : "+v"(sa)); }
                asm volatile("v_mul_f32_dpp %0, %16, %0 row_newbcast:0 row_mask:0xf bank_mask:0xf\n\tv_mul_f32_dpp %1, %16, %1 row_newbcast:1 row_mask:0xf bank_mask:0xf\n\tv_mul_f32_dpp %2, %16, %2 row_newbcast:2 row_mask:0xf bank_mask:0xf\n\tv_mul_f32_dpp %3, %16, %3 row_newbcast:3 row_mask:0xf bank_mask:0xf\n\tv_mul_f32_dpp %4, %16, %4 row_newbcast:4 row_mask:0xf bank_mask:0xf\n\tv_mul_f32_dpp %5, %16, %5 row_newbcast:5 row_mask:0xf bank_mask:0xf\n\tv_mul_f32_dpp %6, %16, %6 row_newbcast:6 row_mask:0xf bank_mask:0xf\n\tv_mul_f32_dpp %7, %16, %7 row_newbcast:7 row_mask:0xf bank_mask:0xf\n\tv_mul_f32_dpp %8, %16, %8 row_newbcast:8 row_mask:0xf bank_mask:0xf\n\tv_mul_f32_dpp %9, %16, %9 row_newbcast:9 row_mask:0xf bank_mask:0xf\n\tv_mul_f32_dpp %10, %16, %10 row_newbcast:10 row_mask:0xf bank_mask:0xf\n\tv_mul_f32_dpp %11, %16, %11 row_newbcast:11 row_mask:0xf bank_mask:0xf\n\tv_mul_f32_dpp %12, %16, %12 row_newbcast:12 row_mask:0xf bank_mask:0xf\n\tv_mul_f32_dpp %13, %16, %13 row_newbcast:13 row_mask:0xf bank_mask:0xf\n\tv_mul_f32_dpp %14, %16, %14 row_newbcast:14 row_mask:0xf bank_mask:0xf\n\tv_mul_f32_dpp %15, %16, %15 row_newbcast:15 row_mask:0xf bank_mask:0xf" : "+v"(st[0]), "+v"(st[1]), "+v"(st[2]), "+v"(st[3]), "+v"(st[4]), "+v"(st[5]), "+v"(st[6]), "+v"(st[7]), "+v"(st[8]), "+v"(st[9]), "+v"(st[10]), "+v"(st[11]), "+v"(st[12]), "+v"(st[13]), "+v"(st[14]), "+v"(st[15]) : "v"(xw));
                asm volatile("v_fmac_f32_dpp %0, %16, %17 row_newbcast:0 row_mask:0xf bank_mask:0xf\n\tv_fmac_f32_dpp %1, %16, %17 row_newbcast:1 row_mask:0xf bank_mask:0xf\n\tv_fmac_f32_dpp %2, %16, %17 row_newbcast:2 row_mask:0xf bank_mask:0xf\n\tv_fmac_f32_dpp %3, %16, %17 row_newbcast:3 row_mask:0xf bank_mask:0xf\n\tv_fmac_f32_dpp %4, %16, %17 row_newbcast:4 row_mask:0xf bank_mask:0xf\n\tv_fmac_f32_dpp %5, %16, %17 row_newbcast:5 row_mask:0xf bank_mask:0xf\n\tv_fmac_f32_dpp %6, %16, %17 row_newbcast:6 row_mask:0xf bank_mask:0xf\n\tv_fmac_f32_dpp %7, %16, %17 row_newbcast:7 row_mask:0xf bank_mask:0xf\n\tv_fmac_f32_dpp %8, %16, %17 row_newbcast:8 row_mask:0xf bank_mask:0xf\n\tv_fmac_f32_dpp %9, %16, %17 row_newbcast:9 row_mask:0xf bank_mask:0xf\n\tv_fmac_f32_dpp %10, %16, %17 row_newbcast:10 row_mask:0xf bank_mask:0xf\n\tv_fmac_f32_dpp %11, %16, %17 row_newbcast:11 row_mask:0xf bank_mask:0xf\n\tv_fmac_f32_dpp %12, %16, %17 row_newbcast:12 row_mask:0xf bank_mask:0xf\n\tv_fmac_f32_dpp %13, %16, %17 row_newbcast:13 row_mask:0xf bank_mask:0xf\n\tv_fmac_f32_dpp %14, %16, %17 row_newbcast:14 row_mask:0xf bank_mask:0xf\n\tv_fmac_f32_dpp %15, %16, %17 row_newbcast:15 row_mask:0xf bank_mask:0xf" : "+v"(st[0]), "+v"(st[1]), "+v"(st[2]), "+v"(st[3]), "+v"(st[4]), "+v"(st[5]), "+v"(st[6]), "+v"(st[7]), "+v"(st[8]), "+v"(st[9]), "+v"(st[10]), "+v"(st[11]), "+v"(st[12]), "+v"(st[13]), "+v"(st[14]), "+v"(st[15]) : "v"(xb), "v"(sa));
                asm volatile("v_fmac_f32_dpp %0, %16, %17 row_newbcast:0 row_mask:0xf bank_mask:0xf\n\tv_fmac_f32_dpp %1, %16, %17 row_newbcast:1 row_mask:0xf bank_mask:0xf\n\tv_fmac_f32_dpp %2, %16, %17 row_newbcast:2 row_mask:0xf bank_mask:0xf\n\tv_fmac_f32_dpp %3, %16, %17 row_newbcast:3 row_mask:0xf bank_mask:0xf\n\tv_fmac_f32_dpp %4, %16, %17 row_newbcast:4 row_mask:0xf bank_mask:0xf\n\tv_fmac_f32_dpp %5, %16, %17 row_newbcast:5 row_mask:0xf bank_mask:0xf\n\tv_fmac_f32_dpp %6, %16, %17 row_newbcast:6 row_mask:0xf bank_mask:0xf\n\tv_fmac_f32_dpp %7, %16, %17 row_newbcast:7 row_mask:0xf bank_mask:0xf\n\tv_fmac_f32_dpp %8, %16, %17 row_newbcast:8 row_mask:0xf bank_mask:0xf\n\tv_fmac_f32_dpp %9, %16, %17 row_newbcast:9 row_mask:0xf bank_mask:0xf\n\tv_fmac_f32_dpp %10, %16, %17 row_newbcast:10 row_mask:0xf bank_mask:0xf\n\tv_fmac_f32_dpp %11, %16, %17 row_newbcast:11 row_mask:0xf bank_mask:0xf\n\tv_fmac_f32_dpp %12, %16, %17 row_newbcast:12 row_mask:0xf bank_mask:0xf\n\tv_fmac_f32_dpp %13, %16, %17 row_newbcast:13 row_mask:0xf bank_mask:0xf\n\tv_fmac_f32_dpp %14, %16, %17 row_newbcast:14 row_mask:0xf bank_mask:0xf\n\tv_fmac_f32_dpp %15, %16, %17 row_newbcast:15 row_mask:0xf bank_mask:0xf" : "+v"(st[0]), "+v"(st[1]), "+v"(st[2]), "+v"(st[3]), "+v"(st[4]), "+v"(st[5]), "+v"(st[6]), "+v"(st[7]), "+v"(st[8]), "+v"(st[9]), "+v"(st[10]), "+v"(st[11]), "+v"(st[12]), "+v"(st[13]), "+v"(st[14]), "+v"(st[15]) : "v"(xk), "v"(vv));
                float y0, y1, y2, y3;
                asm volatile("v_mul_f32_dpp %0, %20, %4 row_newbcast:0 row_mask:0xf bank_mask:0xf\n\tv_mul_f32_dpp %1, %20, %5 row_newbcast:1 row_mask:0xf bank_mask:0xf\n\tv_mul_f32_dpp %2, %20, %6 row_newbcast:2 row_mask:0xf bank_mask:0xf\n\tv_mul_f32_dpp %3, %20, %7 row_newbcast:3 row_mask:0xf bank_mask:0xf\n\tv_fmac_f32_dpp %0, %20, %8 row_newbcast:4 row_mask:0xf bank_mask:0xf\n\tv_fmac_f32_dpp %1, %20, %9 row_newbcast:5 row_mask:0xf bank_mask:0xf\n\tv_fmac_f32_dpp %2, %20, %10 row_newbcast:6 row_mask:0xf bank_mask:0xf\n\tv_fmac_f32_dpp %3, %20, %11 row_newbcast:7 row_mask:0xf bank_mask:0xf\n\tv_fmac_f32_dpp %0, %20, %12 row_newbcast:8 row_mask:0xf bank_mask:0xf\n\tv_fmac_f32_dpp %1, %20, %13 row_newbcast:9 row_mask:0xf bank_mask:0xf\n\tv_fmac_f32_dpp %2, %20, %14 row_newbcast:10 row_mask:0xf bank_mask:0xf\n\tv_fmac_f32_dpp %3, %20, %15 row_newbcast:11 row_mask:0xf bank_mask:0xf\n\tv_fmac_f32_dpp %0, %20, %16 row_newbcast:12 row_mask:0xf bank_mask:0xf\n\tv_fmac_f32_dpp %1, %20, %17 row_newbcast:13 row_mask:0xf bank_mask:0xf\n\tv_fmac_f32_dpp %2, %20, %18 row_newbcast:14 row_mask:0xf bank_mask:0xf\n\tv_fmac_f32_dpp %3, %20, %19 row_newbcast:15 row_mask:0xf bank_mask:0xf" : "=&v"(y0), "=&v"(y1), "=&v"(y2), "=&v"(y3) : "v"(st[0]), "v"(st[1]), "v"(st[2]), "v"(st[3]), "v"(st[4]), "v"(st[5]), "v"(st[6]), "v"(st[7]), "v"(st[8]), "v"(st[9]), "v"(st[10]), "v"(st[11]), "v"(st[12]), "v"(st[13]), "v"(st[14]), "v"(st[15]), "v"(xr));
                const float yp = (y0 + y1) + (y2 + y3);
                const f32x4_t dy = __builtin_amdgcn_mfma_f32_16x16x4f32(1.0f, yp, (f32x4_t){0.f, 0.f, 0.f, 0.f}, 0, 0, 0);
                if (lane < 16) yb[t * 64 + 16 * wid + lane] = dy[0];
                xn = nxn; xw = nxw; xb = nxb; xk = nxk; xr = nxr; vv = nvv;
            }
            LDS_BARRIER();
        }
        __builtin_amdgcn_s_setprio(0);
        if (mode == 1) { float* sm = (float*)(p.ws + OFF_SMID) + (size_t)((s * 4 + h) * 2 + d) * 4096 + 16 * wid + (lane & 15);
#pragma unroll
            for (int i = 0; i < 16; ++i) sm[(16 * (lane >> 4) + i) * 64] = st[i]; }
    }
}

__device__ __forceinline__ float gelu_tanh(float x) { const float u = 0.7978845608028654f * (x + 0.044715f * x * x * x); return x * __builtin_amdgcn_rcpf(1.0f + __builtin_amdgcn_exp2f(-2.885390081777927f * u)); }
__device__ __forceinline__ float neg_expm1_fast(float t) { const float ser = -t * (1.0f + t * (0.5f + t * (0.16666667f + t * (0.041666668f + t * 0.0083333338f)))); return t > -0.25f ? ser : 1.0f - __expf(t); }

__device__ __forceinline__ void lru_unit(const KP& p, unsigned char* lds, int l, int s, int n) {
    typedef short bf16x8_t __attribute__((ext_vector_type(8)));
    typedef float f32x16_t __attribute__((ext_vector_type(16)));
    int tid_o = threadIdx.x; asm volatile("" : "+v"(tid_o)); const int tid = tid_o, lane = tid & 63; const int wid = __builtin_amdgcn_readfirstlane(tid >> 6);
    float* XC = (float*)lds;
    unsigned short* XCb = (unsigned short*)(lds + 16384);
    float* GG = (float*)(lds + 24576);
    float* HF = (float*)(lds + 57344);
    float* YG = (float*)(lds + 73728);
    float* HO = (float*)(lds + 90112);
    float* SEG = (float*)(lds + 106496);
    const bf16* Z = (const bf16*)(p.ws + OFF_Z);
    bf16* OM = (bf16*)(p.ws + OFF_OMIX);
    const int S = seq_len(s), start = seq_start(s); const int NB = S / 64;
    const int t_ = tid >> 3, c8 = (tid & 7) * 8;
    const int r32 = lane & 31, hi = lane >> 5; const int gm = wid & 1, gth = (wid >> 1) & 1, gch = wid >> 2;
    f32x4_t cw0[4], cw1[4];
#pragma unroll
    for (int j = 0; j < 4; ++j) { cw0[j] = *(const f32x4_t*)(p.in[11] + l * 4 * 384 + j * 384 + 64 * n + c8); cw1[j] = *(const f32x4_t*)(p.in[11] + l * 4 * 384 + j * 384 + 64 * n + c8 + 4); }
    const f32x4_t cb0 = *(const f32x4_t*)(p.in[12] + l * 384 + 64 * n + c8), cb1 = *(const f32x4_t*)(p.in[12] + l * 384 + 64 * n + c8 + 4);
    for (int d = 0; d < 2; ++d) {
        const float* wg = (gm == 0 ? p.in[13] : p.in[15]) + (((size_t)l * 2 + d) * 6 + n) * 4096;
        const float gbias = (gm == 0 ? p.in[14] : p.in[16])[(l * 2 + d) * 384 + 64 * n + 32 * gch + r32];
        const float lm = -p.in[17][(l * 2 + d) * 384 + 64 * n + lane]; const float sp8 = -8.0f * (lm > 20.f ? lm : log1pf(__expf(lm)));
        bf16x8_t Bf[4];
#pragma unroll
        for (int ks = 0; ks < 4; ++ks) { const float* wp = wg + (size_t)(16 * ks + 8 * hi) * 64 + 32 * gch + r32; u32x4_t pq;
            pq.x = pk2(wp[0], wp[64]); pq.y = pk2(wp[128], wp[192]); pq.z = pk2(wp[256], wp[320]); pq.w = pk2(wp[384], wp[448]); Bf[ks] = __builtin_bit_cast(bf16x8_t, pq); }
        __threadfence();
        __syncthreads();
        float hcarry = 0.f;
        u32x4_t rr[4], rh, ry;
#define LRU_ISSUE(blk_) do { const int tt = d == 0 ? (blk_) * 64 + t_ : S - 1 - ((blk_) * 64 + t_); \
            _Pragma("unroll") for (int j = 0; j < 4; ++j) { const int t2 = tt - 2 + j; rr[j] = (t2 >= 0 && t2 < S) ? *(const u32x4_t*)(Z + (size_t)(start + t2) * ZP + 64 * n + c8) : (u32x4_t){0u, 0u, 0u, 0u}; } \
            if (d == 1) { rh = *(const u32x4_t*)(OM + (size_t)(start + tt) * DM + 64 * n + c8); ry = *(const u32x4_t*)(Z + (size_t)(start + tt) * ZP + 384 + 64 * n + c8); } } while (0)
        LRU_ISSUE(0);
        for (int blk = 0; blk < NB; ++blk) {
            LDS_BARRIER();
            {
                f32x4_t x0 = cb0, x1 = cb1;
#pragma unroll
                for (int j = 0; j < 4; ++j) {
                    const f32x4_t a = (f32x4_t){__builtin_bit_cast(float, rr[j][0] << 16), __builtin_bit_cast(float, rr[j][0] & 0xffff0000u), __builtin_bit_cast(float, rr[j][1] << 16), __builtin_bit_cast(float, rr[j][1] & 0xffff0000u)};
                    const f32x4_t b = (f32x4_t){__builtin_bit_cast(float, rr[j][2] << 16), __builtin_bit_cast(float, rr[j][2] & 0xffff0000u), __builtin_bit_cast(float, rr[j][3] << 16), __builtin_bit_cast(float, rr[j][3] & 0xffff0000u)};
                    x0 += cw0[j] * a; x1 += cw1[j] * b;
                }
                *(f32x4_t*)(XC + t_ * 64 + c8) = x0; *(f32x4_t*)(XC + t_ * 64 + c8 + 4) = x1;
                { u32x4_t pq; pq.x = pk2(x0[0], x0[1]); pq.y = pk2(x0[2], x0[3]); pq.z = pk2(x1[0], x1[1]); pq.w = pk2(x1[2], x1[3]); *(u32x4_t*)(XCb + t_ * 64 + c8) = pq; }
                if (d == 1) {
                    float hf[8], yg[8];
#pragma unroll
                    for (int q = 0; q < 4; ++q) { hf[2 * q] = __builtin_bit_cast(float, rh[q] << 16); hf[2 * q + 1] = __builtin_bit_cast(float, rh[q] & 0xffff0000u);
                        yg[2 * q] = gelu_tanh(__builtin_bit_cast(float, ry[q] << 16)); yg[2 * q + 1] = gelu_tanh(__builtin_bit_cast(float, ry[q] & 0xffff0000u)); }
                    *(f32x4_t*)(HF + t_ * 64 + c8) = (f32x4_t){hf[0], hf[1], hf[2], hf[3]}; *(f32x4_t*)(HF + t_ * 64 + c8 + 4) = (f32x4_t){hf[4], hf[5], hf[6], hf[7]};
                    *(f32x4_t*)(YG + t_ * 64 + c8) = (f32x4_t){yg[0], yg[1], yg[2], yg[3]}; *(f32x4_t*)(YG + t_ * 64 + c8 + 4) = (f32x4_t){yg[4], yg[5], yg[6], yg[7]};
                }
                if (blk + 1 < NB) LRU_ISSUE(blk + 1);
            }
            LDS_BARRIER();
            {
                f32x16_t acc = {};
#pragma unroll
                for (int ks = 0; ks < 4; ++ks) { const bf16x8_t af = *(const bf16x8_t*)(XCb + (32 * gth + r32) * 64 + 16 * ks + 8 * hi); acc = __builtin_amdgcn_mfma_f32_32x32x16_bf16(af, Bf[ks], acc, 0, 0, 0); }
#pragma unroll
                for (int r = 0; r < 16; ++r) { const int trow = 32 * gth + (r & 3) + 8 * (r >> 2) + 4 * hi; GG[(gm * 64 + trow) * 64 + 32 * gch + r32] = sigmoidf_(acc[r] + gbias); }
            }
            LDS_BARRIER();
            float Pp[8], hl[8];
            {
                float pp = 1.f, hh = 0.f;
#pragma unroll
                for (int q = 0; q < 8; ++q) { const int t = 8 * wid + q; const float ra = GG[t * 64 + lane], ix = GG[(64 + t) * 64 + lane], xc = XC[t * 64 + lane];
                    const float la = sp8 * ra; const float a = __expf(la); const float uu = __builtin_amdgcn_sqrtf(fmaxf(neg_expm1_fast(2.0f * la), 0.f)) * ix * xc;
                    pp *= a; hh = a * hh + uu; Pp[q] = pp; hl[q] = hh; }
                SEG[(wid * 2) * 64 + lane] = pp; SEG[(wid * 2 + 1) * 64 + lane] = hh;
            }
            LDS_BARRIER();
            {
                float sa[8], sh[8];
#pragma unroll
                for (int w = 0; w < 8; ++w) { sa[w] = SEG[(w * 2) * 64 + lane]; sh[w] = SEG[(w * 2 + 1) * 64 + lane]; }
                float carry = hcarry, mine = 0.f;
#pragma unroll
                for (int w = 0; w < 8; ++w) { if (w == wid) mine = carry; carry = sa[w] * carry + sh[w]; }
                hcarry = carry;
#pragma unroll
                for (int q = 0; q < 8; ++q) { const int t = 8 * wid + q; const float hv = Pp[q] * mine + hl[q]; HO[t * 64 + lane] = d == 0 ? hv : (HF[t * 64 + lane] + hv) * YG[t * 64 + lane]; }
            }
            LDS_BARRIER();
            {   const int tt = d == 0 ? blk * 64 + t_ : S - 1 - (blk * 64 + t_);
                const f32x4_t a = *(const f32x4_t*)(HO + t_ * 64 + c8), b = *(const f32x4_t*)(HO + t_ * 64 + c8 + 4);
                u32x4_t w; w.x = pk2(a[0], a[1]); w.y = pk2(a[2], a[3]); w.z = pk2(b[0], b[1]); w.w = pk2(b[2], b[3]);
                *(u32x4_t*)(OM + (size_t)(start + tt) * DM + 64 * n + c8) = w; }
        }
#undef LRU_ISSUE
    }
}

__device__ __forceinline__ void rwkv_post_tile(const KP& p, unsigned char* lds, int l, int tile) {
    int tid_o = threadIdx.x; asm volatile("" : "+v"(tid_o)); const int tid = tid_o, lane = tid & 63;
    float* SG = (float*)lds;
    float* GO = SG + 4096;
    const bf16* Z = (const bf16*)(p.ws + OFF_Z); bf16* OM = (bf16*)(p.ws + OFF_OMIX);
    const float* YF = (const float*)(p.ws + OFF_YF); const float* YBk = (const float*)(p.ws + OFF_YB);
    const float* mu = p.in[18] + l * 1024; const float* g_up = p.in[23] + (size_t)l * 128 * 256;
    const int m0 = tile * 32; const int s = seq_of_row(m0); const int S = seq_len(s), start = seq_start(s);
    __syncthreads();
    {   const float muc = mu[896 + (tid & 127)];
#pragma unroll 1
        for (int ih = 0; ih < 2; ++ih) {
            unsigned short zc_[4], zp_[4], zn_[4];
#pragma unroll
            for (int i = 0; i < 4; ++i) { const int e = tid + NTHR * (4 * ih + i); const int t = e >> 7, c = e & 127; const int m = m0 + t, tt = m - start; const bf16* zp = Z + (size_t)m * ZP + 768 + 896 + c;
                zc_[i] = zp[0]; zp_[i] = zp[tt > 0 ? -ZP : 0]; zn_[i] = zp[tt < S - 1 ? ZP : 0]; }
            asm volatile("" ::: "memory");
#pragma unroll
            for (int i = 0; i < 4; ++i) { const int e = tid + NTHR * (4 * ih + i); const int t = e >> 7; const int tt = m0 + t - start;
                const float f = bf2f(zc_[i]); const float pv = tt > 0 ? bf2f(zp_[i]) : 0.f; const float nx = tt < S - 1 ? bf2f(zn_[i]) : 0.f;
                SG[e] = sigmoidf_(f + muc * (0.5f * (pv + nx) - f)); }
        }
    }
    __syncthreads();
    const int c = tid & 255, tg = tid >> 8;
#pragma unroll 1
    for (int hf = 0; hf < 2; ++hf) {
        float acc[8];
#pragma unroll
        for (int t = 0; t < 8; ++t) acc[t] = 0.f;
#pragma unroll 1
        for (int ib = 0; ib < 128; ib += 16) {
            float wv[16];
#pragma unroll
            for (int u = 0; u < 16; ++u) wv[u] = g_up[(ib + u) * 256 + c];
#pragma unroll
            for (int u4 = 0; u4 < 16; u4 += 4) {
#pragma unroll
                for (int t = 0; t < 8; ++t) { const f32x4_t x = *(const f32x4_t*)(SG + (tg * 16 + hf * 8 + t) * 128 + ib + u4); acc[t] = fmaf(x[0], wv[u4], acc[t]); acc[t] = fmaf(x[1], wv[u4 + 1], acc[t]); acc[t] = fmaf(x[2], wv[u4 + 2], acc[t]); acc[t] = fmaf(x[3], wv[u4 + 3], acc[t]); } }
        }
#pragma unroll
        for (int t = 0; t < 8; ++t) GO[(tg * 16 + hf * 8 + t) * 256 + c] = acc[t];
    }
    const int dc = (s < 4) ? ((m0 - start) >= S / 2 ? 0 : 1) : -1;
    if (dc >= 0) {
        float* SM = (float*)(lds + 49152); unsigned short* YPs = (unsigned short*)(lds + 114688);
        const float* Ydc = dc == 0 ? YF : YBk; float* Yw = (float*)(p.ws + (dc == 0 ? OFF_YF : OFF_YB));
        for (int e = tid; e < 4096; e += NTHR) { const int hh = e >> 10, r4 = (e & 1023) * 4; *(f32x4_t*)(SM + hh * 4096 + r4) = *(const f32x4_t*)((const float*)(p.ws + OFF_SMID) + (size_t)((s * 4 + hh) * 2 + dc) * 4096 + r4); }
        for (int e = tid; e < 1024; e += NTHR) { const int t = e >> 5, hh = (e >> 3) & 3, ch = e & 7; *(u32x4_t*)(YPs + t * 256 + hh * 64 + ch * 8) = *(const u32x4_t*)((const unsigned short*)(Ydc + (size_t)(m0 + t) * 256 + 64 * hh) + 64 + ch * 8); }
        __syncthreads();
        const int hh = c >> 6, v = c & 63; const float* smp = SM + hh * 4096 + v;
#pragma unroll 1
        for (int t = 0; t < 16; ++t) {
            const int tk = tg * 16 + t; const size_t mrow = (size_t)(m0 + tk) * 256;
            float accv = bf2f(((const unsigned short*)(Ydc + mrow + 64 * hh))[v]);
#pragma unroll
            for (int i0 = 0; i0 < 64; i0 += 8) { const u32x4_t w = *(const u32x4_t*)(YPs + tk * 256 + hh * 64 + i0);
                accv += smp[(i0 + 0) * 64] * __builtin_bit_cast(float, w[0] << 16) + smp[(i0 + 1) * 64] * __builtin_bit_cast(float, w[0] & 0xffff0000u) + smp[(i0 + 2) * 64] * __builtin_bit_cast(float, w[1] << 16) + smp[(i0 + 3) * 64] * __builtin_bit_cast(float, w[1] & 0xffff0000u)
                      + smp[(i0 + 4) * 64] * __builtin_bit_cast(float, w[2] << 16) + smp[(i0 + 5) * 64] * __builtin_bit_cast(float, w[2] & 0xffff0000u) + smp[(i0 + 6) * 64] * __builtin_bit_cast(float, w[3] << 16) + smp[(i0 + 7) * 64] * __builtin_bit_cast(float, w[3] & 0xffff0000u); }
            Yw[mrow + c] = accv;
        }
        __threadfence();
        __syncthreads();
    }
    const float rk = p.in[26][l * 256 + c], lg = p.in[27][l * 256 + c], lb = p.in[28][l * 256 + c];
    const float mr = mu[c], mk = mu[256 + c], mv = mu[512 + c];
    unsigned short zc_[9]; float yc_[2];
#define PT_LOAD(T_, ZD, YD) do { const int m_ = m0 + tg * 16 + (T_), tt_ = m_ - start; const bf16* zp_ = Z + (size_t)m_ * ZP + 768 + c; const bf16* zpp_ = zp_ + (tt_ > 0 ? -ZP : 0); const bf16* zpn_ = zp_ + (tt_ < S - 1 ? ZP : 0); \
        _Pragma("unroll") for (int j = 0; j < 3; ++j) { ZD[3 * j] = zp_[256 * j]; ZD[3 * j + 1] = zpp_[256 * j]; ZD[3 * j + 2] = zpn_[256 * j]; } \
        YD[0] = YF[(size_t)m_ * 256 + c]; YD[1] = YBk[(size_t)m_ * 256 + c]; } while (0)
    PT_LOAD(0, zc_, yc_);
#pragma unroll 1
    for (int t = 0; t < 16; ++t) {
        unsigned short zn_[9]; float yn_[2];
        PT_LOAD((t < 15 ? t + 1 : 15), zn_, yn_);
        asm volatile("" ::: "memory");
        const int m = m0 + tg * 16 + t, tt = m - start;
        const bool hp = tt > 0, hn = tt < S - 1;
        float f = bf2f(zc_[0]), pv = hp ? bf2f(zc_[1]) : 0.f, nx = hn ? bf2f(zc_[2]) : 0.f; const float r = f + mr * (0.5f * (pv + nx) - f);
        f = bf2f(zc_[3]); pv = hp ? bf2f(zc_[4]) : 0.f; nx = hn ? bf2f(zc_[5]) : 0.f; const float k = f + mk * (0.5f * (pv + nx) - f);
        f = bf2f(zc_[6]); pv = hp ? bf2f(zc_[7]) : 0.f; nx = hn ? bf2f(zc_[8]) : 0.f; const float v = f + mv * (0.5f * (pv + nx) - f);
        const float y = yc_[0] + yc_[1];
#pragma unroll
        for (int j = 0; j < 9; ++j) zc_[j] = zn_[j];
        yc_[0] = yn_[0]; yc_[1] = yn_[1];
        const float mean = wave_sum(y) * (1.0f / 64.0f); const float dv = y - mean; const float var = wave_sum(dv * dv) * (1.0f / 64.0f);
        const float yn = dv * rsqrtf(var + 64e-5f) * lg + lb;
        const float bon = wave_sum(r * k * rk);
        const float outv = (yn + bon * v) * GO[(tg * 16 + t) * 256 + c];
        OM[(size_t)m * DM + 384 + c] = (bf16)f2bf(outv);
    }
#undef PT_LOAD
    (void)lane;
}

__global__ void __launch_bounds__(NTHR, 2) fwd_megakernel(KP p) {
    extern __shared__ __attribute__((aligned(16))) unsigned char lds[];
    cg::grid_group grid = cg::this_grid();
    const int tid = threadIdx.x, lane = tid & 63, wid = tid >> 6;
    const int G = gridDim.x, bx = blockIdx.x;
    const int gw = bx * 8 + wid, NGW = G * 8;
    unsigned char* ws = p.ws;
    volatile LAS int* misc = (volatile LAS int*)((LAS unsigned char*)lds + MISC_OFF);
    PG8_LAS unsigned char* ldsg = (PG8_LAS unsigned char*)lds;

    {
        float* scr = (float*)(lds + wid * 16384);
        for (int l = 0; l < 2; ++l) {
            unsigned char* wl = ws + OFF_W + l * W_LAYER;
            constexpr int I_IN = 16 * 176, I_OUT = 44 * 32, I_MI = 16 * 76, I_MO = 16 * 32, I_TOT = 2 * I_IN + 2 * I_OUT + I_MI + I_MO;
            for (int it = gw; it < I_TOT; it += NGW) {
                int r = it;
                if (r < 2 * I_IN) { const int f = r / I_IN; transpose_item<1>(p.in[7] + ((size_t)l * 2 + f) * DM * NFF, DM, NFF, (bf16*)(wl + WO_IN + f * 11 * MiB), scr, r % I_IN, lane); continue; } r -= 2 * I_IN;
                if (r < 2 * I_OUT) { const int f = r / I_OUT; transpose_item<0>(p.in[8] + ((size_t)l * 2 + f) * DFF * DM, DFF, DM, (bf16*)(wl + WO_OUT + f * (11 * MiB / 2)), scr, r % I_OUT, lane); continue; } r -= 2 * I_OUT;
                if (r < I_MI) { transpose_item<2>(p.in[9] + (size_t)l * DM * NMIX, DM, NMIX, (bf16*)(wl + WO_MI), scr, r, lane); continue; } r -= I_MI;
                transpose_item<0>(p.in[10] + (size_t)l * DM * DM, DM, DM, (bf16*)(wl + WO_MO), scr, r, lane);
            }
            u32x4_t* padp = (u32x4_t*)(wl + WO_MI + (size_t)NMIX * DM * 2);
            for (int e = bx * NTHR + tid; e < 128 * DM * 2 / 16; e += G * NTHR) padp[e] = (u32x4_t){0u, 0u, 0u, 0u};
        }
        __syncthreads();
        for (int u = bx; u < 2 * 36 * 8; u += G) { const int l = u / 288, r = u % 288;
            smallm_unit<0, 0>(p, (float*)lds, l, 0, p.in[4] + (size_t)l * DM * 9216, 9216, 9216, (float*)(ws + OFF_MOD) + (size_t)l * NSEQ * 9216, 9216, r / 8, r % 8); }
        if (bx == 0) { float* rope = (float*)(ws + OFF_ROPE);
            for (int e = tid; e < 1024; e += NTHR) { const int pos = e >> 4, pp = e & 15; const float inv = exp2f(-(float)pp * (13.287712379549449f / 16.0f)); const float a = (float)pos * inv; const float kr = rintf(a * 0.15915494309189535f); float rr = fmaf(-kr, 6.2831854820251465f, a); rr = fmaf(-kr, -1.7484555e-7f, rr); rope[2 * e] = __cosf(rr); rope[2 * e + 1] = __sinf(rr); } }
    }
    grid.sync();
    {
        const float* MOD = (const float*)(ws + OFF_MOD); float* GV = (float*)(ws + OFF_GV); float* GT = (float*)(ws + OFF_GATE);
        for (int e = bx * NTHR + tid; e < 6 * NSEQ * DM; e += G * NTHR) {
            const int c = e & 1023, s = (e >> 10) % NSEQ, inst = e / (NSEQ * DM); const int l = inst / 3, j = inst % 3;
            const float* mr = MOD + ((size_t)l * NSEQ + s) * 9216; const float* ba = p.in[5] + l * 9216;
            const float sc = mr[(3 * j + 1) * 1024 + c] + ba[(3 * j + 1) * 1024 + c], gg = mr[(3 * j + 2) * 1024 + c] + ba[(3 * j + 2) * 1024 + c];
            GV[e] = p.in[6][(l * 3 + j) * DM + c] * (1.0f + sc); GT[e] = (j == 1 ? 1.0f : 0.5f) * gg;
        }
        for (int u = bx; u < 2 * 432; u += G) { const int l = u / 432, r = u % 432; float* bdst = (float*)(ws + OFF_BIAS);
            if (r < 176) smallm_unit<1, 1>(p, (float*)lds, l, 0, p.in[7] + ((size_t)l * 2 + 0) * DM * NFF, NFF, NFF, bdst + (size_t)(l * 3 + 0) * NSEQ * NFF, NFF, r / 8, r % 8);
            else if (r < 256) smallm_unit<1, 2>(p, (float*)lds, l, 1, p.in[9] + (size_t)l * DM * NMIX, NMIX, NMIX, bdst + (size_t)(l * 3 + 1) * NSEQ * NFF, NFF, (r - 176) / 8, (r - 176) % 8);
            else smallm_unit<1, 1>(p, (float*)lds, l, 2, p.in[7] + ((size_t)l * 2 + 1) * DM * NFF, NFF, NFF, bdst + (size_t)(l * 3 + 2) * NSEQ * NFF, NFF, (r - 256) / 8, (r - 256) % 8); }
        bf16* XN = (bf16*)(ws + OFF_XN); float* SS0 = (float*)(ws + OFF_SS);
        for (int m = gw; m < MTOK; m += NGW) {
            const int s = seq_of_row(m); const float* xr = m < 16384 ? p.in[0] + (size_t)m * DM : p.in[1] + (size_t)(m - 16384) * DM;
            const float* mr = MOD + (size_t)s * 9216 + 1024; const float* ba = p.in[5] + 1024; const float* ng = p.in[6];
            float q = 0.f;
#pragma unroll
            for (int j = 0; j < 4; ++j) { const int c = 4 * lane + 256 * j; const f32x4_t v = *(const f32x4_t*)(xr + c); const f32x4_t sc = *(const f32x4_t*)(mr + c) + *(const f32x4_t*)(ba + c); const f32x4_t g = *(const f32x4_t*)(ng + c) * (sc + 1.0f);
                q += (v[0] * v[0] + v[1] * v[1]) + (v[2] * v[2] + v[3] * v[3]); const f32x4_t o = v * g;
                *(unsigned long long*)(XN + (size_t)m * DM + c) = (unsigned long long)pk2(o[0], o[1]) | ((unsigned long long)pk2(o[2], o[3]) << 32); }
            q = wave_sum(q); if (lane == 0) SS0[m] = q;
        }
    }
    grid.sync();

    for (int l = 0; l < 2; ++l) {
        unsigned char* wl = ws + OFF_W + l * W_LAYER;
        const float* GV = (const float*)(ws + OFF_GV); const float* GT = (const float*)(ws + OFF_GATE); const float* BI = (const float*)(ws + OFF_BIAS); float* SS = (float*)(ws + OFF_SS);
        bf16* XN = (bf16*)(ws + OFF_XN); bf16* HID = (bf16*)(ws + OFF_HID); bf16* OMIX = (bf16*)(ws + OFF_OMIX);
        for (int f = 0; f < 2; ++f) {
            const int j = f == 0 ? 0 : 2; const int inst = l * 3 + j;
            if (f == 1) {
                {
                    pg8::Gemm g{XN, (const pg8::bf16_t*)(wl + WO_MI), MTOK, NMIXP, DM}; pg8::StaticOrder S; S.init(MTOK, NMIXP, G, bx);
                    pg8::EpiZ E{(bf16*)(ws + OFF_Z), (bf16*)(ws + OFF_QK), (bf16*)(ws + OFF_VR), SS + (size_t)(l * 3 + 1) * MTOK, BI + (size_t)(l * 3 + 1) * NSEQ * NFF, p.in[29] + l * 64, p.in[30] + l * 64, (const float*)(ws + OFF_ROPE)};
                    pg8::gemm_phase<pg8::EpiZ, pg8::StaticOrder, true, true>(ldsg, g, S, E);
                }
                grid.sync();
                {
                    unsigned* ctr = (unsigned*)(ws + OFF_CTR) + 64 * l;
                    constexpr int NU_R = 224, NU_L = 120, NU_A = 1152, NU = NU_R + NU_L + NU_A;
                    for (;;) {
                        __syncthreads(); if (tid == 0) misc[0] = (int)atomicAdd(ctr, 1u); __syncthreads();
                        const int u = misc[0]; if (u >= NU) break;
                        if (u < 224) { int s_, h_, d_, md_;
                            if (u < 96) { const int c = u & 31; md_ = 1 + (u >> 5); s_ = c >> 3; h_ = (c >> 1) & 3; d_ = c & 1; } else { const int i2 = u - 96; md_ = 0; s_ = 4 + (i2 >> 3); h_ = (i2 >> 1) & 3; d_ = i2 & 1; }
                            rwkv_unit(p, lds, l, s_, h_, d_, md_); }
                        else if (u < 248) { const int i3 = u - 224; lru_unit(p, lds, l, i3 / 6, i3 % 6); }
                        else if (u < 344) { const int i4 = u - 248; lru_unit(p, lds, l, 4 + i4 / 6, i4 % 6); }
                        else { const int i5 = u - 344; int s_, hq, qb;
                            if (i5 < 384) { s_ = i5 / 96; const int r = i5 % 96; hq = (r / 48) * 3 + (r % 48) / 16; qb = r & 15; }
                            else { const int i6 = i5 - 384; s_ = 4 + i6 / 48; const int r = i6 % 48; hq = (r / 24) * 3 + (r % 24) / 8; qb = r & 7; }
                            const int g_ = hq / 3;
                            attn_body::attn_unit<8>(seq_start(s_), seq_len(s_), qb, 64 * hq, 384 + 64 * g_, 64 * g_, 640 + 64 * hq, (const attn_body::bf16*)(ws + OFF_QK), (const attn_body::bf16*)(ws + OFF_QK), (const attn_body::bf16*)(ws + OFF_VR), (attn_body::bf16*)(ws + OFF_OMIX), (char*)lds); }
                    }
                }
                grid.sync();
                for (int t = bx; t < MTOK / 32; t += G) rwkv_post_tile(p, lds, l, t);
                grid.sync();
                {
                    pg8::Gemm g{OMIX, (const pg8::bf16_t*)(wl + WO_MO), MTOK, DM, DM}; pg8::StaticOrder S; S.init(MTOK, DM, G, bx);
                    pg8::EpiResid E{p.out, p.out + (size_t)16384 * DM, p.out, XN, SS + (size_t)(l * 3 + 2) * MTOK, GT + (size_t)(l * 3 + 1) * NSEQ * DM, GV + (size_t)(l * 3 + 2) * NSEQ * DM};
                    pg8::gemm_phase<pg8::EpiResid, pg8::StaticOrder, true, true>(ldsg, g, S, E);
                }
                grid.sync();
            }
            {
                pg8::Gemm g{XN, (const pg8::bf16_t*)(wl + WO_IN + f * 11 * MiB), MTOK, NFF, DM}; pg8::StaticOrder S; S.init(MTOK, NFF, G, bx);
                pg8::EpiSwiglu E{HID, SS + (size_t)inst * MTOK, BI + (size_t)inst * NSEQ * NFF};
                pg8::gemm_phase<pg8::EpiSwiglu, pg8::StaticOrder, true, true>(ldsg, g, S, E);
            }
            grid.sync();
            {
                const bool first = (l == 0 && f == 0), last = (l == 1 && f == 1);
                const int ninst = inst + 1;
                pg8::Gemm g{HID, (const pg8::bf16_t*)(wl + WO_OUT + f * (11 * MiB / 2)), MTOK, DM, DFF}; pg8::StaticOrder S; S.init(MTOK, DM, G, bx);
                pg8::EpiResid E{first ? p.in[0] : p.out, first ? p.in[1] : p.out + (size_t)16384 * DM, p.out, XN, last ? nullptr : SS + (size_t)ninst * MTOK, GT + (size_t)inst * NSEQ * DM, last ? nullptr : GV + (size_t)ninst * NSEQ * DM};
                pg8::gemm_phase<pg8::EpiResid, pg8::StaticOrder, true, true>(ldsg, g, S, E);
            }
            if (!(l == 1 && f == 1)) grid.sync();
        }
    }
}

extern "C" void kernel_launch(void* const* d_in, const int* in_sizes, int n_in, void* d_out, int out_size, void* d_ws, size_t ws_size, hipStream_t stream) {
    static int grid = 0;
    if (grid == 0) {
        if (n_in != 31 || ws_size < WS_END + 1 * MiB) { fprintf(stderr, "kernel_launch: unexpected n_in %d / ws %zu\n", n_in, ws_size); grid = -1; return; }
        int dev = 0, cus = 0, per_cu = 0;
        hipGetDevice(&dev); hipDeviceGetAttribute(&cus, hipDeviceAttributeMultiprocessorCount, dev);
        hipFuncSetAttribute((const void*)fwd_megakernel, hipFuncAttributeMaxDynamicSharedMemorySize, LDS_BYTES);
        hipOccupancyMaxActiveBlocksPerMultiprocessor(&per_cu, (const void*)fwd_megakernel, NTHR, LDS_BYTES);
        if (per_cu < 1) per_cu = 1;
        grid = cus * per_cu;
        (void)hipGetLastError();
    }
    if (grid < 0) return;
    hipMemsetAsync(d_ws, 0, ZERO_BYTES, stream);
    KP p{};
    for (int i = 0; i < 31; ++i) p.in[i] = (const float*)d_in[i];
    p.out = (float*)d_out; p.ws = (unsigned char*)d_ws;
    void* args[] = {&p};
    hipError_t e = hipLaunchCooperativeKernel((const void*)fwd_megakernel, dim3(grid), dim3(NTHR), args, LDS_BYTES, stream);
    if (e != hipSuccess) fprintf(stderr, "cooperative launch failed: %s (grid %d)\n", hipGetErrorString(e), grid);
}
```

```cpp
#include <hip/hip_runtime.h>
#include <hip/hip_cooperative_groups.h>
#include <cstdio>
#include <cstdint>
namespace cg = cooperative_groups;
namespace pg8 {
#define PG8_LAS __attribute__((address_space(3)))
typedef unsigned short bf16_t;
typedef short bf16x8 __attribute__((ext_vector_type(8)));
typedef float f32x4 __attribute__((ext_vector_type(4)));
typedef unsigned u32x4 __attribute__((ext_vector_type(4)));
constexpr int BM = 256, BK = 64, HALF = 128, HTB = HALF * BK * 2  , STAGE_BYTES = 8 * HTB, NXCD = 8, WGM = 8;

__host__ __device__ __forceinline__ int lds_byte(int r, int c) { const int st = (r >> 4) * 2 + (c >> 5), rr = r & 15, cc = c & 31, ob = rr * 64 + cc * 2; return st * 1024 + (ob ^ (((ob >> 9) & 1) << 5)); }
__host__ __device__ __forceinline__ void stage_rc(int b, int& R, int& C) { const int st = b / 1024, sb = b % 1024, swz = sb ^ (((sb >> 9) & 1) << 5); R = (st >> 1) * 16 + swz / 64; C = (st & 1) * 32 + (swz % 64) / 2; }
__host__ __device__ __forceinline__ int perm32(int rho) { const int n = rho >> 4, i = rho & 15; return 8 * (i >> 2) + 4 * n + (i & 3); }

struct Unit { int pm, pn; };
struct Gemm { const bf16_t* A; const bf16_t* Bt; int M, N, K; };

struct StaticOrder {
    int nM, nN, nwg, G, c;
    __host__ __device__ void init(int M, int N, int G_, int c_) { nM = M / BM; nN = N / BM; nwg = nM * nN; G = G_; c = c_; }
    __host__ __device__ bool next(int i, Unit& u) const {
        const long L = (long)i * G + c; if (L >= nwg) return false;
        int wgid = (int)L; { const int q = nwg / NXCD, r = nwg % NXCD, xcd = wgid % NXCD, off = wgid / NXCD; wgid = (xcd < r ? xcd * (q + 1) : r * (q + 1) + (xcd - r) * q) + off; }
        const int nig = WGM * nN, gid = wgid / nig, fm = gid * WGM, gsz = (nM - fm) < WGM ? (nM - fm) : WGM;
        u.pm = fm + ((wgid % nig) % gsz); u.pn = (wgid % nig) / gsz; return true;
    }
    __device__ __forceinline__ void a_ready(const Unit&) const {}
    __device__ __forceinline__ void done(const Unit&) const {}
};

__device__ __forceinline__ unsigned cvt_pk_bf16(float lo, float hi) { unsigned r; asm volatile("v_cvt_pk_bf16_f32 %0, %1, %2" : "=v"(r) : "v"(lo), "v"(hi)); return r; }
typedef float f32x2 __attribute__((ext_vector_type(2)));
__device__ __forceinline__ f32x2 gelu_pk(f32x2 v) {
    const f32x2 av = __builtin_elementwise_abs(v), d = av * 0.2316418882f + 1.0f;
    f32x2 t; t.x = __builtin_amdgcn_rcpf(d.x); t.y = __builtin_amdgcn_rcpf(d.y);
    f32x2 q = t * 0.5307027145f + (-0.7265760135f); q = q * t + 0.7107068705f; q = q * t + (-0.142248368f); q = q * t + 0.127414796f; q = q * t;
    const f32x2 s = (v * v) * (-0.72134752044f);
    f32x2 e; e.x = __builtin_amdgcn_exp2f(s.x); e.y = __builtin_amdgcn_exp2f(s.y);
    const f32x2 m = v * (q * e), r = v - m;
    f32x2 o; o.x = v.x < 0.f ? m.x : r.x; o.y = v.y < 0.f ? m.y : r.y; return o;
}

template <int ACT  > struct EpiBf16 {
    static constexpr bool PERM = true, AFTER_DRAIN = false; static_assert(ACT == 0 || ACT == 1, "EpiBf16: ACT is 0 (none) or 1 (gelu_pk)");
    bf16_t* O; int ldc; const float* bias; int split_cols; size_t split_stride; float scale0;
    __device__ __forceinline__ void operator()(const f32x4 (&acc)[2][2][4][2], const Unit& u, int wr, int wc, int fr, int fq) const {
        const int row0 = u.pm * BM + wr * 64 + fr; int colt = u.pn * BM; bf16_t* base = O;
        float sc = 1.f; if (split_cols) { const int t = colt / split_cols; base += (size_t)t * split_stride; colt -= t * split_cols; if (t == 0) sc = scale0; }
        const int col0 = colt + wc * 32 + 8 * fq, bcol0 = u.pn * BM + wc * 32 + 8 * fq;
        f32x4 bv[2][2];
#pragma unroll
        for (int bj = 0; bj < 2; ++bj)
#pragma unroll
            for (int n = 0; n < 2; ++n) bv[bj][n] = bias ? *(const f32x4*)(bias + bcol0 + bj * HALF + 4 * n) : (f32x4){0.f, 0.f, 0.f, 0.f};
#pragma unroll
        for (int ai = 0; ai < 2; ++ai)
#pragma unroll
            for (int m = 0; m < 4; ++m) { bf16_t* rowp = base + (size_t)(row0 + ai * HALF + m * 16) * ldc + col0;
#pragma unroll
                for (int bj = 0; bj < 2; ++bj) { f32x4 v0 = acc[ai][bj][m][0] + bv[bj][0], v1 = acc[ai][bj][m][1] + bv[bj][1];
                    if (ACT == 1) { f32x2 a = gelu_pk((f32x2){v0[0], v0[1]}), b = gelu_pk((f32x2){v0[2], v0[3]}), c = gelu_pk((f32x2){v1[0], v1[1]}), d = gelu_pk((f32x2){v1[2], v1[3]});
                        v0 = (f32x4){a.x, a.y, b.x, b.y}; v1 = (f32x4){c.x, c.y, d.x, d.y}; }
                    v0 = v0 * sc; v1 = v1 * sc; u32x4 w; w.x = cvt_pk_bf16(v0[0], v0[1]); w.y = cvt_pk_bf16(v0[2], v0[3]); w.z = cvt_pk_bf16(v1[0], v1[1]); w.w = cvt_pk_bf16(v1[2], v1[3]);
                    *(u32x4*)(rowp + bj * HALF) = w; } }
    }
};
template <class Epi, class Sched, bool ALIGN_EPI = false, bool SP2 = false>
__device__ __forceinline__ void gemm_phase(PG8_LAS unsigned char* lds, const Gemm g, const Sched& S, const Epi& E) {
    int tid_o = threadIdx.x; asm volatile("" : "+v"(tid_o)); const int tid = tid_o, wid = __builtin_amdgcn_readfirstlane(tid >> 6), lane = tid & 63, wr = wid >> 2, wc = wid & 3, fr = lane & 15, fq = lane >> 4;
    const int K = g.K, nt = K / BK;
    unsigned voffA[2], voffB[2];
#pragma unroll
    for (int i = 0; i < 2; ++i) { int R, C; stage_rc(tid * 16 + i * 8192, R, C); const int Rb = Epi::PERM ? ((R & ~31) + perm32(R & 31)) : R;
        voffA[i] = (unsigned)(R * K + C) * 2u; voffB[i] = (unsigned)(Rb * K + C) * 2u; }
    const size_t kstep = (size_t)(BK * 2);
    const size_t hstep = (size_t)HALF * K * 2;
    const size_t tstep = 2 * hstep;
    const unsigned ldsw = (unsigned)wid * 1024u;
    const int aoff = lds_byte(wr * 64 + fr, fq * 8), boff = lds_byte(wc * 32 + fr, fq * 8);
#define PG8_SA(b, h) (((b) * 2 + (h)) * HTB)
#define PG8_SB(b, h) ((4 + (b) * 2 + (h)) * HTB)
#define PG8_STAGE(bufoff, gbase, voff) do { _Pragma("unroll") for (int _i = 0; _i < 2; ++_i) \
        __builtin_amdgcn_global_load_lds((const unsigned*)((const char*)(gbase) + (voff)[_i]), (PG8_LAS unsigned*)(lds + (bufoff) + ldsw + _i * 8192), 16, 0, 0); } while (0)
#define PG8_LDA(dst, b, h) do { _Pragma("unroll") for (int m = 0; m < 4; ++m) _Pragma("unroll") for (int k = 0; k < 2; ++k) dst[m][k] = *(const PG8_LAS bf16x8*)(lds + PG8_SA(b, h) + aoff + m * 2048 + k * 1024); } while (0)
#define PG8_LDB(dst, b, h) do { _Pragma("unroll") for (int n = 0; n < 2; ++n) _Pragma("unroll") for (int k = 0; k < 2; ++k) dst[n][k] = *(const PG8_LAS bf16x8*)(lds + PG8_SB(b, h) + boff + n * 2048 + k * 1024); } while (0)
#define PG8_MMA(ai, bj, At, Bt) do { __builtin_amdgcn_s_setprio(1); _Pragma("unroll") for (int m = 0; m < 4; ++m) _Pragma("unroll") for (int n = 0; n < 2; ++n) _Pragma("unroll") for (int k = 0; k < 2; ++k) \
        acc[ai][bj][m][n] = __builtin_amdgcn_mfma_f32_16x16x32_bf16(Bt[n][k], At[m][k], acc[ai][bj][m][n], 0, 0, 0); __builtin_amdgcn_s_setprio(0); } while (0)
#define PG8_WAIT_V(n) asm volatile("s_waitcnt vmcnt(" #n ")" ::: "memory")
#define PG8_WAIT_L(n) asm volatile("s_waitcnt lgkmcnt(" #n ")" ::: "memory")
#define PG8_BAR __builtin_amdgcn_s_barrier()
#define PG8_SCHED __builtin_amdgcn_sched_barrier(0)
    Unit cur, nxt; int ui = 0;
    if (!S.next(0, cur)) return;
    f32x4 acc[2][2][4][2];
#pragma unroll
    for (int a = 0; a < 2; ++a)
#pragma unroll
        for (int b = 0; b < 2; ++b)
#pragma unroll
            for (int m = 0; m < 4; ++m)
#pragma unroll
                for (int n = 0; n < 2; ++n) acc[a][b][m][n] = (f32x4){0.f, 0.f, 0.f, 0.f};
    bf16x8 At[4][2], B0[2][2], B1[2][2];
    const char* cA = (const char*)g.A + (size_t)cur.pm * tstep; const char* cB = (const char*)g.Bt + (size_t)cur.pn * tstep;
    S.a_ready(cur);
    if constexpr (SP2) {
        PG8_STAGE(PG8_SB(0, 0), cB, voffB); PG8_STAGE(PG8_SB(0, 1), cB + hstep, voffB); PG8_STAGE(PG8_SA(0, 0), cA, voffA); PG8_STAGE(PG8_SA(0, 1), cA + hstep, voffA);
        if (wr == 1) PG8_BAR;
        PG8_WAIT_V(2); PG8_BAR;
        PG8_STAGE(PG8_SB(1, 0), cB + kstep, voffB); PG8_STAGE(PG8_SA(1, 0), cA + kstep, voffA); PG8_STAGE(PG8_SB(1, 1), cB + hstep + kstep, voffB);
        PG8_WAIT_V(6); PG8_BAR;
    } else {
        PG8_STAGE(PG8_SB(0, 0), cB, voffB); PG8_STAGE(PG8_SA(0, 0), cA, voffA); PG8_STAGE(PG8_SB(0, 1), cB + hstep, voffB); PG8_STAGE(PG8_SA(0, 1), cA + hstep, voffA);
        if (wr == 1) PG8_BAR;
        PG8_WAIT_V(4); PG8_BAR;
        PG8_STAGE(PG8_SB(1, 0), cB + kstep, voffB); PG8_STAGE(PG8_SA(1, 0), cA + kstep, voffA); PG8_STAGE(PG8_SB(1, 1), cB + hstep + kstep, voffB);
        PG8_WAIT_V(6); PG8_BAR;
    }
    for (;;) {
        const bool has_next = S.next(ui + 1, nxt);
        const char* nA = has_next ? (const char*)g.A + (size_t)nxt.pm * tstep : cA; const char* nB = has_next ? (const char*)g.Bt + (size_t)nxt.pn * tstep : cB;
        for (int t = 0; t < nt; t += 2) {
            const bool last = (t == nt - 2);
            const char* a1 = cA + (size_t)(t + 1) * kstep;
            const char* a2 = last ? nA : cA + (size_t)(t + 2) * kstep; const char* b2 = last ? nB : cB + (size_t)(t + 2) * kstep;
            const char* a3 = a2 + kstep; const char* b3 = b2 + kstep;
            if (last && has_next) S.a_ready(nxt);
            if constexpr (SP2) {
            PG8_LDB(B0, 0, 0); PG8_LDB(B1, 0, 1); PG8_SCHED; PG8_LDA(At, 0, 0); PG8_STAGE(PG8_SA(1, 1), a1 + hstep, voffA);
            PG8_WAIT_V(8); PG8_WAIT_L(0); PG8_BAR; PG8_MMA(0, 0, At, B0); PG8_MMA(0, 1, At, B1); PG8_BAR; PG8_SCHED;
            PG8_LDA(At, 0, 1); PG8_STAGE(PG8_SB(0, 0), b2, voffB); PG8_STAGE(PG8_SB(0, 1), b2 + hstep, voffB); PG8_STAGE(PG8_SA(0, 0), a2, voffA);
            PG8_WAIT_V(8); PG8_WAIT_L(0); PG8_BAR; PG8_MMA(1, 0, At, B0); PG8_MMA(1, 1, At, B1); PG8_BAR; PG8_SCHED;
            PG8_LDB(B0, 1, 0); PG8_LDB(B1, 1, 1); PG8_SCHED; PG8_LDA(At, 1, 0); PG8_STAGE(PG8_SA(0, 1), a2 + hstep, voffA);
            PG8_WAIT_V(8); PG8_WAIT_L(0); PG8_BAR; PG8_MMA(0, 0, At, B0); PG8_MMA(0, 1, At, B1); PG8_BAR; PG8_SCHED;
            PG8_LDA(At, 1, 1); PG8_STAGE(PG8_SB(1, 0), b3, voffB); PG8_STAGE(PG8_SB(1, 1), b3 + hstep, voffB); PG8_STAGE(PG8_SA(1, 0), a3, voffA);
            PG8_WAIT_V(8); PG8_WAIT_L(0); PG8_BAR; PG8_MMA(1, 0, At, B0); PG8_MMA(1, 1, At, B1); PG8_BAR; PG8_SCHED;
            } else {
            PG8_LDB(B0, 0, 0); PG8_SCHED; PG8_LDA(At, 0, 0); PG8_STAGE(PG8_SA(1, 1), a1 + hstep, voffA);
            PG8_WAIT_L(8); PG8_BAR; PG8_WAIT_L(0); PG8_MMA(0, 0, At, B0); PG8_BAR; PG8_SCHED;
            PG8_LDB(B1, 0, 1); PG8_STAGE(PG8_SB(0, 0), b2, voffB);
            PG8_BAR; PG8_WAIT_L(0); PG8_MMA(0, 1, At, B1); PG8_BAR;
            PG8_LDA(At, 0, 1); PG8_STAGE(PG8_SA(0, 0), a2, voffA);
            PG8_BAR; PG8_WAIT_L(0); PG8_MMA(1, 0, At, B0); PG8_BAR; PG8_SCHED;
            PG8_STAGE(PG8_SB(0, 1), b2 + hstep, voffB);
            PG8_WAIT_V(6); PG8_BAR; PG8_MMA(1, 1, At, B1); PG8_BAR;
            PG8_LDB(B0, 1, 0); PG8_SCHED; PG8_LDA(At, 1, 0); PG8_STAGE(PG8_SA(0, 1), a2 + hstep, voffA);
            PG8_WAIT_L(8); PG8_BAR; PG8_WAIT_L(0); PG8_MMA(0, 0, At, B0); PG8_BAR; PG8_SCHED;
            PG8_LDB(B1, 1, 1); PG8_STAGE(PG8_SB(1, 0), b3, voffB);
            PG8_BAR; PG8_WAIT_L(0); PG8_MMA(0, 1, At, B1); PG8_BAR;
            PG8_LDA(At, 1, 1); PG8_STAGE(PG8_SA(1, 0), a3, voffA);
            PG8_BAR; PG8_WAIT_L(0); PG8_MMA(1, 0, At, B0); PG8_BAR; PG8_SCHED;
            PG8_STAGE(PG8_SB(1, 1), b3 + hstep, voffB);
            PG8_WAIT_V(6); PG8_BAR; PG8_MMA(1, 1, At, B1); PG8_BAR;
            }
        }
        if constexpr (ALIGN_EPI) { if (wr == 0) PG8_BAR; }
        if constexpr (!Epi::AFTER_DRAIN) { E(acc, cur, wr, wc, fr, fq); S.done(cur); }
        if (!has_next) break;
#pragma unroll
        for (int a = 0; a < 2; ++a)
#pragma unroll
            for (int b = 0; b < 2; ++b)
#pragma unroll
                for (int m = 0; m < 4; ++m)
#pragma unroll
                    for (int n = 0; n < 2; ++n) acc[a][b][m][n] = (f32x4){0.f, 0.f, 0.f, 0.f};
        cur = nxt; cA = nA; cB = nB; ++ui;
        if constexpr (ALIGN_EPI) { if (wr == 1) PG8_BAR; }
    }
    PG8_WAIT_V(0);
    if constexpr (!ALIGN_EPI) { if (wr == 0) PG8_BAR; }
    PG8_BAR;
    if constexpr (Epi::AFTER_DRAIN) { E.fused(acc, cur, wr, wc, fr, fq, lds, wid, lane); S.done(cur); }
#undef PG8_SA
#undef PG8_SB
#undef PG8_STAGE
#undef PG8_LDA
#undef PG8_LDB
#undef PG8_MMA
#undef PG8_WAIT_V
#undef PG8_WAIT_L
#undef PG8_BAR
#undef PG8_SCHED
}
}
#include <hip/hip_bf16.h>
#include <cmath>
namespace attn_body {
using bf16=__hip_bfloat16;
using bf16x8=__attribute__((ext_vector_type(8)))short;
using s16x4=__attribute__((ext_vector_type(4)))short;
using f32x16=__attribute__((ext_vector_type(16)))float;
using u32x4=__attribute__((ext_vector_type(4)))unsigned;
constexpr int D=64,QP=512,KP=512,VP=128,OP=1024;
constexpr int NW=8,QBLK=32,QB=QBLK*NW,KVBLK=64;
constexpr int ATTN_UNIT_ROWS=QB;
__device__ __forceinline__ int crow(int r,int hi){return (r&3)+8*(r>>2)+4*hi;}
#define SBAR() __builtin_amdgcn_sched_barrier(0)
__device__ __forceinline__ void cmask(f32x16&p0,f32x16&p1,int jb,int qrel,int hi){
  const float NEG=-INFINITY; int kb=64*jb+4*hi;
  #pragma unroll
  for(int r=0;r<16;++r){int kv=kb+(r&3)+8*(r>>2); if(kv>qrel)p0[r]=NEG; if(kv+32>qrel)p1[r]=NEG;}
}

constexpr int NSLOT=3, SLOTB=8192;
constexpr int LDS_K=0, LDS_V=NSLOT*SLOTB, LDS_WS=2*NSLOT*SLOTB, LDS_OST=LDS_WS+NW*64*4, LDS_BYTES=LDS_OST+NW*4096;
constexpr float C2=0.125f*1.4426950408889634f;
__device__ __forceinline__ void glds16(const void*gsrc,unsigned lds_dst){unsigned keep;
  asm volatile("s_mov_b32 %0, m0\n\ts_mov_b32 m0, %2\n\ts_nop 0\n\tglobal_load_lds_dwordx4 %1, off\n\ts_mov_b32 m0, %0":"=&s"(keep):"v"(gsrc),"s"(lds_dst):"memory");}
__device__ __forceinline__ float max3f(float a,float b,float c){float r;asm("v_max3_f32 %0, %1, %2, %3":"=v"(r):"v"(a),"v"(b),"v"(c));return r;}
__device__ __forceinline__ float max2f(float a,float b){float r;asm("v_max_f32_e32 %0, %1, %2":"=v"(r):"v"(a),"v"(b));return r;}
__device__ __forceinline__ float fadd_s(float a,float b){float r;asm("v_add_f32_e32 %0, %1, %2":"=v"(r):"v"(a),"v"(b));return r;}
__device__ __forceinline__ float fsub_s(float a,float b){float r;asm("v_sub_f32_e32 %0, %1, %2":"=v"(r):"v"(a),"v"(b));return r;}
typedef float f32x2_t __attribute__((ext_vector_type(2))); typedef __bf16 bf16x2_t __attribute__((ext_vector_type(2)));
__device__ __forceinline__ unsigned cvtpk_s(float lo,float hi){f32x2_t v={lo,hi};bf16x2_t b=__builtin_convertvector(v,bf16x2_t);return __builtin_bit_cast(unsigned,b);}
#define WAIT_BAR(N) asm volatile("s_waitcnt vmcnt(" #N ") lgkmcnt(0)\n\ts_barrier":::"memory")

__device__ __forceinline__ void qkt(f32x16&p0,f32x16&p1,const char*Kslot,const bf16x8*qr,const f32x16&negm,int r32,int hi){
  const char*kb=Kslot+hi*1024+r32*16;
  #pragma unroll
  for(int d0=0;d0<4;++d0){
    const bf16x8 b0=*reinterpret_cast<const bf16x8*>(kb+d0*2048);
    const bf16x8 b1=*reinterpret_cast<const bf16x8*>(kb+d0*2048+512);
    if(d0==0){p0=__builtin_amdgcn_mfma_f32_32x32x16_bf16(b0,qr[0],negm,0,0,0);p1=__builtin_amdgcn_mfma_f32_32x32x16_bf16(b1,qr[0],negm,0,0,0);}
    else{p0=__builtin_amdgcn_mfma_f32_32x32x16_bf16(b0,qr[d0],p0,0,0,0);p1=__builtin_amdgcn_mfma_f32_32x32x16_bf16(b1,qr[d0],p1,0,0,0);}}
}
typedef __attribute__((address_space(3))) const char* lds_cptr;
typedef short v4i16_t __attribute__((ext_vector_type(4)));
__device__ __forceinline__ void kload8(bf16x8*kf,lds_cptr kp){
  kf[0]=*(const __attribute__((address_space(3))) bf16x8*)(kp);      kf[1]=*(const __attribute__((address_space(3))) bf16x8*)(kp+512);
  kf[2]=*(const __attribute__((address_space(3))) bf16x8*)(kp+2048); kf[3]=*(const __attribute__((address_space(3))) bf16x8*)(kp+2560);
  kf[4]=*(const __attribute__((address_space(3))) bf16x8*)(kp+4096); kf[5]=*(const __attribute__((address_space(3))) bf16x8*)(kp+4608);
  kf[6]=*(const __attribute__((address_space(3))) bf16x8*)(kp+6144); kf[7]=*(const __attribute__((address_space(3))) bf16x8*)(kp+6656);
}
__device__ __forceinline__ void kload2(bf16x8*kf,lds_cptr kp,int j){ kf[2*j]=*(const __attribute__((address_space(3))) bf16x8*)(kp+j*2048); kf[2*j+1]=*(const __attribute__((address_space(3))) bf16x8*)(kp+j*2048+512); }
__device__ __forceinline__ s16x4 vtr(lds_cptr p){ return __builtin_bit_cast(s16x4,__builtin_amdgcn_ds_read_tr16_b64_v4i16((__attribute__((address_space(3))) v4i16_t*)p)); }
__device__ __forceinline__ float rowmax(const f32x16&p0,const f32x16&p1){
  float a=max3f(p0[0],p0[1],p1[0]),b=max3f(p0[2],p0[3],p1[1]);a=max3f(a,p1[2],p1[3]);
  #pragma unroll
  for(int r=4;r<16;r+=4){a=max3f(a,p0[r],p0[r+1]);b=max3f(b,p0[r+2],p0[r+3]);a=max3f(a,p1[r],p1[r+1]);b=max3f(b,p1[r+2],p1[r+3]);}
  const float m=max2f(a,b);
  auto rr=__builtin_amdgcn_permlane32_swap(__float_as_uint(m),__float_as_uint(m),false,false);
  return max2f(__uint_as_float(rr[0]),__uint_as_float(rr[1]));
}
__device__ __forceinline__ void pv(f32x16*o,int vb,bf16x8 pa0,bf16x8 pa1,bf16x8 pa2,bf16x8 pa3){
  #pragma unroll
  for(int d0=0;d0<2;++d0){s16x4 lo[4],hi[4];
    #pragma unroll
    for(int ks=0;ks<4;++ks){
      asm volatile("ds_read_b64_tr_b16 %0,%1 offset:%c2":"=&v"(lo[ks]):"v"(vb),"i"(d0*4096+ks*1024):"memory");
      asm volatile("ds_read_b64_tr_b16 %0,%1 offset:%c2":"=&v"(hi[ks]):"v"(vb),"i"(d0*4096+ks*1024+512):"memory");}
    asm volatile("s_waitcnt lgkmcnt(0)":::"memory");SBAR();
    #define PK(k) (bf16x8){lo[k][0],lo[k][1],lo[k][2],lo[k][3],hi[k][0],hi[k][1],hi[k][2],hi[k][3]}
    o[d0]=__builtin_amdgcn_mfma_f32_32x32x16_bf16(pa0,PK(0),o[d0],0,0,0);
    o[d0]=__builtin_amdgcn_mfma_f32_32x32x16_bf16(pa1,PK(1),o[d0],0,0,0);
    o[d0]=__builtin_amdgcn_mfma_f32_32x32x16_bf16(pa2,PK(2),o[d0],0,0,0);
    o[d0]=__builtin_amdgcn_mfma_f32_32x32x16_bf16(pa3,PK(3),o[d0],0,0,0);
    #undef PK
  }
}

#ifndef ATTN_STORE16
#define ATTN_STORE16(p,v) (*(u32x4*)(p)=(v))
#endif
template<int THRL> __device__ __forceinline__ void attn_unit(int rowbase_i,int S,int qb,int qcol,int kcol,int vcol,int ocol,const bf16*Q,const bf16*__restrict__ K,const bf16*__restrict__ V,bf16*O,char*shm){
  int tid_o=threadIdx.x; asm volatile("":"+v"(tid_o)); const int tid=tid_o,lane=tid&63,r32=lane&31,hi=lane>>5; const int wid=__builtin_amdgcn_readfirstlane(tid>>6);
  const long rowbase=(long)rowbase_i; const int q0=qb*QB;
  const bf16*Qw=Q+(rowbase+q0+wid*QBLK)*QP+qcol;
  const bf16*Kh=K+rowbase*KP+kcol,*Vh=V+rowbase*VP+vcol;
  const unsigned lds0=(unsigned)(uintptr_t)shm;
  float*wsf=(float*)(shm+LDS_WS)+wid*64;
  const bf16*ksrc=Kh+(long)lane*KP+wid*8;
  const bf16*vsrc=Vh+(long)(16*(wid&3)+(lane>>2))*VP+(wid>>2)*32+(lane&3)*8;
  const unsigned kdst=lds0+LDS_K+wid*1024, vdst=lds0+LDS_V+wid*1024;
  #define DMA_K(t,slot) glds16(ksrc+(long)(t)*KVBLK*KP,(unsigned)__builtin_amdgcn_readfirstlane(kdst+(slot)))
  #define DMA_V(t,slot) glds16(vsrc+(long)(t)*KVBLK*VP,(unsigned)__builtin_amdgcn_readfirstlane(vdst+(slot)))
  const int vb0=(int)(lds0+LDS_V)+((lane>>4)&1)*32+(lane&3)*8+(4*hi+((lane&15)>>2))*64;
  const char*Kbase=shm+LDS_K; bf16x8 kf[8];
  const lds_cptr shm3=(lds_cptr)shm; const lds_cptr kp0=shm3+LDS_K+hi*1024+r32*16; const lds_cptr vp0=shm3+LDS_V+((lane>>4)&1)*32+(lane&3)*8+(4*hi+((lane&15)>>2))*64;
  const int NT=S/KVBLK;
  DMA_K(0,0);DMA_V(0,0);DMA_K(1,SLOTB);
  bf16x8 qr[4];
  #pragma unroll
  for(int d0=0;d0<4;++d0)qr[d0]=*reinterpret_cast<const bf16x8*>(&Qw[(long)r32*QP+d0*16+hi*8]);
  float mhat=0.f,l_reg=0.f;f32x16 o[2];o[0]=f32x16{};o[1]=f32x16{};f32x16 negm=f32x16{};asm volatile("":"+v"(negm));
  const int qrel=wid*QBLK+r32;
  #define CMASK(P0,P1,t) do{}while(0)
  bool resc=false;
  #define START(P0,P1) do{ const float rm=rowmax(P0,P1); resc=false; \
    { const float dl=rm; mhat=fadd_s(mhat,dl); \
      _Pragma("unroll") for(int r=0;r<16;++r){P0[r]=fsub_s(P0[r],dl);P1[r]=fsub_s(P1[r],dl);} \
      _Pragma("unroll") for(int r=0;r<16;++r)negm[r]=-mhat; asm volatile("":"+v"(negm)); } \
    _Pragma("unroll") for(int r=0;r<16;++r)P0[r]=__builtin_amdgcn_exp2f(P0[r]); }while(0)
  #define RESC() do{ if(resc){ asm volatile("s_waitcnt lgkmcnt(0)":::"memory"); \
      _Pragma("unroll") for(int d_=0;d_<2;++d_) _Pragma("unroll") for(int r=0;r<16;++r)o[d_][r]*=wsf[crow(r,hi)]; } }while(0)
  f32x16 pA0,pA1,pB0,pB1;
  int sl_prev=0,sl_cur=0,sl_next=SLOTB;
  #define ROT() do{sl_prev=sl_cur;sl_cur=sl_next;sl_next=(sl_next==(NSLOT-1)*SLOTB)?0:sl_next+SLOTB;}while(0)
  DMA_K(2,2*SLOTB);
  WAIT_BAR(3);
  qkt(pA0,pA1,Kbase,qr,negm,r32,hi);asm volatile("s_nop 15\n\ts_nop 7":"+v"(pA0),"+v"(pA1));CMASK(pA0,pA1,0);
  START(pA0,pA1);
  _Pragma("unroll") for(int r=0;r<16;++r)pA1[r]=__builtin_amdgcn_exp2f(pA1[r]);
  WAIT_BAR(0);
  DMA_K(3,0);DMA_V(1,SLOTB);
  ROT();
  kload8(kf,kp0+sl_cur);
  WAIT_BAR(2);
  s16x4 vlo[8],vhi[8]; u32x4 pw0,pw1,pw2,pw3;
  #define PKW(P,B) cvtpk_s(P[B],P[B+1])
  #define PAF(k) __builtin_bit_cast(bf16x8,pw##k)
  #define VFR(i) (bf16x8){vlo[i][0],vlo[i][1],vlo[i][2],vlo[i][3],vhi[i][0],vhi[i][1],vhi[i][2],vhi[i][3]}
  #define PIN(x) asm volatile("":"+v"(x))
  #define MX3(a,b,c) __builtin_fmaxf(__builtin_fmaxf((a),(b)),(c))
  #define GAPA(MF,A0,A1,A2,A3,W0,W1,PW) do{ MF; sacc+=A0; sacc+=A1; sacc+=A2; sacc+=A3; PIN(sacc); W0; W1; PIN(PW); SBAR(); }while(0)
  #define EX(v) __builtin_amdgcn_exp2f(v)
  #define GAPB(MF,X,B) do{ MF; X[B]=EX(X[B]); X[B+1]=EX(X[B+1]); X[B+2]=EX(X[B+2]); X[B+3]=EX(X[B+3]); PIN(X); SBAR(); }while(0)
  #define VRD(i) do{ vlo[i]=vtr(vp_+(((i)>>2)*4096+((i)&3)*1024)); vhi[i]=vtr(vp_+(((i)>>2)*4096+((i)&3)*1024+512)); }while(0)
  #define KRD(G,j) do{ if(G){ kload2(kf,kp0+sl_next,j); SBAR(); } }while(0)
  #define STEP(C0,C1,P0,P1,t,GK,GV,GL) do{ SBAR(); \
    const lds_cptr vp_=vp0+sl_prev; \
    VRD(0); SBAR(); float sacc=(P0[0]+P0[1]); \
    GAPA(C0=__builtin_amdgcn_mfma_f32_32x32x16_bf16(kf[0],qr[0],negm,0,0,0), P0[2],P0[3],P0[4],P0[5],     pw0[0]=PKW(P0,0), pw0[1]=PKW(P0,2), pw0); \
    VRD(4); SBAR(); GAPA(C1=__builtin_amdgcn_mfma_f32_32x32x16_bf16(kf[1],qr[0],negm,0,0,0), P0[6],P0[7],P0[8],P0[9],     pw0[2]=PKW(P0,4), pw0[3]=PKW(P0,6), pw0); \
    VRD(1); SBAR(); GAPA(C0=__builtin_amdgcn_mfma_f32_32x32x16_bf16(kf[2],qr[1],C0,0,0,0),   P0[10],P0[11],P0[12],P0[13], pw1[0]=PKW(P0,8), pw1[1]=PKW(P0,10), pw1); \
    VRD(5); SBAR(); GAPA(C1=__builtin_amdgcn_mfma_f32_32x32x16_bf16(kf[3],qr[1],C1,0,0,0),   P0[14],P0[15],P1[0],P1[1],   pw1[2]=PKW(P0,12),pw1[3]=PKW(P0,14), pw1); \
    VRD(2); SBAR(); GAPA(C0=__builtin_amdgcn_mfma_f32_32x32x16_bf16(kf[4],qr[2],C0,0,0,0),   P1[2],P1[3],P1[4],P1[5],     pw2[0]=PKW(P1,0), pw2[1]=PKW(P1,2), pw2); \
    VRD(6); SBAR(); GAPA(C1=__builtin_amdgcn_mfma_f32_32x32x16_bf16(kf[5],qr[2],C1,0,0,0),   P1[6],P1[7],P1[8],P1[9],     pw2[2]=PKW(P1,4), pw2[3]=PKW(P1,6), pw2); \
    VRD(3); SBAR(); GAPA(C0=__builtin_amdgcn_mfma_f32_32x32x16_bf16(kf[6],qr[3],C0,0,0,0),   P1[10],P1[11],P1[12],P1[13], pw3[0]=PKW(P1,8), pw3[1]=PKW(P1,10), pw3); \
    VRD(7); SBAR(); GAPA(C1=__builtin_amdgcn_mfma_f32_32x32x16_bf16(kf[7],qr[3],C1,0,0,0),   P1[14],P1[15],0.f,0.f,       pw3[2]=PKW(P1,12),pw3[3]=PKW(P1,14), pw3); \
    l_reg+=sacc; \
    if(GK){DMA_K((t)+3,sl_cur);} if(GV){DMA_V((t)+1,sl_next);} \
    CMASK(C0,C1,t); \
    { float a=MX3(C0[0],C0[1],C1[0]),b=MX3(C0[2],C0[3],C1[1]); a=MX3(a,C1[2],C1[3]); \
      _Pragma("unroll") for(int r=4;r<16;r+=4){a=MX3(a,C0[r],C0[r+1]);b=MX3(b,C0[r+2],C0[r+3]);a=MX3(a,C1[r],C1[r+1]);b=MX3(b,C1[r+2],C1[r+3]);} \
      float rm=__builtin_fmaxf(a,b); { auto rr=__builtin_amdgcn_permlane32_swap(__float_as_uint(rm),__float_as_uint(rm),false,false); rm=__builtin_fmaxf(__uint_as_float(rr[0]),__uint_as_float(rr[1])); } \
      resc=false; \
      if(__builtin_expect(__any(rm>(float)THRL),0)){ const float dl=__builtin_fmaxf(rm,0.f); mhat+=dl; \
        _Pragma("unroll") for(int r=0;r<16;++r){C0[r]-=dl;C1[r]-=dl;} \
        _Pragma("unroll") for(int r=0;r<16;++r)negm[r]=-mhat; asm volatile("":"+v"(negm)); \
        const float f=__builtin_amdgcn_exp2f(-dl); l_reg*=f; if(hi==0)wsf[r32]=f; resc=true; } } \
    SBAR(); \
    GAPB(o[0]=__builtin_amdgcn_mfma_f32_32x32x16_bf16(PAF(0),VFR(0),o[0],0,0,0), C0,0); \
    GAPB(o[1]=__builtin_amdgcn_mfma_f32_32x32x16_bf16(PAF(0),VFR(4),o[1],0,0,0), C0,4); \
    KRD(GL,0); GAPB(o[0]=__builtin_amdgcn_mfma_f32_32x32x16_bf16(PAF(1),VFR(1),o[0],0,0,0), C0,8); \
    KRD(GL,1); GAPB(o[1]=__builtin_amdgcn_mfma_f32_32x32x16_bf16(PAF(1),VFR(5),o[1],0,0,0), C0,12); \
    KRD(GL,2); GAPB(o[0]=__builtin_amdgcn_mfma_f32_32x32x16_bf16(PAF(2),VFR(2),o[0],0,0,0), C1,0); \
    KRD(GL,3); GAPB(o[1]=__builtin_amdgcn_mfma_f32_32x32x16_bf16(PAF(2),VFR(6),o[1],0,0,0), C1,4); \
    GAPB(o[0]=__builtin_amdgcn_mfma_f32_32x32x16_bf16(PAF(3),VFR(3),o[0],0,0,0), C1,8); \
    GAPB(o[1]=__builtin_amdgcn_mfma_f32_32x32x16_bf16(PAF(3),VFR(7),o[1],0,0,0), C1,12); \
    }while(0)
  int t=1;
  #undef CMASK
  #define CMASK(P0,P1,t) do{}while(0)
  for(;t+5<NT;t+=2){
    STEP(pB0,pB1,pA0,pA1,t,true,true,true);     WAIT_BAR(2); RESC(); ROT();
    STEP(pA0,pA1,pB0,pB1,t+1,true,true,true);   WAIT_BAR(2); RESC(); ROT();
  }
  #undef CMASK
  #define CMASK(P0,P1,t) do{}while(0)
  #define ENDW(tt) do{ if((tt)+3<NT){WAIT_BAR(2);} else if((tt)+2<NT){WAIT_BAR(1);} else {WAIT_BAR(0);} }while(0)
  for(;t+1<NT;t+=2){
    STEP(pB0,pB1,pA0,pA1,t,(t+3<NT),(t+1<NT),(t+1<NT));       ENDW(t);   RESC(); ROT();
    STEP(pA0,pA1,pB0,pB1,t+1,(t+4<NT),(t+2<NT),(t+2<NT));     ENDW(t+1); RESC(); ROT();
  }
  STEP(pB0,pB1,pA0,pA1,NT-1,false,false,false); RESC();
  { float sacc=pB0[0]+pB0[1]; _Pragma("unroll") for(int r=2;r<16;++r)sacc+=pB0[r]; _Pragma("unroll") for(int r=0;r<16;++r)sacc+=pB1[r]; l_reg+=sacc;
    pw0=(u32x4){PKW(pB0,0),PKW(pB0,2),PKW(pB0,4),PKW(pB0,6)};pw1=(u32x4){PKW(pB0,8),PKW(pB0,10),PKW(pB0,12),PKW(pB0,14)};pw2=(u32x4){PKW(pB1,0),PKW(pB1,2),PKW(pB1,4),PKW(pB1,6)};pw3=(u32x4){PKW(pB1,8),PKW(pB1,10),PKW(pB1,12),PKW(pB1,14)};
    SBAR(); pv(o,vb0+sl_cur,PAF(0),PAF(1),PAF(2),PAF(3)); }
  #undef PKW
  #undef PAF
  #undef VFR
  #undef PIN
  #undef MX3
  #undef GAPA
  #undef GAPB
  #undef EX
  #undef VRD
  #undef KRD
  #undef STEP
  #undef ENDW
  {auto rr=__builtin_amdgcn_permlane32_swap(__float_as_uint(l_reg),__float_as_uint(l_reg),false,false);l_reg=__uint_as_float(rr[0])+__uint_as_float(rr[1]);}
  if(hi==0)wsf[32+r32]=l_reg;asm volatile("s_waitcnt lgkmcnt(0)":::"memory");
  float rli[16];
  #pragma unroll
  for(int r=0;r<16;++r)rli[r]=__builtin_amdgcn_rcpf(wsf[32+crow(r,hi)]);
  bf16*Ow=O+(rowbase+q0+wid*QBLK)*OP+ocol;
  { bf16*stg=(bf16*)(shm+LDS_OST)+wid*2048;
    #pragma unroll
    for(int r=0;r<16;++r){const int orow=crow(r,hi);
      #pragma unroll
      for(int d0=0;d0<2;++d0)stg[orow*64+d0*32+r32]=__float2bfloat16(o[d0][r]*rli[r]);}
    asm volatile("s_waitcnt lgkmcnt(0)":::"memory");
    #pragma unroll
    for(int i=0;i<4;++i){const int row=i*8+(lane>>3),ch=lane&7; const u32x4 v=*(const u32x4*)(stg+row*64+ch*8); ATTN_STORE16(Ow+(long)row*OP+ch*8,v);} }
  asm volatile("s_waitcnt lgkmcnt(0)\n\ts_barrier":::"memory");
  #undef DMA_K
  #undef DMA_V
  #undef CMASK
  #undef START
  #undef RESC
  #undef ROT
}
constexpr int ATTN_LDS_BYTES=LDS_BYTES;
#undef SBAR
#undef WAIT_BAR
}

#define LAS __attribute__((address_space(3)))
#define LDS_BARRIER() asm volatile("s_waitcnt lgkmcnt(0)\n\ts_barrier" ::: "memory")
typedef unsigned short bf16;
typedef unsigned u32x4_t __attribute__((ext_vector_type(4)));
typedef unsigned u32x2_t __attribute__((ext_vector_type(2)));
typedef float f32x4_t __attribute__((ext_vector_type(4)));
typedef float f32x2_t __attribute__((ext_vector_type(2)));

constexpr int DM = 1024, MTOK = 49152, NSEQ = 20, DFF = 2816, NFF = 5632, NMIXP = 2560, NMIX = 2432, ZP = 1792;
constexpr int NTHR = 512;
constexpr float QSCALE = 0.125f * 1.4426950408889634f;
constexpr size_t MiB = 1u << 20;
constexpr size_t ZERO_BYTES = 8 * MiB;
constexpr size_t OFF_CTR = 0, OFF_ROPE = 32768, OFF_SS = 65536, OFF_MOD = 2 * MiB, OFF_BIAS = 4 * MiB, OFF_GV = 7 * MiB, OFF_GATE = 7 * MiB + 512 * 1024;
constexpr size_t OFF_W = 8 * MiB, W_LAYER = 40 * MiB;
constexpr size_t WO_IN = 0, WO_OUT = 22 * MiB, WO_MI = 33 * MiB, WO_MO = 38 * MiB;
constexpr size_t OFF_XN = 88 * MiB, OFF_YF = 88 * MiB, OFF_YB = 136 * MiB;
constexpr size_t OFF_HID = 184 * MiB, OFF_Z = 184 * MiB, OFF_QK = 352 * MiB, OFF_VR = 400 * MiB, OFF_OMIX = 412 * MiB, WS_END = 508 * MiB;
constexpr size_t OFF_SMID = 508 * MiB;
constexpr int LDS_BYTES = 147456, MISC_OFF = 131072;

struct KP { const float* in[31]; float* out; unsigned char* ws; };

__device__ __forceinline__ int seq_of_row(int m) { return m < 16384 ? (m >> 12) : 4 + ((m - 16384) >> 11); }
__device__ __forceinline__ int seq_start(int s) { return s < 4 ? s * 4096 : 16384 + (s - 4) * 2048; }
__device__ __forceinline__ int seq_len(int s) { return s < 4 ? 4096 : 2048; }
__device__ __forceinline__ unsigned f2bf(float f) { unsigned u = __builtin_bit_cast(unsigned, f); return (u + 0x7fffu + ((u >> 16) & 1u)) >> 16; }
__device__ __forceinline__ unsigned pk2(float lo, float hi) { return f2bf(lo) | (f2bf(hi) << 16); }
__device__ __forceinline__ float bf2f(unsigned short b) { return __builtin_bit_cast(float, (unsigned)b << 16); }
__device__ __forceinline__ float sigmoidf_(float x) { return __builtin_amdgcn_rcpf(1.0f + __builtin_amdgcn_exp2f(-1.4426950408889634f * x)); }
#define DPP_ADD(v, CTRL) ((v) + __builtin_bit_cast(float, __builtin_amdgcn_update_dpp(0, __builtin_bit_cast(int, (v)), (CTRL), 0xf, 0xf, false)))
__device__ __forceinline__ float wave_sum(float v) {
    v = DPP_ADD(v, 0xB1);
    v = DPP_ADD(v, 0x4E);
    v = DPP_ADD(v, 0x141);
    v = DPP_ADD(v, 0x140);
    const f32x4_t d = __builtin_amdgcn_mfma_f32_16x16x4f32(1.0f, v, (f32x4_t){0.f, 0.f, 0.f, 0.f}, 0, 0, 0);
    return d[0];
}
__device__ __forceinline__ float tanh_fast(float x) { const float e = __expf(2.0f * x); return 1.0f - 2.0f * __builtin_amdgcn_rcpf(e + 1.0f); }
__host__ __device__ __forceinline__ int map_ffn(int n) { const int half = n >= DFF ? 1 : 0; const int n2 = half ? n - DFF : n; return 256 * (n2 >> 7) + 128 * half + (n2 & 127); }
__host__ __device__ __forceinline__ int map_mix(int n) {
    if (n < 1792 || n >= 2304) return n;
    const int hh = (n - 1792) >> 6, d = (n - 1792) & 63;
    return 256 * (7 + (hh >> 2)) + 128 * (d >> 5) + 32 * (hh & 3) + 8 * ((d & 15) >> 2) + 4 * ((d >> 4) & 1) + (d & 3);
}

namespace pg8 {
struct EpiSwiglu {
    static constexpr bool PERM = true, AFTER_DRAIN = false;
    bf16_t* H; const float* ss; const float* bias;
    __device__ __forceinline__ void operator()(const f32x4 (&acc)[2][2][4][2], const Unit& u, int wr, int wc, int fr, int fq) const {
        const int row0 = u.pm * BM + wr * 64 + fr; const int s = seq_of_row(u.pm * BM);
        const float* bp = bias + (size_t)s * NFF + u.pn * 256 + wc * 32 + 8 * fq;
        f32x4 bg[2], bu[2];
#pragma unroll
        for (int n = 0; n < 2; ++n) { bg[n] = *(const f32x4*)(bp + 4 * n); bu[n] = *(const f32x4*)(bp + 128 + 4 * n); }
        float rsv[2][4];
#pragma unroll
        for (int ai = 0; ai < 2; ++ai)
#pragma unroll
            for (int m = 0; m < 4; ++m) rsv[ai][m] = ss[row0 + ai * HALF + m * 16];
        asm volatile("" ::: "memory");
#pragma unroll
        for (int ai = 0; ai < 2; ++ai)
#pragma unroll
            for (int m = 0; m < 4; ++m) {
                const int row = row0 + ai * HALF + m * 16;
                const float rs = rsqrtf(rsv[ai][m] * (1.0f / 1024.0f) + 1e-6f);
                float h[8];
#pragma unroll
                for (int n = 0; n < 2; ++n) {
                    const f32x4 g = acc[ai][0][m][n] * rs + bg[n], up = acc[ai][1][m][n] * rs + bu[n];
#pragma unroll
                    for (int i = 0; i < 4; ++i) h[4 * n + i] = g[i] * sigmoidf_(g[i]) * up[i];
                }
                u32x4 w; w.x = cvt_pk_bf16(h[0], h[1]); w.y = cvt_pk_bf16(h[2], h[3]); w.z = cvt_pk_bf16(h[4], h[5]); w.w = cvt_pk_bf16(h[6], h[7]);
                *(u32x4*)(H + (size_t)row * DFF + u.pn * 128 + wc * 32 + 8 * fq) = w;
            }
    }
};
struct EpiZ {
    static constexpr bool PERM = true, AFTER_DRAIN = false;
    bf16_t* Z; bf16_t* QK; bf16_t* VR; const float* ss; const float* bias; const float* qg; const float* kg; const float* rope;
    __device__ __forceinline__ void operator()(const f32x4 (&acc)[2][2][4][2], const Unit& u, int wr, int wc, int fr, int fq) const {
        const int row0 = u.pm * BM + wr * 64 + fr; const int s = seq_of_row(u.pm * BM); const int t0 = row0 - seq_start(s);
        const float* bp = bias + (size_t)s * NFF + u.pn * 256 + wc * 32 + 8 * fq;
        f32x4 bv[2][2];
#pragma unroll
        for (int bj = 0; bj < 2; ++bj)
#pragma unroll
            for (int n = 0; n < 2; ++n) bv[bj][n] = *(const f32x4*)(bp + bj * 128 + 4 * n);
        if (u.pn < 7 || u.pn == 9) {
            float rsv[2][4];
#pragma unroll
            for (int ai = 0; ai < 2; ++ai)
#pragma unroll
                for (int m = 0; m < 4; ++m) rsv[ai][m] = ss[row0 + ai * HALF + m * 16];
            asm volatile("" ::: "memory");
#pragma unroll
            for (int ai = 0; ai < 2; ++ai)
#pragma unroll
                for (int m = 0; m < 4; ++m) {
                    const int row = row0 + ai * HALF + m * 16;
                    const float rs = rsqrtf(rsv[ai][m] * (1.0f / 1024.0f) + 1e-6f);
#pragma unroll
                    for (int bj = 0; bj < 2; ++bj) {
                        const f32x4 v0 = acc[ai][bj][m][0] * rs + bv[bj][0], v1 = acc[ai][bj][m][1] * rs + bv[bj][1];
                        u32x4 w; w.x = cvt_pk_bf16(v0[0], v0[1]); w.y = cvt_pk_bf16(v0[2], v0[3]); w.z = cvt_pk_bf16(v1[0], v1[1]); w.w = cvt_pk_bf16(v1[2], v1[3]);
                        if (u.pn < 7) *(u32x4*)(Z + (size_t)row * ZP + u.pn * 256 + bj * 128 + wc * 32 + 8 * fq) = w;
                        else if (bj == 0) *(u32x4*)(VR + (size_t)row * 128 + wc * 32 + 8 * fq) = w;
                    }
                }
        } else {
            const int hh = (u.pn - 7) * 4 + wc; const bool isq = hh < 6; const float* gp = isq ? qg : kg; const float osc = isq ? QSCALE : 1.0f;
            f32x4 gn[2][2];
#pragma unroll
            for (int bj = 0; bj < 2; ++bj)
#pragma unroll
                for (int n = 0; n < 2; ++n) gn[bj][n] = *(const f32x4*)(gp + 32 * bj + 16 * n + 4 * fq);
#pragma unroll
            for (int ai = 0; ai < 2; ++ai)
#pragma unroll
                for (int m = 0; m < 4; ++m) {
                    const int row = row0 + ai * HALF + m * 16; const int t = t0 + ai * HALF + m * 16;
                    const float rs = rsqrtf(ss[row] * (1.0f / 1024.0f) + 1e-6f);
                    f32x4 v[2][2]; float q = 0.f;
#pragma unroll
                    for (int bj = 0; bj < 2; ++bj)
#pragma unroll
                        for (int n = 0; n < 2; ++n) { v[bj][n] = acc[ai][bj][m][n] * rs + bv[bj][n]; q += (v[bj][n][0] * v[bj][n][0] + v[bj][n][1] * v[bj][n][1]) + (v[bj][n][2] * v[bj][n][2] + v[bj][n][3] * v[bj][n][3]); }
                    q += __shfl_xor(q, 16); q += __shfl_xor(q, 32);
                    const float r = rsqrtf(q * (1.0f / 64.0f) + 1e-6f);
#pragma unroll
                    for (int bj = 0; bj < 2; ++bj) {
                        const int pos = bj == 0 ? (t >> 6) : (t & 63);
                        const f32x4 x1 = v[bj][0] * r * gn[bj][0], x2 = v[bj][1] * r * gn[bj][1];
                        const float* rp = rope + (pos * 16 + 4 * fq) * 2;
                        const f32x4 cs0 = *(const f32x4*)(rp), cs1 = *(const f32x4*)(rp + 4);
                        const float c[4] = {cs0[0], cs0[2], cs1[0], cs1[2]}, sn[4] = {cs0[1], cs0[3], cs1[1], cs1[3]};
                        float o1[4], o2[4];
#pragma unroll
                        for (int i = 0; i < 4; ++i) { o1[i] = (x1[i] * c[i] - x2[i] * sn[i]) * osc; o2[i] = (x2[i] * c[i] + x1[i] * sn[i]) * osc; }
                        u32x4 w; w.x = cvt_pk_bf16(o1[0], o1[1]); w.y = cvt_pk_bf16(o1[2], o1[3]); w.z = cvt_pk_bf16(o2[0], o2[1]); w.w = cvt_pk_bf16(o2[2], o2[3]);
                        *(u32x4*)(QK + (size_t)row * 512 + hh * 64 + 32 * bj + 8 * fq) = w;
                    }
                }
        }
    }
};
struct EpiResid {
    static constexpr bool PERM = false, AFTER_DRAIN = false;
    const float* xin_p; const float* xin_s; float* out; bf16_t* xn; float* ssn; const float* gate; const float* gvn;
    __device__ __forceinline__ void operator()(const f32x4 (&acc)[2][2][4][2], const Unit& u, int wr, int wc, int fr, int fq) const {
        const int rowt = u.pm * BM; const int s = seq_of_row(rowt);
        const float* xb = rowt < 16384 ? xin_p : xin_s - (size_t)16384 * DM;
        const int row0 = rowt + wr * 64 + fr; const int col0 = u.pn * BM + wc * 32 + 4 * fq;
        f32x4 gt[2][2], gv[2][2];
#pragma unroll
        for (int bj = 0; bj < 2; ++bj)
#pragma unroll
            for (int n = 0; n < 2; ++n) { gt[bj][n] = *(const f32x4*)(gate + (size_t)s * DM + col0 + bj * HALF + n * 16); gv[bj][n] = gvn ? *(const f32x4*)(gvn + (size_t)s * DM + col0 + bj * HALF + n * 16) : (f32x4){0.f, 0.f, 0.f, 0.f}; }
        f32x4 xo[2][2][2];
#define ER_LOAD(G, BUF) do { const unsigned off_ = (unsigned)(row0 + ((G) >> 2) * HALF + ((G) & 3) * 16) * DM + col0; \
            _Pragma("unroll") for (int bj = 0; bj < 2; ++bj) _Pragma("unroll") for (int n = 0; n < 2; ++n) xo[BUF][bj][n] = *(const f32x4*)(xb + off_ + bj * HALF + n * 16); } while (0)
        ER_LOAD(0, 0);
#pragma unroll
        for (int gi = 0; gi < 8; ++gi) {
            const int ai = gi >> 2, m = gi & 3;
            if (gi < 7) ER_LOAD(gi + 1, (gi + 1) & 1);
            asm volatile("" ::: "memory");
            const int row = row0 + ai * HALF + m * 16; const unsigned off = (unsigned)row * DM + col0; float q = 0.f;
#pragma unroll
            for (int bj = 0; bj < 2; ++bj)
#pragma unroll
                for (int n = 0; n < 2; ++n) {
                    const f32x4 val = xo[gi & 1][bj][n] + gt[bj][n] * acc[ai][bj][m][n];
                    *(f32x4*)(out + off + bj * HALF + n * 16) = val;
                    if (gvn) {
                        q += (val[0] * val[0] + val[1] * val[1]) + (val[2] * val[2] + val[3] * val[3]);
                        const f32x4 o = val * gv[bj][n]; unsigned long long w = (unsigned long long)cvt_pk_bf16(o[0], o[1]) | ((unsigned long long)cvt_pk_bf16(o[2], o[3]) << 32);
                        *(unsigned long long*)(xn + off + bj * HALF + n * 16) = w;
                    }
                }
            if (gvn) { q += __shfl_xor(q, 16); q += __shfl_xor(q, 32); if (fq == 0) atomicAdd(ssn + row, q); }
        }
#undef ER_LOAD
    }
};
}

template <int MAP> __device__ __forceinline__ void transpose_item(const float* W, int K, int N, bf16* WT, float* scr, int item, int lane) {
    const int nblk = N / 32, kb = item / nblk, nb = item % nblk, k0 = 64 * kb, n0 = 32 * nb;
#pragma unroll 8
    for (int i = 0; i < 32; ++i) { const int kk = 2 * i + (lane >> 5); scr[kk * 33 + (lane & 31)] = W[(size_t)(k0 + kk) * N + n0 + (lane & 31)]; }
    __builtin_amdgcn_wave_barrier(); asm volatile("s_waitcnt lgkmcnt(0)" ::: "memory");
    const int c = lane & 7;
#pragma unroll
    for (int j = 0; j < 4; ++j) { const int n = (lane >> 3) + 8 * j; const float* sp = scr + (8 * c) * 33 + n;
        u32x4_t o; o.x = pk2(sp[0 * 33], sp[1 * 33]); o.y = pk2(sp[2 * 33], sp[3 * 33]); o.z = pk2(sp[4 * 33], sp[5 * 33]); o.w = pk2(sp[6 * 33], sp[7 * 33]);
        const int nsrc = n0 + n; const int nd = MAP == 1 ? map_ffn(nsrc) : (MAP == 2 ? map_mix(nsrc) : nsrc);
        *(u32x4_t*)(WT + (size_t)nd * K + k0 + 8 * c) = o; }
    __builtin_amdgcn_wave_barrier(); asm volatile("s_waitcnt lgkmcnt(0)" ::: "memory");
}

template <int MODE, int MAP> __device__ __forceinline__ void smallm_unit(const KP& p, float* sA, int l, int j, const float* W, int ldw, int nvalid, float* dest, int ldd, int nchunk, int kchunk) {
    int tid_o = threadIdx.x; asm volatile("" : "+v"(tid_o)); const int tid = tid_o; const int k0 = kchunk * 128;
    __syncthreads();
    for (int e = tid; e < 128 * NSEQ; e += NTHR) {
        const int k = e / NSEQ, s = e % NSEQ; float v;
        if (MODE == 0) { const float c = s < 4 ? p.in[2][s * DM + k0 + k] : p.in[3][(s - 4) * DM + k0 + k]; v = c * sigmoidf_(c); }
        else { const float* mod = (const float*)(p.ws + OFF_MOD) + ((size_t)l * NSEQ + s) * 9216 + 3 * j * 1024 + k0 + k; v = *mod + p.in[5][l * 9216 + 3 * j * 1024 + k0 + k]; }
        sA[k * NSEQ + s] = v;
    }
    __syncthreads();
    const int n = nchunk * 256 + (tid & 255), kh = tid >> 8;
    float acc[NSEQ];
#pragma unroll
    for (int s = 0; s < NSEQ; ++s) acc[s] = 0.f;
    if (n < nvalid) {
        for (int kb = 0; kb < 64; kb += 16) {
            float wv[16];
#pragma unroll
            for (int u = 0; u < 16; ++u) wv[u] = W[(size_t)(k0 + kh * 64 + kb + u) * ldw + n];
#pragma unroll
            for (int u = 0; u < 16; ++u) { const int k = kh * 64 + kb + u; const float w = wv[u];
                const f32x4_t* ap = (const f32x4_t*)(sA + k * NSEQ);
#pragma unroll
                for (int q = 0; q < 5; ++q) { const f32x4_t a = ap[q]; acc[4 * q] += a[0] * w; acc[4 * q + 1] += a[1] * w; acc[4 * q + 2] += a[2] * w; acc[4 * q + 3] += a[3] * w; } }
        }
        const int nd = MAP == 1 ? map_ffn(n) : (MAP == 2 ? map_mix(n) : n);
#pragma unroll
        for (int s = 0; s < NSEQ; ++s) atomicAdd(dest + (size_t)s * ldd + nd, acc[s]);
    }
}

#define DPP_FMAC(acc, x, s, J) asm volatile("v_fmac_f32_dpp %0, %1, %2 row_newbcast:" #J " row_mask:0xf bank_mask:0xf" : "+v"(acc) : "v"(x), "v"(s))
#define DPP_FMAC_N(acc, x, s, J) asm volatile("s_nop 1\n\tv_fmac_f32_dpp %0, %1, %2 row_newbcast:" #J " row_mask:0xf bank_mask:0xf" : "+v"(acc) : "v"(x), "v"(s))
#define DPP_MUL(s, x, J) asm volatile("v_mul_f32_dpp %0, %1, %0 row_newbcast:" #J " row_mask:0xf bank_mask:0xf" : "+v"(s) : "v"(x))
#define DPP_MUL_N(s, x, J) asm volatile("s_nop 1\n\tv_mul_f32_dpp %0, %1, %0 row_newbcast:" #J " row_mask:0xf bank_mask:0xf" : "+v"(s) : "v"(x))
#define REP15(M, X) M(1, X) M(2, X) M(3, X) M(4, X) M(5, X) M(6, X) M(7, X) M(8, X) M(9, X) M(10, X) M(11, X) M(12, X) M(13, X) M(14, X) M(15, X)
__device__ __forceinline__ float row4_sum(float x) {
    auto r1 = __builtin_amdgcn_permlane16_swap(__float_as_uint(x), __float_as_uint(x), false, false); x = __uint_as_float(r1[0]) + __uint_as_float(r1[1]);
    auto r2 = __builtin_amdgcn_permlane32_swap(__float_as_uint(x), __float_as_uint(x), false, false); return __uint_as_float(r2[0]) + __uint_as_float(r2[1]);
}
__device__ __forceinline__ void rwkv_unit(const KP& p, unsigned char* lds, int l, int s, int h, int d, int mode) {
    int tid_o = threadIdx.x; asm volatile("" : "+v"(tid_o)); const int tid = tid_o, lane = tid & 63; const int wid = __builtin_amdgcn_readfirstlane(tid >> 6);
    constexpr int TB = 16;
    f32x2_t* W2 = (f32x2_t*)lds;
    float* OPS = (float*)(lds + 32768);
    float* YBUF = (float*)(lds + 32768 + 49152);
    float* PWS = (float*)(lds + 32768 + 49152 + 8192) + (wid & 3) * 1024;
    const bf16* Z = (const bf16*)(p.ws + OFF_Z);
    float* Y = (float*)(p.ws + (d == 0 ? OFF_YF : OFF_YB));
    const float* mu = p.in[18] + l * 1024;
    const float* w_up = p.in[19] + ((size_t)l * 2 + d) * 64 * 256;
    const float* a_up = p.in[21] + (size_t)l * 64 * 256;
    const int S = seq_len(s), start = seq_start(s); const int NS = mode == 0 ? S : S / 2, s0 = mode >= 2 ? S / 2 : 0; const int NB = NS / TB;
    __syncthreads();
    for (int e = tid; e < 4096; e += NTHR) { const int i = e >> 6, j = e & 63; W2[e] = (f32x2_t){w_up[i * 256 + 64 * h + j], a_up[i * 256 + 64 * h + j]}; }
    __syncthreads();
    if (wid >= 4) {
        const int pw = wid - 4;
        unsigned short* XWb = (unsigned short*)PWS; unsigned short* XAb = XWb + 256; float* KK = PWS + 256; float* UA = PWS + 512;
        typedef short bf16x8_t __attribute__((ext_vector_type(8)));
        bf16x8_t Bf[2][4][2];
        { const int kg = lane >> 4, cl = 64 * h + (lane & 15);
          _Pragma("unroll") for (int m = 0; m < 2; ++m) _Pragma("unroll") for (int ct = 0; ct < 4; ++ct) _Pragma("unroll") for (int ks = 0; ks < 2; ++ks) {
              const float* Wm = (m == 0 ? w_up : a_up) + (size_t)(32 * ks + 8 * kg) * 256 + cl + 16 * ct; u32x4_t pq;
              pq.x = pk2(Wm[0], Wm[256]); pq.y = pk2(Wm[512], Wm[768]); pq.z = pk2(Wm[1024], Wm[1280]); pq.w = pk2(Wm[1536], Wm[1792]); Bf[m][ct][ks] = __builtin_bit_cast(bf16x8_t, pq); } }
        const float w0 = p.in[20][(l * 2 + d) * 256 + 64 * h + lane], a0 = p.in[22][(l * 2 + d) * 256 + 64 * h + lane];
        const float k_k = p.in[24][l * 256 + 64 * h + lane], k_a = p.in[25][l * 256 + 64 * h + lane];
        int it_t[3], it_zc[3], it_g[3], it_w[3]; f32x4_t mu0[3], mu1[3];
#pragma unroll
        for (int i = 0; i < 3; ++i) { int e = lane + 64 * i; if (e > 159) e = 159; const int t = e / 40, c = e % 40, g = c >> 3, wi = (c & 7) * 8;
            it_t[i] = t; it_g[i] = g; it_w[i] = wi; it_zc[i] = (g == 0 ? 64 * h : g == 1 ? 256 + 64 * h : g == 2 ? 512 + 64 * h : 768 + (g - 3) * 64) + wi;
            mu0[i] = *(const f32x4_t*)(mu + it_zc[i]); mu1[i] = *(const f32x4_t*)(mu + it_zc[i] + 4); }
        u32x4_t rc[3], rp[3], rn[3];
#define RW_ISSUE(b_) do { _Pragma("unroll") for (int i = 0; i < 3; ++i) { const int si = s0 + (b_) * TB + 4 * pw + it_t[i]; const int tt = d == 0 ? si : S - 1 - si; const bf16* zp = Z + (size_t)(start + tt) * ZP + 768 + it_zc[i]; \
                rc[i] = *(const u32x4_t*)zp; rp[i] = tt > 0 ? *(const u32x4_t*)(zp - ZP) : (u32x4_t){0u, 0u, 0u, 0u}; rn[i] = tt < S - 1 ? *(const u32x4_t*)(zp + ZP) : (u32x4_t){0u, 0u, 0u, 0u}; } } while (0)
#define RW_PREP(b_) do { \
            float* ops = OPS + ((b_) & 1) * (TB * 384); \
            _Pragma("unroll") for (int i = 0; i < 3; ++i) if (lane + 64 * i < 160) { \
                float fs[8]; \
                _Pragma("unroll") for (int q = 0; q < 4; ++q) { \
                    const float c0 = __builtin_bit_cast(float, rc[i][q] << 16), c1 = __builtin_bit_cast(float, rc[i][q] & 0xffff0000u); \
                    const float p0 = __builtin_bit_cast(float, rp[i][q] << 16), p1 = __builtin_bit_cast(float, rp[i][q] & 0xffff0000u); \
                    const float n0 = __builtin_bit_cast(float, rn[i][q] << 16), n1 = __builtin_bit_cast(float, rn[i][q] & 0xffff0000u); \
                    const float m0 = q < 2 ? mu0[i][2 * q] : mu1[i][2 * q - 4], m1 = q < 2 ? mu0[i][2 * q + 1] : mu1[i][2 * q - 3]; \
                    fs[2 * q] = c0 + m0 * (0.5f * (p0 + n0) - c0); fs[2 * q + 1] = c1 + m1 * (0.5f * (p1 + n1) - c1); \
                } \
                const int t = it_t[i], tl = 4 * pw + t, g = it_g[i], wi = it_w[i]; \
                if (g == 0) { *(f32x4_t*)(ops + tl * 384 + 256 + wi) = (f32x4_t){fs[0], fs[1], fs[2], fs[3]}; *(f32x4_t*)(ops + tl * 384 + 256 + wi + 4) = (f32x4_t){fs[4], fs[5], fs[6], fs[7]}; } \
                else if (g == 2) { if (mode == 3) { _Pragma("unroll") for (int q = 0; q < 8; ++q) fs[q] = 0.f; } *(f32x4_t*)(ops + tl * 384 + 320 + wi) = (f32x4_t){fs[0], fs[1], fs[2], fs[3]}; *(f32x4_t*)(ops + tl * 384 + 320 + wi + 4) = (f32x4_t){fs[4], fs[5], fs[6], fs[7]}; } \
                else if (g == 1) { *(f32x4_t*)(KK + t * 64 + wi) = (f32x4_t){fs[0], fs[1], fs[2], fs[3]}; *(f32x4_t*)(KK + t * 64 + wi + 4) = (f32x4_t){fs[4], fs[5], fs[6], fs[7]}; } \
                else if (g == 3) { u32x4_t pq; pq.x = pk2(tanh_fast(fs[0]), tanh_fast(fs[1])); pq.y = pk2(tanh_fast(fs[2]), tanh_fast(fs[3])); pq.z = pk2(tanh_fast(fs[4]), tanh_fast(fs[5])); pq.w = pk2(tanh_fast(fs[6]), tanh_fast(fs[7])); *(u32x4_t*)(XWb + t * 64 + wi) = pq; } \
                else { u32x4_t pq; pq.x = pk2(fs[0], fs[1]); pq.y = pk2(fs[2], fs[3]); pq.z = pk2(fs[4], fs[5]); pq.w = pk2(fs[6], fs[7]); *(u32x4_t*)(XAb + t * 64 + wi) = pq; } \
            } \
            if ((b_) + 1 < NB) RW_ISSUE((b_) + 1); \
            { const int arow = lane & 15, akg = lane >> 4; \
              _Pragma("unroll") for (int m = 0; m < 2; ++m) { \
                bf16x8_t Af[2]; \
                _Pragma("unroll") for (int ks = 0; ks < 2; ++ks) { u32x4_t raw = *(const u32x4_t*)((m ? XAb : XWb) + (arow & 3) * 64 + 32 * ks + 8 * akg); if (arow >= 4) raw = (u32x4_t){0u, 0u, 0u, 0u}; Af[ks] = __builtin_bit_cast(bf16x8_t, raw); } \
                _Pragma("unroll") for (int ct = 0; ct < 4; ++ct) { f32x4_t am = (f32x4_t){0.f, 0.f, 0.f, 0.f}; \
                    am = __builtin_amdgcn_mfma_f32_16x16x32_bf16(Af[0], Bf[m][ct][0], am, 0, 0, 0); am = __builtin_amdgcn_mfma_f32_16x16x32_bf16(Af[1], Bf[m][ct][1], am, 0, 0, 0); \
                    if (lane < 16) { UA[(m * 4 + 0) * 64 + 16 * ct + lane] = am[0]; UA[(m * 4 + 1) * 64 + 16 * ct + lane] = am[1]; UA[(m * 4 + 2) * 64 + 16 * ct + lane] = am[2]; UA[(m * 4 + 3) * 64 + 16 * ct + lane] = am[3]; } } } } \
            float cw = 1.0f; \
            _Pragma("unroll") for (int t = 0; t < 4; ++t) { \
                const int tl = 4 * pw + t; const float k = KK[t * 64 + lane]; const float kkv = k * k_k; \
                const float n2 = wave_sum(kkv * kkv); const float kk = kkv * __builtin_amdgcn_rsqf(fmaxf(n2, 1e-24f)); \
                const float wdec = __expf(-0.6065306597126334f * sigmoidf_(w0 + UA[t * 64 + lane])); const float a = sigmoidf_(a0 + UA[(4 + t) * 64 + lane]); \
                float* o = ops + tl * 384 + lane; const float cwp = cw; cw *= wdec; const float icw = __builtin_amdgcn_rcpf(cw); const float rq = o[256]; \
                o[0] = -kk * cwp; o[64] = cw; o[128] = kk * a * icw; o[192] = k * (1.0f + (a - 1.0f) * k_a) * icw; o[256] = rq * cw; \
            } } while (0)
#define RW_YFLUSH(b_) do { const float* ybp = YBUF + ((b_) & 1) * (TB * 64); \
            _Pragma("unroll") for (int t = 0; t < 4; ++t) { const int si = s0 + (b_) * TB + 4 * pw + t; const int tt = d == 0 ? si : S - 1 - si; float* yp_ = Y + (size_t)(start + tt) * 256 + 64 * h; const float yv_ = ybp[(4 * pw + t) * 64 + lane]; \
                if (mode < 2) yp_[lane] = yv_; else ((unsigned short*)yp_)[(mode == 3 ? 64 : 0) + lane] = (unsigned short)f2bf(yv_); } } while (0)
        RW_ISSUE(0); RW_PREP(0);
        LDS_BARRIER();
        for (int b = 0; b < NB; ++b) {
            if (b > 0) RW_YFLUSH(b - 1);
            if (b + 1 < NB) RW_PREP(b + 1);
            LDS_BARRIER();
        }
        RW_YFLUSH(NB - 1);
#undef RW_ISSUE
#undef RW_PREP
#undef RW_YFLUSH
    } else {
        __builtin_amdgcn_s_setprio(3);
        float st[16];
#pragma unroll
        for (int i = 0; i < 16; ++i) st[i] = (mode == 3 && 16 * (lane >> 4) + i == 16 * wid + (lane & 15)) ? 1.0f : 0.f;
        const int vofs = 320 + 16 * wid + (lane & 15);
        LDS_BARRIER();
        for (int b = 0; b < NB; ++b) {
            const float* ops = OPS + (b & 1) * (TB * 384); float* yb = YBUF + (b & 1) * (TB * 64);
            float xn = ops[lane], xw = ops[64 + lane], xb = ops[128 + lane], xk = ops[192 + lane], xr = ops[256 + lane], vv = ops[vofs];
#pragma unroll 2
            for (int t = 0; t < TB; ++t) {
                const float* nx = ops + (t + 1 < TB ? t + 1 : t) * 384;
                const float nxn = nx[lane], nxw = nx[64 + lane], nxb = nx[128 + lane], nxk = nx[192 + lane], nxr = nx[256 + lane], nvv = nx[vofs];
                float sa0, sa1, sa2, sa3;
                asm volatile("v_mul_f32_dpp %0, %20, %4 row_newbcast:0 row_mask:0xf bank_mask:0xf\n\tv_mul_f32_dpp %1, %20, %5 row_newbcast:1 row_mask:0xf bank_mask:0xf\n\tv_mul_f32_dpp %2, %20, %6 row_newbcast:2 row_mask:0xf bank_mask:0xf\n\tv_mul_f32_dpp %3, %20, %7 row_newbcast:3 row_mask:0xf bank_mask:0xf\n\tv_fmac_f32_dpp %0, %20, %8 row_newbcast:4 row_mask:0xf bank_mask:0xf\n\tv_fmac_f32_dpp %1, %20, %9 row_newbcast:5 row_mask:0xf bank_mask:0xf\n\tv_fmac_f32_dpp %2, %20, %10 row_newbcast:6 row_mask:0xf bank_mask:0xf\n\tv_fmac_f32_dpp %3, %20, %11 row_newbcast:7 row_mask:0xf bank_mask:0xf\n\tv_fmac_f32_dpp %0, %20, %12 row_newbcast:8 row_mask:0xf bank_mask:0xf\n\tv_fmac_f32_dpp %1, %20, %13 row_newbcast:9 row_mask:0xf bank_mask:0xf\n\tv_fmac_f32_dpp %2, %20, %14 row_newbcast:10 row_mask:0xf bank_mask:0xf\n\tv_fmac_f32_dpp %3, %20, %15 row_newbcast:11 row_mask:0xf bank_mask:0xf\n\tv_fmac_f32_dpp %0, %20, %16 row_newbcast:12 row_mask:0xf bank_mask:0xf\n\tv_fmac_f32_dpp %1, %20, %17 row_newbcast:13 row_mask:0xf bank_mask:0xf\n\tv_fmac_f32_dpp %2, %20, %18 row_newbcast:14 row_mask:0xf bank_mask:0xf\n\tv_fmac_f32_dpp %3, %20, %19 row_newbcast:15 row_mask:0xf bank_mask:0xf" : "=&v"(sa0), "=&v"(sa1), "=&v"(sa2), "=&v"(sa3) : "v"(st[0]), "v"(st[1]), "v"(st[2]), "v"(st[3]), "v"(st[4]), "v"(st[5]), "v"(st[6]), "v"(st[7]), "v"(st[8]), "v"(st[9]), "v"(st[10]), "v"(st[11]), "v"(st[12]), "v"(st[13]), "v"(st[14]), "v"(st[15]), "v"(xn));
                float sa = (sa0 + sa1) + (sa2 + sa3);
                { const f32x4_t da = __builtin_amdgcn_mfma_f32_16x16x4f32(1.0f, sa, (f32x4_t){0.f, 0.f, 0.f, 0.f}, 0, 0, 0); sa = da[0]; asm volatile("s_nop 15\n\ts_nop 3" : "+v"(sa)); }
                asm volatile("v_fmac_f32_dpp %0, %16, %17 row_newbcast:0 row_mask:0xf bank_mask:0xf\n\tv_fmac_f32_dpp %1, %16, %17 row_newbcast:1 row_mask:0xf bank_mask:0xf\n\tv_fmac_f32_dpp %2, %16, %17 row_newbcast:2 row_mask:0xf bank_mask:0xf\n\tv_fmac_f32_dpp %3, %16, %17 row_newbcast:3 row_mask:0xf bank_mask:0xf\n\tv_fmac_f32_dpp %4, %16, %17 row_newbcast:4 row_mask:0xf bank_mask:0xf\n\tv_fmac_f32_dpp %5, %16, %17 row_newbcast:5 row_mask:0xf bank_mask:0xf\n\tv_fmac_f32_dpp %6, %16, %17 row_newbcast:6 row_mask:0xf bank_mask:0xf\n\tv_fmac_f32_dpp %7, %16, %17 row_newbcast:7 row_mask:0xf bank_mask:0xf\n\tv_fmac_f32_dpp %8, %16, %17 row_newbcast:8 row_mask:0xf bank_mask:0xf\n\tv_fmac_f32_dpp %9, %16, %17 row_newbcast:9 row_mask:0xf bank_mask:0xf\n\tv_fmac_f32_dpp %10, %16, %17 row_newbcast:10 row_mask:0xf bank_mask:0xf\n\tv_fmac_f32_dpp %11, %16, %17 row_newbcast:11 row_mask:0xf bank_mask:0xf\n\tv_fmac_f32_dpp %12, %16, %17 row_newbcast:12 row_mask:0xf bank_mask:0xf\n\tv_fmac_f32_dpp %13, %16, %17 row_newbcast:13 row_mask:0xf bank_mask:0xf\n\tv_fmac_f32_dpp %14, %16, %17 row_newbcast:14 row_mask:0xf bank_mask:0xf\n\tv_fmac_f32_dpp %15, %16, %17 row_newbcast:15 row_mask:0xf bank_mask:0xf" : "+v"(st[0]), "+v"(st[1]), "+v"(st[2]), "+v"(st[3]), "+v"(st[4]), "+v"(st[5]), "+v"(st[6]), "+v"(st[7]), "+v"(st[8]), "+v"(st[9]), "+v"(st[10]), "+v"(st[11]), "+v"(st[12]), "+v"(st[13]), "+v"(st[14]), "+v"(st[15]) : "v"(xb), "v"(sa));
                asm volatile("v_fmac_f32_dpp %0, %16, %17 row_newbcast:0 row_mask:0xf bank_mask:0xf\n\tv_fmac_f32_dpp %1, %16, %17 row_newbcast:1 row_mask:0xf bank_mask:0xf\n\tv_fmac_f32_dpp %2, %16, %17 row_newbcast:2 row_mask:0xf bank_mask:0xf\n\tv_fmac_f32_dpp %3, %16, %17 row_newbcast:3 row_mask:0xf bank_mask:0xf\n\tv_fmac_f32_dpp %4, %16, %17 row_newbcast:4 row_mask:0xf bank_mask:0xf\n\tv_fmac_f32_dpp %5, %16, %17 row_newbcast:5 row_mask:0xf bank_mask:0xf\n\tv_fmac_f32_dpp %6, %16, %17 row_newbcast:6 row_mask:0xf bank_mask:0xf\n\tv_fmac_f32_dpp %7, %16, %17 row_newbcast:7 row_mask:0xf bank_mask:0xf\n\tv_fmac_f32_dpp %8, %16, %17 row_newbcast:8 row_mask:0xf bank_mask:0xf\n\tv_fmac_f32_dpp %9, %16, %17 row_newbcast:9 row_mask:0xf bank_mask:0xf\n\tv_fmac_f32_dpp %10, %16, %17 row_newbcast:10 row_mask:0xf bank_mask:0xf\n\tv_fmac_f32_dpp %11, %16, %17 row_newbcast:11 row_mask:0xf bank_mask:0xf\n\tv_fmac_f32_dpp %12, %16, %17 row_newbcast:12 row_mask:0xf bank_mask:0xf\n\tv_fmac_f32_dpp %13, %16, %17 row_newbcast:13 row_mask:0xf bank_mask:0xf\n\tv_fmac_f32_dpp %14, %16, %17 row_newbcast:14 row_mask:0xf bank_mask:0xf\n\tv_fmac_f32_dpp %15, %16, %17 row_newbcast:15 row_mask:0xf bank_mask:0xf" : "+v"(st[0]), "+v"(st[1]), "+v"(st[2]), "+v"(st[3]), "+v"(st[4]), "+v"(st[5]), "+v"(st[6]), "+v"(st[7]), "+v"(st[8]), "+v"(st[9]), "+v"(st[10]), "+v"(st[11]), "+v"(st[12]), "+v"(st[13]), "+v"(st[14]), "+v"(st[15]) : "v"(xk), "v"(vv));
                float y0, y1, y2, y3;
                asm volatile("v_mul_f32_dpp %0, %20, %4 row_newbcast:0 row_mask:0xf bank_mask:0xf\n\tv_mul_f32_dpp %1, %20, %5 row_newbcast:1 row_mask:0xf bank_mask:0xf\n\tv_mul_f32_dpp %2, %20, %6 row_newbcast:2 row_mask:0xf bank_mask:0xf\n\tv_mul_f32_dpp %3, %20, %7 row_newbcast:3 row_mask:0xf bank_mask:0xf\n\tv_fmac_f32_dpp %0, %20, %8 row_newbcast:4 row_mask:0xf bank_mask:0xf\n\tv_fmac_f32_dpp %1, %20, %9 row_newbcast:5 row_mask:0xf bank_mask:0xf\n\tv_fmac_f32_dpp %2, %20, %10 row_newbcast:6 row_mask:0xf bank_mask:0xf\n\tv_fmac_f32_dpp %3, %20, %11 row_newbcast:7 row_mask:0xf bank_mask:0xf\n\tv_fmac_f32_dpp %0, %20, %12 row_newbcast:8 row_mask:0xf bank_mask:0xf\n\tv_fmac_f32_dpp %1, %20, %13 row_newbcast:9 row_mask:0xf bank_mask:0xf\n\tv_fmac_f32_dpp %2, %20, %14 row_newbcast:10 row_mask:0xf bank_mask:0xf\n\tv_fmac_f32_dpp %3, %20, %15 row_newbcast:11 row_mask:0xf bank_mask:0xf\n\tv_fmac_f32_dpp %0, %20, %16 row_newbcast:12 row_mask:0xf bank_mask:0xf\n\tv_fmac_f32_dpp %1, %20, %17 row_newbcast:13 row_mask:0xf bank_mask:0xf\n\tv_fmac_f32_dpp %2, %20, %18 row_newbcast:14 row_mask:0xf bank_mask:0xf\n\tv_fmac_f32_dpp %3, %20, %19 row_newbcast:15 row_mask:0xf bank_mask:0xf" : "=&v"(y0), "=&v"(y1), "=&v"(y2), "=&v"(y3) : "v"(st[0]), "v"(st[1]), "v"(st[2]), "v"(st[3]), "v"(st[4]), "v"(st[5]), "v"(st[6]), "v"(st[7]), "v"(st[8]), "v"(st[9]), "v"(st[10]), "v"(st[11]), "v"(st[12]), "v"(st[13]), "v"(st[14]), "v"(st[15]), "v"(xr));
                const float yp = (y0 + y1) + (y2 + y3);
                const f32x4_t dy = __builtin_amdgcn_mfma_f32_16x16x4f32(1.0f, yp, (f32x4_t){0.f, 0.f, 0.f, 0.f}, 0, 0, 0);
                if (lane < 16) yb[t * 64 + 16 * wid + lane] = dy[0];
                if ((t & 3) == 3) {
                    asm volatile("v_mul_f32_dpp %0, %16, %0 row_newbcast:0 row_mask:0xf bank_mask:0xf\n\tv_mul_f32_dpp %1, %16, %1 row_newbcast:1 row_mask:0xf bank_mask:0xf\n\tv_mul_f32_dpp %2, %16, %2 row_newbcast:2 row_mask:0xf bank_mask:0xf\n\tv_mul_f32_dpp %3, %16, %3 row_newbcast:3 row_mask:0xf bank_mask:0xf\n\tv_mul_f32_dpp %4, %16, %4 row_newbcast:4 row_mask:0xf bank_mask:0xf\n\tv_mul_f32_dpp %5, %16, %5 row_newbcast:5 row_mask:0xf bank_mask:0xf\n\tv_mul_f32_dpp %6, %16, %6 row_newbcast:6 row_mask:0xf bank_mask:0xf\n\tv_mul_f32_dpp %7, %16, %7 row_newbcast:7 row_mask:0xf bank_mask:0xf\n\tv_mul_f32_dpp %8, %16, %8 row_newbcast:8 row_mask:0xf bank_mask:0xf\n\tv_mul_f32_dpp %9, %16, %9 row_newbcast:9 row_mask:0xf bank_mask:0xf\n\tv_mul_f32_dpp %10, %16, %10 row_newbcast:10 row_mask:0xf bank_mask:0xf\n\tv_mul_f32_dpp %11, %16, %11 row_newbcast:11 row_mask:0xf bank_mask:0xf\n\tv_mul_f32_dpp %12, %16, %12 row_newbcast:12 row_mask:0xf bank_mask:0xf\n\tv_mul_f32_dpp %13, %16, %13 row_newbcast:13 row_mask:0xf bank_mask:0xf\n\tv_mul_f32_dpp %14, %16, %14 row_newbcast:14 row_mask:0xf bank_mask:0xf\n\tv_mul_f32_dpp %15, %16, %15 row_newbcast:15 row_mask:0xf bank_mask:0xf" : "+v"(st[0]), "+v"(st[1]), "+v"(st[2]), "+v"(st[3]), "+v"(st[4]), "+v"(st[5]), "+v"(st[6]), "+v"(st[7]), "+v"(st[8]), "+v"(st[9]), "+v"(st[10]), "+v"(st[11]), "+v"(st[12]), "+v"(st[13]), "+v"(st[14]), "+v"(st[15]) : "v"(xw));
                }
                xn = nxn; xw = nxw; xb = nxb; xk = nxk; xr = nxr; vv = nvv;
            }
            LDS_BARRIER();
        }
        __builtin_amdgcn_s_setprio(0);
        if (mode == 1) { float* sm = (float*)(p.ws + OFF_SMID) + (size_t)((s * 4 + h) * 2 + d) * 4096 + 16 * wid + (lane & 15);
#pragma unroll
            for (int i = 0; i < 16; ++i) sm[(16 * (lane >> 4) + i) * 64] = st[i]; }
    }
}

__device__ __forceinline__ float gelu_tanh(float x) { const float u = 0.7978845608028654f * (x + 0.044715f * x * x * x); return x * __builtin_amdgcn_rcpf(1.0f + __builtin_amdgcn_exp2f(-2.885390081777927f * u)); }
__device__ __forceinline__ float neg_expm1_fast(float t) { const float ser = -t * (1.0f + t * (0.5f + t * (0.16666667f + t * (0.041666668f + t * 0.0083333338f)))); return t > -0.25f ? ser : 1.0f - __expf(t); }

__device__ __forceinline__ void lru_unit(const KP& p, unsigned char* lds, int l, int s, int n) {
    typedef short bf16x8_t __attribute__((ext_vector_type(8)));
    typedef float f32x16_t __attribute__((ext_vector_type(16)));
    int tid_o = threadIdx.x; asm volatile("" : "+v"(tid_o)); const int tid = tid_o, lane = tid & 63; const int wid = __builtin_amdgcn_readfirstlane(tid >> 6);
    float* XC = (float*)lds;
    unsigned short* XCb = (unsigned short*)(lds + 16384);
    float* GG = (float*)(lds + 24576);
    float* HF = (float*)(lds + 57344);
    float* YG = (float*)(lds + 73728);
    float* HO = (float*)(lds + 90112);
    float* SEG = (float*)(lds + 106496);
    const bf16* Z = (const bf16*)(p.ws + OFF_Z);
    bf16* OM = (bf16*)(p.ws + OFF_OMIX);
    const int S = seq_len(s), start = seq_start(s); const int NB = S / 64;
    const int t_ = tid >> 3, c8 = (tid & 7) * 8;
    const int r32 = lane & 31, hi = lane >> 5; const int gm = wid & 1, gth = (wid >> 1) & 1, gch = wid >> 2;
    f32x4_t cw0[4], cw1[4];
#pragma unroll
    for (int j = 0; j < 4; ++j) { cw0[j] = *(const f32x4_t*)(p.in[11] + l * 4 * 384 + j * 384 + 64 * n + c8); cw1[j] = *(const f32x4_t*)(p.in[11] + l * 4 * 384 + j * 384 + 64 * n + c8 + 4); }
    const f32x4_t cb0 = *(const f32x4_t*)(p.in[12] + l * 384 + 64 * n + c8), cb1 = *(const f32x4_t*)(p.in[12] + l * 384 + 64 * n + c8 + 4);
    for (int d = 0; d < 2; ++d) {
        const float* wg = (gm == 0 ? p.in[13] : p.in[15]) + (((size_t)l * 2 + d) * 6 + n) * 4096;
        const float gbias = (gm == 0 ? p.in[14] : p.in[16])[(l * 2 + d) * 384 + 64 * n + 32 * gch + r32];
        const float lm = -p.in[17][(l * 2 + d) * 384 + 64 * n + lane]; const float sp8 = -8.0f * (lm > 20.f ? lm : log1pf(__expf(lm)));
        bf16x8_t Bf[4];
#pragma unroll
        for (int ks = 0; ks < 4; ++ks) { const float* wp = wg + (size_t)(16 * ks + 8 * hi) * 64 + 32 * gch + r32; u32x4_t pq;
            pq.x = pk2(wp[0], wp[64]); pq.y = pk2(wp[128], wp[192]); pq.z = pk2(wp[256], wp[320]); pq.w = pk2(wp[384], wp[448]); Bf[ks] = __builtin_bit_cast(bf16x8_t, pq); }
        __threadfence();
        __syncthreads();
        float hcarry = 0.f;
        u32x4_t rr[4], rh, ry;
#define LRU_ISSUE(blk_) do { const int tt = d == 0 ? (blk_) * 64 + t_ : S - 1 - ((blk_) * 64 + t_); \
            _Pragma("unroll") for (int j = 0; j < 4; ++j) { const int t2 = tt - 2 + j; rr[j] = (t2 >= 0 && t2 < S) ? *(const u32x4_t*)(Z + (size_t)(start + t2) * ZP + 64 * n + c8) : (u32x4_t){0u, 0u, 0u, 0u}; } \
            if (d == 1) { rh = *(const u32x4_t*)(OM + (size_t)(start + tt) * DM + 64 * n + c8); ry = *(const u32x4_t*)(Z + (size_t)(start + tt) * ZP + 384 + 64 * n + c8); } } while (0)
        LRU_ISSUE(0);
        for (int blk = 0; blk < NB; ++blk) {
            LDS_BARRIER();
            {
                f32x4_t x0 = cb0, x1 = cb1;
#pragma unroll
                for (int j = 0; j < 4; ++j) {
                    const f32x4_t a = (f32x4_t){__builtin_bit_cast(float, rr[j][0] << 16), __builtin_bit_cast(float, rr[j][0] & 0xffff0000u), __builtin_bit_cast(float, rr[j][1] << 16), __builtin_bit_cast(float, rr[j][1] & 0xffff0000u)};
                    const f32x4_t b = (f32x4_t){__builtin_bit_cast(float, rr[j][2] << 16), __builtin_bit_cast(float, rr[j][2] & 0xffff0000u), __builtin_bit_cast(float, rr[j][3] << 16), __builtin_bit_cast(float, rr[j][3] & 0xffff0000u)};
                    x0 += cw0[j] * a; x1 += cw1[j] * b;
                }
                *(f32x4_t*)(XC + t_ * 64 + c8) = x0; *(f32x4_t*)(XC + t_ * 64 + c8 + 4) = x1;
                { u32x4_t pq; pq.x = pk2(x0[0], x0[1]); pq.y = pk2(x0[2], x0[3]); pq.z = pk2(x1[0], x1[1]); pq.w = pk2(x1[2], x1[3]); *(u32x4_t*)(XCb + t_ * 64 + c8) = pq; }
                if (d == 1) {
                    float hf[8], yg[8];
#pragma unroll
                    for (int q = 0; q < 4; ++q) { hf[2 * q] = __builtin_bit_cast(float, rh[q] << 16); hf[2 * q + 1] = __builtin_bit_cast(float, rh[q] & 0xffff0000u);
                        yg[2 * q] = gelu_tanh(__builtin_bit_cast(float, ry[q] << 16)); yg[2 * q + 1] = gelu_tanh(__builtin_bit_cast(float, ry[q] & 0xffff0000u)); }
                    *(f32x4_t*)(HF + t_ * 64 + c8) = (f32x4_t){hf[0], hf[1], hf[2], hf[3]}; *(f32x4_t*)(HF + t_ * 64 + c8 + 4) = (f32x4_t){hf[4], hf[5], hf[6], hf[7]};
                    *(f32x4_t*)(YG + t_ * 64 + c8) = (f32x4_t){yg[0], yg[1], yg[2], yg[3]}; *(f32x4_t*)(YG + t_ * 64 + c8 + 4) = (f32x4_t){yg[4], yg[5], yg[6], yg[7]};
                }
                if (blk + 1 < NB) LRU_ISSUE(blk + 1);
            }
            LDS_BARRIER();
            {
                f32x16_t acc = {};
#pragma unroll
                for (int ks = 0; ks < 4; ++ks) { const bf16x8_t af = *(const bf16x8_t*)(XCb + (32 * gth + r32) * 64 + 16 * ks + 8 * hi); acc = __builtin_amdgcn_mfma_f32_32x32x16_bf16(af, Bf[ks], acc, 0, 0, 0); }
#pragma unroll
                for (int r = 0; r < 16; ++r) { const int trow = 32 * gth + (r & 3) + 8 * (r >> 2) + 4 * hi; GG[(gm * 64 + trow) * 64 + 32 * gch + r32] = sigmoidf_(acc[r] + gbias); }
            }
            LDS_BARRIER();
            float Pp[8], hl[8];
            {
                float pp = 1.f, hh = 0.f;
#pragma unroll
                for (int q = 0; q < 8; ++q) { const int t = 8 * wid + q; const float ra = GG[t * 64 + lane], ix = GG[(64 + t) * 64 + lane], xc = XC[t * 64 + lane];
                    const float la = sp8 * ra; const float a = __expf(la); const float uu = __builtin_amdgcn_sqrtf(fmaxf(neg_expm1_fast(2.0f * la), 0.f)) * ix * xc;
                    pp *= a; hh = a * hh + uu; Pp[q] = pp; hl[q] = hh; }
                SEG[(wid * 2) * 64 + lane] = pp; SEG[(wid * 2 + 1) * 64 + lane] = hh;
            }
            LDS_BARRIER();
            {
                float sa[8], sh[8];
#pragma unroll
                for (int w = 0; w < 8; ++w) { sa[w] = SEG[(w * 2) * 64 + lane]; sh[w] = SEG[(w * 2 + 1) * 64 + lane]; }
                float carry = hcarry, mine = 0.f;
#pragma unroll
                for (int w = 0; w < 8; ++w) { if (w == wid) mine = carry; carry = sa[w] * carry + sh[w]; }
                hcarry = carry;
#pragma unroll
                for (int q = 0; q < 8; ++q) { const int t = 8 * wid + q; const float hv = Pp[q] * mine + hl[q]; HO[t * 64 + lane] = d == 0 ? hv : (HF[t * 64 + lane] + hv) * YG[t * 64 + lane]; }
            }
            LDS_BARRIER();
            {   const int tt = d == 0 ? blk * 64 + t_ : S - 1 - (blk * 64 + t_);
                const f32x4_t a = *(const f32x4_t*)(HO + t_ * 64 + c8), b = *(const f32x4_t*)(HO + t_ * 64 + c8 + 4);
                u32x4_t w; w.x = pk2(a[0], a[1]); w.y = pk2(a[2], a[3]); w.z = pk2(b[0], b[1]); w.w = pk2(b[2], b[3]);
                *(u32x4_t*)(OM + (size_t)(start + tt) * DM + 64 * n + c8) = w; }
        }
#undef LRU_ISSUE
    }
}

__device__ __forceinline__ void rwkv_post_tile(const KP& p, unsigned char* lds, int l, int tile) {
    int tid_o = threadIdx.x; asm volatile("" : "+v"(tid_o)); const int tid = tid_o, lane = tid & 63;
    float* SG = (float*)lds;
    float* GO = SG + 4096;
    const bf16* Z = (const bf16*)(p.ws + OFF_Z); bf16* OM = (bf16*)(p.ws + OFF_OMIX);
    const float* YF = (const float*)(p.ws + OFF_YF); const float* YBk = (const float*)(p.ws + OFF_YB);
    const float* mu = p.in[18] + l * 1024; const float* g_up = p.in[23] + (size_t)l * 128 * 256;
    const int m0 = tile * 32; const int s = seq_of_row(m0); const int S = seq_len(s), start = seq_start(s);
    __syncthreads();
    {   const float muc = mu[896 + (tid & 127)];
#pragma unroll 1
        for (int ih = 0; ih < 2; ++ih) {
            unsigned short zc_[4], zp_[4], zn_[4];
#pragma unroll
            for (int i = 0; i < 4; ++i) { const int e = tid + NTHR * (4 * ih + i); const int t = e >> 7, c = e & 127; const int m = m0 + t, tt = m - start; const bf16* zp = Z + (size_t)m * ZP + 768 + 896 + c;
                zc_[i] = zp[0]; zp_[i] = zp[tt > 0 ? -ZP : 0]; zn_[i] = zp[tt < S - 1 ? ZP : 0]; }
            asm volatile("" ::: "memory");
#pragma unroll
            for (int i = 0; i < 4; ++i) { const int e = tid + NTHR * (4 * ih + i); const int t = e >> 7; const int tt = m0 + t - start;
                const float f = bf2f(zc_[i]); const float pv = tt > 0 ? bf2f(zp_[i]) : 0.f; const float nx = tt < S - 1 ? bf2f(zn_[i]) : 0.f;
                SG[e] = sigmoidf_(f + muc * (0.5f * (pv + nx) - f)); }
        }
    }
    __syncthreads();
    const int c = tid & 255, tg = tid >> 8;
#pragma unroll 1
    for (int hf = 0; hf < 2; ++hf) {
        float acc[8];
#pragma unroll
        for (int t = 0; t < 8; ++t) acc[t] = 0.f;
#pragma unroll 1
        for (int ib = 0; ib < 128; ib += 16) {
            float wv[16];
#pragma unroll
            for (int u = 0; u < 16; ++u) wv[u] = g_up[(ib + u) * 256 + c];
#pragma unroll
            for (int u4 = 0; u4 < 16; u4 += 4) {
#pragma unroll
                for (int t = 0; t < 8; ++t) { const f32x4_t x = *(const f32x4_t*)(SG + (tg * 16 + hf * 8 + t) * 128 + ib + u4); acc[t] = fmaf(x[0], wv[u4], acc[t]); acc[t] = fmaf(x[1], wv[u4 + 1], acc[t]); acc[t] = fmaf(x[2], wv[u4 + 2], acc[t]); acc[t] = fmaf(x[3], wv[u4 + 3], acc[t]); } }
        }
#pragma unroll
        for (int t = 0; t < 8; ++t) GO[(tg * 16 + hf * 8 + t) * 256 + c] = acc[t];
    }
    const int dc = (s < 4) ? ((m0 - start) >= S / 2 ? 0 : 1) : -1;
    if (dc >= 0) {
        float* SM = (float*)(lds + 49152); unsigned short* YPs = (unsigned short*)(lds + 114688);
        const float* Ydc = dc == 0 ? YF : YBk; float* Yw = (float*)(p.ws + (dc == 0 ? OFF_YF : OFF_YB));
        for (int e = tid; e < 4096; e += NTHR) { const int hh = e >> 10, r4 = (e & 1023) * 4; *(f32x4_t*)(SM + hh * 4096 + r4) = *(const f32x4_t*)((const float*)(p.ws + OFF_SMID) + (size_t)((s * 4 + hh) * 2 + dc) * 4096 + r4); }
        for (int e = tid; e < 1024; e += NTHR) { const int t = e >> 5, hh = (e >> 3) & 3, ch = e & 7; *(u32x4_t*)(YPs + t * 256 + hh * 64 + ch * 8) = *(const u32x4_t*)((const unsigned short*)(Ydc + (size_t)(m0 + t) * 256 + 64 * hh) + 64 + ch * 8); }
        __syncthreads();
        const int hh = c >> 6, v = c & 63; const float* smp = SM + hh * 4096 + v;
#pragma unroll 1
        for (int t = 0; t < 16; ++t) {
            const int tk = tg * 16 + t; const size_t mrow = (size_t)(m0 + tk) * 256;
            float accv = bf2f(((const unsigned short*)(Ydc + mrow + 64 * hh))[v]);
#pragma unroll
            for (int i0 = 0; i0 < 64; i0 += 8) { const u32x4_t w = *(const u32x4_t*)(YPs + tk * 256 + hh * 64 + i0);
                accv += smp[(i0 + 0) * 64] * __builtin_bit_cast(float, w[0] << 16) + smp[(i0 + 1) * 64] * __builtin_bit_cast(float, w[0] & 0xffff0000u) + smp[(i0 + 2) * 64] * __builtin_bit_cast(float, w[1] << 16) + smp[(i0 + 3) * 64] * __builtin_bit_cast(float, w[1] & 0xffff0000u)
                      + smp[(i0 + 4) * 64] * __builtin_bit_cast(float, w[2] << 16) + smp[(i0 + 5) * 64] * __builtin_bit_cast(float, w[2] & 0xffff0000u) + smp[(i0 + 6) * 64] * __builtin_bit_cast(float, w[3] << 16) + smp[(i0 + 7) * 64] * __builtin_bit_cast(float, w[3] & 0xffff0000u); }
            Yw[mrow + c] = accv;
        }
        __threadfence();
        __syncthreads();
    }
    const float rk = p.in[26][l * 256 + c], lg = p.in[27][l * 256 + c], lb = p.in[28][l * 256 + c];
    const float mr = mu[c], mk = mu[256 + c], mv = mu[512 + c];
    unsigned short zc_[9]; float yc_[2];
#define PT_LOAD(T_, ZD, YD) do { const int m_ = m0 + tg * 16 + (T_), tt_ = m_ - start; const bf16* zp_ = Z + (size_t)m_ * ZP + 768 + c; const bf16* zpp_ = zp_ + (tt_ > 0 ? -ZP : 0); const bf16* zpn_ = zp_ + (tt_ < S - 1 ? ZP : 0); \
        _Pragma("unroll") for (int j = 0; j < 3; ++j) { ZD[3 * j] = zp_[256 * j]; ZD[3 * j + 1] = zpp_[256 * j]; ZD[3 * j + 2] = zpn_[256 * j]; } \
        YD[0] = YF[(size_t)m_ * 256 + c]; YD[1] = YBk[(size_t)m_ * 256 + c]; } while (0)
    PT_LOAD(0, zc_, yc_);
#pragma unroll 1
    for (int t = 0; t < 16; ++t) {
        unsigned short zn_[9]; float yn_[2];
        PT_LOAD((t < 15 ? t + 1 : 15), zn_, yn_);
        asm volatile("" ::: "memory");
        const int m = m0 + tg * 16 + t, tt = m - start;
        const bool hp = tt > 0, hn = tt < S - 1;
        float f = bf2f(zc_[0]), pv = hp ? bf2f(zc_[1]) : 0.f, nx = hn ? bf2f(zc_[2]) : 0.f; const float r = f + mr * (0.5f * (pv + nx) - f);
        f = bf2f(zc_[3]); pv = hp ? bf2f(zc_[4]) : 0.f; nx = hn ? bf2f(zc_[5]) : 0.f; const float k = f + mk * (0.5f * (pv + nx) - f);
        f = bf2f(zc_[6]); pv = hp ? bf2f(zc_[7]) : 0.f; nx = hn ? bf2f(zc_[8]) : 0.f; const float v = f + mv * (0.5f * (pv + nx) - f);
        const float y = yc_[0] + yc_[1];
#pragma unroll
        for (int j = 0; j < 9; ++j) zc_[j] = zn_[j];
        yc_[0] = yn_[0]; yc_[1] = yn_[1];
        const float mean = wave_sum(y) * (1.0f / 64.0f); const float dv = y - mean; const float var = wave_sum(dv * dv) * (1.0f / 64.0f);
        const float yn = dv * rsqrtf(var + 64e-5f) * lg + lb;
        const float bon = wave_sum(r * k * rk);
        const float outv = (yn + bon * v) * GO[(tg * 16 + t) * 256 + c];
        OM[(size_t)m * DM + 384 + c] = (bf16)f2bf(outv);
    }
#undef PT_LOAD
    (void)lane;
}

__global__ void __launch_bounds__(NTHR, 2) fwd_megakernel(KP p) {
    extern __shared__ __attribute__((aligned(16))) unsigned char lds[];
    cg::grid_group grid = cg::this_grid();
    const int tid = threadIdx.x, lane = tid & 63, wid = tid >> 6;
    const int G = gridDim.x, bx = blockIdx.x;
    const int gw = bx * 8 + wid, NGW = G * 8;
    unsigned char* ws = p.ws;
    volatile LAS int* misc = (volatile LAS int*)((LAS unsigned char*)lds + MISC_OFF);
    PG8_LAS unsigned char* ldsg = (PG8_LAS unsigned char*)lds;

    {
        float* scr = (float*)(lds + wid * 16384);
        for (int l = 0; l < 2; ++l) {
            unsigned char* wl = ws + OFF_W + l * W_LAYER;
            constexpr int I_IN = 16 * 176, I_OUT = 44 * 32, I_MI = 16 * 76, I_MO = 16 * 32, I_TOT = 2 * I_IN + 2 * I_OUT + I_MI + I_MO;
            for (int it = gw; it < I_TOT; it += NGW) {
                int r = it;
                if (r < 2 * I_IN) { const int f = r / I_IN; transpose_item<1>(p.in[7] + ((size_t)l * 2 + f) * DM * NFF, DM, NFF, (bf16*)(wl + WO_IN + f * 11 * MiB), scr, r % I_IN, lane); continue; } r -= 2 * I_IN;
                if (r < 2 * I_OUT) { const int f = r / I_OUT; transpose_item<0>(p.in[8] + ((size_t)l * 2 + f) * DFF * DM, DFF, DM, (bf16*)(wl + WO_OUT + f * (11 * MiB / 2)), scr, r % I_OUT, lane); continue; } r -= 2 * I_OUT;
                if (r < I_MI) { transpose_item<2>(p.in[9] + (size_t)l * DM * NMIX, DM, NMIX, (bf16*)(wl + WO_MI), scr, r, lane); continue; } r -= I_MI;
                transpose_item<0>(p.in[10] + (size_t)l * DM * DM, DM, DM, (bf16*)(wl + WO_MO), scr, r, lane);
            }
            u32x4_t* padp = (u32x4_t*)(wl + WO_MI + (size_t)NMIX * DM * 2);
            for (int e = bx * NTHR + tid; e < 128 * DM * 2 / 16; e += G * NTHR) padp[e] = (u32x4_t){0u, 0u, 0u, 0u};
        }
        __syncthreads();
        for (int u = bx; u < 2 * 36 * 8; u += G) { const int l = u / 288, r = u % 288;
            smallm_unit<0, 0>(p, (float*)lds, l, 0, p.in[4] + (size_t)l * DM * 9216, 9216, 9216, (float*)(ws + OFF_MOD) + (size_t)l * NSEQ * 9216, 9216, r / 8, r % 8); }
        if (bx == 0) { float* rope = (float*)(ws + OFF_ROPE);
            for (int e = tid; e < 1024; e += NTHR) { const int pos = e >> 4, pp = e & 15; const float inv = exp2f(-(float)pp * (13.287712379549449f / 16.0f)); const float a = (float)pos * inv; const float kr = rintf(a * 0.15915494309189535f); float rr = fmaf(-kr, 6.2831854820251465f, a); rr = fmaf(-kr, -1.7484555e-7f, rr); rope[2 * e] = __cosf(rr); rope[2 * e + 1] = __sinf(rr); } }
    }
    grid.sync();
    {
        const float* MOD = (const float*)(ws + OFF_MOD); float* GV = (float*)(ws + OFF_GV); float* GT = (float*)(ws + OFF_GATE);
        for (int e = bx * NTHR + tid; e < 6 * NSEQ * DM; e += G * NTHR) {
            const int c = e & 1023, s = (e >> 10) % NSEQ, inst = e / (NSEQ * DM); const int l = inst / 3, j = inst % 3;
            const float* mr = MOD + ((size_t)l * NSEQ + s) * 9216; const float* ba = p.in[5] + l * 9216;
            const float sc = mr[(3 * j + 1) * 1024 + c] + ba[(3 * j + 1) * 1024 + c], gg = mr[(3 * j + 2) * 1024 + c] + ba[(3 * j + 2) * 1024 + c];
            GV[e] = p.in[6][(l * 3 + j) * DM + c] * (1.0f + sc); GT[e] = (j == 1 ? 1.0f : 0.5f) * gg;
        }
        for (int u = bx; u < 2 * 432; u += G) { const int l = u / 432, r = u % 432; float* bdst = (float*)(ws + OFF_BIAS);
            if (r < 176) smallm_unit<1, 1>(p, (float*)lds, l, 0, p.in[7] + ((size_t)l * 2 + 0) * DM * NFF, NFF, NFF, bdst + (size_t)(l * 3 + 0) * NSEQ * NFF, NFF, r / 8, r % 8);
            else if (r < 256) smallm_unit<1, 2>(p, (float*)lds, l, 1, p.in[9] + (size_t)l * DM * NMIX, NMIX, NMIX, bdst + (size_t)(l * 3 + 1) * NSEQ * NFF, NFF, (r - 176) / 8, (r - 176) % 8);
            else smallm_unit<1, 1>(p, (float*)lds, l, 2, p.in[7] + ((size_t)l * 2 + 1) * DM * NFF, NFF, NFF, bdst + (size_t)(l * 3 + 2) * NSEQ * NFF, NFF, (r - 256) / 8, (r - 256) % 8); }
        bf16* XN = (bf16*)(ws + OFF_XN); float* SS0 = (float*)(ws + OFF_SS);
        for (int m = gw; m < MTOK; m += NGW) {
            const int s = seq_of_row(m); const float* xr = m < 16384 ? p.in[0] + (size_t)m * DM : p.in[1] + (size_t)(m - 16384) * DM;
            const float* mr = MOD + (size_t)s * 9216 + 1024; const float* ba = p.in[5] + 1024; const float* ng = p.in[6];
            float q = 0.f;
#pragma unroll
            for (int j = 0; j < 4; ++j) { const int c = 4 * lane + 256 * j; const f32x4_t v = *(const f32x4_t*)(xr + c); const f32x4_t sc = *(const f32x4_t*)(mr + c) + *(const f32x4_t*)(ba + c); const f32x4_t g = *(const f32x4_t*)(ng + c) * (sc + 1.0f);
                q += (v[0] * v[0] + v[1] * v[1]) + (v[2] * v[2] + v[3] * v[3]); const f32x4_t o = v * g;
                *(unsigned long long*)(XN + (size_t)m * DM + c) = (unsigned long long)pk2(o[0], o[1]) | ((unsigned long long)pk2(o[2], o[3]) << 32); }
            q = wave_sum(q); if (lane == 0) SS0[m] = q;
        }
    }
    grid.sync();

    for (int l = 0; l < 2; ++l) {
        unsigned char* wl = ws + OFF_W + l * W_LAYER;
        const float* GV = (const float*)(ws + OFF_GV); const float* GT = (const float*)(ws + OFF_GATE); const float* BI = (const float*)(ws + OFF_BIAS); float* SS = (float*)(ws + OFF_SS);
        bf16* XN = (bf16*)(ws + OFF_XN); bf16* HID = (bf16*)(ws + OFF_HID); bf16* OMIX = (bf16*)(ws + OFF_OMIX);
        for (int f = 0; f < 2; ++f) {
            const int j = f == 0 ? 0 : 2; const int inst = l * 3 + j;
            if (f == 1) {
                {
                    pg8::Gemm g{XN, (const pg8::bf16_t*)(wl + WO_MI), MTOK, NMIXP, DM}; pg8::StaticOrder S; S.init(MTOK, NMIXP, G, bx);
                    pg8::EpiZ E{(bf16*)(ws + OFF_Z), (bf16*)(ws + OFF_QK), (bf16*)(ws + OFF_VR), SS + (size_t)(l * 3 + 1) * MTOK, BI + (size_t)(l * 3 + 1) * NSEQ * NFF, p.in[29] + l * 64, p.in[30] + l * 64, (const float*)(ws + OFF_ROPE)};
                    pg8::gemm_phase<pg8::EpiZ, pg8::StaticOrder, true, true>(ldsg, g, S, E);
                }
                grid.sync();
                {
                    unsigned* ctr = (unsigned*)(ws + OFF_CTR) + 64 * l;
                    constexpr int NU_R = 224, NU_L = 120, NU_A = 1152, NU = NU_R + NU_L + NU_A;
                    for (;;) {
                        __syncthreads(); if (tid == 0) misc[0] = (int)atomicAdd(ctr, 1u); __syncthreads();
                        const int u = misc[0]; if (u >= NU) break;
                        if (u < 224) { int s_, h_, d_, md_;
                            if (u < 96) { const int c = u & 31; md_ = 1 + (u >> 5); s_ = c >> 3; h_ = (c >> 1) & 3; d_ = c & 1; } else { const int i2 = u - 96; md_ = 0; s_ = 4 + (i2 >> 3); h_ = (i2 >> 1) & 3; d_ = i2 & 1; }
                            rwkv_unit(p, lds, l, s_, h_, d_, md_); }
                        else if (u < 248) { const int i3 = u - 224; lru_unit(p, lds, l, i3 / 6, i3 % 6); }
                        else if (u < 344) { const int i4 = u - 248; lru_unit(p, lds, l, 4 + i4 / 6, i4 % 6); }
                        else { const int i5 = u - 344; int s_, hq, qb;
                            if (i5 < 384) { s_ = i5 / 96; const int r = i5 % 96; hq = (r / 48) * 3 + (r % 48) / 16; qb = r & 15; }
                            else { const int i6 = i5 - 384; s_ = 4 + i6 / 48; const int r = i6 % 48; hq = (r / 24) * 3 + (r % 24) / 8; qb = r & 7; }
                            const int g_ = hq / 3;
                            attn_body::attn_unit<8>(seq_start(s_), seq_len(s_), qb, 64 * hq, 384 + 64 * g_, 64 * g_, 640 + 64 * hq, (const attn_body::bf16*)(ws + OFF_QK), (const attn_body::bf16*)(ws + OFF_QK), (const attn_body::bf16*)(ws + OFF_VR), (attn_body::bf16*)(ws + OFF_OMIX), (char*)lds); }
                    }
                }
                grid.sync();
                for (int t = bx; t < MTOK / 32; t += G) rwkv_post_tile(p, lds, l, t);
                grid.sync();
                {
                    pg8::Gemm g{OMIX, (const pg8::bf16_t*)(wl + WO_MO), MTOK, DM, DM}; pg8::StaticOrder S; S.init(MTOK, DM, G, bx);
                    pg8::EpiResid E{p.out, p.out + (size_t)16384 * DM, p.out, XN, SS + (size_t)(l * 3 + 2) * MTOK, GT + (size_t)(l * 3 + 1) * NSEQ * DM, GV + (size_t)(l * 3 + 2) * NSEQ * DM};
                    pg8::gemm_phase<pg8::EpiResid, pg8::StaticOrder, true, true>(ldsg, g, S, E);
                }
                grid.sync();
            }
            {
                pg8::Gemm g{XN, (const pg8::bf16_t*)(wl + WO_IN + f * 11 * MiB), MTOK, NFF, DM}; pg8::StaticOrder S; S.init(MTOK, NFF, G, bx);
                pg8::EpiSwiglu E{HID, SS + (size_t)inst * MTOK, BI + (size_t)inst * NSEQ * NFF};
                pg8::gemm_phase<pg8::EpiSwiglu, pg8::StaticOrder, true, true>(ldsg, g, S, E);
            }
            grid.sync();
            {
                const bool first = (l == 0 && f == 0), last = (l == 1 && f == 1);
                const int ninst = inst + 1;
                pg8::Gemm g{HID, (const pg8::bf16_t*)(wl + WO_OUT + f * (11 * MiB / 2)), MTOK, DM, DFF}; pg8::StaticOrder S; S.init(MTOK, DM, G, bx);
                pg8::EpiResid E{first ? p.in[0] : p.out, first ? p.in[1] : p.out + (size_t)16384 * DM, p.out, XN, last ? nullptr : SS + (size_t)ninst * MTOK, GT + (size_t)inst * NSEQ * DM, last ? nullptr : GV + (size_t)ninst * NSEQ * DM};
                pg8::gemm_phase<pg8::EpiResid, pg8::StaticOrder, true, true>(ldsg, g, S, E);
            }
            if (!(l == 1 && f == 1)) grid.sync();
        }
    }
}

extern "C" void kernel_launch(void* const* d_in, const int* in_sizes, int n_in, void* d_out, int out_size, void* d_ws, size_t ws_size, hipStream_t stream) {
    static int grid = 0;
    if (grid == 0) {
        if (n_in != 31 || ws_size < WS_END + 1 * MiB) { fprintf(stderr, "kernel_launch: unexpected n_in %d / ws %zu\n", n_in, ws_size); grid = -1; return; }
        int dev = 0, cus = 0, per_cu = 0;
        hipGetDevice(&dev); hipDeviceGetAttribute(&cus, hipDeviceAttributeMultiprocessorCount, dev);
        hipFuncSetAttribute((const void*)fwd_megakernel, hipFuncAttributeMaxDynamicSharedMemorySize, LDS_BYTES);
        hipOccupancyMaxActiveBlocksPerMultiprocessor(&per_cu, (const void*)fwd_megakernel, NTHR, LDS_BYTES);
        if (per_cu < 1) per_cu = 1;
        grid = cus * per_cu;
        (void)hipGetLastError();
    }
    if (grid < 0) return;
    hipMemsetAsync(d_ws, 0, ZERO_BYTES, stream);
    KP p{};
    for (int i = 0; i < 31; ++i) p.in[i] = (const float*)d_in[i];
    p.out = (float*)d_out; p.ws = (unsigned char*)d_ws;
    void* args[] = {&p};
    hipError_t e = hipLaunchCooperativeKernel((const void*)fwd_megakernel, dim3(grid), dim3(NTHR), args, LDS_BYTES, stream);
    if (e != hipSuccess) fprintf(stderr, "cooperative launch failed: %s (grid %d)\n", hipGetErrorString(e), grid);
}
```

```cpp
#include <hip/hip_runtime.h>
#include <hip/hip_cooperative_groups.h>
#include <cstdio>
#include <cstdint>
namespace cg = cooperative_groups;
namespace pg8 {
#define PG8_LAS __attribute__((address_space(3)))
typedef unsigned short bf16_t;
typedef short bf16x8 __attribute__((ext_vector_type(8)));
typedef float f32x4 __attribute__((ext_vector_type(4)));
typedef unsigned u32x4 __attribute__((ext_vector_type(4)));
constexpr int BM = 256, BK = 64, HALF = 128, HTB = HALF * BK * 2  , STAGE_BYTES = 8 * HTB, NXCD = 8, WGM = 8;

__host__ __device__ __forceinline__ int lds_byte(int r, int c) { const int st = (r >> 4) * 2 + (c >> 5), rr = r & 15, cc = c & 31, ob = rr * 64 + cc * 2; return st * 1024 + (ob ^ (((ob >> 9) & 1) << 5)); }
__host__ __device__ __forceinline__ void stage_rc(int b, int& R, int& C) { const int st = b / 1024, sb = b % 1024, swz = sb ^ (((sb >> 9) & 1) << 5); R = (st >> 1) * 16 + swz / 64; C = (st & 1) * 32 + (swz % 64) / 2; }
__host__ __device__ __forceinline__ int perm32(int rho) { const int n = rho >> 4, i = rho & 15; return 8 * (i >> 2) + 4 * n + (i & 3); }

struct Unit { int pm, pn; };
struct Gemm { const bf16_t* A; const bf16_t* Bt; int M, N, K; };

struct StaticOrder {
    int nM, nN, nwg, G, c;
    __host__ __device__ void init(int M, int N, int G_, int c_) { nM = M / BM; nN = N / BM; nwg = nM * nN; G = G_; c = c_; }
    __host__ __device__ bool next(int i, Unit& u) const {
        const long L = (long)i * G + c; if (L >= nwg) return false;
        int wgid = (int)L; { const int q = nwg / NXCD, r = nwg % NXCD, xcd = wgid % NXCD, off = wgid / NXCD; wgid = (xcd < r ? xcd * (q + 1) : r * (q + 1) + (xcd - r) * q) + off; }
        const int nig = WGM * nN, gid = wgid / nig, fm = gid * WGM, gsz = (nM - fm) < WGM ? (nM - fm) : WGM;
        u.pm = fm + ((wgid % nig) % gsz); u.pn = (wgid % nig) / gsz; return true;
    }
    __device__ __forceinline__ void a_ready(const Unit&) const {}
    __device__ __forceinline__ void done(const Unit&) const {}
};

__device__ __forceinline__ unsigned cvt_pk_bf16(float lo, float hi) { unsigned r; asm volatile("v_cvt_pk_bf16_f32 %0, %1, %2" : "=v"(r) : "v"(lo), "v"(hi)); return r; }
typedef float f32x2 __attribute__((ext_vector_type(2)));
__device__ __forceinline__ f32x2 gelu_pk(f32x2 v) {
    const f32x2 av = __builtin_elementwise_abs(v), d = av * 0.2316418882f + 1.0f;
    f32x2 t; t.x = __builtin_amdgcn_rcpf(d.x); t.y = __builtin_amdgcn_rcpf(d.y);
    f32x2 q = t * 0.5307027145f + (-0.7265760135f); q = q * t + 0.7107068705f; q = q * t + (-0.142248368f); q = q * t + 0.127414796f; q = q * t;
    const f32x2 s = (v * v) * (-0.72134752044f);
    f32x2 e; e.x = __builtin_amdgcn_exp2f(s.x); e.y = __builtin_amdgcn_exp2f(s.y);
    const f32x2 m = v * (q * e), r = v - m;
    f32x2 o; o.x = v.x < 0.f ? m.x : r.x; o.y = v.y < 0.f ? m.y : r.y; return o;
}

template <int ACT  > struct EpiBf16 {
    static constexpr bool PERM = true, AFTER_DRAIN = false; static_assert(ACT == 0 || ACT == 1, "EpiBf16: ACT is 0 (none) or 1 (gelu_pk)");
    bf16_t* O; int ldc; const float* bias; int split_cols; size_t split_stride; float scale0;
    __device__ __forceinline__ void operator()(const f32x4 (&acc)[2][2][4][2], const Unit& u, int wr, int wc, int fr, int fq) const {
        const int row0 = u.pm * BM + wr * 64 + fr; int colt = u.pn * BM; bf16_t* base = O;
        float sc = 1.f; if (split_cols) { const int t = colt / split_cols; base += (size_t)t * split_stride; colt -= t * split_cols; if (t == 0) sc = scale0; }
        const int col0 = colt + wc * 32 + 8 * fq, bcol0 = u.pn * BM + wc * 32 + 8 * fq;
        f32x4 bv[2][2];
#pragma unroll
        for (int bj = 0; bj < 2; ++bj)
#pragma unroll
            for (int n = 0; n < 2; ++n) bv[bj][n] = bias ? *(const f32x4*)(bias + bcol0 + bj * HALF + 4 * n) : (f32x4){0.f, 0.f, 0.f, 0.f};
#pragma unroll
        for (int ai = 0; ai < 2; ++ai)
#pragma unroll
            for (int m = 0; m < 4; ++m) { bf16_t* rowp = base + (size_t)(row0 + ai * HALF + m * 16) * ldc + col0;
#pragma unroll
                for (int bj = 0; bj < 2; ++bj) { f32x4 v0 = acc[ai][bj][m][0] + bv[bj][0], v1 = acc[ai][bj][m][1] + bv[bj][1];
                    if (ACT == 1) { f32x2 a = gelu_pk((f32x2){v0[0], v0[1]}), b = gelu_pk((f32x2){v0[2], v0[3]}), c = gelu_pk((f32x2){v1[0], v1[1]}), d = gelu_pk((f32x2){v1[2], v1[3]});
                        v0 = (f32x4){a.x, a.y, b.x, b.y}; v1 = (f32x4){c.x, c.y, d.x, d.y}; }
                    v0 = v0 * sc; v1 = v1 * sc; u32x4 w; w.x = cvt_pk_bf16(v0[0], v0[1]); w.y = cvt_pk_bf16(v0[2], v0[3]); w.z = cvt_pk_bf16(v1[0], v1[1]); w.w = cvt_pk_bf16(v1[2], v1[3]);
                    *(u32x4*)(rowp + bj * HALF) = w; } }
    }
};
template <class Epi, class Sched, bool ALIGN_EPI = false, bool SP2 = false>
__device__ __forceinline__ void gemm_phase(PG8_LAS unsigned char* lds, const Gemm g, const Sched& S, const Epi& E) {
    int tid_o = threadIdx.x; asm volatile("" : "+v"(tid_o)); const int tid = tid_o, wid = __builtin_amdgcn_readfirstlane(tid >> 6), lane = tid & 63, wr = wid >> 2, wc = wid & 3, fr = lane & 15, fq = lane >> 4;
    const int K = g.K, nt = K / BK;
    unsigned voffA[2], voffB[2];
#pragma unroll
    for (int i = 0; i < 2; ++i) { int R, C; stage_rc(tid * 16 + i * 8192, R, C); const int Rb = Epi::PERM ? ((R & ~31) + perm32(R & 31)) : R;
        voffA[i] = (unsigned)(R * K + C) * 2u; voffB[i] = (unsigned)(Rb * K + C) * 2u; }
    const size_t kstep = (size_t)(BK * 2);
    const size_t hstep = (size_t)HALF * K * 2;
    const size_t tstep = 2 * hstep;
    const unsigned ldsw = (unsigned)wid * 1024u;
    const int aoff = lds_byte(wr * 64 + fr, fq * 8), boff = lds_byte(wc * 32 + fr, fq * 8);
#define PG8_SA(b, h) (((b) * 2 + (h)) * HTB)
#define PG8_SB(b, h) ((4 + (b) * 2 + (h)) * HTB)
#define PG8_STAGE(bufoff, gbase, voff) do { _Pragma("unroll") for (int _i = 0; _i < 2; ++_i) \
        __builtin_amdgcn_global_load_lds((const unsigned*)((const char*)(gbase) + (voff)[_i]), (PG8_LAS unsigned*)(lds + (bufoff) + ldsw + _i * 8192), 16, 0, 0); } while (0)
#define PG8_LDA(dst, b, h) do { _Pragma("unroll") for (int m = 0; m < 4; ++m) _Pragma("unroll") for (int k = 0; k < 2; ++k) dst[m][k] = *(const PG8_LAS bf16x8*)(lds + PG8_SA(b, h) + aoff + m * 2048 + k * 1024); } while (0)
#define PG8_LDB(dst, b, h) do { _Pragma("unroll") for (int n = 0; n < 2; ++n) _Pragma("unroll") for (int k = 0; k < 2; ++k) dst[n][k] = *(const PG8_LAS bf16x8*)(lds + PG8_SB(b, h) + boff + n * 2048 + k * 1024); } while (0)
#define PG8_MMA(ai, bj, At, Bt) do { __builtin_amdgcn_s_setprio(1); _Pragma("unroll") for (int m = 0; m < 4; ++m) _Pragma("unroll") for (int n = 0; n < 2; ++n) _Pragma("unroll") for (int k = 0; k < 2; ++k) \
        acc[ai][bj][m][n] = __builtin_amdgcn_mfma_f32_16x16x32_bf16(Bt[n][k], At[m][k], acc[ai][bj][m][n], 0, 0, 0); __builtin_amdgcn_s_setprio(0); } while (0)
#define PG8_WAIT_V(n) asm volatile("s_waitcnt vmcnt(" #n ")" ::: "memory")
#define PG8_WAIT_L(n) asm volatile("s_waitcnt lgkmcnt(" #n ")" ::: "memory")
#define PG8_BAR __builtin_amdgcn_s_barrier()
#define PG8_SCHED __builtin_amdgcn_sched_barrier(0)
    Unit cur, nxt; int ui = 0;
    if (!S.next(0, cur)) return;
    f32x4 acc[2][2][4][2];
#pragma unroll
    for (int a = 0; a < 2; ++a)
#pragma unroll
        for (int b = 0; b < 2; ++b)
#pragma unroll
            for (int m = 0; m < 4; ++m)
#pragma unroll
                for (int n = 0; n < 2; ++n) acc[a][b][m][n] = (f32x4){0.f, 0.f, 0.f, 0.f};
    bf16x8 At[4][2], B0[2][2], B1[2][2];
    const char* cA = (const char*)g.A + (size_t)cur.pm * tstep; const char* cB = (const char*)g.Bt + (size_t)cur.pn * tstep;
    S.a_ready(cur);
    if constexpr (SP2) {
        PG8_STAGE(PG8_SB(0, 0), cB, voffB); PG8_STAGE(PG8_SB(0, 1), cB + hstep, voffB); PG8_STAGE(PG8_SA(0, 0), cA, voffA); PG8_STAGE(PG8_SA(0, 1), cA + hstep, voffA);
        if (wr == 1) PG8_BAR;
        PG8_WAIT_V(2); PG8_BAR;
        PG8_STAGE(PG8_SB(1, 0), cB + kstep, voffB); PG8_STAGE(PG8_SA(1, 0), cA + kstep, voffA); PG8_STAGE(PG8_SB(1, 1), cB + hstep + kstep, voffB);
        PG8_WAIT_V(6); PG8_BAR;
    } else {
        PG8_STAGE(PG8_SB(0, 0), cB, voffB); PG8_STAGE(PG8_SA(0, 0), cA, voffA); PG8_STAGE(PG8_SB(0, 1), cB + hstep, voffB); PG8_STAGE(PG8_SA(0, 1), cA + hstep, voffA);
        if (wr == 1) PG8_BAR;
        PG8_WAIT_V(4); PG8_BAR;
        PG8_STAGE(PG8_SB(1, 0), cB + kstep, voffB); PG8_STAGE(PG8_SA(1, 0), cA + kstep, voffA); PG8_STAGE(PG8_SB(1, 1), cB + hstep + kstep, voffB);
        PG8_WAIT_V(6); PG8_BAR;
    }
    for (;;) {
        const bool has_next = S.next(ui + 1, nxt);
        const char* nA = has_next ? (const char*)g.A + (size_t)nxt.pm * tstep : cA; const char* nB = has_next ? (const char*)g.Bt + (size_t)nxt.pn * tstep : cB;
        for (int t = 0; t < nt; t += 2) {
            const bool last = (t == nt - 2);
            const char* a1 = cA + (size_t)(t + 1) * kstep;
            const char* a2 = last ? nA : cA + (size_t)(t + 2) * kstep; const char* b2 = last ? nB : cB + (size_t)(t + 2) * kstep;
            const char* a3 = a2 + kstep; const char* b3 = b2 + kstep;
            if (last && has_next) S.a_ready(nxt);
            if constexpr (SP2) {
            PG8_LDB(B0, 0, 0); PG8_LDB(B1, 0, 1); PG8_SCHED; PG8_LDA(At, 0, 0); PG8_STAGE(PG8_SA(1, 1), a1 + hstep, voffA);
            PG8_WAIT_V(8); PG8_WAIT_L(0); PG8_BAR; PG8_MMA(0, 0, At, B0); PG8_MMA(0, 1, At, B1); PG8_BAR; PG8_SCHED;
            PG8_LDA(At, 0, 1); PG8_STAGE(PG8_SB(0, 0), b2, voffB); PG8_STAGE(PG8_SB(0, 1), b2 + hstep, voffB); PG8_STAGE(PG8_SA(0, 0), a2, voffA);
            PG8_WAIT_V(8); PG8_WAIT_L(0); PG8_BAR; PG8_MMA(1, 0, At, B0); PG8_MMA(1, 1, At, B1); PG8_BAR; PG8_SCHED;
            PG8_LDB(B0, 1, 0); PG8_LDB(B1, 1, 1); PG8_SCHED; PG8_LDA(At, 1, 0); PG8_STAGE(PG8_SA(0, 1), a2 + hstep, voffA);
            PG8_WAIT_V(8); PG8_WAIT_L(0); PG8_BAR; PG8_MMA(0, 0, At, B0); PG8_MMA(0, 1, At, B1); PG8_BAR; PG8_SCHED;
            PG8_LDA(At, 1, 1); PG8_STAGE(PG8_SB(1, 0), b3, voffB); PG8_STAGE(PG8_SB(1, 1), b3 + hstep, voffB); PG8_STAGE(PG8_SA(1, 0), a3, voffA);
            PG8_WAIT_V(8); PG8_WAIT_L(0); PG8_BAR; PG8_MMA(1, 0, At, B0); PG8_MMA(1, 1, At, B1); PG8_BAR; PG8_SCHED;
            } else {
            PG8_LDB(B0, 0, 0); PG8_SCHED; PG8_LDA(At, 0, 0); PG8_STAGE(PG8_SA(1, 1), a1 + hstep, voffA);
            PG8_WAIT_L(8); PG8_BAR; PG8_WAIT_L(0); PG8_MMA(0, 0, At, B0); PG8_BAR; PG8_SCHED;
            PG8_LDB(B1, 0, 1); PG8_STAGE(PG8_SB(0, 0), b2, voffB);
            PG8_BAR; PG8_WAIT_L(0); PG8_MMA(0, 1, At, B1); PG8_BAR;
            PG8_LDA(At, 0, 1); PG8_STAGE(PG8_SA(0, 0), a2, voffA);
            PG8_BAR; PG8_WAIT_L(0); PG8_MMA(1, 0, At, B0); PG8_BAR; PG8_SCHED;
            PG8_STAGE(PG8_SB(0, 1), b2 + hstep, voffB);
            PG8_WAIT_V(6); PG8_BAR; PG8_MMA(1, 1, At, B1); PG8_BAR;
            PG8_LDB(B0, 1, 0); PG8_SCHED; PG8_LDA(At, 1, 0); PG8_STAGE(PG8_SA(0, 1), a2 + hstep, voffA);
            PG8_WAIT_L(8); PG8_BAR; PG8_WAIT_L(0); PG8_MMA(0, 0, At, B0); PG8_BAR; PG8_SCHED;
            PG8_LDB(B1, 1, 1); PG8_STAGE(PG8_SB(1, 0), b3, voffB);
            PG8_BAR; PG8_WAIT_L(0); PG8_MMA(0, 1, At, B1); PG8_BAR;
            PG8_LDA(At, 1, 1); PG8_STAGE(PG8_SA(1, 0), a3, voffA);
            PG8_BAR; PG8_WAIT_L(0); PG8_MMA(1, 0, At, B0); PG8_BAR; PG8_SCHED;
            PG8_STAGE(PG8_SB(1, 1), b3 + hstep, voffB);
            PG8_WAIT_V(6); PG8_BAR; PG8_MMA(1, 1, At, B1); PG8_BAR;
            }
        }
        if constexpr (ALIGN_EPI) { if (wr == 0) PG8_BAR; }
        if constexpr (!Epi::AFTER_DRAIN) { E(acc, cur, wr, wc, fr, fq); S.done(cur); }
        if (!has_next) break;
#pragma unroll
        for (int a = 0; a < 2; ++a)
#pragma unroll
            for (int b = 0; b < 2; ++b)
#pragma unroll
                for (int m = 0; m < 4; ++m)
#pragma unroll
                    for (int n = 0; n < 2; ++n) acc[a][b][m][n] = (f32x4){0.f, 0.f, 0.f, 0.f};
        cur = nxt; cA = nA; cB = nB; ++ui;
        if constexpr (ALIGN_EPI) { if (wr == 1) PG8_BAR; }
    }
    PG8_WAIT_V(0);
    if constexpr (!ALIGN_EPI) { if (wr == 0) PG8_BAR; }
    PG8_BAR;
    if constexpr (Epi::AFTER_DRAIN) { E.fused(acc, cur, wr, wc, fr, fq, lds, wid, lane); S.done(cur); }
#undef PG8_SA
#undef PG8_SB
#undef PG8_STAGE
#undef PG8_LDA
#undef PG8_LDB
#undef PG8_MMA
#undef PG8_WAIT_V
#undef PG8_WAIT_L
#undef PG8_BAR
#undef PG8_SCHED
}
}
#include <hip/hip_bf16.h>
#include <cmath>
namespace attn_body {
using bf16=__hip_bfloat16;
using bf16x8=__attribute__((ext_vector_type(8)))short;
using s16x4=__attribute__((ext_vector_type(4)))short;
using f32x16=__attribute__((ext_vector_type(16)))float;
using u32x4=__attribute__((ext_vector_type(4)))unsigned;
constexpr int D=64,QP=512,KP=512,VP=128,OP=1024;
constexpr int NW=8,QBLK=32,QB=QBLK*NW,KVBLK=64;
constexpr int ATTN_UNIT_ROWS=QB;
__device__ __forceinline__ int crow(int r,int hi){return (r&3)+8*(r>>2)+4*hi;}
#define SBAR() __builtin_amdgcn_sched_barrier(0)
__device__ __forceinline__ void cmask(f32x16&p0,f32x16&p1,int jb,int qrel,int hi){
  const float NEG=-INFINITY; int kb=64*jb+4*hi;
  #pragma unroll
  for(int r=0;r<16;++r){int kv=kb+(r&3)+8*(r>>2); if(kv>qrel)p0[r]=NEG; if(kv+32>qrel)p1[r]=NEG;}
}

constexpr int NSLOT=3, SLOTB=8192;
constexpr int LDS_K=0, LDS_V=NSLOT*SLOTB, LDS_WS=2*NSLOT*SLOTB, LDS_OST=LDS_WS+NW*64*4, LDS_BYTES=LDS_OST+NW*4096;
constexpr float C2=0.125f*1.4426950408889634f;
__device__ __forceinline__ void glds16(const void*gsrc,unsigned lds_dst){unsigned keep;
  asm volatile("s_mov_b32 %0, m0\n\ts_mov_b32 m0, %2\n\ts_nop 0\n\tglobal_load_lds_dwordx4 %1, off\n\ts_mov_b32 m0, %0":"=&s"(keep):"v"(gsrc),"s"(lds_dst):"memory");}
__device__ __forceinline__ float max3f(float a,float b,float c){float r;asm("v_max3_f32 %0, %1, %2, %3":"=v"(r):"v"(a),"v"(b),"v"(c));return r;}
__device__ __forceinline__ float max2f(float a,float b){float r;asm("v_max_f32_e32 %0, %1, %2":"=v"(r):"v"(a),"v"(b));return r;}
__device__ __forceinline__ float fadd_s(float a,float b){float r;asm("v_add_f32_e32 %0, %1, %2":"=v"(r):"v"(a),"v"(b));return r;}
__device__ __forceinline__ float fsub_s(float a,float b){float r;asm("v_sub_f32_e32 %0, %1, %2":"=v"(r):"v"(a),"v"(b));return r;}
typedef float f32x2_t __attribute__((ext_vector_type(2))); typedef __bf16 bf16x2_t __attribute__((ext_vector_type(2)));
__device__ __forceinline__ unsigned cvtpk_s(float lo,float hi){f32x2_t v={lo,hi};bf16x2_t b=__builtin_convertvector(v,bf16x2_t);return __builtin_bit_cast(unsigned,b);}
#define WAIT_BAR(N) asm volatile("s_waitcnt vmcnt(" #N ") lgkmcnt(0)\n\ts_barrier":::"memory")

__device__ __forceinline__ void qkt(f32x16&p0,f32x16&p1,const char*Kslot,const bf16x8*qr,const f32x16&negm,int r32,int hi){
  const char*kb=Kslot+hi*1024+r32*16;
  #pragma unroll
  for(int d0=0;d0<4;++d0){
    const bf16x8 b0=*reinterpret_cast<const bf16x8*>(kb+d0*2048);
    const bf16x8 b1=*reinterpret_cast<const bf16x8*>(kb+d0*2048+512);
    if(d0==0){p0=__builtin_amdgcn_mfma_f32_32x32x16_bf16(b0,qr[0],negm,0,0,0);p1=__builtin_amdgcn_mfma_f32_32x32x16_bf16(b1,qr[0],negm,0,0,0);}
    else{p0=__builtin_amdgcn_mfma_f32_32x32x16_bf16(b0,qr[d0],p0,0,0,0);p1=__builtin_amdgcn_mfma_f32_32x32x16_bf16(b1,qr[d0],p1,0,0,0);}}
}
typedef __attribute__((address_space(3))) const char* lds_cptr;
typedef short v4i16_t __attribute__((ext_vector_type(4)));
__device__ __forceinline__ void kload8(bf16x8*kf,lds_cptr kp){
  kf[0]=*(const __attribute__((address_space(3))) bf16x8*)(kp);      kf[1]=*(const __attribute__((address_space(3))) bf16x8*)(kp+512);
  kf[2]=*(const __attribute__((address_space(3))) bf16x8*)(kp+2048); kf[3]=*(const __attribute__((address_space(3))) bf16x8*)(kp+2560);
  kf[4]=*(const __attribute__((address_space(3))) bf16x8*)(kp+4096); kf[5]=*(const __attribute__((address_space(3))) bf16x8*)(kp+4608);
  kf[6]=*(const __attribute__((address_space(3))) bf16x8*)(kp+6144); kf[7]=*(const __attribute__((address_space(3))) bf16x8*)(kp+6656);
}
__device__ __forceinline__ void kload2(bf16x8*kf,lds_cptr kp,int j){ kf[2*j]=*(const __attribute__((address_space(3))) bf16x8*)(kp+j*2048); kf[2*j+1]=*(const __attribute__((address_space(3))) bf16x8*)(kp+j*2048+512); }
__device__ __forceinline__ s16x4 vtr(lds_cptr p){ return __builtin_bit_cast(s16x4,__builtin_amdgcn_ds_read_tr16_b64_v4i16((__attribute__((address_space(3))) v4i16_t*)p)); }
__device__ __forceinline__ float rowmax(const f32x16&p0,const f32x16&p1){
  float a=max3f(p0[0],p0[1],p1[0]),b=max3f(p0[2],p0[3],p1[1]);a=max3f(a,p1[2],p1[3]);
  #pragma unroll
  for(int r=4;r<16;r+=4){a=max3f(a,p0[r],p0[r+1]);b=max3f(b,p0[r+2],p0[r+3]);a=max3f(a,p1[r],p1[r+1]);b=max3f(b,p1[r+2],p1[r+3]);}
  const float m=max2f(a,b);
  auto rr=__builtin_amdgcn_permlane32_swap(__float_as_uint(m),__float_as_uint(m),false,false);
  return max2f(__uint_as_float(rr[0]),__uint_as_float(rr[1]));
}
__device__ __forceinline__ void pv(f32x16*o,int vb,bf16x8 pa0,bf16x8 pa1,bf16x8 pa2,bf16x8 pa3){
  #pragma unroll
  for(int d0=0;d0<2;++d0){s16x4 lo[4],hi[4];
    #pragma unroll
    for(int ks=0;ks<4;++ks){
      asm volatile("ds_read_b64_tr_b16 %0,%1 offset:%c2":"=&v"(lo[ks]):"v"(vb),"i"(d0*4096+ks*1024):"memory");
      asm volatile("ds_read_b64_tr_b16 %0,%1 offset:%c2":"=&v"(hi[ks]):"v"(vb),"i"(d0*4096+ks*1024+512):"memory");}
    asm volatile("s_waitcnt lgkmcnt(0)":::"memory");SBAR();
    #define PK(k) (bf16x8){lo[k][0],lo[k][1],lo[k][2],lo[k][3],hi[k][0],hi[k][1],hi[k][2],hi[k][3]}
    o[d0]=__builtin_amdgcn_mfma_f32_32x32x16_bf16(pa0,PK(0),o[d0],0,0,0);
    o[d0]=__builtin_amdgcn_mfma_f32_32x32x16_bf16(pa1,PK(1),o[d0],0,0,0);
    o[d0]=__builtin_amdgcn_mfma_f32_32x32x16_bf16(pa2,PK(2),o[d0],0,0,0);
    o[d0]=__builtin_amdgcn_mfma_f32_32x32x16_bf16(pa3,PK(3),o[d0],0,0,0);
    #undef PK
  }
}

#ifndef ATTN_STORE16
#define ATTN_STORE16(p,v) (*(u32x4*)(p)=(v))
#endif
template<int THRL> __device__ __forceinline__ void attn_unit(int rowbase_i,int S,int qb,int qcol,int kcol,int vcol,int ocol,const bf16*Q,const bf16*__restrict__ K,const bf16*__restrict__ V,bf16*O,char*shm){
  int tid_o=threadIdx.x; asm volatile("":"+v"(tid_o)); const int tid=tid_o,lane=tid&63,r32=lane&31,hi=lane>>5; const int wid=__builtin_amdgcn_readfirstlane(tid>>6);
  const long rowbase=(long)rowbase_i; const int q0=qb*QB;
  const bf16*Qw=Q+(rowbase+q0+wid*QBLK)*QP+qcol;
  const bf16*Kh=K+rowbase*KP+kcol,*Vh=V+rowbase*VP+vcol;
  const unsigned lds0=(unsigned)(uintptr_t)shm;
  float*wsf=(float*)(shm+LDS_WS)+wid*64;
  const bf16*ksrc=Kh+(long)lane*KP+wid*8;
  const bf16*vsrc=Vh+(long)(16*(wid&3)+(lane>>2))*VP+(wid>>2)*32+(lane&3)*8;
  const unsigned kdst=lds0+LDS_K+wid*1024, vdst=lds0+LDS_V+wid*1024;
  #define DMA_K(t,slot) glds16(ksrc+(long)(t)*KVBLK*KP,(unsigned)__builtin_amdgcn_readfirstlane(kdst+(slot)))
  #define DMA_V(t,slot) glds16(vsrc+(long)(t)*KVBLK*VP,(unsigned)__builtin_amdgcn_readfirstlane(vdst+(slot)))
  const int vb0=(int)(lds0+LDS_V)+((lane>>4)&1)*32+(lane&3)*8+(4*hi+((lane&15)>>2))*64;
  const char*Kbase=shm+LDS_K; bf16x8 kf[8];
  const lds_cptr shm3=(lds_cptr)shm; const lds_cptr kp0=shm3+LDS_K+hi*1024+r32*16; const lds_cptr vp0=shm3+LDS_V+((lane>>4)&1)*32+(lane&3)*8+(4*hi+((lane&15)>>2))*64;
  const int NT=S/KVBLK;
  DMA_K(0,0);DMA_V(0,0);DMA_K(1,SLOTB);
  bf16x8 qr[4];
  #pragma unroll
  for(int d0=0;d0<4;++d0)qr[d0]=*reinterpret_cast<const bf16x8*>(&Qw[(long)r32*QP+d0*16+hi*8]);
  float mhat=0.f,l_reg=0.f;f32x16 o[2];o[0]=f32x16{};o[1]=f32x16{};f32x16 negm=f32x16{};asm volatile("":"+v"(negm));
  const int qrel=wid*QBLK+r32;
  #define CMASK(P0,P1,t) do{}while(0)
  bool resc=false;
  #define START(P0,P1) do{ const float rm=rowmax(P0,P1); resc=false; \
    { const float dl=rm; mhat=fadd_s(mhat,dl); \
      _Pragma("unroll") for(int r=0;r<16;++r){P0[r]=fsub_s(P0[r],dl);P1[r]=fsub_s(P1[r],dl);} \
      _Pragma("unroll") for(int r=0;r<16;++r)negm[r]=-mhat; asm volatile("":"+v"(negm)); } \
    _Pragma("unroll") for(int r=0;r<16;++r)P0[r]=__builtin_amdgcn_exp2f(P0[r]); }while(0)
  #define RESC() do{ if(resc){ asm volatile("s_waitcnt lgkmcnt(0)":::"memory"); \
      _Pragma("unroll") for(int d_=0;d_<2;++d_) _Pragma("unroll") for(int r=0;r<16;++r)o[d_][r]*=wsf[crow(r,hi)]; } }while(0)
  f32x16 pA0,pA1,pB0,pB1;
  int sl_prev=0,sl_cur=0,sl_next=SLOTB;
  #define ROT() do{sl_prev=sl_cur;sl_cur=sl_next;sl_next=(sl_next==(NSLOT-1)*SLOTB)?0:sl_next+SLOTB;}while(0)
  DMA_K(2,2*SLOTB);
  WAIT_BAR(3);
  qkt(pA0,pA1,Kbase,qr,negm,r32,hi);asm volatile("s_nop 15\n\ts_nop 7":"+v"(pA0),"+v"(pA1));CMASK(pA0,pA1,0);
  START(pA0,pA1);
  _Pragma("unroll") for(int r=0;r<16;++r)pA1[r]=__builtin_amdgcn_exp2f(pA1[r]);
  WAIT_BAR(0);
  DMA_K(3,0);DMA_V(1,SLOTB);
  ROT();
  kload8(kf,kp0+sl_cur);
  WAIT_BAR(2);
  s16x4 vlo[8],vhi[8]; u32x4 pw0,pw1,pw2,pw3;
  #define PKW(P,B) cvtpk_s(P[B],P[B+1])
  #define PAF(k) __builtin_bit_cast(bf16x8,pw##k)
  #define VFR(i) (bf16x8){vlo[i][0],vlo[i][1],vlo[i][2],vlo[i][3],vhi[i][0],vhi[i][1],vhi[i][2],vhi[i][3]}
  #define PIN(x) asm volatile("":"+v"(x))
  #define MX3(a,b,c) __builtin_fmaxf(__builtin_fmaxf((a),(b)),(c))
  #define GAPA(MF,A0,A1,A2,A3,W0,W1,PW) do{ MF; sacc+=A0; sacc+=A1; sacc+=A2; sacc+=A3; PIN(sacc); W0; W1; PIN(PW); SBAR(); }while(0)
  #define EX(v) __builtin_amdgcn_exp2f(v)
  #define GAPB(MF,X,B) do{ MF; X[B]=EX(X[B]); X[B+1]=EX(X[B+1]); X[B+2]=EX(X[B+2]); X[B+3]=EX(X[B+3]); PIN(X); SBAR(); }while(0)
  #define VRD(i) do{ vlo[i]=vtr(vp_+(((i)>>2)*4096+((i)&3)*1024)); vhi[i]=vtr(vp_+(((i)>>2)*4096+((i)&3)*1024+512)); }while(0)
  #define KRD(G,j) do{ if(G){ kload2(kf,kp0+sl_next,j); SBAR(); } }while(0)
  #define STEP(C0,C1,P0,P1,t,GK,GV,GL) do{ SBAR(); \
    const lds_cptr vp_=vp0+sl_prev; \
    VRD(0); SBAR(); float sacc=(P0[0]+P0[1]); \
    GAPA(C0=__builtin_amdgcn_mfma_f32_32x32x16_bf16(kf[0],qr[0],negm,0,0,0), P0[2],P0[3],P0[4],P0[5],     pw0[0]=PKW(P0,0), pw0[1]=PKW(P0,2), pw0); \
    VRD(4); SBAR(); GAPA(C1=__builtin_amdgcn_mfma_f32_32x32x16_bf16(kf[1],qr[0],negm,0,0,0), P0[6],P0[7],P0[8],P0[9],     pw0[2]=PKW(P0,4), pw0[3]=PKW(P0,6), pw0); \
    VRD(1); SBAR(); GAPA(C0=__builtin_amdgcn_mfma_f32_32x32x16_bf16(kf[2],qr[1],C0,0,0,0),   P0[10],P0[11],P0[12],P0[13], pw1[0]=PKW(P0,8), pw1[1]=PKW(P0,10), pw1); \
    VRD(5); SBAR(); GAPA(C1=__builtin_amdgcn_mfma_f32_32x32x16_bf16(kf[3],qr[1],C1,0,0,0),   P0[14],P0[15],P1[0],P1[1],   pw1[2]=PKW(P0,12),pw1[3]=PKW(P0,14), pw1); \
    VRD(2); SBAR(); GAPA(C0=__builtin_amdgcn_mfma_f32_32x32x16_bf16(kf[4],qr[2],C0,0,0,0),   P1[2],P1[3],P1[4],P1[5],     pw2[0]=PKW(P1,0), pw2[1]=PKW(P1,2), pw2); \
    VRD(6); SBAR(); GAPA(C1=__builtin_amdgcn_mfma_f32_32x32x16_bf16(kf[5],qr[2],C1,0,0,0),   P1[6],P1[7],P1[8],P1[9],     pw2[2]=PKW(P1,4), pw2[3]=PKW(P1,6), pw2); \
    VRD(3); SBAR(); GAPA(C0=__builtin_amdgcn_mfma_f32_32x32x16_bf16(kf[6],qr[3],C0,0,0,0),   P1[10],P1[11],P1[12],P1[13], pw3[0]=PKW(P1,8), pw3[1]=PKW(P1,10), pw3); \
    VRD(7); SBAR(); GAPA(C1=__builtin_amdgcn_mfma_f32_32x32x16_bf16(kf[7],qr[3],C1,0,0,0),   P1[14],P1[15],0.f,0.f,       pw3[2]=PKW(P1,12),pw3[3]=PKW(P1,14), pw3); \
    l_reg+=sacc; \
    if(GK){DMA_K((t)+3,sl_cur);} if(GV){DMA_V((t)+1,sl_next);} \
    CMASK(C0,C1,t); \
    { float a=MX3(C0[0],C0[1],C1[0]),b=MX3(C0[2],C0[3],C1[1]); a=MX3(a,C1[2],C1[3]); \
      _Pragma("unroll") for(int r=4;r<16;r+=4){a=MX3(a,C0[r],C0[r+1]);b=MX3(b,C0[r+2],C0[r+3]);a=MX3(a,C1[r],C1[r+1]);b=MX3(b,C1[r+2],C1[r+3]);} \
      float rm=__builtin_fmaxf(a,b); { auto rr=__builtin_amdgcn_permlane32_swap(__float_as_uint(rm),__float_as_uint(rm),false,false); rm=__builtin_fmaxf(__uint_as_float(rr[0]),__uint_as_float(rr[1])); } \
      resc=false; \
      if(__builtin_expect(__any(rm>(float)THRL),0)){ const float dl=__builtin_fmaxf(rm,0.f); mhat+=dl; \
        _Pragma("unroll") for(int r=0;r<16;++r){C0[r]-=dl;C1[r]-=dl;} \
        _Pragma("unroll") for(int r=0;r<16;++r)negm[r]=-mhat; asm volatile("":"+v"(negm)); \
        const float f=__builtin_amdgcn_exp2f(-dl); l_reg*=f; if(hi==0)wsf[r32]=f; resc=true; } } \
    SBAR(); \
    GAPB(o[0]=__builtin_amdgcn_mfma_f32_32x32x16_bf16(PAF(0),VFR(0),o[0],0,0,0), C0,0); \
    GAPB(o[1]=__builtin_amdgcn_mfma_f32_32x32x16_bf16(PAF(0),VFR(4),o[1],0,0,0), C0,4); \
    KRD(GL,0); GAPB(o[0]=__builtin_amdgcn_mfma_f32_32x32x16_bf16(PAF(1),VFR(1),o[0],0,0,0), C0,8); \
    KRD(GL,1); GAPB(o[1]=__builtin_amdgcn_mfma_f32_32x32x16_bf16(PAF(1),VFR(5),o[1],0,0,0), C0,12); \
    KRD(GL,2); GAPB(o[0]=__builtin_amdgcn_mfma_f32_32x32x16_bf16(PAF(2),VFR(2),o[0],0,0,0), C1,0); \
    KRD(GL,3); GAPB(o[1]=__builtin_amdgcn_mfma_f32_32x32x16_bf16(PAF(2),VFR(6),o[1],0,0,0), C1,4); \
    GAPB(o[0]=__builtin_amdgcn_mfma_f32_32x32x16_bf16(PAF(3),VFR(3),o[0],0,0,0), C1,8); \
    GAPB(o[1]=__builtin_amdgcn_mfma_f32_32x32x16_bf16(PAF(3),VFR(7),o[1],0,0,0), C1,12); \
    }while(0)
  int t=1;
  #undef CMASK
  #define CMASK(P0,P1,t) do{}while(0)
  for(;t+5<NT;t+=2){
    STEP(pB0,pB1,pA0,pA1,t,true,true,true);     WAIT_BAR(2); RESC(); ROT();
    STEP(pA0,pA1,pB0,pB1,t+1,true,true,true);   WAIT_BAR(2); RESC(); ROT();
  }
  #undef CMASK
  #define CMASK(P0,P1,t) do{}while(0)
  #define ENDW(tt) do{ if((tt)+3<NT){WAIT_BAR(2);} else if((tt)+2<NT){WAIT_BAR(1);} else {WAIT_BAR(0);} }while(0)
  for(;t+1<NT;t+=2){
    STEP(pB0,pB1,pA0,pA1,t,(t+3<NT),(t+1<NT),(t+1<NT));       ENDW(t);   RESC(); ROT();
    STEP(pA0,pA1,pB0,pB1,t+1,(t+4<NT),(t+2<NT),(t+2<NT));     ENDW(t+1); RESC(); ROT();
  }
  STEP(pB0,pB1,pA0,pA1,NT-1,false,false,false); RESC();
  { float sacc=pB0[0]+pB0[1]; _Pragma("unroll") for(int r=2;r<16;++r)sacc+=pB0[r]; _Pragma("unroll") for(int r=0;r<16;++r)sacc+=pB1[r]; l_reg+=sacc;
    pw0=(u32x4){PKW(pB0,0),PKW(pB0,2),PKW(pB0,4),PKW(pB0,6)};pw1=(u32x4){PKW(pB0,8),PKW(pB0,10),PKW(pB0,12),PKW(pB0,14)};pw2=(u32x4){PKW(pB1,0),PKW(pB1,2),PKW(pB1,4),PKW(pB1,6)};pw3=(u32x4){PKW(pB1,8),PKW(pB1,10),PKW(pB1,12),PKW(pB1,14)};
    SBAR(); pv(o,vb0+sl_cur,PAF(0),PAF(1),PAF(2),PAF(3)); }
  #undef PKW
  #undef PAF
  #undef VFR
  #undef PIN
  #undef MX3
  #undef GAPA
  #undef GAPB
  #undef EX
  #undef VRD
  #undef KRD
  #undef STEP
  #undef ENDW
  {auto rr=__builtin_amdgcn_permlane32_swap(__float_as_uint(l_reg),__float_as_uint(l_reg),false,false);l_reg=__uint_as_float(rr[0])+__uint_as_float(rr[1]);}
  if(hi==0)wsf[32+r32]=l_reg;asm volatile("s_waitcnt lgkmcnt(0)":::"memory");
  float rli[16];
  #pragma unroll
  for(int r=0;r<16;++r)rli[r]=__builtin_amdgcn_rcpf(wsf[32+crow(r,hi)]);
  bf16*Ow=O+(rowbase+q0+wid*QBLK)*OP+ocol;
  { bf16*stg=(bf16*)(shm+LDS_OST)+wid*2048;
    #pragma unroll
    for(int r=0;r<16;++r){const int orow=crow(r,hi);
      #pragma unroll
      for(int d0=0;d0<2;++d0)stg[orow*64+d0*32+r32]=__float2bfloat16(o[d0][r]*rli[r]);}
    asm volatile("s_waitcnt lgkmcnt(0)":::"memory");
    #pragma unroll
    for(int i=0;i<4;++i){const int row=i*8+(lane>>3),ch=lane&7; const u32x4 v=*(const u32x4*)(stg+row*64+ch*8); ATTN_STORE16(Ow+(long)row*OP+ch*8,v);} }
  asm volatile("s_waitcnt lgkmcnt(0)\n\ts_barrier":::"memory");
  #undef DMA_K
  #undef DMA_V
  #undef CMASK
  #undef START
  #undef RESC
  #undef ROT
}
constexpr int ATTN_LDS_BYTES=LDS_BYTES;
#undef SBAR
#undef WAIT_BAR
}

#define LAS __attribute__((address_space(3)))
#define LDS_BARRIER() asm volatile("s_waitcnt lgkmcnt(0)\n\ts_barrier" ::: "memory")
typedef unsigned short bf16;
typedef unsigned u32x4_t __attribute__((ext_vector_type(4)));
typedef unsigned u32x2_t __attribute__((ext_vector_type(2)));
typedef float f32x4_t __attribute__((ext_vector_type(4)));
typedef float f32x2_t __attribute__((ext_vector_type(2)));

constexpr int DM = 1024, MTOK = 49152, NSEQ = 20, DFF = 2816, NFF = 5632, NMIXP = 2560, NMIX = 2432, ZP = 1792;
constexpr int NTHR = 512;
constexpr float QSCALE = 0.125f * 1.4426950408889634f;
constexpr size_t MiB = 1u << 20;
constexpr size_t ZERO_BYTES = 8 * MiB;
constexpr size_t OFF_CTR = 0, OFF_ROPE = 32768, OFF_SS = 65536, OFF_MOD = 2 * MiB, OFF_BIAS = 4 * MiB, OFF_GV = 7 * MiB, OFF_GATE = 7 * MiB + 512 * 1024;
constexpr size_t OFF_W = 8 * MiB, W_LAYER = 40 * MiB;
constexpr size_t WO_IN = 0, WO_OUT = 22 * MiB, WO_MI = 33 * MiB, WO_MO = 38 * MiB;
constexpr size_t OFF_XN = 88 * MiB, OFF_YF = 88 * MiB, OFF_YB = 136 * MiB;
constexpr size_t OFF_HID = 184 * MiB, OFF_Z = 184 * MiB, OFF_QK = 352 * MiB, OFF_VR = 400 * MiB, OFF_OMIX = 412 * MiB, WS_END = 508 * MiB;
constexpr size_t OFF_SMID = 508 * MiB;
constexpr int LDS_BYTES = 147456, MISC_OFF = 131072;

struct KP { const float* in[31]; float* out; unsigned char* ws; };

__device__ __forceinline__ int seq_of_row(int m) { return m < 16384 ? (m >> 12) : 4 + ((m - 16384) >> 11); }
__device__ __forceinline__ int seq_start(int s) { return s < 4 ? s * 4096 : 16384 + (s - 4) * 2048; }
__device__ __forceinline__ int seq_len(int s) { return s < 4 ? 4096 : 2048; }
__device__ __forceinline__ unsigned f2bf(float f) { unsigned u = __builtin_bit_cast(unsigned, f); return (u + 0x7fffu + ((u >> 16) & 1u)) >> 16; }
__device__ __forceinline__ unsigned pk2(float lo, float hi) { return f2bf(lo) | (f2bf(hi) << 16); }
__device__ __forceinline__ float bf2f(unsigned short b) { return __builtin_bit_cast(float, (unsigned)b << 16); }
__device__ __forceinline__ float sigmoidf_(float x) { return __builtin_amdgcn_rcpf(1.0f + __builtin_amdgcn_exp2f(-1.4426950408889634f * x)); }
#define DPP_ADD(v, CTRL) ((v) + __builtin_bit_cast(float, __builtin_amdgcn_update_dpp(0, __builtin_bit_cast(int, (v)), (CTRL), 0xf, 0xf, false)))
__device__ __forceinline__ float wave_sum(float v) {
    v = DPP_ADD(v, 0xB1);
    v = DPP_ADD(v, 0x4E);
    v = DPP_ADD(v, 0x141);
    v = DPP_ADD(v, 0x140);
    const f32x4_t d = __builtin_amdgcn_mfma_f32_16x16x4f32(1.0f, v, (f32x4_t){0.f, 0.f, 0.f, 0.f}, 0, 0, 0);
    return d[0];
}
__device__ __forceinline__ float tanh_fast(float x) { const float e = __expf(2.0f * x); return 1.0f - 2.0f * __builtin_amdgcn_rcpf(e + 1.0f); }
__host__ __device__ __forceinline__ int map_ffn(int n) { const int half = n >= DFF ? 1 : 0; const int n2 = half ? n - DFF : n; return 256 * (n2 >> 7) + 128 * half + (n2 & 127); }
__host__ __device__ __forceinline__ int map_mix(int n) {
    if (n < 1792 || n >= 2304) return n;
    const int hh = (n - 1792) >> 6, d = (n - 1792) & 63;
    return 256 * (7 + (hh >> 2)) + 128 * (d >> 5) + 32 * (hh & 3) + 8 * ((d & 15) >> 2) + 4 * ((d >> 4) & 1) + (d & 3);
}

namespace pg8 {
struct EpiSwiglu {
    static constexpr bool PERM = true, AFTER_DRAIN = false;
    bf16_t* H; const float* ss; const float* bias;
    __device__ __forceinline__ void operator()(const f32x4 (&acc)[2][2][4][2], const Unit& u, int wr, int wc, int fr, int fq) const {
        const int row0 = u.pm * BM + wr * 64 + fr; const int s = seq_of_row(u.pm * BM);
        const float* bp = bias + (size_t)s * NFF + u.pn * 256 + wc * 32 + 8 * fq;
        f32x4 bg[2], bu[2];
#pragma unroll
        for (int n = 0; n < 2; ++n) { bg[n] = *(const f32x4*)(bp + 4 * n); bu[n] = *(const f32x4*)(bp + 128 + 4 * n); }
        float rsv[2][4];
#pragma unroll
        for (int ai = 0; ai < 2; ++ai)
#pragma unroll
            for (int m = 0; m < 4; ++m) rsv[ai][m] = ss[row0 + ai * HALF + m * 16];
        asm volatile("" ::: "memory");
#pragma unroll
        for (int ai = 0; ai < 2; ++ai)
#pragma unroll
            for (int m = 0; m < 4; ++m) {
                const int row = row0 + ai * HALF + m * 16;
                const float rs = rsqrtf(rsv[ai][m] * (1.0f / 1024.0f) + 1e-6f);
                float h[8];
#pragma unroll
                for (int n = 0; n < 2; ++n) {
                    const f32x4 g = acc[ai][0][m][n] * rs + bg[n], up = acc[ai][1][m][n] * rs + bu[n];
#pragma unroll
                    for (int i = 0; i < 4; ++i) h[4 * n + i] = g[i] * sigmoidf_(g[i]) * up[i];
                }
                u32x4 w; w.x = cvt_pk_bf16(h[0], h[1]); w.y = cvt_pk_bf16(h[2], h[3]); w.z = cvt_pk_bf16(h[4], h[5]); w.w = cvt_pk_bf16(h[6], h[7]);
                *(u32x4*)(H + (size_t)row * DFF + u.pn * 128 + wc * 32 + 8 * fq) = w;
            }
    }
};
struct EpiZ {
    static constexpr bool PERM = true, AFTER_DRAIN = false;
    bf16_t* Z; bf16_t* QK; bf16_t* VR; const float* ss; const float* bias; const float* qg; const float* kg; const float* rope;
    __device__ __forceinline__ void operator()(const f32x4 (&acc)[2][2][4][2], const Unit& u, int wr, int wc, int fr, int fq) const {
        const int row0 = u.pm * BM + wr * 64 + fr; const int s = seq_of_row(u.pm * BM); const int t0 = row0 - seq_start(s);
        const float* bp = bias + (size_t)s * NFF + u.pn * 256 + wc * 32 + 8 * fq;
        f32x4 bv[2][2];
#pragma unroll
        for (int bj = 0; bj < 2; ++bj)
#pragma unroll
            for (int n = 0; n < 2; ++n) bv[bj][n] = *(const f32x4*)(bp + bj * 128 + 4 * n);
        if (u.pn < 7 || u.pn == 9) {
            float rsv[2][4];
#pragma unroll
            for (int ai = 0; ai < 2; ++ai)
#pragma unroll
                for (int m = 0; m < 4; ++m) rsv[ai][m] = ss[row0 + ai * HALF + m * 16];
            asm volatile("" ::: "memory");
#pragma unroll
            for (int ai = 0; ai < 2; ++ai)
#pragma unroll
                for (int m = 0; m < 4; ++m) {
                    const int row = row0 + ai * HALF + m * 16;
                    const float rs = rsqrtf(rsv[ai][m] * (1.0f / 1024.0f) + 1e-6f);
#pragma unroll
                    for (int bj = 0; bj < 2; ++bj) {
                        const f32x4 v0 = acc[ai][bj][m][0] * rs + bv[bj][0], v1 = acc[ai][bj][m][1] * rs + bv[bj][1];
                        u32x4 w; w.x = cvt_pk_bf16(v0[0], v0[1]); w.y = cvt_pk_bf16(v0[2], v0[3]); w.z = cvt_pk_bf16(v1[0], v1[1]); w.w = cvt_pk_bf16(v1[2], v1[3]);
                        if (u.pn < 7) *(u32x4*)(Z + (size_t)row * ZP + u.pn * 256 + bj * 128 + wc * 32 + 8 * fq) = w;
                        else if (bj == 0) *(u32x4*)(VR + (size_t)row * 128 + wc * 32 + 8 * fq) = w;
                    }
                }
        } else {
            const int hh = (u.pn - 7) * 4 + wc; const bool isq = hh < 6; const float* gp = isq ? qg : kg; const float osc = isq ? QSCALE : 1.0f;
            f32x4 gn[2][2];
#pragma unroll
            for (int bj = 0; bj < 2; ++bj)
#pragma unroll
                for (int n = 0; n < 2; ++n) gn[bj][n] = *(const f32x4*)(gp + 32 * bj + 16 * n + 4 * fq);
#pragma unroll
            for (int ai = 0; ai < 2; ++ai)
#pragma unroll
                for (int m = 0; m < 4; ++m) {
                    const int row = row0 + ai * HALF + m * 16; const int t = t0 + ai * HALF + m * 16;
                    const float rs = rsqrtf(ss[row] * (1.0f / 1024.0f) + 1e-6f);
                    f32x4 v[2][2]; float q = 0.f;
#pragma unroll
                    for (int bj = 0; bj < 2; ++bj)
#pragma unroll
                        for (int n = 0; n < 2; ++n) { v[bj][n] = acc[ai][bj][m][n] * rs + bv[bj][n]; q += (v[bj][n][0] * v[bj][n][0] + v[bj][n][1] * v[bj][n][1]) + (v[bj][n][2] * v[bj][n][2] + v[bj][n][3] * v[bj][n][3]); }
                    q += __shfl_xor(q, 16); q += __shfl_xor(q, 32);
                    const float r = rsqrtf(q * (1.0f / 64.0f) + 1e-6f);
#pragma unroll
                    for (int bj = 0; bj < 2; ++bj) {
                        const int pos = bj == 0 ? (t >> 6) : (t & 63);
                        const f32x4 x1 = v[bj][0] * r * gn[bj][0], x2 = v[bj][1] * r * gn[bj][1];
                        const float* rp = rope + (pos * 16 + 4 * fq) * 2;
                        const f32x4 cs0 = *(const f32x4*)(rp), cs1 = *(const f32x4*)(rp + 4);
                        const float c[4] = {cs0[0], cs0[2], cs1[0], cs1[2]}, sn[4] = {cs0[1], cs0[3], cs1[1], cs1[3]};
                        float o1[4], o2[4];
#pragma unroll
                        for (int i = 0; i < 4; ++i) { o1[i] = (x1[i] * c[i] - x2[i] * sn[i]) * osc; o2[i] = (x2[i] * c[i] + x1[i] * sn[i]) * osc; }
                        u32x4 w; w.x = cvt_pk_bf16(o1[0], o1[1]); w.y = cvt_pk_bf16(o1[2], o1[3]); w.z = cvt_pk_bf16(o2[0], o2[1]); w.w = cvt_pk_bf16(o2[2], o2[3]);
                        *(u32x4*)(QK + (size_t)row * 512 + hh * 64 + 32 * bj + 8 * fq) = w;
                    }
                }
        }
    }
};
struct EpiResid {
    static constexpr bool PERM = false, AFTER_DRAIN = false;
    const float* xin_p; const float* xin_s; float* out; bf16_t* xn; float* ssn; const float* gate; const float* gvn;
    __device__ __forceinline__ void operator()(const f32x4 (&acc)[2][2][4][2], const Unit& u, int wr, int wc, int fr, int fq) const {
        const int rowt = u.pm * BM; const int s = seq_of_row(rowt);
        const float* xb = rowt < 16384 ? xin_p : xin_s - (size_t)16384 * DM;
        const int row0 = rowt + wr * 64 + fr; const int col0 = u.pn * BM + wc * 32 + 4 * fq;
        f32x4 gt[2][2], gv[2][2];
#pragma unroll
        for (int bj = 0; bj < 2; ++bj)
#pragma unroll
            for (int n = 0; n < 2; ++n) { gt[bj][n] = *(const f32x4*)(gate + (size_t)s * DM + col0 + bj * HALF + n * 16); gv[bj][n] = gvn ? *(const f32x4*)(gvn + (size_t)s * DM + col0 + bj * HALF + n * 16) : (f32x4){0.f, 0.f, 0.f, 0.f}; }
        f32x4 xo[2][2][2];
#define ER_LOAD(G, BUF) do { const unsigned off_ = (unsigned)(row0 + ((G) >> 2) * HALF + ((G) & 3) * 16) * DM + col0; \
            _Pragma("unroll") for (int bj = 0; bj < 2; ++bj) _Pragma("unroll") for (int n = 0; n < 2; ++n) xo[BUF][bj][n] = *(const f32x4*)(xb + off_ + bj * HALF + n * 16); } while (0)
        ER_LOAD(0, 0);
#pragma unroll
        for (int gi = 0; gi < 8; ++gi) {
            const int ai = gi >> 2, m = gi & 3;
            if (gi < 7) ER_LOAD(gi + 1, (gi + 1) & 1);
            asm volatile("" ::: "memory");
            const int row = row0 + ai * HALF + m * 16; const unsigned off = (unsigned)row * DM + col0; float q = 0.f;
#pragma unroll
            for (int bj = 0; bj < 2; ++bj)
#pragma unroll
                for (int n = 0; n < 2; ++n) {
                    const f32x4 val = xo[gi & 1][bj][n] + gt[bj][n] * acc[ai][bj][m][n];
                    *(f32x4*)(out + off + bj * HALF + n * 16) = val;
                    if (gvn) {
                        q += (val[0] * val[0] + val[1] * val[1]) + (val[2] * val[2] + val[3] * val[3]);
                        const f32x4 o = val * gv[bj][n]; unsigned long long w = (unsigned long long)cvt_pk_bf16(o[0], o[1]) | ((unsigned long long)cvt_pk_bf16(o[2], o[3]) << 32);
                        *(unsigned long long*)(xn + off + bj * HALF + n * 16) = w;
                    }
                }
            if (gvn) { q += __shfl_xor(q, 16); q += __shfl_xor(q, 32); if (fq == 0) atomicAdd(ssn + row, q); }
        }
#undef ER_LOAD
    }
};
}

template <int MAP> __device__ __forceinline__ void transpose_item(const float* W, int K, int N, bf16* WT, float* scr, int item, int lane) {
    const int nblk = N / 32, kb = item / nblk, nb = item % nblk, k0 = 64 * kb, n0 = 32 * nb;
#pragma unroll 8
    for (int i = 0; i < 32; ++i) { const int kk = 2 * i + (lane >> 5); scr[kk * 33 + (lane & 31)] = W[(size_t)(k0 + kk) * N + n0 + (lane & 31)]; }
    __builtin_amdgcn_wave_barrier(); asm volatile("s_waitcnt lgkmcnt(0)" ::: "memory");
    const int c = lane & 7;
#pragma unroll
    for (int j = 0; j < 4; ++j) { const int n = (lane >> 3) + 8 * j; const float* sp = scr + (8 * c) * 33 + n;
        u32x4_t o; o.x = pk2(sp[0 * 33], sp[1 * 33]); o.y = pk2(sp[2 * 33], sp[3 * 33]); o.z = pk2(sp[4 * 33], sp[5 * 33]); o.w = pk2(sp[6 * 33], sp[7 * 33]);
        const int nsrc = n0 + n; const int nd = MAP == 1 ? map_ffn(nsrc) : (MAP == 2 ? map_mix(nsrc) : nsrc);
        *(u32x4_t*)(WT + (size_t)nd * K + k0 + 8 * c) = o; }
    __builtin_amdgcn_wave_barrier(); asm volatile("s_waitcnt lgkmcnt(0)" ::: "memory");
}

template <int MODE, int MAP> __device__ __forceinline__ void smallm_unit(const KP& p, float* sA, int l, int j, const float* W, int ldw, int nvalid, float* dest, int ldd, int nchunk, int kchunk) {
    int tid_o = threadIdx.x; asm volatile("" : "+v"(tid_o)); const int tid = tid_o; const int k0 = kchunk * 128;
    __syncthreads();
    for (int e = tid; e < 128 * NSEQ; e += NTHR) {
        const int k = e / NSEQ, s = e % NSEQ; float v;
        if (MODE == 0) { const float c = s < 4 ? p.in[2][s * DM + k0 + k] : p.in[3][(s - 4) * DM + k0 + k]; v = c * sigmoidf_(c); }
        else { const float* mod = (const float*)(p.ws + OFF_MOD) + ((size_t)l * NSEQ + s) * 9216 + 3 * j * 1024 + k0 + k; v = *mod + p.in[5][l * 9216 + 3 * j * 1024 + k0 + k]; }
        sA[k * NSEQ + s] = v;
    }
    __syncthreads();
    const int n = nchunk * 256 + (tid & 255), kh = tid >> 8;
    float acc[NSEQ];
#pragma unroll
    for (int s = 0; s < NSEQ; ++s) acc[s] = 0.f;
    if (n < nvalid) {
        for (int kb = 0; kb < 64; kb += 16) {
            float wv[16];
#pragma unroll
            for (int u = 0; u < 16; ++u) wv[u] = W[(size_t)(k0 + kh * 64 + kb + u) * ldw + n];
#pragma unroll
            for (int u = 0; u < 16; ++u) { const int k = kh * 64 + kb + u; const float w = wv[u];
                const f32x4_t* ap = (const f32x4_t*)(sA + k * NSEQ);
#pragma unroll
                for (int q = 0; q < 5; ++q) { const f32x4_t a = ap[q]; acc[4 * q] += a[0] * w; acc[4 * q + 1] += a[1] * w; acc[4 * q + 2] += a[2] * w; acc[4 * q + 3] += a[3] * w; } }
        }
        const int nd = MAP == 1 ? map_ffn(n) : (MAP == 2 ? map_mix(n) : n);
#pragma unroll
        for (int s = 0; s < NSEQ; ++s) atomicAdd(dest + (size_t)s * ldd + nd, acc[s]);
    }
}

#define DPP_FMAC(acc, x, s, J) asm volatile("v_fmac_f32_dpp %0, %1, %2 row_newbcast:" #J " row_mask:0xf bank_mask:0xf" : "+v"(acc) : "v"(x), "v"(s))
#define DPP_FMAC_N(acc, x, s, J) asm volatile("s_nop 1\n\tv_fmac_f32_dpp %0, %1, %2 row_newbcast:" #J " row_mask:0xf bank_mask:0xf" : "+v"(acc) : "v"(x), "v"(s))
#define DPP_MUL(s, x, J) asm volatile("v_mul_f32_dpp %0, %1, %0 row_newbcast:" #J " row_mask:0xf bank_mask:0xf" : "+v"(s) : "v"(x))
#define DPP_MUL_N(s, x, J) asm volatile("s_nop 1\n\tv_mul_f32_dpp %0, %1, %0 row_newbcast:" #J " row_mask:0xf bank_mask:0xf" : "+v"(s) : "v"(x))
#define REP15(M, X) M(1, X) M(2, X) M(3, X) M(4, X) M(5, X) M(6, X) M(7, X) M(8, X) M(9, X) M(10, X) M(11, X) M(12, X) M(13, X) M(14, X) M(15, X)
__device__ __forceinline__ float row4_sum(float x) {
    auto r1 = __builtin_amdgcn_permlane16_swap(__float_as_uint(x), __float_as_uint(x), false, false); x = __uint_as_float(r1[0]) + __uint_as_float(r1[1]);
    auto r2 = __builtin_amdgcn_permlane32_swap(__float_as_uint(x), __float_as_uint(x), false, false); return __uint_as_float(r2[0]) + __uint_as_float(r2[1]);
}
__device__ __forceinline__ void rwkv_unit(const KP& p, unsigned char* lds, int l, int s, int h, int d, int mode) {
    int tid_o = threadIdx.x; asm volatile("" : "+v"(tid_o)); const int tid = tid_o, lane = tid & 63; const int wid = __builtin_amdgcn_readfirstlane(tid >> 6);
    constexpr int TB = 16;
    f32x2_t* W2 = (f32x2_t*)lds;
    float* OPS = (float*)(lds + 32768);
    float* YBUF = (float*)(lds + 32768 + 49152);
    float* PWS = (float*)(lds + 32768 + 49152 + 8192) + (wid & 3) * 1024;
    const bf16* Z = (const bf16*)(p.ws + OFF_Z);
    float* Y = (float*)(p.ws + (d == 0 ? OFF_YF : OFF_YB));
    const float* mu = p.in[18] + l * 1024;
    const float* w_up = p.in[19] + ((size_t)l * 2 + d) * 64 * 256;
    const float* a_up = p.in[21] + (size_t)l * 64 * 256;
    const int S = seq_len(s), start = seq_start(s); const int NS = mode == 0 ? S : S / 2, s0 = mode >= 2 ? S / 2 : 0; const int NB = NS / TB;
    __syncthreads();
    for (int e = tid; e < 4096; e += NTHR) { const int i = e >> 6, j = e & 63; W2[e] = (f32x2_t){w_up[i * 256 + 64 * h + j], a_up[i * 256 + 64 * h + j]}; }
    __syncthreads();
    if (wid >= 4) {
        const int pw = wid - 4;
        unsigned short* XWb = (unsigned short*)PWS; unsigned short* XAb = XWb + 256; float* KK = PWS + 256; float* UA = PWS + 512;
        typedef short bf16x8_t __attribute__((ext_vector_type(8)));
        bf16x8_t Bf[2][4][2];
        { const int kg = lane >> 4, cl = 64 * h + (lane & 15);
          _Pragma("unroll") for (int m = 0; m < 2; ++m) _Pragma("unroll") for (int ct = 0; ct < 4; ++ct) _Pragma("unroll") for (int ks = 0; ks < 2; ++ks) {
              const float* Wm = (m == 0 ? w_up : a_up) + (size_t)(32 * ks + 8 * kg) * 256 + cl + 16 * ct; u32x4_t pq;
              pq.x = pk2(Wm[0], Wm[256]); pq.y = pk2(Wm[512], Wm[768]); pq.z = pk2(Wm[1024], Wm[1280]); pq.w = pk2(Wm[1536], Wm[1792]); Bf[m][ct][ks] = __builtin_bit_cast(bf16x8_t, pq); } }
        const float w0 = p.in[20][(l * 2 + d) * 256 + 64 * h + lane], a0 = p.in[22][(l * 2 + d) * 256 + 64 * h + lane];
        const float k_k = p.in[24][l * 256 + 64 * h + lane], k_a = p.in[25][l * 256 + 64 * h + lane];
        int it_t[3], it_zc[3], it_g[3], it_w[3]; f32x4_t mu0[3], mu1[3];
#pragma unroll
        for (int i = 0; i < 3; ++i) { int e = lane + 64 * i; if (e > 159) e = 159; const int t = e / 40, c = e % 40, g = c >> 3, wi = (c & 7) * 8;
            it_t[i] = t; it_g[i] = g; it_w[i] = wi; it_zc[i] = (g == 0 ? 64 * h : g == 1 ? 256 + 64 * h : g == 2 ? 512 + 64 * h : 768 + (g - 3) * 64) + wi;
            mu0[i] = *(const f32x4_t*)(mu + it_zc[i]); mu1[i] = *(const f32x4_t*)(mu + it_zc[i] + 4); }
        u32x4_t rc[3], rp[3], rn[3];
#define RW_ISSUE(b_) do { _Pragma("unroll") for (int i = 0; i < 3; ++i) { const int si = s0 + (b_) * TB + 4 * pw + it_t[i]; const int tt = d == 0 ? si : S - 1 - si; const bf16* zp = Z + (size_t)(start + tt) * ZP + 768 + it_zc[i]; \
                rc[i] = *(const u32x4_t*)zp; rp[i] = tt > 0 ? *(const u32x4_t*)(zp - ZP) : (u32x4_t){0u, 0u, 0u, 0u}; rn[i] = tt < S - 1 ? *(const u32x4_t*)(zp + ZP) : (u32x4_t){0u, 0u, 0u, 0u}; } } while (0)
#define RW_PREP(b_) do { \
            float* ops = OPS + ((b_) & 1) * (TB * 384); \
            _Pragma("unroll") for (int i = 0; i < 3; ++i) if (lane + 64 * i < 160) { \
                float fs[8]; \
                _Pragma("unroll") for (int q = 0; q < 4; ++q) { \
                    const float c0 = __builtin_bit_cast(float, rc[i][q] << 16), c1 = __builtin_bit_cast(float, rc[i][q] & 0xffff0000u); \
                    const float p0 = __builtin_bit_cast(float, rp[i][q] << 16), p1 = __builtin_bit_cast(float, rp[i][q] & 0xffff0000u); \
                    const float n0 = __builtin_bit_cast(float, rn[i][q] << 16), n1 = __builtin_bit_cast(float, rn[i][q] & 0xffff0000u); \
                    const float m0 = q < 2 ? mu0[i][2 * q] : mu1[i][2 * q - 4], m1 = q < 2 ? mu0[i][2 * q + 1] : mu1[i][2 * q - 3]; \
                    fs[2 * q] = c0 + m0 * (0.5f * (p0 + n0) - c0); fs[2 * q + 1] = c1 + m1 * (0.5f * (p1 + n1) - c1); \
                } \
                const int t = it_t[i], tl = 4 * pw + t, g = it_g[i], wi = it_w[i]; \
                if (g == 0) { *(f32x4_t*)(ops + tl * 384 + 256 + wi) = (f32x4_t){fs[0], fs[1], fs[2], fs[3]}; *(f32x4_t*)(ops + tl * 384 + 256 + wi + 4) = (f32x4_t){fs[4], fs[5], fs[6], fs[7]}; } \
                else if (g == 2) { if (mode == 3) { _Pragma("unroll") for (int q = 0; q < 8; ++q) fs[q] = 0.f; } *(f32x4_t*)(ops + tl * 384 + 320 + wi) = (f32x4_t){fs[0], fs[1], fs[2], fs[3]}; *(f32x4_t*)(ops + tl * 384 + 320 + wi + 4) = (f32x4_t){fs[4], fs[5], fs[6], fs[7]}; } \
                else if (g == 1) { *(f32x4_t*)(KK + t * 64 + wi) = (f32x4_t){fs[0], fs[1], fs[2], fs[3]}; *(f32x4_t*)(KK + t * 64 + wi + 4) = (f32x4_t){fs[4], fs[5], fs[6], fs[7]}; } \
                else if (g == 3) { u32x4_t pq; pq.x = pk2(tanh_fast(fs[0]), tanh_fast(fs[1])); pq.y = pk2(tanh_fast(fs[2]), tanh_fast(fs[3])); pq.z = pk2(tanh_fast(fs[4]), tanh_fast(fs[5])); pq.w = pk2(tanh_fast(fs[6]), tanh_fast(fs[7])); *(u32x4_t*)(XWb + t * 64 + wi) = pq; } \
                else { u32x4_t pq; pq.x = pk2(fs[0], fs[1]); pq.y = pk2(fs[2], fs[3]); pq.z = pk2(fs[4], fs[5]); pq.w = pk2(fs[6], fs[7]); *(u32x4_t*)(XAb + t * 64 + wi) = pq; } \
            } \
            if ((b_) + 1 < NB) RW_ISSUE((b_) + 1); \
            { const int arow = lane & 15, akg = lane >> 4; \
              _Pragma("unroll") for (int m = 0; m < 2; ++m) { \
                bf16x8_t Af[2]; \
                _Pragma("unroll") for (int ks = 0; ks < 2; ++ks) { u32x4_t raw = *(const u32x4_t*)((m ? XAb : XWb) + (arow & 3) * 64 + 32 * ks + 8 * akg); if (arow >= 4) raw = (u32x4_t){0u, 0u, 0u, 0u}; Af[ks] = __builtin_bit_cast(bf16x8_t, raw); } \
                _Pragma("unroll") for (int ct = 0; ct < 4; ++ct) { f32x4_t am = (f32x4_t){0.f, 0.f, 0.f, 0.f}; \
                    am = __builtin_amdgcn_mfma_f32_16x16x32_bf16(Af[0], Bf[m][ct][0], am, 0, 0, 0); am = __builtin_amdgcn_mfma_f32_16x16x32_bf16(Af[1], Bf[m][ct][1], am, 0, 0, 0); \
                    if (lane < 16) { UA[(m * 4 + 0) * 64 + 16 * ct + lane] = am[0]; UA[(m * 4 + 1) * 64 + 16 * ct + lane] = am[1]; UA[(m * 4 + 2) * 64 + 16 * ct + lane] = am[2]; UA[(m * 4 + 3) * 64 + 16 * ct + lane] = am[3]; } } } } \
            float cw = 1.0f; \
            _Pragma("unroll") for (int t = 0; t < 4; ++t) { \
                const int tl = 4 * pw + t; const float k = KK[t * 64 + lane]; const float kkv = k * k_k; \
                const float n2 = wave_sum(kkv * kkv); const float kk = kkv * __builtin_amdgcn_rsqf(fmaxf(n2, 1e-24f)); \
                const float wdec = __expf(-0.6065306597126334f * sigmoidf_(w0 + UA[t * 64 + lane])); const float a = sigmoidf_(a0 + UA[(4 + t) * 64 + lane]); \
                float* o = ops + tl * 384 + lane; const float cwp = cw; cw *= wdec; const float icw = __builtin_amdgcn_rcpf(cw); const float rq = o[256]; \
                o[0] = -kk * cwp; o[64] = cw; o[128] = kk * a * icw; o[192] = k * (1.0f + (a - 1.0f) * k_a) * icw; o[256] = rq * cw; \
            } } while (0)
#define RW_YFLUSH(b_) do { const float* ybp = YBUF + ((b_) & 1) * (TB * 64); \
            _Pragma("unroll") for (int t = 0; t < 4; ++t) { const int si = s0 + (b_) * TB + 4 * pw + t; const int tt = d == 0 ? si : S - 1 - si; float* yp_ = Y + (size_t)(start + tt) * 256 + 64 * h; const float yv_ = ybp[(4 * pw + t) * 64 + lane]; \
                if (mode < 2) yp_[lane] = yv_; else ((unsigned short*)yp_)[(mode == 3 ? 64 : 0) + lane] = (unsigned short)f2bf(yv_); } } while (0)
        RW_ISSUE(0); RW_PREP(0);
        LDS_BARRIER();
        for (int b = 0; b < NB; ++b) {
            if (b > 0) RW_YFLUSH(b - 1);
            if (b + 1 < NB) RW_PREP(b + 1);
            LDS_BARRIER();
        }
        RW_YFLUSH(NB - 1);
#undef RW_ISSUE
#undef RW_PREP
#undef RW_YFLUSH
    } else {
        __builtin_amdgcn_s_setprio(3);
        float st[16];
#pragma unroll
        for (int i = 0; i < 16; ++i) st[i] = (mode == 3 && 16 * (lane >> 4) + i == 16 * wid + (lane & 15)) ? 1.0f : 0.f;
        const int vofs = 320 + 16 * wid + (lane & 15);
        LDS_BARRIER();
        for (int b = 0; b < NB; ++b) {
            const float* ops = OPS + (b & 1) * (TB * 384); float* yb = YBUF + (b & 1) * (TB * 64);
            float xn = ops[lane], xw = ops[64 + lane], xb = ops[128 + lane], xk = ops[192 + lane], xr = ops[256 + lane], vv = ops[vofs];
#pragma unroll 2
            for (int t = 0; t < TB; ++t) {
                const float* nx = ops + (t + 1 < TB ? t + 1 : t) * 384;
                const float nxn = nx[lane], nxw = nx[64 + lane], nxb = nx[128 + lane], nxk = nx[192 + lane], nxr = nx[256 + lane], nvv = nx[vofs];
                float sa0, sa1, sa2, sa3;
                asm volatile("v_mul_f32_dpp %0, %20, %4 row_newbcast:0 row_mask:0xf bank_mask:0xf\n\tv_mul_f32_dpp %1, %20, %5 row_newbcast:1 row_mask:0xf bank_mask:0xf\n\tv_mul_f32_dpp %2, %20, %6 row_newbcast:2 row_mask:0xf bank_mask:0xf\n\tv_mul_f32_dpp %3, %20, %7 row_newbcast:3 row_mask:0xf bank_mask:0xf\n\tv_fmac_f32_dpp %0, %20, %8 row_newbcast:4 row_mask:0xf bank_mask:0xf\n\tv_fmac_f32_dpp %1, %20, %9 row_newbcast:5 row_mask:0xf bank_mask:0xf\n\tv_fmac_f32_dpp %2, %20, %10 row_newbcast:6 row_mask:0xf bank_mask:0xf\n\tv_fmac_f32_dpp %3, %20, %11 row_newbcast:7 row_mask:0xf bank_mask:0xf\n\tv_fmac_f32_dpp %0, %20, %12 row_newbcast:8 row_mask:0xf bank_mask:0xf\n\tv_fmac_f32_dpp %1, %20, %13 row_newbcast:9 row_mask:0xf bank_mask:0xf\n\tv_fmac_f32_dpp %2, %20, %14 row_newbcast:10 row_mask:0xf bank_mask:0xf\n\tv_fmac_f32_dpp %3, %20, %15 row_newbcast:11 row_mask:0xf bank_mask:0xf\n\tv_fmac_f32_dpp %0, %20, %16 row_newbcast:12 row_mask:0xf bank_mask:0xf\n\tv_fmac_f32_dpp %1, %20, %17 row_newbcast:13 row_mask:0xf bank_mask:0xf\n\tv_fmac_f32_dpp %2, %20, %18 row_newbcast:14 row_mask:0xf bank_mask:0xf\n\tv_fmac_f32_dpp %3, %20, %19 row_newbcast:15 row_mask:0xf bank_mask:0xf" : "=&v"(sa0), "=&v"(sa1), "=&v"(sa2), "=&v"(sa3) : "v"(st[0]), "v"(st[1]), "v"(st[2]), "v"(st[3]), "v"(st[4]), "v"(st[5]), "v"(st[6]), "v"(st[7]), "v"(st[8]), "v"(st[9]), "v"(st[10]), "v"(st[11]), "v"(st[12]), "v"(st[13]), "v"(st[14]), "v"(st[15]), "v"(xn));
                float sa = (sa0 + sa1) + (sa2 + sa3);
                { const f32x4_t da = __builtin_amdgcn_mfma_f32_16x16x4f32(1.0f, sa, (f32x4_t){0.f, 0.f, 0.f, 0.f}, 0, 0, 0); sa = da[0]; asm volatile("s_nop 15\n\ts_nop 3" : "+v"(sa)); }
                asm volatile("v_fmac_f32_dpp %0, %16, %17 row_newbcast:0 row_mask:0xf bank_mask:0xf\n\tv_fmac_f32_dpp %1, %16, %17 row_newbcast:1 row_mask:0xf bank_mask:0xf\n\tv_fmac_f32_dpp %2, %16, %17 row_newbcast:2 row_mask:0xf bank_mask:0xf\n\tv_fmac_f32_dpp %3, %16, %17 row_newbcast:3 row_mask:0xf bank_mask:0xf\n\tv_fmac_f32_dpp %4, %16, %17 row_newbcast:4 row_mask:0xf bank_mask:0xf\n\tv_fmac_f32_dpp %5, %16, %17 row_newbcast:5 row_mask:0xf bank_mask:0xf\n\tv_fmac_f32_dpp %6, %16, %17 row_newbcast:6 row_mask:0xf bank_mask:0xf\n\tv_fmac_f32_dpp %7, %16, %17 row_newbcast:7 row_mask:0xf bank_mask:0xf\n\tv_fmac_f32_dpp %8, %16, %17 row_newbcast:8 row_mask:0xf bank_mask:0xf\n\tv_fmac_f32_dpp %9, %16, %17 row_newbcast:9 row_mask:0xf bank_mask:0xf\n\tv_fmac_f32_dpp %10, %16, %17 row_newbcast:10 row_mask:0xf bank_mask:0xf\n\tv_fmac_f32_dpp %11, %16, %17 row_newbcast:11 row_mask:0xf bank_mask:0xf\n\tv_fmac_f32_dpp %12, %16, %17 row_newbcast:12 row_mask:0xf bank_mask:0xf\n\tv_fmac_f32_dpp %13, %16, %17 row_newbcast:13 row_mask:0xf bank_mask:0xf\n\tv_fmac_f32_dpp %14, %16, %17 row_newbcast:14 row_mask:0xf bank_mask:0xf\n\tv_fmac_f32_dpp %15, %16, %17 row_newbcast:15 row_mask:0xf bank_mask:0xf" : "+v"(st[0]), "+v"(st[1]), "+v"(st[2]), "+v"(st[3]), "+v"(st[4]), "+v"(st[5]), "+v"(st[6]), "+v"(st[7]), "+v"(st[8]), "+v"(st[9]), "+v"(st[10]), "+v"(st[11]), "+v"(st[12]), "+v"(st[13]), "+v"(st[14]), "+v"(st[15]) : "v"(xb), "v"(sa));
                asm volatile("v_fmac_f32_dpp %0, %16, %17 row_newbcast:0 row_mask:0xf bank_mask:0xf\n\tv_fmac_f32_dpp %1, %16, %17 row_newbcast:1 row_mask:0xf bank_mask:0xf\n\tv_fmac_f32_dpp %2, %16, %17 row_newbcast:2 row_mask:0xf bank_mask:0xf\n\tv_fmac_f32_dpp %3, %16, %17 row_newbcast:3 row_mask:0xf bank_mask:0xf\n\tv_fmac_f32_dpp %4, %16, %17 row_newbcast:4 row_mask:0xf bank_mask:0xf\n\tv_fmac_f32_dpp %5, %16, %17 row_newbcast:5 row_mask:0xf bank_mask:0xf\n\tv_fmac_f32_dpp %6, %16, %17 row_newbcast:6 row_mask:0xf bank_mask:0xf\n\tv_fmac_f32_dpp %7, %16, %17 row_newbcast:7 row_mask:0xf bank_mask:0xf\n\tv_fmac_f32_dpp %8, %16, %17 row_newbcast:8 row_mask:0xf bank_mask:0xf\n\tv_fmac_f32_dpp %9, %16, %17 row_newbcast:9 row_mask:0xf bank_mask:0xf\n\tv_fmac_f32_dpp %10, %16, %17 row_newbcast:10 row_mask:0xf bank_mask:0xf\n\tv_fmac_f32_dpp %11, %16, %17 row_newbcast:11 row_mask:0xf bank_mask:0xf\n\tv_fmac_f32_dpp %12, %16, %17 row_newbcast:12 row_mask:0xf bank_mask:0xf\n\tv_fmac_f32_dpp %13, %16, %17 row_newbcast:13 row_mask:0xf bank_mask:0xf\n\tv_fmac_f32_dpp %14, %16, %17 row_newbcast:14 row_mask:0xf bank_mask:0xf\n\tv_fmac_f32_dpp %15, %16, %17 row_newbcast:15 row_mask:0xf bank_mask:0xf" : "+v"(st[0]), "+v"(st[1]), "+v"(st[2]), "+v"(st[3]), "+v"(st[4]), "+v"(st[5]), "+v"(st[6]), "+v"(st[7]), "+v"(st[8]), "+v"(st[9]), "+v"(st[10]), "+v"(st[11]), "+v"(st[12]), "+v"(st[13]), "+v"(st[14]), "+v"(st[15]) : "v"(xk), "v"(vv));
                float y0, y1, y2, y3;
                asm volatile("v_mul_f32_dpp %0, %20, %4 row_newbcast:0 row_mask:0xf bank_mask:0xf\n\tv_mul_f32_dpp %1, %20, %5 row_newbcast:1 row_mask:0xf bank_mask:0xf\n\tv_mul_f32_dpp %2, %20, %6 row_newbcast:2 row_mask:0xf bank_mask:0xf\n\tv_mul_f32_dpp %3, %20, %7 row_newbcast:3 row_mask:0xf bank_mask:0xf\n\tv_fmac_f32_dpp %0, %20, %8 row_newbcast:4 row_mask:0xf bank_mask:0xf\n\tv_fmac_f32_dpp %1, %20, %9 row_newbcast:5 row_mask:0xf bank_mask:0xf\n\tv_fmac_f32_dpp %2, %20, %10 row_newbcast:6 row_mask:0xf bank_mask:0xf\n\tv_fmac_f32_dpp %3, %20, %11 row_newbcast:7 row_mask:0xf bank_mask:0xf\n\tv_fmac_f32_dpp %0, %20, %12 row_newbcast:8 row_mask:0xf bank_mask:0xf\n\tv_fmac_f32_dpp %1, %20, %13 row_newbcast:9 row_mask:0xf bank_mask:0xf\n\tv_fmac_f32_dpp %2, %20, %14 row_newbcast:10 row_mask:0xf bank_mask:0xf\n\tv_fmac_f32_dpp %3, %20, %15 row_newbcast:11 row_mask:0xf bank_mask:0xf\n\tv_fmac_f32_dpp %0, %20, %16 row_newbcast:12 row_mask:0xf bank_mask:0xf\n\tv_fmac_f32_dpp %1, %20, %17 row_newbcast:13 row_mask:0xf bank_mask:0xf\n\tv_fmac_f32_dpp %2, %20, %18 row_newbcast:14 row_mask:0xf bank_mask:0xf\n\tv_fmac_f32_dpp %3, %20, %19 row_newbcast:15 row_mask:0xf bank_mask:0xf" : "=&v"(y0), "=&v"(y1), "=&v"(y2), "=&v"(y3) : "v"(st[0]), "v"(st[1]), "v"(st[2]), "v"(st[3]), "v"(st[4]), "v"(st[5]), "v"(st[6]), "v"(st[7]), "v"(st[8]), "v"(st[9]), "v"(st[10]), "v"(st[11]), "v"(st[12]), "v"(st[13]), "v"(st[14]), "v"(st[15]), "v"(xr));
                const float yp = (y0 + y1) + (y2 + y3);
                const f32x4_t dy = __builtin_amdgcn_mfma_f32_16x16x4f32(1.0f, yp, (f32x4_t){0.f, 0.f, 0.f, 0.f}, 0, 0, 0);
                if (lane < 16) yb[t * 64 + 16 * wid + lane] = dy[0];
                if ((t & 3) == 3) {
                    asm volatile("v_mul_f32_dpp %0, %16, %0 row_newbcast:0 row_mask:0xf bank_mask:0xf\n\tv_mul_f32_dpp %1, %16, %1 row_newbcast:1 row_mask:0xf bank_mask:0xf\n\tv_mul_f32_dpp %2, %16, %2 row_newbcast:2 row_mask:0xf bank_mask:0xf\n\tv_mul_f32_dpp %3, %16, %3 row_newbcast:3 row_mask:0xf bank_mask:0xf\n\tv_mul_f32_dpp %4, %16, %4 row_newbcast:4 row_mask:0xf bank_mask:0xf\n\tv_mul_f32_dpp %5, %16, %5 row_newbcast:5 row_mask:0xf bank_mask:0xf\n\tv_mul_f32_dpp %6, %16, %6 row_newbcast:6 row_mask:0xf bank_mask:0xf\n\tv_mul_f32_dpp %7, %16, %7 row_newbcast:7 row_mask:0xf bank_mask:0xf\n\tv_mul_f32_dpp %8, %16, %8 row_newbcast:8 row_mask:0xf bank_mask:0xf\n\tv_mul_f32_dpp %9, %16, %9 row_newbcast:9 row_mask:0xf bank_mask:0xf\n\tv_mul_f32_dpp %10, %16, %10 row_newbcast:10 row_mask:0xf bank_mask:0xf\n\tv_mul_f32_dpp %11, %16, %11 row_newbcast:11 row_mask:0xf bank_mask:0xf\n\tv_mul_f32_dpp %12, %16, %12 row_newbcast:12 row_mask:0xf bank_mask:0xf\n\tv_mul_f32_dpp %13, %16, %13 row_newbcast:13 row_mask:0xf bank_mask:0xf\n\tv_mul_f32_dpp %14, %16, %14 row_newbcast:14 row_mask:0xf bank_mask:0xf\n\tv_mul_f32_dpp %15, %16, %15 row_newbcast:15 row_mask:0xf bank_mask:0xf" : "+v"(st[0]), "+v"(st[1]), "+v"(st[2]), "+v"(st[3]), "+v"(st[4]), "+v"(st[5]), "+v"(st[6]), "+v"(st[7]), "+v"(st[8]), "+v"(st[9]), "+v"(st[10]), "+v"(st[11]), "+v"(st[12]), "+v"(st[13]), "+v"(st[14]), "+v"(st[15]) : "v"(xw));
                }
                xn = nxn; xw = nxw; xb = nxb; xk = nxk; xr = nxr; vv = nvv;
            }
            LDS_BARRIER();
        }
        __builtin_amdgcn_s_setprio(0);
        if (mode == 1) { float* sm = (float*)(p.ws + OFF_SMID) + (size_t)((s * 4 + h) * 2 + d) * 4096 + 16 * wid + (lane & 15);
#pragma unroll
            for (int i = 0; i < 16; ++i) sm[(16 * (lane >> 4) + i) * 64] = st[i]; }
    }
}

__device__ __forceinline__ float gelu_tanh(float x) { const float u = 0.7978845608028654f * (x + 0.044715f * x * x * x); return x * __builtin_amdgcn_rcpf(1.0f + __builtin_amdgcn_exp2f(-2.885390081777927f * u)); }
__device__ __forceinline__ float neg_expm1_fast(float t) { const float ser = -t * (1.0f + t * (0.5f + t * (0.16666667f + t * (0.041666668f + t * 0.0083333338f)))); return t > -0.25f ? ser : 1.0f - __expf(t); }

__device__ __forceinline__ void lru_unit(const KP& p, unsigned char* lds, int l, int s, int n) {
    typedef short bf16x8_t __attribute__((ext_vector_type(8)));
    typedef float f32x16_t __attribute__((ext_vector_type(16)));
    int tid_o = threadIdx.x; asm volatile("" : "+v"(tid_o)); const int tid = tid_o, lane = tid & 63; const int wid = __builtin_amdgcn_readfirstlane(tid >> 6);
    float* XC = (float*)lds;
    unsigned short* XCb = (unsigned short*)(lds + 16384);
    float* GG = (float*)(lds + 24576);
    float* HF = (float*)(lds + 57344);
    float* YG = (float*)(lds + 73728);
    float* HO = (float*)(lds + 90112);
    float* SEG = (float*)(lds + 106496);
    const bf16* Z = (const bf16*)(p.ws + OFF_Z);
    bf16* OM = (bf16*)(p.ws + OFF_OMIX);
    const int S = seq_len(s), start = seq_start(s); const int NB = S / 64;
    const int t_ = tid >> 3, c8 = (tid & 7) * 8;
    const int r32 = lane & 31, hi = lane >> 5; const int gm = wid & 1, gth = (wid >> 1) & 1, gch = wid >> 2;
    f32x4_t cw0[4], cw1[4];
#pragma unroll
    for (int j = 0; j < 4; ++j) { cw0[j] = *(const f32x4_t*)(p.in[11] + l * 4 * 384 + j * 384 + 64 * n + c8); cw1[j] = *(const f32x4_t*)(p.in[11] + l * 4 * 384 + j * 384 + 64 * n + c8 + 4); }
    const f32x4_t cb0 = *(const f32x4_t*)(p.in[12] + l * 384 + 64 * n + c8), cb1 = *(const f32x4_t*)(p.in[12] + l * 384 + 64 * n + c8 + 4);
    for (int d = 0; d < 2; ++d) {
        const float* wg = (gm == 0 ? p.in[13] : p.in[15]) + (((size_t)l * 2 + d) * 6 + n) * 4096;
        const float gbias = (gm == 0 ? p.in[14] : p.in[16])[(l * 2 + d) * 384 + 64 * n + 32 * gch + r32];
        const float lm = -p.in[17][(l * 2 + d) * 384 + 64 * n + lane]; const float sp8 = -8.0f * (lm > 20.f ? lm : log1pf(__expf(lm)));
        bf16x8_t Bf[4];
#pragma unroll
        for (int ks = 0; ks < 4; ++ks) { const float* wp = wg + (size_t)(16 * ks + 8 * hi) * 64 + 32 * gch + r32; u32x4_t pq;
            pq.x = pk2(wp[0], wp[64]); pq.y = pk2(wp[128], wp[192]); pq.z = pk2(wp[256], wp[320]); pq.w = pk2(wp[384], wp[448]); Bf[ks] = __builtin_bit_cast(bf16x8_t, pq); }
        __threadfence();
        __syncthreads();
        float hcarry = 0.f;
        u32x4_t rr[4], rh, ry;
#define LRU_ISSUE(blk_) do { const int tt = d == 0 ? (blk_) * 64 + t_ : S - 1 - ((blk_) * 64 + t_); \
            _Pragma("unroll") for (int j = 0; j < 4; ++j) { const int t2 = tt - 2 + j; rr[j] = (t2 >= 0 && t2 < S) ? *(const u32x4_t*)(Z + (size_t)(start + t2) * ZP + 64 * n + c8) : (u32x4_t){0u, 0u, 0u, 0u}; } \
            if (d == 1) { rh = *(const u32x4_t*)(OM + (size_t)(start + tt) * DM + 64 * n + c8); ry = *(const u32x4_t*)(Z + (size_t)(start + tt) * ZP + 384 + 64 * n + c8); } } while (0)
        LRU_ISSUE(0);
        for (int blk = 0; blk < NB; ++blk) {
            LDS_BARRIER();
            {
                f32x4_t x0 = cb0, x1 = cb1;
#pragma unroll
                for (int j = 0; j < 4; ++j) {
                    const f32x4_t a = (f32x4_t){__builtin_bit_cast(float, rr[j][0] << 16), __builtin_bit_cast(float, rr[j][0] & 0xffff0000u), __builtin_bit_cast(float, rr[j][1] << 16), __builtin_bit_cast(float, rr[j][1] & 0xffff0000u)};
                    const f32x4_t b = (f32x4_t){__builtin_bit_cast(float, rr[j][2] << 16), __builtin_bit_cast(float, rr[j][2] & 0xffff0000u), __builtin_bit_cast(float, rr[j][3] << 16), __builtin_bit_cast(float, rr[j][3] & 0xffff0000u)};
                    x0 += cw0[j] * a; x1 += cw1[j] * b;
                }
                *(f32x4_t*)(XC + t_ * 64 + c8) = x0; *(f32x4_t*)(XC + t_ * 64 + c8 + 4) = x1;
                { u32x4_t pq; pq.x = pk2(x0[0], x0[1]); pq.y = pk2(x0[2], x0[3]); pq.z = pk2(x1[0], x1[1]); pq.w = pk2(x1[2], x1[3]); *(u32x4_t*)(XCb + t_ * 64 + c8) = pq; }
                if (d == 1) {
                    float hf[8], yg[8];
#pragma unroll
                    for (int q = 0; q < 4; ++q) { hf[2 * q] = __builtin_bit_cast(float, rh[q] << 16); hf[2 * q + 1] = __builtin_bit_cast(float, rh[q] & 0xffff0000u);
                        yg[2 * q] = gelu_tanh(__builtin_bit_cast(float, ry[q] << 16)); yg[2 * q + 1] = gelu_tanh(__builtin_bit_cast(float, ry[q] & 0xffff0000u)); }
                    *(f32x4_t*)(HF + t_ * 64 + c8) = (f32x4_t){hf[0], hf[1], hf[2], hf[3]}; *(f32x4_t*)(HF + t_ * 64 + c8 + 4) = (f32x4_t){hf[4], hf[5], hf[6], hf[7]};
                    *(f32x4_t*)(YG + t_ * 64 + c8) = (f32x4_t){yg[0], yg[1], yg[2], yg[3]}; *(f32x4_t*)(YG + t_ * 64 + c8 + 4) = (f32x4_t){yg[4], yg[5], yg[6], yg[7]};
                }
                if (blk + 1 < NB) LRU_ISSUE(blk + 1);
            }
            LDS_BARRIER();
            {
                f32x16_t acc = {};
#pragma unroll
                for (int ks = 0; ks < 4; ++ks) { const bf16x8_t af = *(const bf16x8_t*)(XCb + (32 * gth + r32) * 64 + 16 * ks + 8 * hi); acc = __builtin_amdgcn_mfma_f32_32x32x16_bf16(af, Bf[ks], acc, 0, 0, 0); }
#pragma unroll
                for (int r = 0; r < 16; ++r) { const int trow = 32 * gth + (r & 3) + 8 * (r >> 2) + 4 * hi; GG[(gm * 64 + trow) * 64 + 32 * gch + r32] = sigmoidf_(acc[r] + gbias); }
            }
            LDS_BARRIER();
            float Pp[8], hl[8];
            {
                float pp = 1.f, hh = 0.f;
#pragma unroll
                for (int q = 0; q < 8; ++q) { const int t = 8 * wid + q; const float ra = GG[t * 64 + lane], ix = GG[(64 + t) * 64 + lane], xc = XC[t * 64 + lane];
                    const float la = sp8 * ra; const float a = __expf(la); const float uu = __builtin_amdgcn_sqrtf(fmaxf(neg_expm1_fast(2.0f * la), 0.f)) * ix * xc;
                    pp *= a; hh = a * hh + uu; Pp[q] = pp; hl[q] = hh; }
                SEG[(wid * 2) * 64 + lane] = pp; SEG[(wid * 2 + 1) * 64 + lane] = hh;
            }
            LDS_BARRIER();
            {
                float sa[8], sh[8];
#pragma unroll
                for (int w = 0; w < 8; ++w) { sa[w] = SEG[(w * 2) * 64 + lane]; sh[w] = SEG[(w * 2 + 1) * 64 + lane]; }
                float carry = hcarry, mine = 0.f;
#pragma unroll
                for (int w = 0; w < 8; ++w) { if (w == wid) mine = carry; carry = sa[w] * carry + sh[w]; }
                hcarry = carry;
#pragma unroll
                for (int q = 0; q < 8; ++q) { const int t = 8 * wid + q; const float hv = Pp[q] * mine + hl[q]; HO[t * 64 + lane] = d == 0 ? hv : (HF[t * 64 + lane] + hv) * YG[t * 64 + lane]; }
            }
            LDS_BARRIER();
            {   const int tt = d == 0 ? blk * 64 + t_ : S - 1 - (blk * 64 + t_);
                const f32x4_t a = *(const f32x4_t*)(HO + t_ * 64 + c8), b = *(const f32x4_t*)(HO + t_ * 64 + c8 + 4);
                u32x4_t w; w.x = pk2(a[0], a[1]); w.y = pk2(a[2], a[3]); w.z = pk2(b[0], b[1]); w.w = pk2(b[2], b[3]);
                *(u32x4_t*)(OM + (size_t)(start + tt) * DM + 64 * n + c8) = w; }
        }
#undef LRU_ISSUE
    }
}

__device__ __forceinline__ void rwkv_post_tile(const KP& p, unsigned char* lds, int l, int tile) {
    int tid_o = threadIdx.x; asm volatile("" : "+v"(tid_o)); const int tid = tid_o, lane = tid & 63;
    float* SG = (float*)lds;
    float* GO = SG + 4096;
    const bf16* Z = (const bf16*)(p.ws + OFF_Z); bf16* OM = (bf16*)(p.ws + OFF_OMIX);
    const float* YF = (const float*)(p.ws + OFF_YF); const float* YBk = (const float*)(p.ws + OFF_YB);
    const float* mu = p.in[18] + l * 1024; const float* g_up = p.in[23] + (size_t)l * 128 * 256;
    const int m0 = tile * 32; const int s = seq_of_row(m0); const int S = seq_len(s), start = seq_start(s);
    __syncthreads();
    {   const float muc = mu[896 + (tid & 127)];
#pragma unroll 1
        for (int ih = 0; ih < 2; ++ih) {
            unsigned short zc_[4], zp_[4], zn_[4];
#pragma unroll
            for (int i = 0; i < 4; ++i) { const int e = tid + NTHR * (4 * ih + i); const int t = e >> 7, c = e & 127; const int m = m0 + t, tt = m - start; const bf16* zp = Z + (size_t)m * ZP + 768 + 896 + c;
                zc_[i] = zp[0]; zp_[i] = zp[tt > 0 ? -ZP : 0]; zn_[i] = zp[tt < S - 1 ? ZP : 0]; }
            asm volatile("" ::: "memory");
#pragma unroll
            for (int i = 0; i < 4; ++i) { const int e = tid + NTHR * (4 * ih + i); const int t = e >> 7; const int tt = m0 + t - start;
                const float f = bf2f(zc_[i]); const float pv = tt > 0 ? bf2f(zp_[i]) : 0.f; const float nx = tt < S - 1 ? bf2f(zn_[i]) : 0.f;
                SG[e] = sigmoidf_(f + muc * (0.5f * (pv + nx) - f)); }
        }
    }
    __syncthreads();
    const int c = tid & 255, tg = tid >> 8;
#pragma unroll 1
    for (int hf = 0; hf < 2; ++hf) {
        float acc[8];
#pragma unroll
        for (int t = 0; t < 8; ++t) acc[t] = 0.f;
#pragma unroll 1
        for (int ib = 0; ib < 128; ib += 16) {
            float wv[16];
#pragma unroll
            for (int u = 0; u < 16; ++u) wv[u] = g_up[(ib + u) * 256 + c];
#pragma unroll
            for (int u4 = 0; u4 < 16; u4 += 4) {
#pragma unroll
                for (int t = 0; t < 8; ++t) { const f32x4_t x = *(const f32x4_t*)(SG + (tg * 16 + hf * 8 + t) * 128 + ib + u4); acc[t] = fmaf(x[0], wv[u4], acc[t]); acc[t] = fmaf(x[1], wv[u4 + 1], acc[t]); acc[t] = fmaf(x[2], wv[u4 + 2], acc[t]); acc[t] = fmaf(x[3], wv[u4 + 3], acc[t]); } }
        }
#pragma unroll
        for (int t = 0; t < 8; ++t) GO[(tg * 16 + hf * 8 + t) * 256 + c] = acc[t];
    }
    const int dc = (s < 4) ? ((m0 - start) >= S / 2 ? 0 : 1) : -1;
    if (dc >= 0) {
        float* SM = (float*)(lds + 49152); unsigned short* YPs = (unsigned short*)(lds + 114688);
        const float* Ydc = dc == 0 ? YF : YBk; float* Yw = (float*)(p.ws + (dc == 0 ? OFF_YF : OFF_YB));
        for (int e = tid; e < 4096; e += NTHR) { const int hh = e >> 10, r4 = (e & 1023) * 4; *(f32x4_t*)(SM + hh * 4096 + r4) = *(const f32x4_t*)((const float*)(p.ws + OFF_SMID) + (size_t)((s * 4 + hh) * 2 + dc) * 4096 + r4); }
        for (int e = tid; e < 1024; e += NTHR) { const int t = e >> 5, hh = (e >> 3) & 3, ch = e & 7; *(u32x4_t*)(YPs + t * 256 + hh * 64 + ch * 8) = *(const u32x4_t*)((const unsigned short*)(Ydc + (size_t)(m0 + t) * 256 + 64 * hh) + 64 + ch * 8); }
        __syncthreads();
        const int hh = c >> 6, v = c & 63; const float* smp = SM + hh * 4096 + v;
#pragma unroll 1
        for (int t = 0; t < 16; ++t) {
            const int tk = tg * 16 + t; const size_t mrow = (size_t)(m0 + tk) * 256;
            float accv = bf2f(((const unsigned short*)(Ydc + mrow + 64 * hh))[v]);
#pragma unroll
            for (int i0 = 0; i0 < 64; i0 += 8) { const u32x4_t w = *(const u32x4_t*)(YPs + tk * 256 + hh * 64 + i0);
                accv += smp[(i0 + 0) * 64] * __builtin_bit_cast(float, w[0] << 16) + smp[(i0 + 1) * 64] * __builtin_bit_cast(float, w[0] & 0xffff0000u) + smp[(i0 + 2) * 64] * __builtin_bit_cast(float, w[1] << 16) + smp[(i0 + 3) * 64] * __builtin_bit_cast(float, w[1] & 0xffff0000u)
                      + smp[(i0 + 4) * 64] * __builtin_bit_cast(float, w[2] << 16) + smp[(i0 + 5) * 64] * __builtin_bit_cast(float, w[2] & 0xffff0000u) + smp[(i0 + 6) * 64] * __builtin_bit_cast(float, w[3] << 16) + smp[(i0 + 7) * 64] * __builtin_bit_cast(float, w[3] & 0xffff0000u); }
            Yw[mrow + c] = accv;
        }
        __threadfence();
        __syncthreads();
    }
    const float rk = p.in[26][l * 256 + c], lg = p.in[27][l * 256 + c], lb = p.in[28][l * 256 + c];
    const float mr = mu[c], mk = mu[256 + c], mv = mu[512 + c];
    unsigned short zc_[9]; float yc_[2];
#define PT_LOAD(T_, ZD, YD) do { const int m_ = m0 + tg * 16 + (T_), tt_ = m_ - start; const bf16* zp_ = Z + (size_t)m_ * ZP + 768 + c; const bf16* zpp_ = zp_ + (tt_ > 0 ? -ZP : 0); const bf16* zpn_ = zp_ + (tt_ < S - 1 ? ZP : 0); \
        _Pragma("unroll") for (int j = 0; j < 3; ++j) { ZD[3 * j] = zp_[256 * j]; ZD[3 * j + 1] = zpp_[256 * j]; ZD[3 * j + 2] = zpn_[256 * j]; } \
        YD[0] = YF[(size_t)m_ * 256 + c]; YD[1] = YBk[(size_t)m_ * 256 + c]; } while (0)
    PT_LOAD(0, zc_, yc_);
#pragma unroll 1
    for (int t = 0; t < 16; ++t) {
        unsigned short zn_[9]; float yn_[2];
        PT_LOAD((t < 15 ? t + 1 : 15), zn_, yn_);
        asm volatile("" ::: "memory");
        const int m = m0 + tg * 16 + t, tt = m - start;
        const bool hp = tt > 0, hn = tt < S - 1;
        float f = bf2f(zc_[0]), pv = hp ? bf2f(zc_[1]) : 0.f, nx = hn ? bf2f(zc_[2]) : 0.f; const float r = f + mr * (0.5f * (pv + nx) - f);
        f = bf2f(zc_[3]); pv = hp ? bf2f(zc_[4]) : 0.f; nx = hn ? bf2f(zc_[5]) : 0.f; const float k = f + mk * (0.5f * (pv + nx) - f);
        f = bf2f(zc_[6]); pv = hp ? bf2f(zc_[7]) : 0.f; nx = hn ? bf2f(zc_[8]) : 0.f; const float v = f + mv * (0.5f * (pv + nx) - f);
        const float y = yc_[0] + yc_[1];
#pragma unroll
        for (int j = 0; j < 9; ++j) zc_[j] = zn_[j];
        yc_[0] = yn_[0]; yc_[1] = yn_[1];
        const float mean = wave_sum(y) * (1.0f / 64.0f); const float dv = y - mean; const float var = wave_sum(dv * dv) * (1.0f / 64.0f);
        const float yn = dv * rsqrtf(var + 64e-5f) * lg + lb;
        const float bon = wave_sum(r * k * rk);
        const float outv = (yn + bon * v) * GO[(tg * 16 + t) * 256 + c];
        OM[(size_t)m * DM + 384 + c] = (bf16)f2bf(outv);
    }
#undef PT_LOAD
    (void)lane;
}

#define RLX_AGENT __ATOMIC_RELAXED, __HIP_MEMORY_SCOPE_AGENT
#define XB_TMO      128
#define XB_XCNT(j)  (256  + 64 * (j))
#define XB_XSUB(j)  (1280 + 64 * (j))
#define XB_XGEN(j)  (2304 + 64 * (j))
#define XB_TOP      3328
#define XB_TOPGEN   3392
#define XCD_BAR_WORDS 3456
#define XB_SPIN_CAP (1u << 18)

__device__ __forceinline__ unsigned xb_ld(unsigned* p)              { return __hip_atomic_load(p, __ATOMIC_RELAXED, __HIP_MEMORY_SCOPE_AGENT); }
__device__ __forceinline__ unsigned xb_add(unsigned* p, unsigned v) { return __hip_atomic_fetch_add(p, v, __ATOMIC_RELAXED, __HIP_MEMORY_SCOPE_AGENT); }
__device__ __forceinline__ unsigned xb_xcc_id() { return (unsigned)__builtin_amdgcn_s_getreg((3 << 11) | 20) & 0xFu; }
#define XB_SPIN(cond, bar) do { unsigned _sp = 0; while (cond) { __builtin_amdgcn_s_sleep(1); \
    if ((++_sp & 255u) == 0u) { if (xb_ld(&(bar)[XB_TMO])) break; if (_sp > XB_SPIN_CAP) { atomicAdd(&(bar)[XB_TMO], 1u); break; } } } } while (0)

struct XcdBarrier {
    unsigned* bar; unsigned x;
    volatile LAS unsigned* st;
};

__device__ __forceinline__ XcdBarrier xcd_barrier_post(unsigned* bar, volatile LAS unsigned* st) {
    XcdBarrier b; b.bar = bar; b.x = xb_xcc_id(); b.st = st;
    if (threadIdx.x == 0) (void)xb_add(&bar[XB_XCNT(b.x)], 1u);
    return b;
}
__device__ __forceinline__ void xcd_barrier_complete(unsigned* bar, unsigned x, unsigned& nloc, unsigned& nx) {
    const unsigned G = gridDim.x * gridDim.y * gridDim.z;
    unsigned sum, cnt, mine, sp = 0u;
    for (;;) {
        sum = 0u; cnt = 0u; mine = 0u;
#pragma unroll
        for (unsigned j = 0; j < 16; ++j) { const unsigned c = xb_ld(&bar[XB_XCNT(j)]); sum += c; cnt += (c > 0u) ? 1u : 0u; mine = (j == x) ? c : mine; }
        if (sum == G) break;
        __builtin_amdgcn_s_sleep(1);
        if ((++sp & 255u) == 0u) { if (xb_ld(&bar[XB_TMO])) break; if (sp > XB_SPIN_CAP) { atomicAdd(&bar[XB_TMO], 1u); break; } }
    }
    nloc = mine > 0u ? mine : 1u; nx = cnt > 0u ? cnt : 1u;
}

__device__ __forceinline__ void xcd_barrier(const XcdBarrier& b) {
    asm volatile("s_waitcnt vmcnt(0)" ::: "memory");
    __syncthreads();
    if (threadIdx.x == 0) {
        unsigned bx_ = xb_xcc_id(); asm volatile("" : "+s"(bx_));
        unsigned* bar = b.bar; asm volatile("" : "+s"(bar));
        __builtin_amdgcn_s_waitcnt(0);
        unsigned nloc = b.st[0], nx = b.st[1];
        if (nloc == 0u) { xcd_barrier_complete(bar, bx_, nloc, nx); b.st[0] = nloc; b.st[1] = nx; }
        const unsigned old = xb_add(&bar[XB_XSUB(bx_)], 1u);
        const unsigned gen = old / nloc;
        if (old + 1u == (gen + 1u) * nloc) {
            __builtin_amdgcn_fence(__ATOMIC_RELEASE, "agent");
            asm volatile("s_waitcnt vmcnt(0)" ::: "memory");
            const unsigned og = xb_add(&bar[XB_TOP], 1u);
            const unsigned tg = og / nx;
            if (og + 1u == (tg + 1u) * nx) xb_add(&bar[XB_TOPGEN], 1u);
            else XB_SPIN(xb_ld(&bar[XB_TOPGEN]) == tg, bar);
            __builtin_amdgcn_fence(__ATOMIC_ACQUIRE, "agent");
            xb_add(&bar[XB_XGEN(bx_)], 1u);
            asm volatile("s_waitcnt vmcnt(0)" ::: "memory");
        } else {
            XB_SPIN(xb_ld(&bar[XB_XGEN(bx_)]) == gen, bar);
            __builtin_amdgcn_fence(__ATOMIC_ACQUIRE, "agent");
            asm volatile("s_waitcnt vmcnt(0)" ::: "memory");
        }
    }
    __syncthreads();
}

__global__ void __launch_bounds__(NTHR, 2) fwd_megakernel(KP p) {
    extern __shared__ __attribute__((aligned(16))) unsigned char lds[];
    cg::grid_group grid = cg::this_grid();
    const int tid = threadIdx.x, lane = tid & 63, wid = tid >> 6;
    const int G = gridDim.x, bx = blockIdx.x;
    const int gw = bx * 8 + wid, NGW = G * 8;
    unsigned char* ws = p.ws;
    volatile LAS int* misc = (volatile LAS int*)((LAS unsigned char*)lds + MISC_OFF);
    PG8_LAS unsigned char* ldsg = (PG8_LAS unsigned char*)lds;
    if (tid < 32) ((volatile LAS unsigned*)((LAS unsigned char*)lds + MISC_OFF))[tid] = 0u;
    __syncthreads();
    const XcdBarrier xbar = xcd_barrier_post((unsigned*)(p.ws + 16384), (volatile LAS unsigned*)((LAS unsigned char*)lds + MISC_OFF + 32));

    {
        float* scr = (float*)(lds + wid * 16384);
        for (int l = 0; l < 2; ++l) {
            unsigned char* wl = ws + OFF_W + l * W_LAYER;
            constexpr int I_IN = 16 * 176, I_OUT = 44 * 32, I_MI = 16 * 76, I_MO = 16 * 32, I_TOT = 2 * I_IN + 2 * I_OUT + I_MI + I_MO;
            for (int it = gw; it < I_TOT; it += NGW) {
                int r = it;
                if (r < 2 * I_IN) { const int f = r / I_IN; transpose_item<1>(p.in[7] + ((size_t)l * 2 + f) * DM * NFF, DM, NFF, (bf16*)(wl + WO_IN + f * 11 * MiB), scr, r % I_IN, lane); continue; } r -= 2 * I_IN;
                if (r < 2 * I_OUT) { const int f = r / I_OUT; transpose_item<0>(p.in[8] + ((size_t)l * 2 + f) * DFF * DM, DFF, DM, (bf16*)(wl + WO_OUT + f * (11 * MiB / 2)), scr, r % I_OUT, lane); continue; } r -= 2 * I_OUT;
                if (r < I_MI) { transpose_item<2>(p.in[9] + (size_t)l * DM * NMIX, DM, NMIX, (bf16*)(wl + WO_MI), scr, r, lane); continue; } r -= I_MI;
                transpose_item<0>(p.in[10] + (size_t)l * DM * DM, DM, DM, (bf16*)(wl + WO_MO), scr, r, lane);
            }
            u32x4_t* padp = (u32x4_t*)(wl + WO_MI + (size_t)NMIX * DM * 2);
            for (int e = bx * NTHR + tid; e < 128 * DM * 2 / 16; e += G * NTHR) padp[e] = (u32x4_t){0u, 0u, 0u, 0u};
        }
        __syncthreads();
        for (int u = bx; u < 2 * 36 * 8; u += G) { const int l = u / 288, r = u % 288;
            smallm_unit<0, 0>(p, (float*)lds, l, 0, p.in[4] + (size_t)l * DM * 9216, 9216, 9216, (float*)(ws + OFF_MOD) + (size_t)l * NSEQ * 9216, 9216, r / 8, r % 8); }
        if (bx == 0) { float* rope = (float*)(ws + OFF_ROPE);
            for (int e = tid; e < 1024; e += NTHR) { const int pos = e >> 4, pp = e & 15; const float inv = exp2f(-(float)pp * (13.287712379549449f / 16.0f)); const float a = (float)pos * inv; const float kr = rintf(a * 0.15915494309189535f); float rr = fmaf(-kr, 6.2831854820251465f, a); rr = fmaf(-kr, -1.7484555e-7f, rr); rope[2 * e] = __cosf(rr); rope[2 * e + 1] = __sinf(rr); } }
    }
    grid.sync();
    {
        const float* MOD = (const float*)(ws + OFF_MOD); float* GV = (float*)(ws + OFF_GV); float* GT = (float*)(ws + OFF_GATE);
        for (int e = bx * NTHR + tid; e < 6 * NSEQ * DM; e += G * NTHR) {
            const int c = e & 1023, s = (e >> 10) % NSEQ, inst = e / (NSEQ * DM); const int l = inst / 3, j = inst % 3;
            const float* mr = MOD + ((size_t)l * NSEQ + s) * 9216; const float* ba = p.in[5] + l * 9216;
            const float sc = mr[(3 * j + 1) * 1024 + c] + ba[(3 * j + 1) * 1024 + c], gg = mr[(3 * j + 2) * 1024 + c] + ba[(3 * j + 2) * 1024 + c];
            GV[e] = p.in[6][(l * 3 + j) * DM + c] * (1.0f + sc); GT[e] = (j == 1 ? 1.0f : 0.5f) * gg;
        }
        for (int u = bx; u < 2 * 432; u += G) { const int l = u / 432, r = u % 432; float* bdst = (float*)(ws + OFF_BIAS);
            if (r < 176) smallm_unit<1, 1>(p, (float*)lds, l, 0, p.in[7] + ((size_t)l * 2 + 0) * DM * NFF, NFF, NFF, bdst + (size_t)(l * 3 + 0) * NSEQ * NFF, NFF, r / 8, r % 8);
            else if (r < 256) smallm_unit<1, 2>(p, (float*)lds, l, 1, p.in[9] + (size_t)l * DM * NMIX, NMIX, NMIX, bdst + (size_t)(l * 3 + 1) * NSEQ * NFF, NFF, (r - 176) / 8, (r - 176) % 8);
            else smallm_unit<1, 1>(p, (float*)lds, l, 2, p.in[7] + ((size_t)l * 2 + 1) * DM * NFF, NFF, NFF, bdst + (size_t)(l * 3 + 2) * NSEQ * NFF, NFF, (r - 256) / 8, (r - 256) % 8); }
        bf16* XN = (bf16*)(ws + OFF_XN); float* SS0 = (float*)(ws + OFF_SS);
        for (int m = gw; m < MTOK; m += NGW) {
            const int s = seq_of_row(m); const float* xr = m < 16384 ? p.in[0] + (size_t)m * DM : p.in[1] + (size_t)(m - 16384) * DM;
            const float* mr = MOD + (size_t)s * 9216 + 1024; const float* ba = p.in[5] + 1024; const float* ng = p.in[6];
            float q = 0.f;
#pragma unroll
            for (int j = 0; j < 4; ++j) { const int c = 4 * lane + 256 * j; const f32x4_t v = *(const f32x4_t*)(xr + c); const f32x4_t sc = *(const f32x4_t*)(mr + c) + *(const f32x4_t*)(ba + c); const f32x4_t g = *(const f32x4_t*)(ng + c) * (sc + 1.0f);
                q += (v[0] * v[0] + v[1] * v[1]) + (v[2] * v[2] + v[3] * v[3]); const f32x4_t o = v * g;
                *(unsigned long long*)(XN + (size_t)m * DM + c) = (unsigned long long)pk2(o[0], o[1]) | ((unsigned long long)pk2(o[2], o[3]) << 32); }
            q = wave_sum(q); if (lane == 0) SS0[m] = q;
        }
    }
    xcd_barrier(xbar);

    for (int ph = 0; ph < 16; ++ph) {
        const int l = ph >> 3, r = ph & 7; const int f = r >= 6 ? 1 : 0;
        unsigned char* wl = ws + OFF_W + l * W_LAYER;
        const float* GV = (const float*)(ws + OFF_GV); const float* GT = (const float*)(ws + OFF_GATE); const float* BI = (const float*)(ws + OFF_BIAS); float* SS = (float*)(ws + OFF_SS);
        bf16* XN = (bf16*)(ws + OFF_XN); bf16* HID = (bf16*)(ws + OFF_HID); bf16* OMIX = (bf16*)(ws + OFF_OMIX);
        const int j = f == 0 ? 0 : 2; const int inst = l * 3 + j;
        if (r == 2) {
                {
                    pg8::Gemm g{XN, (const pg8::bf16_t*)(wl + WO_MI), MTOK, NMIXP, DM}; pg8::StaticOrder S; S.init(MTOK, NMIXP, G, bx);
                    pg8::EpiZ E{(bf16*)(ws + OFF_Z), (bf16*)(ws + OFF_QK), (bf16*)(ws + OFF_VR), SS + (size_t)(l * 3 + 1) * MTOK, BI + (size_t)(l * 3 + 1) * NSEQ * NFF, p.in[29] + l * 64, p.in[30] + l * 64, (const float*)(ws + OFF_ROPE)};
                    pg8::gemm_phase<pg8::EpiZ, pg8::StaticOrder, true, true>(ldsg, g, S, E);
                }
        } else if (r == 3) {
                {
                    unsigned* ctr = (unsigned*)(ws + OFF_CTR) + 64 * l;
                    constexpr int NU_R = 224, NU_L = 120, NU_A = 1152, NU = NU_R + NU_L + NU_A;
                    for (;;) {
                        __syncthreads(); if (tid == 0) misc[0] = (int)atomicAdd(ctr, 1u); __syncthreads();
                        const int u = misc[0]; if (u >= NU) break;
                        if (u < 224) { int s_, h_, d_, md_;
                            if (u < 96) { const int c = u & 31; md_ = 1 + (u >> 5); s_ = c >> 3; h_ = (c >> 1) & 3; d_ = c & 1; } else { const int i2 = u - 96; md_ = 0; s_ = 4 + (i2 >> 3); h_ = (i2 >> 1) & 3; d_ = i2 & 1; }
                            rwkv_unit(p, lds, l, s_, h_, d_, md_); }
                        else if (u < 248) { const int i3 = u - 224; lru_unit(p, lds, l, i3 / 6, i3 % 6); }
                        else if (u < 344) { const int i4 = u - 248; lru_unit(p, lds, l, 4 + i4 / 6, i4 % 6); }
                        else { const int i5 = u - 344; int s_, hq, qb;
                            if (i5 < 384) { s_ = i5 / 96; const int r = i5 % 96; hq = (r / 48) * 3 + (r % 48) / 16; qb = r & 15; }
                            else { const int i6 = i5 - 384; s_ = 4 + i6 / 48; const int r = i6 % 48; hq = (r / 24) * 3 + (r % 24) / 8; qb = r & 7; }
                            const int g_ = hq / 3;
                            attn_body::attn_unit<8>(seq_start(s_), seq_len(s_), qb, 64 * hq, 384 + 64 * g_, 64 * g_, 640 + 64 * hq, (const attn_body::bf16*)(ws + OFF_QK), (const attn_body::bf16*)(ws + OFF_QK), (const attn_body::bf16*)(ws + OFF_VR), (attn_body::bf16*)(ws + OFF_OMIX), (char*)lds); }
                    }
                }
        } else if (r == 4) {
                for (int t = bx; t < MTOK / 32; t += G) rwkv_post_tile(p, lds, l, t);
        } else if (r == 5) {
                {
                    pg8::Gemm g{OMIX, (const pg8::bf16_t*)(wl + WO_MO), MTOK, DM, DM}; pg8::StaticOrder S; S.init(MTOK, DM, G, bx);
                    pg8::EpiResid E{p.out, p.out + (size_t)16384 * DM, p.out, XN, SS + (size_t)(l * 3 + 2) * MTOK, GT + (size_t)(l * 3 + 1) * NSEQ * DM, GV + (size_t)(l * 3 + 2) * NSEQ * DM};
                    pg8::gemm_phase<pg8::EpiResid, pg8::StaticOrder, true, true>(ldsg, g, S, E);
                }
        } else if (r == 0 || r == 6) {
            {
                pg8::Gemm g{XN, (const pg8::bf16_t*)(wl + WO_IN + f * 11 * MiB), MTOK, NFF, DM}; pg8::StaticOrder S; S.init(MTOK, NFF, G, bx);
                pg8::EpiSwiglu E{HID, SS + (size_t)inst * MTOK, BI + (size_t)inst * NSEQ * NFF};
                pg8::gemm_phase<pg8::EpiSwiglu, pg8::StaticOrder, true, true>(ldsg, g, S, E);
            }
        } else {
            {
                const bool first = (l == 0 && f == 0), last = (l == 1 && f == 1);
                const int ninst = inst + 1;
                pg8::Gemm g{HID, (const pg8::bf16_t*)(wl + WO_OUT + f * (11 * MiB / 2)), MTOK, DM, DFF}; pg8::StaticOrder S; S.init(MTOK, DM, G, bx);
                pg8::EpiResid E{first ? p.in[0] : p.out, first ? p.in[1] : p.out + (size_t)16384 * DM, p.out, XN, last ? nullptr : SS + (size_t)ninst * MTOK, GT + (size_t)inst * NSEQ * DM, last ? nullptr : GV + (size_t)ninst * NSEQ * DM};
                pg8::gemm_phase<pg8::EpiResid, pg8::StaticOrder, true, true>(ldsg, g, S, E);
            }
        }
        if (ph != 15) xcd_barrier(xbar);
    }
}

extern "C" void kernel_launch(void* const* d_in, const int* in_sizes, int n_in, void* d_out, int out_size, void* d_ws, size_t ws_size, hipStream_t stream) {
    static int grid = 0;
    if (grid == 0) {
        if (n_in != 31 || ws_size < WS_END + 1 * MiB) { fprintf(stderr, "kernel_launch: unexpected n_in %d / ws %zu\n", n_in, ws_size); grid = -1; return; }
        int dev = 0, cus = 0, per_cu = 0;
        hipGetDevice(&dev); hipDeviceGetAttribute(&cus, hipDeviceAttributeMultiprocessorCount, dev);
        hipFuncSetAttribute((const void*)fwd_megakernel, hipFuncAttributeMaxDynamicSharedMemorySize, LDS_BYTES);
        hipOccupancyMaxActiveBlocksPerMultiprocessor(&per_cu, (const void*)fwd_megakernel, NTHR, LDS_BYTES);
        if (per_cu < 1) per_cu = 1;
        grid = cus * per_cu;
        (void)hipGetLastError();
    }
    if (grid < 0) return;
    hipMemsetAsync(d_ws, 0, ZERO_BYTES, stream);
    KP p{};
    for (int i = 0; i < 31; ++i) p.in[i] = (const float*)d_in[i];
    p.out = (float*)d_out; p.ws = (unsigned char*)d_ws;
    void* args[] = {&p};
    hipError_t e = hipLaunchCooperativeKernel((const void*)fwd_megakernel, dim3(grid), dim3(NTHR), args, LDS_BYTES, stream);
    if (e != hipSuccess) fprintf(stderr, "cooperative launch failed: %s (grid %d)\n", hipGetErrorString(e), grid);
}
```

```cpp
#include <hip/hip_runtime.h>
#include <hip/hip_cooperative_groups.h>
#include <cstdio>
#include <cstdint>
namespace cg = cooperative_groups;
namespace pg8 {
#define PG8_LAS __attribute__((address_space(3)))
typedef unsigned short bf16_t;
typedef short bf16x8 __attribute__((ext_vector_type(8)));
typedef float f32x4 __attribute__((ext_vector_type(4)));
typedef unsigned u32x4 __attribute__((ext_vector_type(4)));
constexpr int BM = 256, BK = 64, HALF = 128, HTB = HALF * BK * 2  , STAGE_BYTES = 8 * HTB, NXCD = 8, WGM = 8;

__host__ __device__ __forceinline__ int lds_byte(int r, int c) { const int st = (r >> 4) * 2 + (c >> 5), rr = r & 15, cc = c & 31, ob = rr * 64 + cc * 2; return st * 1024 + (ob ^ (((ob >> 9) & 1) << 5)); }
__host__ __device__ __forceinline__ void stage_rc(int b, int& R, int& C) { const int st = b / 1024, sb = b % 1024, swz = sb ^ (((sb >> 9) & 1) << 5); R = (st >> 1) * 16 + swz / 64; C = (st & 1) * 32 + (swz % 64) / 2; }
__host__ __device__ __forceinline__ int perm32(int rho) { const int n = rho >> 4, i = rho & 15; return 8 * (i >> 2) + 4 * n + (i & 3); }

struct Unit { int pm, pn; };
struct Gemm { const bf16_t* A; const bf16_t* Bt; int M, N, K; };

struct StaticOrder {
    int nM, nN, nwg, G, c;
    __host__ __device__ void init(int M, int N, int G_, int c_) { nM = M / BM; nN = N / BM; nwg = nM * nN; G = G_; c = c_; }
    __host__ __device__ bool next(int i, Unit& u) const {
        const long L = (long)i * G + c; if (L >= nwg) return false;
        int wgid = (int)L; { const int q = nwg / NXCD, r = nwg % NXCD, xcd = wgid % NXCD, off = wgid / NXCD; wgid = (xcd < r ? xcd * (q + 1) : r * (q + 1) + (xcd - r) * q) + off; }
        const int nig = WGM * nN, gid = wgid / nig, fm = gid * WGM, gsz = (nM - fm) < WGM ? (nM - fm) : WGM;
        u.pm = fm + ((wgid % nig) % gsz); u.pn = (wgid % nig) / gsz; return true;
    }
    __device__ __forceinline__ void a_ready(const Unit&) const {}
    __device__ __forceinline__ void done(const Unit&) const {}
};

__device__ __forceinline__ unsigned cvt_pk_bf16(float lo, float hi) { unsigned r; asm volatile("v_cvt_pk_bf16_f32 %0, %1, %2" : "=v"(r) : "v"(lo), "v"(hi)); return r; }
typedef float f32x2 __attribute__((ext_vector_type(2)));
__device__ __forceinline__ f32x2 gelu_pk(f32x2 v) {
    const f32x2 av = __builtin_elementwise_abs(v), d = av * 0.2316418882f + 1.0f;
    f32x2 t; t.x = __builtin_amdgcn_rcpf(d.x); t.y = __builtin_amdgcn_rcpf(d.y);
    f32x2 q = t * 0.5307027145f + (-0.7265760135f); q = q * t + 0.7107068705f; q = q * t + (-0.142248368f); q = q * t + 0.127414796f; q = q * t;
    const f32x2 s = (v * v) * (-0.72134752044f);
    f32x2 e; e.x = __builtin_amdgcn_exp2f(s.x); e.y = __builtin_amdgcn_exp2f(s.y);
    const f32x2 m = v * (q * e), r = v - m;
    f32x2 o; o.x = v.x < 0.f ? m.x : r.x; o.y = v.y < 0.f ? m.y : r.y; return o;
}

template <int ACT  > struct EpiBf16 {
    static constexpr bool PERM = true, AFTER_DRAIN = false; static_assert(ACT == 0 || ACT == 1, "EpiBf16: ACT is 0 (none) or 1 (gelu_pk)");
    bf16_t* O; int ldc; const float* bias; int split_cols; size_t split_stride; float scale0;
    __device__ __forceinline__ void operator()(const f32x4 (&acc)[2][2][4][2], const Unit& u, int wr, int wc, int fr, int fq) const {
        const int row0 = u.pm * BM + wr * 64 + fr; int colt = u.pn * BM; bf16_t* base = O;
        float sc = 1.f; if (split_cols) { const int t = colt / split_cols; base += (size_t)t * split_stride; colt -= t * split_cols; if (t == 0) sc = scale0; }
        const int col0 = colt + wc * 32 + 8 * fq, bcol0 = u.pn * BM + wc * 32 + 8 * fq;
        f32x4 bv[2][2];
#pragma unroll
        for (int bj = 0; bj < 2; ++bj)
#pragma unroll
            for (int n = 0; n < 2; ++n) bv[bj][n] = bias ? *(const f32x4*)(bias + bcol0 + bj * HALF + 4 * n) : (f32x4){0.f, 0.f, 0.f, 0.f};
#pragma unroll
        for (int ai = 0; ai < 2; ++ai)
#pragma unroll
            for (int m = 0; m < 4; ++m) { bf16_t* rowp = base + (size_t)(row0 + ai * HALF + m * 16) * ldc + col0;
#pragma unroll
                for (int bj = 0; bj < 2; ++bj) { f32x4 v0 = acc[ai][bj][m][0] + bv[bj][0], v1 = acc[ai][bj][m][1] + bv[bj][1];
                    if (ACT == 1) { f32x2 a = gelu_pk((f32x2){v0[0], v0[1]}), b = gelu_pk((f32x2){v0[2], v0[3]}), c = gelu_pk((f32x2){v1[0], v1[1]}), d = gelu_pk((f32x2){v1[2], v1[3]});
                        v0 = (f32x4){a.x, a.y, b.x, b.y}; v1 = (f32x4){c.x, c.y, d.x, d.y}; }
                    v0 = v0 * sc; v1 = v1 * sc; u32x4 w; w.x = cvt_pk_bf16(v0[0], v0[1]); w.y = cvt_pk_bf16(v0[2], v0[3]); w.z = cvt_pk_bf16(v1[0], v1[1]); w.w = cvt_pk_bf16(v1[2], v1[3]);
                    *(u32x4*)(rowp + bj * HALF) = w; } }
    }
};
template <class Epi, class Sched, bool ALIGN_EPI = false, bool SP2 = false>
__device__ __forceinline__ void gemm_phase(PG8_LAS unsigned char* lds, const Gemm g, const Sched& S, const Epi& E) {
    int tid_o = threadIdx.x; asm volatile("" : "+v"(tid_o)); const int tid = tid_o, wid = __builtin_amdgcn_readfirstlane(tid >> 6), lane = tid & 63, wr = wid >> 2, wc = wid & 3, fr = lane & 15, fq = lane >> 4;
    const int K = g.K, nt = K / BK;
    unsigned voffA[2], voffB[2];
#pragma unroll
    for (int i = 0; i < 2; ++i) { int R, C; stage_rc(tid * 16 + i * 8192, R, C); const int Rb = Epi::PERM ? ((R & ~31) + perm32(R & 31)) : R;
        voffA[i] = (unsigned)(R * K + C) * 2u; voffB[i] = (unsigned)(Rb * K + C) * 2u; }
    const size_t kstep = (size_t)(BK * 2);
    const size_t hstep = (size_t)HALF * K * 2;
    const size_t tstep = 2 * hstep;
    const unsigned ldsw = (unsigned)wid * 1024u;
    const int aoff = lds_byte(wr * 64 + fr, fq * 8), boff = lds_byte(wc * 32 + fr, fq * 8);
#define PG8_SA(b, h) (((b) * 2 + (h)) * HTB)
#define PG8_SB(b, h) ((4 + (b) * 2 + (h)) * HTB)
#define PG8_STAGE(bufoff, gbase, voff) do { _Pragma("unroll") for (int _i = 0; _i < 2; ++_i) \
        __builtin_amdgcn_global_load_lds((const unsigned*)((const char*)(gbase) + (voff)[_i]), (PG8_LAS unsigned*)(lds + (bufoff) + ldsw + _i * 8192), 16, 0, 0); } while (0)
#define PG8_LDA(dst, b, h) do { _Pragma("unroll") for (int m = 0; m < 4; ++m) _Pragma("unroll") for (int k = 0; k < 2; ++k) dst[m][k] = *(const PG8_LAS bf16x8*)(lds + PG8_SA(b, h) + aoff + m * 2048 + k * 1024); } while (0)
#define PG8_LDB(dst, b, h) do { _Pragma("unroll") for (int n = 0; n < 2; ++n) _Pragma("unroll") for (int k = 0; k < 2; ++k) dst[n][k] = *(const PG8_LAS bf16x8*)(lds + PG8_SB(b, h) + boff + n * 2048 + k * 1024); } while (0)
#define PG8_MMA(ai, bj, At, Bt) do { __builtin_amdgcn_s_setprio(1); _Pragma("unroll") for (int m = 0; m < 4; ++m) _Pragma("unroll") for (int n = 0; n < 2; ++n) _Pragma("unroll") for (int k = 0; k < 2; ++k) \
        acc[ai][bj][m][n] = __builtin_amdgcn_mfma_f32_16x16x32_bf16(Bt[n][k], At[m][k], acc[ai][bj][m][n], 0, 0, 0); __builtin_amdgcn_s_setprio(0); } while (0)
#define PG8_WAIT_V(n) asm volatile("s_waitcnt vmcnt(" #n ")" ::: "memory")
#define PG8_WAIT_L(n) asm volatile("s_waitcnt lgkmcnt(" #n ")" ::: "memory")
#define PG8_BAR __builtin_amdgcn_s_barrier()
#define PG8_SCHED __builtin_amdgcn_sched_barrier(0)
    Unit cur, nxt; int ui = 0;
    if (!S.next(0, cur)) return;
    f32x4 acc[2][2][4][2];
#pragma unroll
    for (int a = 0; a < 2; ++a)
#pragma unroll
        for (int b = 0; b < 2; ++b)
#pragma unroll
            for (int m = 0; m < 4; ++m)
#pragma unroll
                for (int n = 0; n < 2; ++n) acc[a][b][m][n] = (f32x4){0.f, 0.f, 0.f, 0.f};
    bf16x8 At[4][2], B0[2][2], B1[2][2];
    const char* cA = (const char*)g.A + (size_t)cur.pm * tstep; const char* cB = (const char*)g.Bt + (size_t)cur.pn * tstep;
    S.a_ready(cur);
    if constexpr (SP2) {
        PG8_STAGE(PG8_SB(0, 0), cB, voffB); PG8_STAGE(PG8_SB(0, 1), cB + hstep, voffB); PG8_STAGE(PG8_SA(0, 0), cA, voffA); PG8_STAGE(PG8_SA(0, 1), cA + hstep, voffA);
        if (wr == 1) PG8_BAR;
        PG8_WAIT_V(2); PG8_BAR;
        PG8_STAGE(PG8_SB(1, 0), cB + kstep, voffB); PG8_STAGE(PG8_SA(1, 0), cA + kstep, voffA); PG8_STAGE(PG8_SB(1, 1), cB + hstep + kstep, voffB);
        PG8_WAIT_V(6); PG8_BAR;
    } else {
        PG8_STAGE(PG8_SB(0, 0), cB, voffB); PG8_STAGE(PG8_SA(0, 0), cA, voffA); PG8_STAGE(PG8_SB(0, 1), cB + hstep, voffB); PG8_STAGE(PG8_SA(0, 1), cA + hstep, voffA);
        if (wr == 1) PG8_BAR;
        PG8_WAIT_V(4); PG8_BAR;
        PG8_STAGE(PG8_SB(1, 0), cB + kstep, voffB); PG8_STAGE(PG8_SA(1, 0), cA + kstep, voffA); PG8_STAGE(PG8_SB(1, 1), cB + hstep + kstep, voffB);
        PG8_WAIT_V(6); PG8_BAR;
    }
    for (;;) {
        const bool has_next = S.next(ui + 1, nxt);
        const char* nA = has_next ? (const char*)g.A + (size_t)nxt.pm * tstep : cA; const char* nB = has_next ? (const char*)g.Bt + (size_t)nxt.pn * tstep : cB;
        for (int t = 0; t < nt; t += 2) {
            const bool last = (t == nt - 2);
            const char* a1 = cA + (size_t)(t + 1) * kstep;
            const char* a2 = last ? nA : cA + (size_t)(t + 2) * kstep; const char* b2 = last ? nB : cB + (size_t)(t + 2) * kstep;
            const char* a3 = a2 + kstep; const char* b3 = b2 + kstep;
            if (last && has_next) S.a_ready(nxt);
            if constexpr (SP2) {
            PG8_LDB(B0, 0, 0); PG8_LDB(B1, 0, 1); PG8_SCHED; PG8_LDA(At, 0, 0); PG8_STAGE(PG8_SA(1, 1), a1 + hstep, voffA);
            PG8_WAIT_V(8); PG8_WAIT_L(0); PG8_BAR; PG8_MMA(0, 0, At, B0); PG8_MMA(0, 1, At, B1); PG8_BAR; PG8_SCHED;
            PG8_LDA(At, 0, 1); PG8_STAGE(PG8_SB(0, 0), b2, voffB); PG8_STAGE(PG8_SB(0, 1), b2 + hstep, voffB); PG8_STAGE(PG8_SA(0, 0), a2, voffA);
            PG8_WAIT_V(8); PG8_WAIT_L(0); PG8_BAR; PG8_MMA(1, 0, At, B0); PG8_MMA(1, 1, At, B1); PG8_BAR; PG8_SCHED;
            PG8_LDB(B0, 1, 0); PG8_LDB(B1, 1, 1); PG8_SCHED; PG8_LDA(At, 1, 0); PG8_STAGE(PG8_SA(0, 1), a2 + hstep, voffA);
            PG8_WAIT_V(8); PG8_WAIT_L(0); PG8_BAR; PG8_MMA(0, 0, At, B0); PG8_MMA(0, 1, At, B1); PG8_BAR; PG8_SCHED;
            PG8_LDA(At, 1, 1); PG8_STAGE(PG8_SB(1, 0), b3, voffB); PG8_STAGE(PG8_SB(1, 1), b3 + hstep, voffB); PG8_STAGE(PG8_SA(1, 0), a3, voffA);
            PG8_WAIT_V(8); PG8_WAIT_L(0); PG8_BAR; PG8_MMA(1, 0, At, B0); PG8_MMA(1, 1, At, B1); PG8_BAR; PG8_SCHED;
            } else {
            PG8_LDB(B0, 0, 0); PG8_SCHED; PG8_LDA(At, 0, 0); PG8_STAGE(PG8_SA(1, 1), a1 + hstep, voffA);
            PG8_WAIT_L(8); PG8_BAR; PG8_WAIT_L(0); PG8_MMA(0, 0, At, B0); PG8_BAR; PG8_SCHED;
            PG8_LDB(B1, 0, 1); PG8_STAGE(PG8_SB(0, 0), b2, voffB);
            PG8_BAR; PG8_WAIT_L(0); PG8_MMA(0, 1, At, B1); PG8_BAR;
            PG8_LDA(At, 0, 1); PG8_STAGE(PG8_SA(0, 0), a2, voffA);
            PG8_BAR; PG8_WAIT_L(0); PG8_MMA(1, 0, At, B0); PG8_BAR; PG8_SCHED;
            PG8_STAGE(PG8_SB(0, 1), b2 + hstep, voffB);
            PG8_WAIT_V(6); PG8_BAR; PG8_MMA(1, 1, At, B1); PG8_BAR;
            PG8_LDB(B0, 1, 0); PG8_SCHED; PG8_LDA(At, 1, 0); PG8_STAGE(PG8_SA(0, 1), a2 + hstep, voffA);
            PG8_WAIT_L(8); PG8_BAR; PG8_WAIT_L(0); PG8_MMA(0, 0, At, B0); PG8_BAR; PG8_SCHED;
            PG8_LDB(B1, 1, 1); PG8_STAGE(PG8_SB(1, 0), b3, voffB);
            PG8_BAR; PG8_WAIT_L(0); PG8_MMA(0, 1, At, B1); PG8_BAR;
            PG8_LDA(At, 1, 1); PG8_STAGE(PG8_SA(1, 0), a3, voffA);
            PG8_BAR; PG8_WAIT_L(0); PG8_MMA(1, 0, At, B0); PG8_BAR; PG8_SCHED;
            PG8_STAGE(PG8_SB(1, 1), b3 + hstep, voffB);
            PG8_WAIT_V(6); PG8_BAR; PG8_MMA(1, 1, At, B1); PG8_BAR;
            }
        }
        if constexpr (ALIGN_EPI) { if (wr == 0) PG8_BAR; }
        if constexpr (!Epi::AFTER_DRAIN) { E(acc, cur, wr, wc, fr, fq); S.done(cur); }
        if (!has_next) break;
#pragma unroll
        for (int a = 0; a < 2; ++a)
#pragma unroll
            for (int b = 0; b < 2; ++b)
#pragma unroll
                for (int m = 0; m < 4; ++m)
#pragma unroll
                    for (int n = 0; n < 2; ++n) acc[a][b][m][n] = (f32x4){0.f, 0.f, 0.f, 0.f};
        cur = nxt; cA = nA; cB = nB; ++ui;
        if constexpr (ALIGN_EPI) { if (wr == 1) PG8_BAR; }
    }
    PG8_WAIT_V(0);
    if constexpr (!ALIGN_EPI) { if (wr == 0) PG8_BAR; }
    PG8_BAR;
    if constexpr (Epi::AFTER_DRAIN) { E.fused(acc, cur, wr, wc, fr, fq, lds, wid, lane); S.done(cur); }
#undef PG8_SA
#undef PG8_SB
#undef PG8_STAGE
#undef PG8_LDA
#undef PG8_LDB
#undef PG8_MMA
#undef PG8_WAIT_V
#undef PG8_WAIT_L
#undef PG8_BAR
#undef PG8_SCHED
}
}
#include <hip/hip_bf16.h>
#include <cmath>
namespace attn_body {
using bf16=__hip_bfloat16;
using bf16x8=__attribute__((ext_vector_type(8)))short;
using s16x4=__attribute__((ext_vector_type(4)))short;
using f32x16=__attribute__((ext_vector_type(16)))float;
using u32x4=__attribute__((ext_vector_type(4)))unsigned;
constexpr int D=64,QP=512,KP=512,VP=128,OP=1024;
constexpr int NW=8,QBLK=32,QB=QBLK*NW,KVBLK=64;
constexpr int ATTN_UNIT_ROWS=QB;
__device__ __forceinline__ int crow(int r,int hi){return (r&3)+8*(r>>2)+4*hi;}
#define SBAR() __builtin_amdgcn_sched_barrier(0)
__device__ __forceinline__ void cmask(f32x16&p0,f32x16&p1,int jb,int qrel,int hi){
  const float NEG=-INFINITY; int kb=64*jb+4*hi;
  #pragma unroll
  for(int r=0;r<16;++r){int kv=kb+(r&3)+8*(r>>2); if(kv>qrel)p0[r]=NEG; if(kv+32>qrel)p1[r]=NEG;}
}

constexpr int NSLOT=3, SLOTB=8192;
constexpr int LDS_K=0, LDS_V=NSLOT*SLOTB, LDS_WS=2*NSLOT*SLOTB, LDS_OST=LDS_WS+NW*64*4, LDS_BYTES=LDS_OST+NW*4096;
constexpr float C2=0.125f*1.4426950408889634f;
__device__ __forceinline__ void glds16(const void*gsrc,unsigned lds_dst){unsigned keep;
  asm volatile("s_mov_b32 %0, m0\n\ts_mov_b32 m0, %2\n\ts_nop 0\n\tglobal_load_lds_dwordx4 %1, off\n\ts_mov_b32 m0, %0":"=&s"(keep):"v"(gsrc),"s"(lds_dst):"memory");}
__device__ __forceinline__ float max3f(float a,float b,float c){float r;asm("v_max3_f32 %0, %1, %2, %3":"=v"(r):"v"(a),"v"(b),"v"(c));return r;}
__device__ __forceinline__ float max2f(float a,float b){float r;asm("v_max_f32_e32 %0, %1, %2":"=v"(r):"v"(a),"v"(b));return r;}
__device__ __forceinline__ float fadd_s(float a,float b){float r;asm("v_add_f32_e32 %0, %1, %2":"=v"(r):"v"(a),"v"(b));return r;}
__device__ __forceinline__ float fsub_s(float a,float b){float r;asm("v_sub_f32_e32 %0, %1, %2":"=v"(r):"v"(a),"v"(b));return r;}
typedef float f32x2_t __attribute__((ext_vector_type(2))); typedef __bf16 bf16x2_t __attribute__((ext_vector_type(2)));
__device__ __forceinline__ unsigned cvtpk_s(float lo,float hi){f32x2_t v={lo,hi};bf16x2_t b=__builtin_convertvector(v,bf16x2_t);return __builtin_bit_cast(unsigned,b);}
#define WAIT_BAR(N) asm volatile("s_waitcnt vmcnt(" #N ") lgkmcnt(0)\n\ts_barrier":::"memory")

__device__ __forceinline__ void qkt(f32x16&p0,f32x16&p1,const char*Kslot,const bf16x8*qr,const f32x16&negm,int r32,int hi){
  const char*kb=Kslot+hi*1024+r32*16;
  #pragma unroll
  for(int d0=0;d0<4;++d0){
    const bf16x8 b0=*reinterpret_cast<const bf16x8*>(kb+d0*2048);
    const bf16x8 b1=*reinterpret_cast<const bf16x8*>(kb+d0*2048+512);
    if(d0==0){p0=__builtin_amdgcn_mfma_f32_32x32x16_bf16(b0,qr[0],negm,0,0,0);p1=__builtin_amdgcn_mfma_f32_32x32x16_bf16(b1,qr[0],negm,0,0,0);}
    else{p0=__builtin_amdgcn_mfma_f32_32x32x16_bf16(b0,qr[d0],p0,0,0,0);p1=__builtin_amdgcn_mfma_f32_32x32x16_bf16(b1,qr[d0],p1,0,0,0);}}
}
typedef __attribute__((address_space(3))) const char* lds_cptr;
typedef short v4i16_t __attribute__((ext_vector_type(4)));
__device__ __forceinline__ void kload8(bf16x8*kf,lds_cptr kp){
  kf[0]=*(const __attribute__((address_space(3))) bf16x8*)(kp);      kf[1]=*(const __attribute__((address_space(3))) bf16x8*)(kp+512);
  kf[2]=*(const __attribute__((address_space(3))) bf16x8*)(kp+2048); kf[3]=*(const __attribute__((address_space(3))) bf16x8*)(kp+2560);
  kf[4]=*(const __attribute__((address_space(3))) bf16x8*)(kp+4096); kf[5]=*(const __attribute__((address_space(3))) bf16x8*)(kp+4608);
  kf[6]=*(const __attribute__((address_space(3))) bf16x8*)(kp+6144); kf[7]=*(const __attribute__((address_space(3))) bf16x8*)(kp+6656);
}
__device__ __forceinline__ void kload2(bf16x8*kf,lds_cptr kp,int j){ kf[2*j]=*(const __attribute__((address_space(3))) bf16x8*)(kp+j*2048); kf[2*j+1]=*(const __attribute__((address_space(3))) bf16x8*)(kp+j*2048+512); }
__device__ __forceinline__ s16x4 vtr(lds_cptr p){ return __builtin_bit_cast(s16x4,__builtin_amdgcn_ds_read_tr16_b64_v4i16((__attribute__((address_space(3))) v4i16_t*)p)); }
__device__ __forceinline__ float rowmax(const f32x16&p0,const f32x16&p1){
  float a=max3f(p0[0],p0[1],p1[0]),b=max3f(p0[2],p0[3],p1[1]);a=max3f(a,p1[2],p1[3]);
  #pragma unroll
  for(int r=4;r<16;r+=4){a=max3f(a,p0[r],p0[r+1]);b=max3f(b,p0[r+2],p0[r+3]);a=max3f(a,p1[r],p1[r+1]);b=max3f(b,p1[r+2],p1[r+3]);}
  const float m=max2f(a,b);
  auto rr=__builtin_amdgcn_permlane32_swap(__float_as_uint(m),__float_as_uint(m),false,false);
  return max2f(__uint_as_float(rr[0]),__uint_as_float(rr[1]));
}
__device__ __forceinline__ void pv(f32x16*o,int vb,bf16x8 pa0,bf16x8 pa1,bf16x8 pa2,bf16x8 pa3){
  #pragma unroll
  for(int d0=0;d0<2;++d0){s16x4 lo[4],hi[4];
    #pragma unroll
    for(int ks=0;ks<4;++ks){
      asm volatile("ds_read_b64_tr_b16 %0,%1 offset:%c2":"=&v"(lo[ks]):"v"(vb),"i"(d0*4096+ks*1024):"memory");
      asm volatile("ds_read_b64_tr_b16 %0,%1 offset:%c2":"=&v"(hi[ks]):"v"(vb),"i"(d0*4096+ks*1024+512):"memory");}
    asm volatile("s_waitcnt lgkmcnt(0)":::"memory");SBAR();
    #define PK(k) (bf16x8){lo[k][0],lo[k][1],lo[k][2],lo[k][3],hi[k][0],hi[k][1],hi[k][2],hi[k][3]}
    o[d0]=__builtin_amdgcn_mfma_f32_32x32x16_bf16(pa0,PK(0),o[d0],0,0,0);
    o[d0]=__builtin_amdgcn_mfma_f32_32x32x16_bf16(pa1,PK(1),o[d0],0,0,0);
    o[d0]=__builtin_amdgcn_mfma_f32_32x32x16_bf16(pa2,PK(2),o[d0],0,0,0);
    o[d0]=__builtin_amdgcn_mfma_f32_32x32x16_bf16(pa3,PK(3),o[d0],0,0,0);
    #undef PK
  }
}

#ifndef ATTN_STORE16
#define ATTN_STORE16(p,v) (*(u32x4*)(p)=(v))
#endif
template<int THRL> __device__ __forceinline__ void attn_unit(int rowbase_i,int S,int qb,int qcol,int kcol,int vcol,int ocol,const bf16*Q,const bf16*__restrict__ K,const bf16*__restrict__ V,bf16*O,char*shm){
  int tid_o=threadIdx.x; asm volatile("":"+v"(tid_o)); const int tid=tid_o,lane=tid&63,r32=lane&31,hi=lane>>5; const int wid=__builtin_amdgcn_readfirstlane(tid>>6);
  const long rowbase=(long)rowbase_i; const int q0=qb*QB;
  const bf16*Qw=Q+(rowbase+q0+wid*QBLK)*QP+qcol;
  const bf16*Kh=K+rowbase*KP+kcol,*Vh=V+rowbase*VP+vcol;
  const unsigned lds0=(unsigned)(uintptr_t)shm;
  float*wsf=(float*)(shm+LDS_WS)+wid*64;
  const bf16*ksrc=Kh+(long)lane*KP+wid*8;
  const bf16*vsrc=Vh+(long)(16*(wid&3)+(lane>>2))*VP+(wid>>2)*32+(lane&3)*8;
  const unsigned kdst=lds0+LDS_K+wid*1024, vdst=lds0+LDS_V+wid*1024;
  #define DMA_K(t,slot) glds16(ksrc+(long)(t)*KVBLK*KP,(unsigned)__builtin_amdgcn_readfirstlane(kdst+(slot)))
  #define DMA_V(t,slot) glds16(vsrc+(long)(t)*KVBLK*VP,(unsigned)__builtin_amdgcn_readfirstlane(vdst+(slot)))
  const int vb0=(int)(lds0+LDS_V)+((lane>>4)&1)*32+(lane&3)*8+(4*hi+((lane&15)>>2))*64;
  const char*Kbase=shm+LDS_K; bf16x8 kf[8];
  const lds_cptr shm3=(lds_cptr)shm; const lds_cptr kp0=shm3+LDS_K+hi*1024+r32*16; const lds_cptr vp0=shm3+LDS_V+((lane>>4)&1)*32+(lane&3)*8+(4*hi+((lane&15)>>2))*64;
  const int NT=S/KVBLK;
  DMA_K(0,0);DMA_V(0,0);DMA_K(1,SLOTB);
  bf16x8 qr[4];
  #pragma unroll
  for(int d0=0;d0<4;++d0)qr[d0]=*reinterpret_cast<const bf16x8*>(&Qw[(long)r32*QP+d0*16+hi*8]);
  float mhat=0.f,l_reg=0.f;f32x16 o[2];o[0]=f32x16{};o[1]=f32x16{};f32x16 negm=f32x16{};asm volatile("":"+v"(negm));
  const int qrel=wid*QBLK+r32;
  #define CMASK(P0,P1,t) do{}while(0)
  bool resc=false;
  #define START(P0,P1) do{ const float rm=rowmax(P0,P1); resc=false; \
    { const float dl=rm; mhat=fadd_s(mhat,dl); \
      _Pragma("unroll") for(int r=0;r<16;++r){P0[r]=fsub_s(P0[r],dl);P1[r]=fsub_s(P1[r],dl);} \
      _Pragma("unroll") for(int r=0;r<16;++r)negm[r]=-mhat; asm volatile("":"+v"(negm)); } \
    _Pragma("unroll") for(int r=0;r<16;++r)P0[r]=__builtin_amdgcn_exp2f(P0[r]); }while(0)
  #define RESC() do{ if(resc){ asm volatile("s_waitcnt lgkmcnt(0)":::"memory"); \
      _Pragma("unroll") for(int d_=0;d_<2;++d_) _Pragma("unroll") for(int r=0;r<16;++r)o[d_][r]*=wsf[crow(r,hi)]; } }while(0)
  f32x16 pA0,pA1,pB0,pB1;
  int sl_prev=0,sl_cur=0,sl_next=SLOTB;
  #define ROT() do{sl_prev=sl_cur;sl_cur=sl_next;sl_next=(sl_next==(NSLOT-1)*SLOTB)?0:sl_next+SLOTB;}while(0)
  DMA_K(2,2*SLOTB);
  WAIT_BAR(3);
  qkt(pA0,pA1,Kbase,qr,negm,r32,hi);asm volatile("s_nop 15\n\ts_nop 7":"+v"(pA0),"+v"(pA1));CMASK(pA0,pA1,0);
  START(pA0,pA1);
  _Pragma("unroll") for(int r=0;r<16;++r)pA1[r]=__builtin_amdgcn_exp2f(pA1[r]);
  WAIT_BAR(0);
  DMA_K(3,0);DMA_V(1,SLOTB);
  ROT();
  kload8(kf,kp0+sl_cur);
  WAIT_BAR(2);
  s16x4 vlo[8],vhi[8]; u32x4 pw0,pw1,pw2,pw3;
  #define PKW(P,B) cvtpk_s(P[B],P[B+1])
  #define PAF(k) __builtin_bit_cast(bf16x8,pw##k)
  #define VFR(i) (bf16x8){vlo[i][0],vlo[i][1],vlo[i][2],vlo[i][3],vhi[i][0],vhi[i][1],vhi[i][2],vhi[i][3]}
  #define PIN(x) asm volatile("":"+v"(x))
  #define MX3(a,b,c) __builtin_fmaxf(__builtin_fmaxf((a),(b)),(c))
  #define GAPA(MF,A0,A1,A2,A3,W0,W1,PW) do{ MF; sacc+=A0; sacc+=A1; sacc+=A2; sacc+=A3; PIN(sacc); W0; W1; PIN(PW); SBAR(); }while(0)
  #define EX(v) __builtin_amdgcn_exp2f(v)
  #define GAPB(MF,X,B) do{ MF; X[B]=EX(X[B]); X[B+1]=EX(X[B+1]); X[B+2]=EX(X[B+2]); X[B+3]=EX(X[B+3]); PIN(X); SBAR(); }while(0)
  #define VRD(i) do{ vlo[i]=vtr(vp_+(((i)>>2)*4096+((i)&3)*1024)); vhi[i]=vtr(vp_+(((i)>>2)*4096+((i)&3)*1024+512)); }while(0)
  #define KRD(G,j) do{ if(G){ kload2(kf,kp0+sl_next,j); SBAR(); } }while(0)
  #define STEP(C0,C1,P0,P1,t,GK,GV,GL) do{ SBAR(); \
    const lds_cptr vp_=vp0+sl_prev; \
    VRD(0); SBAR(); float sacc=(P0[0]+P0[1]); \
    GAPA(C0=__builtin_amdgcn_mfma_f32_32x32x16_bf16(kf[0],qr[0],negm,0,0,0), P0[2],P0[3],P0[4],P0[5],     pw0[0]=PKW(P0,0), pw0[1]=PKW(P0,2), pw0); \
    VRD(4); SBAR(); GAPA(C1=__builtin_amdgcn_mfma_f32_32x32x16_bf16(kf[1],qr[0],negm,0,0,0), P0[6],P0[7],P0[8],P0[9],     pw0[2]=PKW(P0,4), pw0[3]=PKW(P0,6), pw0); \
    VRD(1); SBAR(); GAPA(C0=__builtin_amdgcn_mfma_f32_32x32x16_bf16(kf[2],qr[1],C0,0,0,0),   P0[10],P0[11],P0[12],P0[13], pw1[0]=PKW(P0,8), pw1[1]=PKW(P0,10), pw1); \
    VRD(5); SBAR(); GAPA(C1=__builtin_amdgcn_mfma_f32_32x32x16_bf16(kf[3],qr[1],C1,0,0,0),   P0[14],P0[15],P1[0],P1[1],   pw1[2]=PKW(P0,12),pw1[3]=PKW(P0,14), pw1); \
    VRD(2); SBAR(); GAPA(C0=__builtin_amdgcn_mfma_f32_32x32x16_bf16(kf[4],qr[2],C0,0,0,0),   P1[2],P1[3],P1[4],P1[5],     pw2[0]=PKW(P1,0), pw2[1]=PKW(P1,2), pw2); \
    VRD(6); SBAR(); GAPA(C1=__builtin_amdgcn_mfma_f32_32x32x16_bf16(kf[5],qr[2],C1,0,0,0),   P1[6],P1[7],P1[8],P1[9],     pw2[2]=PKW(P1,4), pw2[3]=PKW(P1,6), pw2); \
    VRD(3); SBAR(); GAPA(C0=__builtin_amdgcn_mfma_f32_32x32x16_bf16(kf[6],qr[3],C0,0,0,0),   P1[10],P1[11],P1[12],P1[13], pw3[0]=PKW(P1,8), pw3[1]=PKW(P1,10), pw3); \
    VRD(7); SBAR(); GAPA(C1=__builtin_amdgcn_mfma_f32_32x32x16_bf16(kf[7],qr[3],C1,0,0,0),   P1[14],P1[15],0.f,0.f,       pw3[2]=PKW(P1,12),pw3[3]=PKW(P1,14), pw3); \
    l_reg+=sacc; \
    if(GK){DMA_K((t)+3,sl_cur);} if(GV){DMA_V((t)+1,sl_next);} \
    CMASK(C0,C1,t); \
    { float a=MX3(C0[0],C0[1],C1[0]),b=MX3(C0[2],C0[3],C1[1]); a=MX3(a,C1[2],C1[3]); \
      _Pragma("unroll") for(int r=4;r<16;r+=4){a=MX3(a,C0[r],C0[r+1]);b=MX3(b,C0[r+2],C0[r+3]);a=MX3(a,C1[r],C1[r+1]);b=MX3(b,C1[r+2],C1[r+3]);} \
      float rm=__builtin_fmaxf(a,b); { auto rr=__builtin_amdgcn_permlane32_swap(__float_as_uint(rm),__float_as_uint(rm),false,false); rm=__builtin_fmaxf(__uint_as_float(rr[0]),__uint_as_float(rr[1])); } \
      resc=false; \
      if(__builtin_expect(__any(rm>(float)THRL),0)){ const float dl=__builtin_fmaxf(rm,0.f); mhat+=dl; \
        _Pragma("unroll") for(int r=0;r<16;++r){C0[r]-=dl;C1[r]-=dl;} \
        _Pragma("unroll") for(int r=0;r<16;++r)negm[r]=-mhat; asm volatile("":"+v"(negm)); \
        const float f=__builtin_amdgcn_exp2f(-dl); l_reg*=f; if(hi==0)wsf[r32]=f; resc=true; } } \
    SBAR(); \
    GAPB(o[0]=__builtin_amdgcn_mfma_f32_32x32x16_bf16(PAF(0),VFR(0),o[0],0,0,0), C0,0); \
    GAPB(o[1]=__builtin_amdgcn_mfma_f32_32x32x16_bf16(PAF(0),VFR(4),o[1],0,0,0), C0,4); \
    KRD(GL,0); GAPB(o[0]=__builtin_amdgcn_mfma_f32_32x32x16_bf16(PAF(1),VFR(1),o[0],0,0,0), C0,8); \
    KRD(GL,1); GAPB(o[1]=__builtin_amdgcn_mfma_f32_32x32x16_bf16(PAF(1),VFR(5),o[1],0,0,0), C0,12); \
    KRD(GL,2); GAPB(o[0]=__builtin_amdgcn_mfma_f32_32x32x16_bf16(PAF(2),VFR(2),o[0],0,0,0), C1,0); \
    KRD(GL,3); GAPB(o[1]=__builtin_amdgcn_mfma_f32_32x32x16_bf16(PAF(2),VFR(6),o[1],0,0,0), C1,4); \
    GAPB(o[0]=__builtin_amdgcn_mfma_f32_32x32x16_bf16(PAF(3),VFR(3),o[0],0,0,0), C1,8); \
    GAPB(o[1]=__builtin_amdgcn_mfma_f32_32x32x16_bf16(PAF(3),VFR(7),o[1],0,0,0), C1,12); \
    }while(0)
  int t=1;
  #undef CMASK
  #define CMASK(P0,P1,t) do{}while(0)
  for(;t+5<NT;t+=2){
    STEP(pB0,pB1,pA0,pA1,t,true,true,true);     WAIT_BAR(2); RESC(); ROT();
    STEP(pA0,pA1,pB0,pB1,t+1,true,true,true);   WAIT_BAR(2); RESC(); ROT();
  }
  #undef CMASK
  #define CMASK(P0,P1,t) do{}while(0)
  #define ENDW(tt) do{ if((tt)+3<NT){WAIT_BAR(2);} else if((tt)+2<NT){WAIT_BAR(1);} else {WAIT_BAR(0);} }while(0)
  for(;t+1<NT;t+=2){
    STEP(pB0,pB1,pA0,pA1,t,(t+3<NT),(t+1<NT),(t+1<NT));       ENDW(t);   RESC(); ROT();
    STEP(pA0,pA1,pB0,pB1,t+1,(t+4<NT),(t+2<NT),(t+2<NT));     ENDW(t+1); RESC(); ROT();
  }
  STEP(pB0,pB1,pA0,pA1,NT-1,false,false,false); RESC();
  { float sacc=pB0[0]+pB0[1]; _Pragma("unroll") for(int r=2;r<16;++r)sacc+=pB0[r]; _Pragma("unroll") for(int r=0;r<16;++r)sacc+=pB1[r]; l_reg+=sacc;
    pw0=(u32x4){PKW(pB0,0),PKW(pB0,2),PKW(pB0,4),PKW(pB0,6)};pw1=(u32x4){PKW(pB0,8),PKW(pB0,10),PKW(pB0,12),PKW(pB0,14)};pw2=(u32x4){PKW(pB1,0),PKW(pB1,2),PKW(pB1,4),PKW(pB1,6)};pw3=(u32x4){PKW(pB1,8),PKW(pB1,10),PKW(pB1,12),PKW(pB1,14)};
    SBAR(); pv(o,vb0+sl_cur,PAF(0),PAF(1),PAF(2),PAF(3)); }
  #undef PKW
  #undef PAF
  #undef VFR
  #undef PIN
  #undef MX3
  #undef GAPA
  #undef GAPB
  #undef EX
  #undef VRD
  #undef KRD
  #undef STEP
  #undef ENDW
  {auto rr=__builtin_amdgcn_permlane32_swap(__float_as_uint(l_reg),__float_as_uint(l_reg),false,false);l_reg=__uint_as_float(rr[0])+__uint_as_float(rr[1]);}
  if(hi==0)wsf[32+r32]=l_reg;asm volatile("s_waitcnt lgkmcnt(0)":::"memory");
  float rli[16];
  #pragma unroll
  for(int r=0;r<16;++r)rli[r]=__builtin_amdgcn_rcpf(wsf[32+crow(r,hi)]);
  bf16*Ow=O+(rowbase+q0+wid*QBLK)*OP+ocol;
  { bf16*stg=(bf16*)(shm+LDS_OST)+wid*2048;
    #pragma unroll
    for(int r=0;r<16;++r){const int orow=crow(r,hi);
      #pragma unroll
      for(int d0=0;d0<2;++d0)stg[orow*64+d0*32+r32]=__float2bfloat16(o[d0][r]*rli[r]);}
    asm volatile("s_waitcnt lgkmcnt(0)":::"memory");
    #pragma unroll
    for(int i=0;i<4;++i){const int row=i*8+(lane>>3),ch=lane&7; const u32x4 v=*(const u32x4*)(stg+row*64+ch*8); ATTN_STORE16(Ow+(long)row*OP+ch*8,v);} }
  asm volatile("s_waitcnt lgkmcnt(0)\n\ts_barrier":::"memory");
  #undef DMA_K
  #undef DMA_V
  #undef CMASK
  #undef START
  #undef RESC
  #undef ROT
}
constexpr int ATTN_LDS_BYTES=LDS_BYTES;
#undef SBAR
#undef WAIT_BAR
}

#define LAS __attribute__((address_space(3)))
#define LDS_BARRIER() asm volatile("s_waitcnt lgkmcnt(0)\n\ts_barrier" ::: "memory")
typedef unsigned short bf16;
typedef unsigned u32x4_t __attribute__((ext_vector_type(4)));
typedef unsigned u32x2_t __attribute__((ext_vector_type(2)));
typedef float f32x4_t __attribute__((ext_vector_type(4)));
typedef float f32x2_t __attribute__((ext_vector_type(2)));

constexpr int DM = 1024, MTOK = 49152, NSEQ = 20, DFF = 2816, NFF = 5632, NMIXP = 2560, NMIX = 2432, ZP = 1792;
constexpr int NTHR = 512;
constexpr float QSCALE = 0.125f * 1.4426950408889634f;
constexpr size_t MiB = 1u << 20;
constexpr size_t ZERO_BYTES = 8 * MiB;
constexpr size_t OFF_CTR = 0, OFF_ROPE = 32768, OFF_SS = 65536, OFF_MOD = 2 * MiB, OFF_BIAS = 4 * MiB, OFF_GV = 7 * MiB, OFF_GATE = 7 * MiB + 512 * 1024;
constexpr size_t OFF_W = 8 * MiB, W_LAYER = 40 * MiB;
constexpr size_t WO_IN = 0, WO_OUT = 22 * MiB, WO_MI = 33 * MiB, WO_MO = 38 * MiB;
constexpr size_t OFF_XN = 88 * MiB, OFF_YF = 88 * MiB, OFF_YB = 136 * MiB;
constexpr size_t OFF_HID = 184 * MiB, OFF_Z = 184 * MiB, OFF_QK = 352 * MiB, OFF_VR = 400 * MiB, OFF_OMIX = 412 * MiB, WS_END = 508 * MiB;
constexpr size_t OFF_SMID = 508 * MiB;
constexpr int LDS_BYTES = 147456, MISC_OFF = 131072;

struct KP { const float* in[31]; float* out; unsigned char* ws; };

__device__ __forceinline__ int seq_of_row(int m) { return m < 16384 ? (m >> 12) : 4 + ((m - 16384) >> 11); }
__device__ __forceinline__ int seq_start(int s) { return s < 4 ? s * 4096 : 16384 + (s - 4) * 2048; }
__device__ __forceinline__ int seq_len(int s) { return s < 4 ? 4096 : 2048; }
__device__ __forceinline__ unsigned f2bf(float f) { unsigned u = __builtin_bit_cast(unsigned, f); return (u + 0x7fffu + ((u >> 16) & 1u)) >> 16; }
__device__ __forceinline__ unsigned pk2(float lo, float hi) { return f2bf(lo) | (f2bf(hi) << 16); }
__device__ __forceinline__ float bf2f(unsigned short b) { return __builtin_bit_cast(float, (unsigned)b << 16); }
__device__ __forceinline__ float sigmoidf_(float x) { return __builtin_amdgcn_rcpf(1.0f + __builtin_amdgcn_exp2f(-1.4426950408889634f * x)); }
#define DPP_ADD(v, CTRL) ((v) + __builtin_bit_cast(float, __builtin_amdgcn_update_dpp(0, __builtin_bit_cast(int, (v)), (CTRL), 0xf, 0xf, false)))
__device__ __forceinline__ float wave_sum(float v) {
    v = DPP_ADD(v, 0xB1);
    v = DPP_ADD(v, 0x4E);
    v = DPP_ADD(v, 0x141);
    v = DPP_ADD(v, 0x140);
    const f32x4_t d = __builtin_amdgcn_mfma_f32_16x16x4f32(1.0f, v, (f32x4_t){0.f, 0.f, 0.f, 0.f}, 0, 0, 0);
    return d[0];
}
__device__ __forceinline__ float tanh_fast(float x) { const float e = __expf(2.0f * x); return 1.0f - 2.0f * __builtin_amdgcn_rcpf(e + 1.0f); }
__host__ __device__ __forceinline__ int map_ffn(int n) { const int half = n >= DFF ? 1 : 0; const int n2 = half ? n - DFF : n; return 256 * (n2 >> 7) + 128 * half + (n2 & 127); }
__host__ __device__ __forceinline__ int map_mix(int n) {
    if (n < 1792 || n >= 2304) return n;
    const int hh = (n - 1792) >> 6, d = (n - 1792) & 63;
    return 256 * (7 + (hh >> 2)) + 128 * (d >> 5) + 32 * (hh & 3) + 8 * ((d & 15) >> 2) + 4 * ((d >> 4) & 1) + (d & 3);
}

namespace pg8 {
struct EpiSwiglu {
    static constexpr bool PERM = true, AFTER_DRAIN = false;
    bf16_t* H; const float* ss; const float* bias;
    __device__ __forceinline__ void operator()(const f32x4 (&acc)[2][2][4][2], const Unit& u, int wr, int wc, int fr, int fq) const {
        const int row0 = u.pm * BM + wr * 64 + fr; const int s = seq_of_row(u.pm * BM);
        const float* bp = bias + (size_t)s * NFF + u.pn * 256 + wc * 32 + 8 * fq;
        f32x4 bg[2], bu[2];
#pragma unroll
        for (int n = 0; n < 2; ++n) { bg[n] = *(const f32x4*)(bp + 4 * n); bu[n] = *(const f32x4*)(bp + 128 + 4 * n); }
        float rsv[2][4];
#pragma unroll
        for (int ai = 0; ai < 2; ++ai)
#pragma unroll
            for (int m = 0; m < 4; ++m) rsv[ai][m] = ss[row0 + ai * HALF + m * 16];
        asm volatile("" ::: "memory");
#pragma unroll
        for (int ai = 0; ai < 2; ++ai)
#pragma unroll
            for (int m = 0; m < 4; ++m) {
                const int row = row0 + ai * HALF + m * 16;
                const float rs = rsqrtf(rsv[ai][m] * (1.0f / 1024.0f) + 1e-6f);
                float h[8];
#pragma unroll
                for (int n = 0; n < 2; ++n) {
                    const f32x4 g = acc[ai][0][m][n] * rs + bg[n], up = acc[ai][1][m][n] * rs + bu[n];
#pragma unroll
                    for (int i = 0; i < 4; ++i) h[4 * n + i] = g[i] * sigmoidf_(g[i]) * up[i];
                }
                u32x4 w; w.x = cvt_pk_bf16(h[0], h[1]); w.y = cvt_pk_bf16(h[2], h[3]); w.z = cvt_pk_bf16(h[4], h[5]); w.w = cvt_pk_bf16(h[6], h[7]);
                *(u32x4*)(H + (size_t)row * DFF + u.pn * 128 + wc * 32 + 8 * fq) = w;
            }
    }
};
struct EpiZ {
    static constexpr bool PERM = true, AFTER_DRAIN = false;
    bf16_t* Z; bf16_t* QK; bf16_t* VR; const float* ss; const float* bias; const float* qg; const float* kg; const float* rope;
    __device__ __forceinline__ void operator()(const f32x4 (&acc)[2][2][4][2], const Unit& u, int wr, int wc, int fr, int fq) const {
        const int row0 = u.pm * BM + wr * 64 + fr; const int s = seq_of_row(u.pm * BM); const int t0 = row0 - seq_start(s);
        const float* bp = bias + (size_t)s * NFF + u.pn * 256 + wc * 32 + 8 * fq;
        f32x4 bv[2][2];
#pragma unroll
        for (int bj = 0; bj < 2; ++bj)
#pragma unroll
            for (int n = 0; n < 2; ++n) bv[bj][n] = *(const f32x4*)(bp + bj * 128 + 4 * n);
        if (u.pn < 7 || u.pn == 9) {
            float rsv[2][4];
#pragma unroll
            for (int ai = 0; ai < 2; ++ai)
#pragma unroll
                for (int m = 0; m < 4; ++m) rsv[ai][m] = ss[row0 + ai * HALF + m * 16];
            asm volatile("" ::: "memory");
#pragma unroll
            for (int ai = 0; ai < 2; ++ai)
#pragma unroll
                for (int m = 0; m < 4; ++m) {
                    const int row = row0 + ai * HALF + m * 16;
                    const float rs = rsqrtf(rsv[ai][m] * (1.0f / 1024.0f) + 1e-6f);
#pragma unroll
                    for (int bj = 0; bj < 2; ++bj) {
                        const f32x4 v0 = acc[ai][bj][m][0] * rs + bv[bj][0], v1 = acc[ai][bj][m][1] * rs + bv[bj][1];
                        u32x4 w; w.x = cvt_pk_bf16(v0[0], v0[1]); w.y = cvt_pk_bf16(v0[2], v0[3]); w.z = cvt_pk_bf16(v1[0], v1[1]); w.w = cvt_pk_bf16(v1[2], v1[3]);
                        if (u.pn < 7) *(u32x4*)(Z + (size_t)row * ZP + u.pn * 256 + bj * 128 + wc * 32 + 8 * fq) = w;
                        else if (bj == 0) *(u32x4*)(VR + (size_t)row * 128 + wc * 32 + 8 * fq) = w;
                    }
                }
        } else {
            const int hh = (u.pn - 7) * 4 + wc; const bool isq = hh < 6; const float* gp = isq ? qg : kg; const float osc = isq ? QSCALE : 1.0f;
            f32x4 gn[2][2];
#pragma unroll
            for (int bj = 0; bj < 2; ++bj)
#pragma unroll
                for (int n = 0; n < 2; ++n) gn[bj][n] = *(const f32x4*)(gp + 32 * bj + 16 * n + 4 * fq);
#pragma unroll
            for (int ai = 0; ai < 2; ++ai)
#pragma unroll
                for (int m = 0; m < 4; ++m) {
                    const int row = row0 + ai * HALF + m * 16; const int t = t0 + ai * HALF + m * 16;
                    const float rs = rsqrtf(ss[row] * (1.0f / 1024.0f) + 1e-6f);
                    f32x4 v[2][2]; float q = 0.f;
#pragma unroll
                    for (int bj = 0; bj < 2; ++bj)
#pragma unroll
                        for (int n = 0; n < 2; ++n) { v[bj][n] = acc[ai][bj][m][n] * rs + bv[bj][n]; q += (v[bj][n][0] * v[bj][n][0] + v[bj][n][1] * v[bj][n][1]) + (v[bj][n][2] * v[bj][n][2] + v[bj][n][3] * v[bj][n][3]); }
                    q += __shfl_xor(q, 16); q += __shfl_xor(q, 32);
                    const float r = rsqrtf(q * (1.0f / 64.0f) + 1e-6f);
#pragma unroll
                    for (int bj = 0; bj < 2; ++bj) {
                        const int pos = bj == 0 ? (t >> 6) : (t & 63);
                        const f32x4 x1 = v[bj][0] * r * gn[bj][0], x2 = v[bj][1] * r * gn[bj][1];
                        const float* rp = rope + (pos * 16 + 4 * fq) * 2;
                        const f32x4 cs0 = *(const f32x4*)(rp), cs1 = *(const f32x4*)(rp + 4);
                        const float c[4] = {cs0[0], cs0[2], cs1[0], cs1[2]}, sn[4] = {cs0[1], cs0[3], cs1[1], cs1[3]};
                        float o1[4], o2[4];
#pragma unroll
                        for (int i = 0; i < 4; ++i) { o1[i] = (x1[i] * c[i] - x2[i] * sn[i]) * osc; o2[i] = (x2[i] * c[i] + x1[i] * sn[i]) * osc; }
                        u32x4 w; w.x = cvt_pk_bf16(o1[0], o1[1]); w.y = cvt_pk_bf16(o1[2], o1[3]); w.z = cvt_pk_bf16(o2[0], o2[1]); w.w = cvt_pk_bf16(o2[2], o2[3]);
                        *(u32x4*)(QK + (size_t)row * 512 + hh * 64 + 32 * bj + 8 * fq) = w;
                    }
                }
        }
    }
};
struct EpiResid {
    static constexpr bool PERM = false, AFTER_DRAIN = false;
    const float* xin_p; const float* xin_s; float* out; bf16_t* xn; float* ssn; const float* gate; const float* gvn;
    __device__ __forceinline__ void operator()(const f32x4 (&acc)[2][2][4][2], const Unit& u, int wr, int wc, int fr, int fq) const {
        const int rowt = u.pm * BM; const int s = seq_of_row(rowt);
        const float* xb = rowt < 16384 ? xin_p : xin_s - (size_t)16384 * DM;
        const int row0 = rowt + wr * 64 + fr; const int col0 = u.pn * BM + wc * 32 + 4 * fq;
        f32x4 gt[2][2], gv[2][2];
#pragma unroll
        for (int bj = 0; bj < 2; ++bj)
#pragma unroll
            for (int n = 0; n < 2; ++n) { gt[bj][n] = *(const f32x4*)(gate + (size_t)s * DM + col0 + bj * HALF + n * 16); gv[bj][n] = gvn ? *(const f32x4*)(gvn + (size_t)s * DM + col0 + bj * HALF + n * 16) : (f32x4){0.f, 0.f, 0.f, 0.f}; }
        f32x4 xo[2][2][2];
#define ER_LOAD(G, BUF) do { const unsigned off_ = (unsigned)(row0 + ((G) >> 2) * HALF + ((G) & 3) * 16) * DM + col0; \
            _Pragma("unroll") for (int bj = 0; bj < 2; ++bj) _Pragma("unroll") for (int n = 0; n < 2; ++n) xo[BUF][bj][n] = *(const f32x4*)(xb + off_ + bj * HALF + n * 16); } while (0)
        ER_LOAD(0, 0);
#pragma unroll
        for (int gi = 0; gi < 8; ++gi) {
            const int ai = gi >> 2, m = gi & 3;
            if (gi < 7) ER_LOAD(gi + 1, (gi + 1) & 1);
            asm volatile("" ::: "memory");
            const int row = row0 + ai * HALF + m * 16; const unsigned off = (unsigned)row * DM + col0; float q = 0.f;
#pragma unroll
            for (int bj = 0; bj < 2; ++bj)
#pragma unroll
                for (int n = 0; n < 2; ++n) {
                    const f32x4 val = xo[gi & 1][bj][n] + gt[bj][n] * acc[ai][bj][m][n];
                    *(f32x4*)(out + off + bj * HALF + n * 16) = val;
                    if (gvn) {
                        q += (val[0] * val[0] + val[1] * val[1]) + (val[2] * val[2] + val[3] * val[3]);
                        const f32x4 o = val * gv[bj][n]; unsigned long long w = (unsigned long long)cvt_pk_bf16(o[0], o[1]) | ((unsigned long long)cvt_pk_bf16(o[2], o[3]) << 32);
                        *(unsigned long long*)(xn + off + bj * HALF + n * 16) = w;
                    }
                }
            if (gvn) { q += __shfl_xor(q, 16); q += __shfl_xor(q, 32); if (fq == 0) atomicAdd(ssn + row, q); }
        }
#undef ER_LOAD
    }
};
}

template <int MAP> __device__ __forceinline__ void transpose_item(const float* W, int K, int N, bf16* WT, float* scr, int item, int lane) {
    const int nblk = N / 32, kb = item / nblk, nb = item % nblk, k0 = 64 * kb, n0 = 32 * nb;
#pragma unroll 8
    for (int i = 0; i < 32; ++i) { const int kk = 2 * i + (lane >> 5); scr[kk * 33 + (lane & 31)] = W[(size_t)(k0 + kk) * N + n0 + (lane & 31)]; }
    __builtin_amdgcn_wave_barrier(); asm volatile("s_waitcnt lgkmcnt(0)" ::: "memory");
    const int c = lane & 7;
#pragma unroll
    for (int j = 0; j < 4; ++j) { const int n = (lane >> 3) + 8 * j; const float* sp = scr + (8 * c) * 33 + n;
        u32x4_t o; o.x = pk2(sp[0 * 33], sp[1 * 33]); o.y = pk2(sp[2 * 33], sp[3 * 33]); o.z = pk2(sp[4 * 33], sp[5 * 33]); o.w = pk2(sp[6 * 33], sp[7 * 33]);
        const int nsrc = n0 + n; const int nd = MAP == 1 ? map_ffn(nsrc) : (MAP == 2 ? map_mix(nsrc) : nsrc);
        *(u32x4_t*)(WT + (size_t)nd * K + k0 + 8 * c) = o; }
    __builtin_amdgcn_wave_barrier(); asm volatile("s_waitcnt lgkmcnt(0)" ::: "memory");
}

template <int MODE, int MAP> __device__ __forceinline__ void smallm_unit(const KP& p, float* sA, int l, int j, const float* W, int ldw, int nvalid, float* dest, int ldd, int nchunk, int kchunk) {
    int tid_o = threadIdx.x; asm volatile("" : "+v"(tid_o)); const int tid = tid_o; const int k0 = kchunk * 128;
    __syncthreads();
    for (int e = tid; e < 128 * NSEQ; e += NTHR) {
        const int k = e / NSEQ, s = e % NSEQ; float v;
        if (MODE == 0) { const float c = s < 4 ? p.in[2][s * DM + k0 + k] : p.in[3][(s - 4) * DM + k0 + k]; v = c * sigmoidf_(c); }
        else { const float* mod = (const float*)(p.ws + OFF_MOD) + ((size_t)l * NSEQ + s) * 9216 + 3 * j * 1024 + k0 + k; v = *mod + p.in[5][l * 9216 + 3 * j * 1024 + k0 + k]; }
        sA[k * NSEQ + s] = v;
    }
    __syncthreads();
    const int n = nchunk * 256 + (tid & 255), kh = tid >> 8;
    float acc[NSEQ];
#pragma unroll
    for (int s = 0; s < NSEQ; ++s) acc[s] = 0.f;
    if (n < nvalid) {
        for (int kb = 0; kb < 64; kb += 16) {
            float wv[16];
#pragma unroll
            for (int u = 0; u < 16; ++u) wv[u] = W[(size_t)(k0 + kh * 64 + kb + u) * ldw + n];
#pragma unroll
            for (int u = 0; u < 16; ++u) { const int k = kh * 64 + kb + u; const float w = wv[u];
                const f32x4_t* ap = (const f32x4_t*)(sA + k * NSEQ);
#pragma unroll
                for (int q = 0; q < 5; ++q) { const f32x4_t a = ap[q]; acc[4 * q] += a[0] * w; acc[4 * q + 1] += a[1] * w; acc[4 * q + 2] += a[2] * w; acc[4 * q + 3] += a[3] * w; } }
        }
        const int nd = MAP == 1 ? map_ffn(n) : (MAP == 2 ? map_mix(n) : n);
#pragma unroll
        for (int s = 0; s < NSEQ; ++s) atomicAdd(dest + (size_t)s * ldd + nd, acc[s]);
    }
}

#define DPP_FMAC(acc, x, s, J) asm volatile("v_fmac_f32_dpp %0, %1, %2 row_newbcast:" #J " row_mask:0xf bank_mask:0xf" : "+v"(acc) : "v"(x), "v"(s))
#define DPP_FMAC_N(acc, x, s, J) asm volatile("s_nop 1\n\tv_fmac_f32_dpp %0, %1, %2 row_newbcast:" #J " row_mask:0xf bank_mask:0xf" : "+v"(acc) : "v"(x), "v"(s))
#define DPP_MUL(s, x, J) asm volatile("v_mul_f32_dpp %0, %1, %0 row_newbcast:" #J " row_mask:0xf bank_mask:0xf" : "+v"(s) : "v"(x))
#define DPP_MUL_N(s, x, J) asm volatile("s_nop 1\n\tv_mul_f32_dpp %0, %1, %0 row_newbcast:" #J " row_mask:0xf bank_mask:0xf" : "+v"(s) : "v"(x))
#define REP15(M, X) M(1, X) M(2, X) M(3, X) M(4, X) M(5, X) M(6, X) M(7, X) M(8, X) M(9, X) M(10, X) M(11, X) M(12, X) M(13, X) M(14, X) M(15, X)
__device__ __forceinline__ float row4_sum(float x) {
    auto r1 = __builtin_amdgcn_permlane16_swap(__float_as_uint(x), __float_as_uint(x), false, false); x = __uint_as_float(r1[0]) + __uint_as_float(r1[1]);
    auto r2 = __builtin_amdgcn_permlane32_swap(__float_as_uint(x), __float_as_uint(x), false, false); return __uint_as_float(r2[0]) + __uint_as_float(r2[1]);
}
__device__ __forceinline__ void rwkv_unit(const KP& p, unsigned char* lds, int l, int s, int h, int d, int mode) {
    int tid_o = threadIdx.x; asm volatile("" : "+v"(tid_o)); const int tid = tid_o, lane = tid & 63; const int wid = __builtin_amdgcn_readfirstlane(tid >> 6);
    constexpr int TB = 16;
    f32x2_t* W2 = (f32x2_t*)lds;
    float* OPS = (float*)(lds + 32768);
    float* YBUF = (float*)(lds + 32768 + 49152);
    float* PWS = (float*)(lds + 32768 + 49152 + 8192) + (wid & 3) * 1024;
    const bf16* Z = (const bf16*)(p.ws + OFF_Z);
    float* Y = (float*)(p.ws + (d == 0 ? OFF_YF : OFF_YB));
    const float* mu = p.in[18] + l * 1024;
    const float* w_up = p.in[19] + ((size_t)l * 2 + d) * 64 * 256;
    const float* a_up = p.in[21] + (size_t)l * 64 * 256;
    const int S = seq_len(s), start = seq_start(s); const int NS = mode == 0 ? S : S / 2, s0 = mode >= 2 ? S / 2 : 0; const int NB = NS / TB;
    __syncthreads();
    for (int e = tid; e < 4096; e += NTHR) { const int i = e >> 6, j = e & 63; W2[e] = (f32x2_t){w_up[i * 256 + 64 * h + j], a_up[i * 256 + 64 * h + j]}; }
    __syncthreads();
    if (wid >= 4) {
        const int pw = wid - 4;
        unsigned short* XWb = (unsigned short*)PWS; unsigned short* XAb = XWb + 256; float* KK = PWS + 256; float* UA = PWS + 512;
        typedef short bf16x8_t __attribute__((ext_vector_type(8)));
        bf16x8_t Bf[2][4][2];
        { const int kg = lane >> 4, cl = 64 * h + (lane & 15);
          _Pragma("unroll") for (int m = 0; m < 2; ++m) _Pragma("unroll") for (int ct = 0; ct < 4; ++ct) _Pragma("unroll") for (int ks = 0; ks < 2; ++ks) {
              const float* Wm = (m == 0 ? w_up : a_up) + (size_t)(32 * ks + 8 * kg) * 256 + cl + 16 * ct; u32x4_t pq;
              pq.x = pk2(Wm[0], Wm[256]); pq.y = pk2(Wm[512], Wm[768]); pq.z = pk2(Wm[1024], Wm[1280]); pq.w = pk2(Wm[1536], Wm[1792]); Bf[m][ct][ks] = __builtin_bit_cast(bf16x8_t, pq); } }
        const float w0 = p.in[20][(l * 2 + d) * 256 + 64 * h + lane], a0 = p.in[22][(l * 2 + d) * 256 + 64 * h + lane];
        const float k_k = p.in[24][l * 256 + 64 * h + lane], k_a = p.in[25][l * 256 + 64 * h + lane];
        int it_t[3], it_zc[3], it_g[3], it_w[3]; f32x4_t mu0[3], mu1[3];
#pragma unroll
        for (int i = 0; i < 3; ++i) { int e = lane + 64 * i; if (e > 159) e = 159; const int t = e / 40, c = e % 40, g = c >> 3, wi = (c & 7) * 8;
            it_t[i] = t; it_g[i] = g; it_w[i] = wi; it_zc[i] = (g == 0 ? 64 * h : g == 1 ? 256 + 64 * h : g == 2 ? 512 + 64 * h : 768 + (g - 3) * 64) + wi;
            mu0[i] = *(const f32x4_t*)(mu + it_zc[i]); mu1[i] = *(const f32x4_t*)(mu + it_zc[i] + 4); }
        u32x4_t rc[3], rp[3], rn[3];
#define RW_ISSUE(b_) do { _Pragma("unroll") for (int i = 0; i < 3; ++i) { const int si = s0 + (b_) * TB + 4 * pw + it_t[i]; const int tt = d == 0 ? si : S - 1 - si; const bf16* zp = Z + (size_t)(start + tt) * ZP + 768 + it_zc[i]; \
                rc[i] = *(const u32x4_t*)zp; rp[i] = tt > 0 ? *(const u32x4_t*)(zp - ZP) : (u32x4_t){0u, 0u, 0u, 0u}; rn[i] = tt < S - 1 ? *(const u32x4_t*)(zp + ZP) : (u32x4_t){0u, 0u, 0u, 0u}; } } while (0)
#define RW_PREP(b_) do { \
            float* ops = OPS + ((b_) & 1) * (TB * 384); \
            _Pragma("unroll") for (int i = 0; i < 3; ++i) if (lane + 64 * i < 160) { \
                float fs[8]; \
                _Pragma("unroll") for (int q = 0; q < 4; ++q) { \
                    const float c0 = __builtin_bit_cast(float, rc[i][q] << 16), c1 = __builtin_bit_cast(float, rc[i][q] & 0xffff0000u); \
                    const float p0 = __builtin_bit_cast(float, rp[i][q] << 16), p1 = __builtin_bit_cast(float, rp[i][q] & 0xffff0000u); \
                    const float n0 = __builtin_bit_cast(float, rn[i][q] << 16), n1 = __builtin_bit_cast(float, rn[i][q] & 0xffff0000u); \
                    const float m0 = q < 2 ? mu0[i][2 * q] : mu1[i][2 * q - 4], m1 = q < 2 ? mu0[i][2 * q + 1] : mu1[i][2 * q - 3]; \
                    fs[2 * q] = c0 + m0 * (0.5f * (p0 + n0) - c0); fs[2 * q + 1] = c1 + m1 * (0.5f * (p1 + n1) - c1); \
                } \
                const int t = it_t[i], tl = 4 * pw + t, g = it_g[i], wi = it_w[i]; \
                if (g == 0) { *(f32x4_t*)(ops + tl * 384 + 256 + wi) = (f32x4_t){fs[0], fs[1], fs[2], fs[3]}; *(f32x4_t*)(ops + tl * 384 + 256 + wi + 4) = (f32x4_t){fs[4], fs[5], fs[6], fs[7]}; } \
                else if (g == 2) { if (mode == 3) { _Pragma("unroll") for (int q = 0; q < 8; ++q) fs[q] = 0.f; } *(f32x4_t*)(ops + tl * 384 + 320 + wi) = (f32x4_t){fs[0], fs[1], fs[2], fs[3]}; *(f32x4_t*)(ops + tl * 384 + 320 + wi + 4) = (f32x4_t){fs[4], fs[5], fs[6], fs[7]}; } \
                else if (g == 1) { *(f32x4_t*)(KK + t * 64 + wi) = (f32x4_t){fs[0], fs[1], fs[2], fs[3]}; *(f32x4_t*)(KK + t * 64 + wi + 4) = (f32x4_t){fs[4], fs[5], fs[6], fs[7]}; } \
                else if (g == 3) { u32x4_t pq; pq.x = pk2(tanh_fast(fs[0]), tanh_fast(fs[1])); pq.y = pk2(tanh_fast(fs[2]), tanh_fast(fs[3])); pq.z = pk2(tanh_fast(fs[4]), tanh_fast(fs[5])); pq.w = pk2(tanh_fast(fs[6]), tanh_fast(fs[7])); *(u32x4_t*)(XWb + t * 64 + wi) = pq; } \
                else { u32x4_t pq; pq.x = pk2(fs[0], fs[1]); pq.y = pk2(fs[2], fs[3]); pq.z = pk2(fs[4], fs[5]); pq.w = pk2(fs[6], fs[7]); *(u32x4_t*)(XAb + t * 64 + wi) = pq; } \
            } \
            if ((b_) + 1 < NB) RW_ISSUE((b_) + 1); \
            { const int arow = lane & 15, akg = lane >> 4; \
              _Pragma("unroll") for (int m = 0; m < 2; ++m) { \
                bf16x8_t Af[2]; \
                _Pragma("unroll") for (int ks = 0; ks < 2; ++ks) { u32x4_t raw = *(const u32x4_t*)((m ? XAb : XWb) + (arow & 3) * 64 + 32 * ks + 8 * akg); if (arow >= 4) raw = (u32x4_t){0u, 0u, 0u, 0u}; Af[ks] = __builtin_bit_cast(bf16x8_t, raw); } \
                _Pragma("unroll") for (int ct = 0; ct < 4; ++ct) { f32x4_t am = (f32x4_t){0.f, 0.f, 0.f, 0.f}; \
                    am = __builtin_amdgcn_mfma_f32_16x16x32_bf16(Af[0], Bf[m][ct][0], am, 0, 0, 0); am = __builtin_amdgcn_mfma_f32_16x16x32_bf16(Af[1], Bf[m][ct][1], am, 0, 0, 0); \
                    if (lane < 16) { UA[(m * 4 + 0) * 64 + 16 * ct + lane] = am[0]; UA[(m * 4 + 1) * 64 + 16 * ct + lane] = am[1]; UA[(m * 4 + 2) * 64 + 16 * ct + lane] = am[2]; UA[(m * 4 + 3) * 64 + 16 * ct + lane] = am[3]; } } } } \
            float cw = 1.0f; \
            _Pragma("unroll") for (int t = 0; t < 4; ++t) { \
                const int tl = 4 * pw + t; const float k = KK[t * 64 + lane]; const float kkv = k * k_k; \
                const float n2 = wave_sum(kkv * kkv); const float kk = kkv * __builtin_amdgcn_rsqf(fmaxf(n2, 1e-24f)); \
                const float wdec = __expf(-0.6065306597126334f * sigmoidf_(w0 + UA[t * 64 + lane])); const float a = sigmoidf_(a0 + UA[(4 + t) * 64 + lane]); \
                float* o = ops + tl * 384 + lane; const float cwp = cw; cw *= wdec; const float icw = __builtin_amdgcn_rcpf(cw); const float rq = o[256]; \
                o[0] = -kk * cwp; o[64] = cw; o[128] = kk * a * icw; o[192] = k * (1.0f + (a - 1.0f) * k_a) * icw; o[256] = rq * cw; \
            } } while (0)
#define RW_YFLUSH(b_) do { const float* ybp = YBUF + ((b_) & 1) * (TB * 64); \
            _Pragma("unroll") for (int t = 0; t < 4; ++t) { const int si = s0 + (b_) * TB + 4 * pw + t; const int tt = d == 0 ? si : S - 1 - si; float* yp_ = Y + (size_t)(start + tt) * 256 + 64 * h; const float yv_ = ybp[(4 * pw + t) * 64 + lane]; \
                if (mode < 2) yp_[lane] = yv_; else ((unsigned short*)yp_)[(mode == 3 ? 64 : 0) + lane] = (unsigned short)f2bf(yv_); } } while (0)
        RW_ISSUE(0); RW_PREP(0);
        LDS_BARRIER();
        for (int b = 0; b < NB; ++b) {
            if (b > 0) RW_YFLUSH(b - 1);
            if (b + 1 < NB) RW_PREP(b + 1);
            LDS_BARRIER();
        }
        RW_YFLUSH(NB - 1);
#undef RW_ISSUE
#undef RW_PREP
#undef RW_YFLUSH
    } else {
        __builtin_amdgcn_s_setprio(3);
        float st[16];
#pragma unroll
        for (int i = 0; i < 16; ++i) st[i] = (mode == 3 && 16 * (lane >> 4) + i == 16 * wid + (lane & 15)) ? 1.0f : 0.f;
        const int vofs = 320 + 16 * wid + (lane & 15);
        LDS_BARRIER();
        for (int b = 0; b < NB; ++b) {
            const float* ops = OPS + (b & 1) * (TB * 384); float* yb = YBUF + (b & 1) * (TB * 64);
            float xn = ops[lane], xw = ops[64 + lane], xb = ops[128 + lane], xk = ops[192 + lane], xr = ops[256 + lane], vv = ops[vofs];
#pragma unroll 2
            for (int t = 0; t < TB; ++t) {
                const float* nx = ops + (t + 1 < TB ? t + 1 : t) * 384;
                const float nxn = nx[lane], nxw = nx[64 + lane], nxb = nx[128 + lane], nxk = nx[192 + lane], nxr = nx[256 + lane], nvv = nx[vofs];
                float sa0, sa1, sa2, sa3;
                asm volatile("v_mul_f32_dpp %0, %20, %4 row_newbcast:0 row_mask:0xf bank_mask:0xf\n\tv_mul_f32_dpp %1, %20, %5 row_newbcast:1 row_mask:0xf bank_mask:0xf\n\tv_mul_f32_dpp %2, %20, %6 row_newbcast:2 row_mask:0xf bank_mask:0xf\n\tv_mul_f32_dpp %3, %20, %7 row_newbcast:3 row_mask:0xf bank_mask:0xf\n\tv_fmac_f32_dpp %0, %20, %8 row_newbcast:4 row_mask:0xf bank_mask:0xf\n\tv_fmac_f32_dpp %1, %20, %9 row_newbcast:5 row_mask:0xf bank_mask:0xf\n\tv_fmac_f32_dpp %2, %20, %10 row_newbcast:6 row_mask:0xf bank_mask:0xf\n\tv_fmac_f32_dpp %3, %20, %11 row_newbcast:7 row_mask:0xf bank_mask:0xf\n\tv_fmac_f32_dpp %0, %20, %12 row_newbcast:8 row_mask:0xf bank_mask:0xf\n\tv_fmac_f32_dpp %1, %20, %13 row_newbcast:9 row_mask:0xf bank_mask:0xf\n\tv_fmac_f32_dpp %2, %20, %14 row_newbcast:10 row_mask:0xf bank_mask:0xf\n\tv_fmac_f32_dpp %3, %20, %15 row_newbcast:11 row_mask:0xf bank_mask:0xf\n\tv_fmac_f32_dpp %0, %20, %16 row_newbcast:12 row_mask:0xf bank_mask:0xf\n\tv_fmac_f32_dpp %1, %20, %17 row_newbcast:13 row_mask:0xf bank_mask:0xf\n\tv_fmac_f32_dpp %2, %20, %18 row_newbcast:14 row_mask:0xf bank_mask:0xf\n\tv_fmac_f32_dpp %3, %20, %19 row_newbcast:15 row_mask:0xf bank_mask:0xf" : "=&v"(sa0), "=&v"(sa1), "=&v"(sa2), "=&v"(sa3) : "v"(st[0]), "v"(st[1]), "v"(st[2]), "v"(st[3]), "v"(st[4]), "v"(st[5]), "v"(st[6]), "v"(st[7]), "v"(st[8]), "v"(st[9]), "v"(st[10]), "v"(st[11]), "v"(st[12]), "v"(st[13]), "v"(st[14]), "v"(st[15]), "v"(xn));
                float sa = (sa0 + sa1) + (sa2 + sa3);
                { const f32x4_t da = __builtin_amdgcn_mfma_f32_16x16x4f32(1.0f, sa, (f32x4_t){0.f, 0.f, 0.f, 0.f}, 0, 0, 0); sa = da[0]; asm volatile("s_nop 15\n\ts_nop 3" : "+v"(sa)); }
                asm volatile("v_fmac_f32_dpp %0, %16, %17 row_newbcast:0 row_mask:0xf bank_mask:0xf\n\tv_fmac_f32_dpp %1, %16, %17 row_newbcast:1 row_mask:0xf bank_mask:0xf\n\tv_fmac_f32_dpp %2, %16, %17 row_newbcast:2 row_mask:0xf bank_mask:0xf\n\tv_fmac_f32_dpp %3, %16, %17 row_newbcast:3 row_mask:0xf bank_mask:0xf\n\tv_fmac_f32_dpp %4, %16, %17 row_newbcast:4 row_mask:0xf bank_mask:0xf\n\tv_fmac_f32_dpp %5, %16, %17 row_newbcast:5 row_mask:0xf bank_mask:0xf\n\tv_fmac_f32_dpp %6, %16, %17 row_newbcast:6 row_mask:0xf bank_mask:0xf\n\tv_fmac_f32_dpp %7, %16, %17 row_newbcast:7 row_mask:0xf bank_mask:0xf\n\tv_fmac_f32_dpp %8, %16, %17 row_newbcast:8 row_mask:0xf bank_mask:0xf\n\tv_fmac_f32_dpp %9, %16, %17 row_newbcast:9 row_mask:0xf bank_mask:0xf\n\tv_fmac_f32_dpp %10, %16, %17 row_newbcast:10 row_mask:0xf bank_mask:0xf\n\tv_fmac_f32_dpp %11, %16, %17 row_newbcast:11 row_mask:0xf bank_mask:0xf\n\tv_fmac_f32_dpp %12, %16, %17 row_newbcast:12 row_mask:0xf bank_mask:0xf\n\tv_fmac_f32_dpp %13, %16, %17 row_newbcast:13 row_mask:0xf bank_mask:0xf\n\tv_fmac_f32_dpp %14, %16, %17 row_newbcast:14 row_mask:0xf bank_mask:0xf\n\tv_fmac_f32_dpp %15, %16, %17 row_newbcast:15 row_mask:0xf bank_mask:0xf" : "+v"(st[0]), "+v"(st[1]), "+v"(st[2]), "+v"(st[3]), "+v"(st[4]), "+v"(st[5]), "+v"(st[6]), "+v"(st[7]), "+v"(st[8]), "+v"(st[9]), "+v"(st[10]), "+v"(st[11]), "+v"(st[12]), "+v"(st[13]), "+v"(st[14]), "+v"(st[15]) : "v"(xb), "v"(sa));
                asm volatile("v_fmac_f32_dpp %0, %16, %17 row_newbcast:0 row_mask:0xf bank_mask:0xf\n\tv_fmac_f32_dpp %1, %16, %17 row_newbcast:1 row_mask:0xf bank_mask:0xf\n\tv_fmac_f32_dpp %2, %16, %17 row_newbcast:2 row_mask:0xf bank_mask:0xf\n\tv_fmac_f32_dpp %3, %16, %17 row_newbcast:3 row_mask:0xf bank_mask:0xf\n\tv_fmac_f32_dpp %4, %16, %17 row_newbcast:4 row_mask:0xf bank_mask:0xf\n\tv_fmac_f32_dpp %5, %16, %17 row_newbcast:5 row_mask:0xf bank_mask:0xf\n\tv_fmac_f32_dpp %6, %16, %17 row_newbcast:6 row_mask:0xf bank_mask:0xf\n\tv_fmac_f32_dpp %7, %16, %17 row_newbcast:7 row_mask:0xf bank_mask:0xf\n\tv_fmac_f32_dpp %8, %16, %17 row_newbcast:8 row_mask:0xf bank_mask:0xf\n\tv_fmac_f32_dpp %9, %16, %17 row_newbcast:9 row_mask:0xf bank_mask:0xf\n\tv_fmac_f32_dpp %10, %16, %17 row_newbcast:10 row_mask:0xf bank_mask:0xf\n\tv_fmac_f32_dpp %11, %16, %17 row_newbcast:11 row_mask:0xf bank_mask:0xf\n\tv_fmac_f32_dpp %12, %16, %17 row_newbcast:12 row_mask:0xf bank_mask:0xf\n\tv_fmac_f32_dpp %13, %16, %17 row_newbcast:13 row_mask:0xf bank_mask:0xf\n\tv_fmac_f32_dpp %14, %16, %17 row_newbcast:14 row_mask:0xf bank_mask:0xf\n\tv_fmac_f32_dpp %15, %16, %17 row_newbcast:15 row_mask:0xf bank_mask:0xf" : "+v"(st[0]), "+v"(st[1]), "+v"(st[2]), "+v"(st[3]), "+v"(st[4]), "+v"(st[5]), "+v"(st[6]), "+v"(st[7]), "+v"(st[8]), "+v"(st[9]), "+v"(st[10]), "+v"(st[11]), "+v"(st[12]), "+v"(st[13]), "+v"(st[14]), "+v"(st[15]) : "v"(xk), "v"(vv));
                float y0, y1, y2, y3;
                asm volatile("v_mul_f32_dpp %0, %20, %4 row_newbcast:0 row_mask:0xf bank_mask:0xf\n\tv_mul_f32_dpp %1, %20, %5 row_newbcast:1 row_mask:0xf bank_mask:0xf\n\tv_mul_f32_dpp %2, %20, %6 row_newbcast:2 row_mask:0xf bank_mask:0xf\n\tv_mul_f32_dpp %3, %20, %7 row_newbcast:3 row_mask:0xf bank_mask:0xf\n\tv_fmac_f32_dpp %0, %20, %8 row_newbcast:4 row_mask:0xf bank_mask:0xf\n\tv_fmac_f32_dpp %1, %20, %9 row_newbcast:5 row_mask:0xf bank_mask:0xf\n\tv_fmac_f32_dpp %2, %20, %10 row_newbcast:6 row_mask:0xf bank_mask:0xf\n\tv_fmac_f32_dpp %3, %20, %11 row_newbcast:7 row_mask:0xf bank_mask:0xf\n\tv_fmac_f32_dpp %0, %20, %12 row_newbcast:8 row_mask:0xf bank_mask:0xf\n\tv_fmac_f32_dpp %1, %20, %13 row_newbcast:9 row_mask:0xf bank_mask:0xf\n\tv_fmac_f32_dpp %2, %20, %14 row_newbcast:10 row_mask:0xf bank_mask:0xf\n\tv_fmac_f32_dpp %3, %20, %15 row_newbcast:11 row_mask:0xf bank_mask:0xf\n\tv_fmac_f32_dpp %0, %20, %16 row_newbcast:12 row_mask:0xf bank_mask:0xf\n\tv_fmac_f32_dpp %1, %20, %17 row_newbcast:13 row_mask:0xf bank_mask:0xf\n\tv_fmac_f32_dpp %2, %20, %18 row_newbcast:14 row_mask:0xf bank_mask:0xf\n\tv_fmac_f32_dpp %3, %20, %19 row_newbcast:15 row_mask:0xf bank_mask:0xf" : "=&v"(y0), "=&v"(y1), "=&v"(y2), "=&v"(y3) : "v"(st[0]), "v"(st[1]), "v"(st[2]), "v"(st[3]), "v"(st[4]), "v"(st[5]), "v"(st[6]), "v"(st[7]), "v"(st[8]), "v"(st[9]), "v"(st[10]), "v"(st[11]), "v"(st[12]), "v"(st[13]), "v"(st[14]), "v"(st[15]), "v"(xr));
                const float yp = (y0 + y1) + (y2 + y3);
                const f32x4_t dy = __builtin_amdgcn_mfma_f32_16x16x4f32(1.0f, yp, (f32x4_t){0.f, 0.f, 0.f, 0.f}, 0, 0, 0);
                if (lane < 16) yb[t * 64 + 16 * wid + lane] = dy[0];
                if ((t & 3) == 3) {
                    asm volatile("v_mul_f32_dpp %0, %16, %0 row_newbcast:0 row_mask:0xf bank_mask:0xf\n\tv_mul_f32_dpp %1, %16, %1 row_newbcast:1 row_mask:0xf bank_mask:0xf\n\tv_mul_f32_dpp %2, %16, %2 row_newbcast:2 row_mask:0xf bank_mask:0xf\n\tv_mul_f32_dpp %3, %16, %3 row_newbcast:3 row_mask:0xf bank_mask:0xf\n\tv_mul_f32_dpp %4, %16, %4 row_newbcast:4 row_mask:0xf bank_mask:0xf\n\tv_mul_f32_dpp %5, %16, %5 row_newbcast:5 row_mask:0xf bank_mask:0xf\n\tv_mul_f32_dpp %6, %16, %6 row_newbcast:6 row_mask:0xf bank_mask:0xf\n\tv_mul_f32_dpp %7, %16, %7 row_newbcast:7 row_mask:0xf bank_mask:0xf\n\tv_mul_f32_dpp %8, %16, %8 row_newbcast:8 row_mask:0xf bank_mask:0xf\n\tv_mul_f32_dpp %9, %16, %9 row_newbcast:9 row_mask:0xf bank_mask:0xf\n\tv_mul_f32_dpp %10, %16, %10 row_newbcast:10 row_mask:0xf bank_mask:0xf\n\tv_mul_f32_dpp %11, %16, %11 row_newbcast:11 row_mask:0xf bank_mask:0xf\n\tv_mul_f32_dpp %12, %16, %12 row_newbcast:12 row_mask:0xf bank_mask:0xf\n\tv_mul_f32_dpp %13, %16, %13 row_newbcast:13 row_mask:0xf bank_mask:0xf\n\tv_mul_f32_dpp %14, %16, %14 row_newbcast:14 row_mask:0xf bank_mask:0xf\n\tv_mul_f32_dpp %15, %16, %15 row_newbcast:15 row_mask:0xf bank_mask:0xf" : "+v"(st[0]), "+v"(st[1]), "+v"(st[2]), "+v"(st[3]), "+v"(st[4]), "+v"(st[5]), "+v"(st[6]), "+v"(st[7]), "+v"(st[8]), "+v"(st[9]), "+v"(st[10]), "+v"(st[11]), "+v"(st[12]), "+v"(st[13]), "+v"(st[14]), "+v"(st[15]) : "v"(xw));
                }
                xn = nxn; xw = nxw; xb = nxb; xk = nxk; xr = nxr; vv = nvv;
            }
            LDS_BARRIER();
        }
        __builtin_amdgcn_s_setprio(0);
        if (mode == 1) { float* sm = (float*)(p.ws + OFF_SMID) + (size_t)((s * 4 + h) * 2 + d) * 4096 + 16 * wid + (lane & 15);
#pragma unroll
            for (int i = 0; i < 16; ++i) sm[(16 * (lane >> 4) + i) * 64] = st[i]; }
    }
}

__device__ __forceinline__ float gelu_tanh(float x) { const float u = 0.7978845608028654f * (x + 0.044715f * x * x * x); return x * __builtin_amdgcn_rcpf(1.0f + __builtin_amdgcn_exp2f(-2.885390081777927f * u)); }
__device__ __forceinline__ float neg_expm1_fast(float t) { const float ser = -t * (1.0f + t * (0.5f + t * (0.16666667f + t * (0.041666668f + t * 0.0083333338f)))); return t > -0.25f ? ser : 1.0f - __expf(t); }

__device__ __forceinline__ void lru_unit(const KP& p, unsigned char* lds, int l, int s, int n) {
    typedef short bf16x8_t __attribute__((ext_vector_type(8)));
    typedef float f32x16_t __attribute__((ext_vector_type(16)));
    int tid_o = threadIdx.x; asm volatile("" : "+v"(tid_o)); const int tid = tid_o, lane = tid & 63; const int wid = __builtin_amdgcn_readfirstlane(tid >> 6);
    float* XC = (float*)lds;
    unsigned short* XCb = (unsigned short*)(lds + 16384);
    float* GG = (float*)(lds + 24576);
    float* HF = (float*)(lds + 57344);
    float* YG = (float*)(lds + 73728);
    float* HO = (float*)(lds + 90112);
    float* SEG = (float*)(lds + 106496);
    const bf16* Z = (const bf16*)(p.ws + OFF_Z);
    bf16* OM = (bf16*)(p.ws + OFF_OMIX);
    const int S = seq_len(s), start = seq_start(s); const int NB = S / 64;
    const int t_ = tid >> 3, c8 = (tid & 7) * 8;
    const int r32 = lane & 31, hi = lane >> 5; const int gm = wid & 1, gth = (wid >> 1) & 1, gch = wid >> 2;
    f32x4_t cw0[4], cw1[4];
#pragma unroll
    for (int j = 0; j < 4; ++j) { cw0[j] = *(const f32x4_t*)(p.in[11] + l * 4 * 384 + j * 384 + 64 * n + c8); cw1[j] = *(const f32x4_t*)(p.in[11] + l * 4 * 384 + j * 384 + 64 * n + c8 + 4); }
    const f32x4_t cb0 = *(const f32x4_t*)(p.in[12] + l * 384 + 64 * n + c8), cb1 = *(const f32x4_t*)(p.in[12] + l * 384 + 64 * n + c8 + 4);
    for (int d = 0; d < 2; ++d) {
        const float* wg = (gm == 0 ? p.in[13] : p.in[15]) + (((size_t)l * 2 + d) * 6 + n) * 4096;
        const float gbias = (gm == 0 ? p.in[14] : p.in[16])[(l * 2 + d) * 384 + 64 * n + 32 * gch + r32];
        const float lm = -p.in[17][(l * 2 + d) * 384 + 64 * n + lane]; const float sp8 = -8.0f * (lm > 20.f ? lm : log1pf(__expf(lm)));
        bf16x8_t Bf[4];
#pragma unroll
        for (int ks = 0; ks < 4; ++ks) { const float* wp = wg + (size_t)(16 * ks + 8 * hi) * 64 + 32 * gch + r32; u32x4_t pq;
            pq.x = pk2(wp[0], wp[64]); pq.y = pk2(wp[128], wp[192]); pq.z = pk2(wp[256], wp[320]); pq.w = pk2(wp[384], wp[448]); Bf[ks] = __builtin_bit_cast(bf16x8_t, pq); }
        __threadfence();
        __syncthreads();
        float hcarry = 0.f;
        u32x4_t rr[4], rh, ry;
#define LRU_ISSUE(blk_) do { const int tt = d == 0 ? (blk_) * 64 + t_ : S - 1 - ((blk_) * 64 + t_); \
            _Pragma("unroll") for (int j = 0; j < 4; ++j) { const int t2 = tt - 2 + j; rr[j] = (t2 >= 0 && t2 < S) ? *(const u32x4_t*)(Z + (size_t)(start + t2) * ZP + 64 * n + c8) : (u32x4_t){0u, 0u, 0u, 0u}; } \
            if (d == 1) { rh = *(const u32x4_t*)(OM + (size_t)(start + tt) * DM + 64 * n + c8); ry = *(const u32x4_t*)(Z + (size_t)(start + tt) * ZP + 384 + 64 * n + c8); } } while (0)
        LRU_ISSUE(0);
        for (int blk = 0; blk < NB; ++blk) {
            LDS_BARRIER();
            {
                f32x4_t x0 = cb0, x1 = cb1;
#pragma unroll
                for (int j = 0; j < 4; ++j) {
                    const f32x4_t a = (f32x4_t){__builtin_bit_cast(float, rr[j][0] << 16), __builtin_bit_cast(float, rr[j][0] & 0xffff0000u), __builtin_bit_cast(float, rr[j][1] << 16), __builtin_bit_cast(float, rr[j][1] & 0xffff0000u)};
                    const f32x4_t b = (f32x4_t){__builtin_bit_cast(float, rr[j][2] << 16), __builtin_bit_cast(float, rr[j][2] & 0xffff0000u), __builtin_bit_cast(float, rr[j][3] << 16), __builtin_bit_cast(float, rr[j][3] & 0xffff0000u)};
                    x0 += cw0[j] * a; x1 += cw1[j] * b;
                }
                *(f32x4_t*)(XC + t_ * 64 + c8) = x0; *(f32x4_t*)(XC + t_ * 64 + c8 + 4) = x1;
                { u32x4_t pq; pq.x = pk2(x0[0], x0[1]); pq.y = pk2(x0[2], x0[3]); pq.z = pk2(x1[0], x1[1]); pq.w = pk2(x1[2], x1[3]); *(u32x4_t*)(XCb + t_ * 64 + c8) = pq; }
                if (d == 1) {
                    float hf[8], yg[8];
#pragma unroll
                    for (int q = 0; q < 4; ++q) { hf[2 * q] = __builtin_bit_cast(float, rh[q] << 16); hf[2 * q + 1] = __builtin_bit_cast(float, rh[q] & 0xffff0000u);
                        yg[2 * q] = gelu_tanh(__builtin_bit_cast(float, ry[q] << 16)); yg[2 * q + 1] = gelu_tanh(__builtin_bit_cast(float, ry[q] & 0xffff0000u)); }
                    *(f32x4_t*)(HF + t_ * 64 + c8) = (f32x4_t){hf[0], hf[1], hf[2], hf[3]}; *(f32x4_t*)(HF + t_ * 64 + c8 + 4) = (f32x4_t){hf[4], hf[5], hf[6], hf[7]};
                    *(f32x4_t*)(YG + t_ * 64 + c8) = (f32x4_t){yg[0], yg[1], yg[2], yg[3]}; *(f32x4_t*)(YG + t_ * 64 + c8 + 4) = (f32x4_t){yg[4], yg[5], yg[6], yg[7]};
                }
                if (blk + 1 < NB) LRU_ISSUE(blk + 1);
            }
            LDS_BARRIER();
            {
                f32x16_t acc = {};
#pragma unroll
                for (int ks = 0; ks < 4; ++ks) { const bf16x8_t af = *(const bf16x8_t*)(XCb + (32 * gth + r32) * 64 + 16 * ks + 8 * hi); acc = __builtin_amdgcn_mfma_f32_32x32x16_bf16(af, Bf[ks], acc, 0, 0, 0); }
#pragma unroll
                for (int r = 0; r < 16; ++r) { const int trow = 32 * gth + (r & 3) + 8 * (r >> 2) + 4 * hi; GG[(gm * 64 + trow) * 64 + 32 * gch + r32] = sigmoidf_(acc[r] + gbias); }
            }
            LDS_BARRIER();
            float Pp[8], hl[8];
            {
                float pp = 1.f, hh = 0.f;
#pragma unroll
                for (int q = 0; q < 8; ++q) { const int t = 8 * wid + q; const float ra = GG[t * 64 + lane], ix = GG[(64 + t) * 64 + lane], xc = XC[t * 64 + lane];
                    const float la = sp8 * ra; const float a = __expf(la); const float uu = __builtin_amdgcn_sqrtf(fmaxf(neg_expm1_fast(2.0f * la), 0.f)) * ix * xc;
                    pp *= a; hh = a * hh + uu; Pp[q] = pp; hl[q] = hh; }
                SEG[(wid * 2) * 64 + lane] = pp; SEG[(wid * 2 + 1) * 64 + lane] = hh;
            }
            LDS_BARRIER();
            {
                float sa[8], sh[8];
#pragma unroll
                for (int w = 0; w < 8; ++w) { sa[w] = SEG[(w * 2) * 64 + lane]; sh[w] = SEG[(w * 2 + 1) * 64 + lane]; }
                float carry = hcarry, mine = 0.f;
#pragma unroll
                for (int w = 0; w < 8; ++w) { if (w == wid) mine = carry; carry = sa[w] * carry + sh[w]; }
                hcarry = carry;
#pragma unroll
                for (int q = 0; q < 8; ++q) { const int t = 8 * wid + q; const float hv = Pp[q] * mine + hl[q]; HO[t * 64 + lane] = d == 0 ? hv : (HF[t * 64 + lane] + hv) * YG[t * 64 + lane]; }
            }
            LDS_BARRIER();
            {   const int tt = d == 0 ? blk * 64 + t_ : S - 1 - (blk * 64 + t_);
                const f32x4_t a = *(const f32x4_t*)(HO + t_ * 64 + c8), b = *(const f32x4_t*)(HO + t_ * 64 + c8 + 4);
                u32x4_t w; w.x = pk2(a[0], a[1]); w.y = pk2(a[2], a[3]); w.z = pk2(b[0], b[1]); w.w = pk2(b[2], b[3]);
                *(u32x4_t*)(OM + (size_t)(start + tt) * DM + 64 * n + c8) = w; }
        }
#undef LRU_ISSUE
    }
}

typedef short pt_bf16x8_t __attribute__((ext_vector_type(8)));
typedef float pt_f32x16_t __attribute__((ext_vector_type(16)));
__device__ __forceinline__ void rwkv_post_tile(const KP& p, unsigned char* lds, int l, int tile) {
    int tid_o = threadIdx.x; asm volatile("" : "+v"(tid_o)); const int tid = tid_o, lane = tid & 63;
    unsigned short* SGb = (unsigned short*)lds;
    float* SG = (float*)lds;
    float* GO = SG + 4096;
    const bf16* Z = (const bf16*)(p.ws + OFF_Z); bf16* OM = (bf16*)(p.ws + OFF_OMIX);
    const float* YF = (const float*)(p.ws + OFF_YF); const float* YBk = (const float*)(p.ws + OFF_YB);
    const float* mu = p.in[18] + l * 1024; const float* g_up = p.in[23] + (size_t)l * 128 * 256;
    const int m0 = tile * 32; const int s = seq_of_row(m0); const int S = seq_len(s), start = seq_start(s);
    __syncthreads();
    {   const float muc = mu[896 + (tid & 127)];
#pragma unroll 1
        for (int ih = 0; ih < 2; ++ih) {
            unsigned short zc_[4], zp_[4], zn_[4];
#pragma unroll
            for (int i = 0; i < 4; ++i) { const int e = tid + NTHR * (4 * ih + i); const int t = e >> 7, c = e & 127; const int m = m0 + t, tt = m - start; const bf16* zp = Z + (size_t)m * ZP + 768 + 896 + c;
                zc_[i] = zp[0]; zp_[i] = zp[tt > 0 ? -ZP : 0]; zn_[i] = zp[tt < S - 1 ? ZP : 0]; }
            asm volatile("" ::: "memory");
#pragma unroll
            for (int i = 0; i < 4; ++i) { const int e = tid + NTHR * (4 * ih + i); const int t = e >> 7; const int tt = m0 + t - start;
                const float f = bf2f(zc_[i]); const float pv = tt > 0 ? bf2f(zp_[i]) : 0.f; const float nx = tt < S - 1 ? bf2f(zn_[i]) : 0.f;
                SGb[e] = (unsigned short)f2bf(sigmoidf_(f + muc * (0.5f * (pv + nx) - f))); }
        }
    }
    __syncthreads();
    const int c = tid & 255, tg = tid >> 8;
    {
        const int r32 = lane & 31, hi = lane >> 5, wv_ = tid >> 6;
        const float* gu = g_up + 32 * wv_ + r32;
        pt_f32x16_t acc = {};
#pragma unroll 1
        for (int kh = 0; kh < 2; ++kh) {
            float raw[4][8];
#pragma unroll
            for (int k4 = 0; k4 < 4; ++k4) { const float* gp = gu + (size_t)(16 * (4 * kh + k4) + 8 * hi) * 256;
#pragma unroll
                for (int q = 0; q < 8; ++q) raw[k4][q] = gp[q * 256]; }
            asm volatile("" ::: "memory");
#pragma unroll
            for (int k4 = 0; k4 < 4; ++k4) { const int ks = 4 * kh + k4; u32x4_t pq; pq.x = pk2(raw[k4][0], raw[k4][1]); pq.y = pk2(raw[k4][2], raw[k4][3]); pq.z = pk2(raw[k4][4], raw[k4][5]); pq.w = pk2(raw[k4][6], raw[k4][7]);
                const pt_bf16x8_t af = *(const pt_bf16x8_t*)(SGb + r32 * 128 + 16 * ks + 8 * hi); acc = __builtin_amdgcn_mfma_f32_32x32x16_bf16(af, __builtin_bit_cast(pt_bf16x8_t, pq), acc, 0, 0, 0); }
        }
#pragma unroll
        for (int r = 0; r < 16; ++r) GO[((r & 3) + 8 * (r >> 2) + 4 * hi) * 256 + 32 * wv_ + r32] = acc[r];
    }
    __syncthreads();
    const int dc = (s < 4) ? ((m0 - start) >= S / 2 ? 0 : 1) : -1;
    if (dc >= 0) {
        float* SM = (float*)(lds + 49152); unsigned short* YPs = (unsigned short*)(lds + 114688);
        const float* Ydc = dc == 0 ? YF : YBk; float* Yw = (float*)(p.ws + (dc == 0 ? OFF_YF : OFF_YB));
        for (int e = tid; e < 4096; e += NTHR) { const int hh = e >> 10, r4 = (e & 1023) * 4; *(f32x4_t*)(SM + hh * 4096 + r4) = *(const f32x4_t*)((const float*)(p.ws + OFF_SMID) + (size_t)((s * 4 + hh) * 2 + dc) * 4096 + r4); }
        for (int e = tid; e < 1024; e += NTHR) { const int t = e >> 5, hh = (e >> 3) & 3, ch = e & 7; *(u32x4_t*)(YPs + t * 256 + hh * 64 + ch * 8) = *(const u32x4_t*)((const unsigned short*)(Ydc + (size_t)(m0 + t) * 256 + 64 * hh) + 64 + ch * 8); }
        __syncthreads();
        const int hh = c >> 6, v = c & 63; const float* smp = SM + hh * 4096 + v;
#pragma unroll 1
        for (int t = 0; t < 16; ++t) {
            const int tk = tg * 16 + t; const size_t mrow = (size_t)(m0 + tk) * 256;
            float accv = bf2f(((const unsigned short*)(Ydc + mrow + 64 * hh))[v]);
#pragma unroll
            for (int i0 = 0; i0 < 64; i0 += 8) { const u32x4_t w = *(const u32x4_t*)(YPs + tk * 256 + hh * 64 + i0);
                accv += smp[(i0 + 0) * 64] * __builtin_bit_cast(float, w[0] << 16) + smp[(i0 + 1) * 64] * __builtin_bit_cast(float, w[0] & 0xffff0000u) + smp[(i0 + 2) * 64] * __builtin_bit_cast(float, w[1] << 16) + smp[(i0 + 3) * 64] * __builtin_bit_cast(float, w[1] & 0xffff0000u)
                      + smp[(i0 + 4) * 64] * __builtin_bit_cast(float, w[2] << 16) + smp[(i0 + 5) * 64] * __builtin_bit_cast(float, w[2] & 0xffff0000u) + smp[(i0 + 6) * 64] * __builtin_bit_cast(float, w[3] << 16) + smp[(i0 + 7) * 64] * __builtin_bit_cast(float, w[3] & 0xffff0000u); }
            Yw[mrow + c] = accv;
        }
        __threadfence();
        __syncthreads();
    }
    const float rk = p.in[26][l * 256 + c], lg = p.in[27][l * 256 + c], lb = p.in[28][l * 256 + c];
    const float mr = mu[c], mk = mu[256 + c], mv = mu[512 + c];
    unsigned short zc_[9]; float yc_[2];
#define PT_LOAD(T_, ZD, YD) do { const int m_ = m0 + tg * 16 + (T_), tt_ = m_ - start; const bf16* zp_ = Z + (size_t)m_ * ZP + 768 + c; const bf16* zpp_ = zp_ + (tt_ > 0 ? -ZP : 0); const bf16* zpn_ = zp_ + (tt_ < S - 1 ? ZP : 0); \
        _Pragma("unroll") for (int j = 0; j < 3; ++j) { ZD[3 * j] = zp_[256 * j]; ZD[3 * j + 1] = zpp_[256 * j]; ZD[3 * j + 2] = zpn_[256 * j]; } \
        YD[0] = YF[(size_t)m_ * 256 + c]; YD[1] = YBk[(size_t)m_ * 256 + c]; } while (0)
    PT_LOAD(0, zc_, yc_);
#pragma unroll 1
    for (int t = 0; t < 16; ++t) {
        unsigned short zn_[9]; float yn_[2];
        PT_LOAD((t < 15 ? t + 1 : 15), zn_, yn_);
        asm volatile("" ::: "memory");
        const int m = m0 + tg * 16 + t, tt = m - start;
        const bool hp = tt > 0, hn = tt < S - 1;
        float f = bf2f(zc_[0]), pv = hp ? bf2f(zc_[1]) : 0.f, nx = hn ? bf2f(zc_[2]) : 0.f; const float r = f + mr * (0.5f * (pv + nx) - f);
        f = bf2f(zc_[3]); pv = hp ? bf2f(zc_[4]) : 0.f; nx = hn ? bf2f(zc_[5]) : 0.f; const float k = f + mk * (0.5f * (pv + nx) - f);
        f = bf2f(zc_[6]); pv = hp ? bf2f(zc_[7]) : 0.f; nx = hn ? bf2f(zc_[8]) : 0.f; const float v = f + mv * (0.5f * (pv + nx) - f);
        const float y = yc_[0] + yc_[1];
#pragma unroll
        for (int j = 0; j < 9; ++j) zc_[j] = zn_[j];
        yc_[0] = yn_[0]; yc_[1] = yn_[1];
        const float mean = wave_sum(y) * (1.0f / 64.0f); const float dv = y - mean; const float var = wave_sum(dv * dv) * (1.0f / 64.0f);
        const float yn = dv * rsqrtf(var + 64e-5f) * lg + lb;
        const float bon = wave_sum(r * k * rk);
        const float outv = (yn + bon * v) * GO[(tg * 16 + t) * 256 + c];
        OM[(size_t)m * DM + 384 + c] = (bf16)f2bf(outv);
    }
#undef PT_LOAD
    (void)lane;
}

#define RLX_AGENT __ATOMIC_RELAXED, __HIP_MEMORY_SCOPE_AGENT
#define XB_TMO      128
#define XB_XCNT(j)  (256  + 64 * (j))
#define XB_XSUB(j)  (1280 + 64 * (j))
#define XB_XGEN(j)  (2304 + 64 * (j))
#define XB_TOP      3328
#define XB_TOPGEN   3392
#define XCD_BAR_WORDS 3456
#define XB_SPIN_CAP (1u << 18)

__device__ __forceinline__ unsigned xb_ld(unsigned* p)              { return __hip_atomic_load(p, __ATOMIC_RELAXED, __HIP_MEMORY_SCOPE_AGENT); }
__device__ __forceinline__ unsigned xb_add(unsigned* p, unsigned v) { return __hip_atomic_fetch_add(p, v, __ATOMIC_RELAXED, __HIP_MEMORY_SCOPE_AGENT); }
__device__ __forceinline__ unsigned xb_xcc_id() { return (unsigned)__builtin_amdgcn_s_getreg((3 << 11) | 20) & 0xFu; }
#define XB_SPIN(cond, bar) do { unsigned _sp = 0; while (cond) { __builtin_amdgcn_s_sleep(1); \
    if ((++_sp & 255u) == 0u) { if (xb_ld(&(bar)[XB_TMO])) break; if (_sp > XB_SPIN_CAP) { atomicAdd(&(bar)[XB_TMO], 1u); break; } } } } while (0)

struct XcdBarrier {
    unsigned* bar; unsigned x;
    volatile LAS unsigned* st;
};

__device__ __forceinline__ XcdBarrier xcd_barrier_post(unsigned* bar, volatile LAS unsigned* st) {
    XcdBarrier b; b.bar = bar; b.x = xb_xcc_id(); b.st = st;
    if (threadIdx.x == 0) (void)xb_add(&bar[XB_XCNT(b.x)], 1u);
    return b;
}
__device__ __forceinline__ void xcd_barrier_complete(unsigned* bar, unsigned x, unsigned& nloc, unsigned& nx) {
    const unsigned G = gridDim.x * gridDim.y * gridDim.z;
    unsigned sum, cnt, mine, sp = 0u;
    for (;;) {
        sum = 0u; cnt = 0u; mine = 0u;
#pragma unroll
        for (unsigned j = 0; j < 16; ++j) { const unsigned c = xb_ld(&bar[XB_XCNT(j)]); sum += c; cnt += (c > 0u) ? 1u : 0u; mine = (j == x) ? c : mine; }
        if (sum == G) break;
        __builtin_amdgcn_s_sleep(1);
        if ((++sp & 255u) == 0u) { if (xb_ld(&bar[XB_TMO])) break; if (sp > XB_SPIN_CAP) { atomicAdd(&bar[XB_TMO], 1u); break; } }
    }
    nloc = mine > 0u ? mine : 1u; nx = cnt > 0u ? cnt : 1u;
}

__device__ __forceinline__ void xcd_barrier(const XcdBarrier& b) {
    asm volatile("s_waitcnt vmcnt(0)" ::: "memory");
    __syncthreads();
    if (threadIdx.x == 0) {
        unsigned bx_ = xb_xcc_id(); asm volatile("" : "+s"(bx_));
        unsigned* bar = b.bar; asm volatile("" : "+s"(bar));
        __builtin_amdgcn_s_waitcnt(0);
        unsigned nloc = b.st[0], nx = b.st[1];
        if (nloc == 0u) { xcd_barrier_complete(bar, bx_, nloc, nx); b.st[0] = nloc; b.st[1] = nx; }
        const unsigned old = xb_add(&bar[XB_XSUB(bx_)], 1u);
        const unsigned gen = old / nloc;
        if (old + 1u == (gen + 1u) * nloc) {
            __builtin_amdgcn_fence(__ATOMIC_RELEASE, "agent");
            asm volatile("s_waitcnt vmcnt(0)" ::: "memory");
            const unsigned og = xb_add(&bar[XB_TOP], 1u);
            const unsigned tg = og / nx;
            if (og + 1u == (tg + 1u) * nx) xb_add(&bar[XB_TOPGEN], 1u);
            else XB_SPIN(xb_ld(&bar[XB_TOPGEN]) == tg, bar);
            __builtin_amdgcn_fence(__ATOMIC_ACQUIRE, "agent");
            xb_add(&bar[XB_XGEN(bx_)], 1u);
            asm volatile("s_waitcnt vmcnt(0)" ::: "memory");
        } else {
            XB_SPIN(xb_ld(&bar[XB_XGEN(bx_)]) == gen, bar);
            __builtin_amdgcn_fence(__ATOMIC_ACQUIRE, "agent");
            asm volatile("s_waitcnt vmcnt(0)" ::: "memory");
        }
    }
    __syncthreads();
}

__global__ void __launch_bounds__(NTHR, 2) fwd_megakernel(KP p) {
    extern __shared__ __attribute__((aligned(16))) unsigned char lds[];
    cg::grid_group grid = cg::this_grid();
    const int tid = threadIdx.x, lane = tid & 63, wid = tid >> 6;
    const int G = gridDim.x, bx = blockIdx.x;
    const int gw = bx * 8 + wid, NGW = G * 8;
    unsigned char* ws = p.ws;
    volatile LAS int* misc = (volatile LAS int*)((LAS unsigned char*)lds + MISC_OFF);
    PG8_LAS unsigned char* ldsg = (PG8_LAS unsigned char*)lds;
    if (tid < 32) ((volatile LAS unsigned*)((LAS unsigned char*)lds + MISC_OFF))[tid] = 0u;
    __syncthreads();
    const XcdBarrier xbar = xcd_barrier_post((unsigned*)(p.ws + 16384), (volatile LAS unsigned*)((LAS unsigned char*)lds + MISC_OFF + 32));

    {
        float* scr = (float*)(lds + wid * 16384);
        for (int l = 0; l < 2; ++l) {
            unsigned char* wl = ws + OFF_W + l * W_LAYER;
            constexpr int I_IN = 16 * 176, I_OUT = 44 * 32, I_MI = 16 * 76, I_MO = 16 * 32, I_TOT = 2 * I_IN + 2 * I_OUT + I_MI + I_MO;
            for (int it = gw; it < I_TOT; it += NGW) {
                int r = it;
                if (r < 2 * I_IN) { const int f = r / I_IN; transpose_item<1>(p.in[7] + ((size_t)l * 2 + f) * DM * NFF, DM, NFF, (bf16*)(wl + WO_IN + f * 11 * MiB), scr, r % I_IN, lane); continue; } r -= 2 * I_IN;
                if (r < 2 * I_OUT) { const int f = r / I_OUT; transpose_item<0>(p.in[8] + ((size_t)l * 2 + f) * DFF * DM, DFF, DM, (bf16*)(wl + WO_OUT + f * (11 * MiB / 2)), scr, r % I_OUT, lane); continue; } r -= 2 * I_OUT;
                if (r < I_MI) { transpose_item<2>(p.in[9] + (size_t)l * DM * NMIX, DM, NMIX, (bf16*)(wl + WO_MI), scr, r, lane); continue; } r -= I_MI;
                transpose_item<0>(p.in[10] + (size_t)l * DM * DM, DM, DM, (bf16*)(wl + WO_MO), scr, r, lane);
            }
            u32x4_t* padp = (u32x4_t*)(wl + WO_MI + (size_t)NMIX * DM * 2);
            for (int e = bx * NTHR + tid; e < 128 * DM * 2 / 16; e += G * NTHR) padp[e] = (u32x4_t){0u, 0u, 0u, 0u};
        }
        __syncthreads();
        for (int u = bx; u < 2 * 36 * 8; u += G) { const int l = u / 288, r = u % 288;
            smallm_unit<0, 0>(p, (float*)lds, l, 0, p.in[4] + (size_t)l * DM * 9216, 9216, 9216, (float*)(ws + OFF_MOD) + (size_t)l * NSEQ * 9216, 9216, r / 8, r % 8); }
        if (bx == 0) { float* rope = (float*)(ws + OFF_ROPE);
            for (int e = tid; e < 1024; e += NTHR) { const int pos = e >> 4, pp = e & 15; const float inv = exp2f(-(float)pp * (13.287712379549449f / 16.0f)); const float a = (float)pos * inv; const float kr = rintf(a * 0.15915494309189535f); float rr = fmaf(-kr, 6.2831854820251465f, a); rr = fmaf(-kr, -1.7484555e-7f, rr); rope[2 * e] = __cosf(rr); rope[2 * e + 1] = __sinf(rr); } }
    }
    grid.sync();
    {
        const float* MOD = (const float*)(ws + OFF_MOD); float* GV = (float*)(ws + OFF_GV); float* GT = (float*)(ws + OFF_GATE);
        for (int e = bx * NTHR + tid; e < 6 * NSEQ * DM; e += G * NTHR) {
            const int c = e & 1023, s = (e >> 10) % NSEQ, inst = e / (NSEQ * DM); const int l = inst / 3, j = inst % 3;
            const float* mr = MOD + ((size_t)l * NSEQ + s) * 9216; const float* ba = p.in[5] + l * 9216;
            const float sc = mr[(3 * j + 1) * 1024 + c] + ba[(3 * j + 1) * 1024 + c], gg = mr[(3 * j + 2) * 1024 + c] + ba[(3 * j + 2) * 1024 + c];
            GV[e] = p.in[6][(l * 3 + j) * DM + c] * (1.0f + sc); GT[e] = (j == 1 ? 1.0f : 0.5f) * gg;
        }
        for (int u = bx; u < 2 * 432; u += G) { const int l = u / 432, r = u % 432; float* bdst = (float*)(ws + OFF_BIAS);
            if (r < 176) smallm_unit<1, 1>(p, (float*)lds, l, 0, p.in[7] + ((size_t)l * 2 + 0) * DM * NFF, NFF, NFF, bdst + (size_t)(l * 3 + 0) * NSEQ * NFF, NFF, r / 8, r % 8);
            else if (r < 256) smallm_unit<1, 2>(p, (float*)lds, l, 1, p.in[9] + (size_t)l * DM * NMIX, NMIX, NMIX, bdst + (size_t)(l * 3 + 1) * NSEQ * NFF, NFF, (r - 176) / 8, (r - 176) % 8);
            else smallm_unit<1, 1>(p, (float*)lds, l, 2, p.in[7] + ((size_t)l * 2 + 1) * DM * NFF, NFF, NFF, bdst + (size_t)(l * 3 + 2) * NSEQ * NFF, NFF, (r - 256) / 8, (r - 256) % 8); }
        bf16* XN = (bf16*)(ws + OFF_XN); float* SS0 = (float*)(ws + OFF_SS);
        for (int m = gw; m < MTOK; m += NGW) {
            const int s = seq_of_row(m); const float* xr = m < 16384 ? p.in[0] + (size_t)m * DM : p.in[1] + (size_t)(m - 16384) * DM;
            const float* mr = MOD + (size_t)s * 9216 + 1024; const float* ba = p.in[5] + 1024; const float* ng = p.in[6];
            float q = 0.f;
#pragma unroll
            for (int j = 0; j < 4; ++j) { const int c = 4 * lane + 256 * j; const f32x4_t v = *(const f32x4_t*)(xr + c); const f32x4_t sc = *(const f32x4_t*)(mr + c) + *(const f32x4_t*)(ba + c); const f32x4_t g = *(const f32x4_t*)(ng + c) * (sc + 1.0f);
                q += (v[0] * v[0] + v[1] * v[1]) + (v[2] * v[2] + v[3] * v[3]); const f32x4_t o = v * g;
                *(unsigned long long*)(XN + (size_t)m * DM + c) = (unsigned long long)pk2(o[0], o[1]) | ((unsigned long long)pk2(o[2], o[3]) << 32); }
            q = wave_sum(q); if (lane == 0) SS0[m] = q;
        }
    }
    xcd_barrier(xbar);

    for (int ph = 0; ph < 16; ++ph) {
        const int l = ph >> 3, r = ph & 7; const int f = r >= 6 ? 1 : 0;
        unsigned char* wl = ws + OFF_W + l * W_LAYER;
        const float* GV = (const float*)(ws + OFF_GV); const float* GT = (const float*)(ws + OFF_GATE); const float* BI = (const float*)(ws + OFF_BIAS); float* SS = (float*)(ws + OFF_SS);
        bf16* XN = (bf16*)(ws + OFF_XN); bf16* HID = (bf16*)(ws + OFF_HID); bf16* OMIX = (bf16*)(ws + OFF_OMIX);
        const int j = f == 0 ? 0 : 2; const int inst = l * 3 + j;
        if (r == 2) {
                {
                    pg8::Gemm g{XN, (const pg8::bf16_t*)(wl + WO_MI), MTOK, NMIXP, DM}; pg8::StaticOrder S; S.init(MTOK, NMIXP, G, bx);
                    pg8::EpiZ E{(bf16*)(ws + OFF_Z), (bf16*)(ws + OFF_QK), (bf16*)(ws + OFF_VR), SS + (size_t)(l * 3 + 1) * MTOK, BI + (size_t)(l * 3 + 1) * NSEQ * NFF, p.in[29] + l * 64, p.in[30] + l * 64, (const float*)(ws + OFF_ROPE)};
                    pg8::gemm_phase<pg8::EpiZ, pg8::StaticOrder, true, true>(ldsg, g, S, E);
                }
        } else if (r == 3) {
                {
                    unsigned* ctr = (unsigned*)(ws + OFF_CTR) + 64 * l;
                    constexpr int NU_R = 224, NU_L = 120, NU_A = 1152, NU = NU_R + NU_L + NU_A;
                    for (;;) {
                        __syncthreads(); if (tid == 0) misc[0] = (int)atomicAdd(ctr, 1u); __syncthreads();
                        const int u = misc[0]; if (u >= NU) break;
                        if (u < 224) { int s_, h_, d_, md_;
                            if (u < 96) { const int c = u & 31; md_ = 1 + (u >> 5); s_ = c >> 3; h_ = (c >> 1) & 3; d_ = c & 1; } else { const int i2 = u - 96; md_ = 0; s_ = 4 + (i2 >> 3); h_ = (i2 >> 1) & 3; d_ = i2 & 1; }
                            rwkv_unit(p, lds, l, s_, h_, d_, md_); }
                        else if (u < 248) { const int i3 = u - 224; lru_unit(p, lds, l, i3 / 6, i3 % 6); }
                        else if (u < 344) { const int i4 = u - 248; lru_unit(p, lds, l, 4 + i4 / 6, i4 % 6); }
                        else { const int i5 = u - 344; int s_, hq, qb;
                            if (i5 < 384) { s_ = i5 / 96; const int r = i5 % 96; hq = (r / 48) * 3 + (r % 48) / 16; qb = r & 15; }
                            else { const int i6 = i5 - 384; s_ = 4 + i6 / 48; const int r = i6 % 48; hq = (r / 24) * 3 + (r % 24) / 8; qb = r & 7; }
                            const int g_ = hq / 3;
                            attn_body::attn_unit<8>(seq_start(s_), seq_len(s_), qb, 64 * hq, 384 + 64 * g_, 64 * g_, 640 + 64 * hq, (const attn_body::bf16*)(ws + OFF_QK), (const attn_body::bf16*)(ws + OFF_QK), (const attn_body::bf16*)(ws + OFF_VR), (attn_body::bf16*)(ws + OFF_OMIX), (char*)lds); }
                    }
                }
        } else if (r == 4) {
                for (int t = bx; t < MTOK / 32; t += G) rwkv_post_tile(p, lds, l, t);
        } else if (r == 5) {
                {
                    pg8::Gemm g{OMIX, (const pg8::bf16_t*)(wl + WO_MO), MTOK, DM, DM}; pg8::StaticOrder S; S.init(MTOK, DM, G, bx);
                    pg8::EpiResid E{p.out, p.out + (size_t)16384 * DM, p.out, XN, SS + (size_t)(l * 3 + 2) * MTOK, GT + (size_t)(l * 3 + 1) * NSEQ * DM, GV + (size_t)(l * 3 + 2) * NSEQ * DM};
                    pg8::gemm_phase<pg8::EpiResid, pg8::StaticOrder, true, true>(ldsg, g, S, E);
                }
        } else if (r == 0 || r == 6) {
            {
                pg8::Gemm g{XN, (const pg8::bf16_t*)(wl + WO_IN + f * 11 * MiB), MTOK, NFF, DM}; pg8::StaticOrder S; S.init(MTOK, NFF, G, bx);
                pg8::EpiSwiglu E{HID, SS + (size_t)inst * MTOK, BI + (size_t)inst * NSEQ * NFF};
                pg8::gemm_phase<pg8::EpiSwiglu, pg8::StaticOrder, true, true>(ldsg, g, S, E);
            }
        } else {
            {
                const bool first = (l == 0 && f == 0), last = (l == 1 && f == 1);
                const int ninst = inst + 1;
                pg8::Gemm g{HID, (const pg8::bf16_t*)(wl + WO_OUT + f * (11 * MiB / 2)), MTOK, DM, DFF}; pg8::StaticOrder S; S.init(MTOK, DM, G, bx);
                pg8::EpiResid E{first ? p.in[0] : p.out, first ? p.in[1] : p.out + (size_t)16384 * DM, p.out, XN, last ? nullptr : SS + (size_t)ninst * MTOK, GT + (size_t)inst * NSEQ * DM, last ? nullptr : GV + (size_t)ninst * NSEQ * DM};
                pg8::gemm_phase<pg8::EpiResid, pg8::StaticOrder, true, true>(ldsg, g, S, E);
            }
        }
        if (ph != 15) xcd_barrier(xbar);
    }
}

extern "C" void kernel_launch(void* const* d_in, const int* in_sizes, int n_in, void* d_out, int out_size, void* d_ws, size_t ws_size, hipStream_t stream) {
    static int grid = 0;
    if (grid == 0) {
        if (n_in != 31 || ws_size < WS_END + 1 * MiB) { fprintf(stderr, "kernel_launch: unexpected n_in %d / ws %zu\n", n_in, ws_size); grid = -1; return; }
        int dev = 0, cus = 0, per_cu = 0;
        hipGetDevice(&dev); hipDeviceGetAttribute(&cus, hipDeviceAttributeMultiprocessorCount, dev);
        hipFuncSetAttribute((const void*)fwd_megakernel, hipFuncAttributeMaxDynamicSharedMemorySize, LDS_BYTES);
        hipOccupancyMaxActiveBlocksPerMultiprocessor(&per_cu, (const void*)fwd_megakernel, NTHR, LDS_BYTES);
        if (per_cu < 1) per_cu = 1;
        grid = cus * per_cu;
        (void)hipGetLastError();
    }
    if (grid < 0) return;
    hipMemsetAsync(d_ws, 0, ZERO_BYTES, stream);
    KP p{};
    for (int i = 0; i < 31; ++i) p.in[i] = (const float*)d_in[i];
    p.out = (float*)d_out; p.ws = (unsigned char*)d_ws;
    void* args[] = {&p};
    hipError_t e = hipLaunchCooperativeKernel((const void*)fwd_megakernel, dim3(grid), dim3(NTHR), args, LDS_BYTES, stream);
    if (e != hipSuccess) fprintf(stderr, "cooperative launch failed: %s (grid %d)\n", hipGetErrorString(e), grid);
}
```
